# Optimizing an MI355X kernel written in HIP

```python
import jax, jax.numpy as jnp
from jax import lax
import numpy as np

D_MODEL = 1024
BATCH = 32
SEQ = 2048
DEPTH = 1

CHUNK = 64
N_MEM = 256

A_HEADS = 8
A_HEAD_DIM = 64
A_WIDTH = A_HEADS * A_HEAD_DIM
DECAY_LORA = 64
AAA_LORA = 64
GATE_LORA = 128
LNX_EPS = 64e-5

B_BLOCKS = 8
B_WIDTH = 512
B_BLOCK_DIM = B_WIDTH // B_BLOCKS
B_CONV = 4
LRU_C = 8.0

X_HEADS = 4
X_HEAD_DIM = D_MODEL // X_HEADS

D_FF = 2816
FFN_CONV = 3

NORM_EPS = 1e-6

RWKV_COLS = 3 * A_WIDTH + DECAY_LORA + AAA_LORA + GATE_LORA
P_IN = RWKV_COLS + 2 * B_WIDTH + 2 * D_MODEL

kernel_name = "hybrid_rwkv7_rglru_gated_block"


def rms_norm(x, g):
    xf = x.astype(jnp.float32)
    y = xf * lax.rsqrt(jnp.mean(xf * xf, axis=-1, keepdims=True) + NORM_EPS)
    return (y * g.astype(jnp.float32)).astype(x.dtype)


def causal_dwconv(x, w, b):
    k_width = w.shape[0]
    s = x.shape[1]
    xp = jnp.pad(x, ((0, 0), (k_width - 1, 0), (0, 0)))
    y = b
    for j in range(k_width):
        y = y + xp[:, j:j + s] * w[j]
    return y


def token_shift(p):
    return jnp.pad(p, ((0, 0), (1, 0), (0, 0)))[:, :-1]


def rwkv7_recurrence(r, decay, k, v, a, b):
    def step(state, inp):
        r_t, w_t, k_t, v_t, a_t, b_t = inp
        sa = jnp.einsum('bhij,bhj->bhi', state, a_t)
        state = (state * w_t[:, :, None, :]
                 + sa[..., None] * b_t[:, :, None, :]
                 + v_t[..., None] * k_t[:, :, None, :])
        y_t = jnp.einsum('bhij,bhj->bhi', state, r_t)
        return state, y_t
    bsz, _, nh, nd = r.shape
    xs = tuple(jnp.swapaxes(t, 0, 1) for t in (r, decay, k, v, a, b))
    s0 = jnp.zeros((bsz, nh, nd, nd), jnp.float32)
    _, ys = lax.scan(step, s0, xs)
    return jnp.swapaxes(ys, 0, 1)


def rwkv7_branch(p, mu, w0, w_up, a0, a_up, g_up, k_k, k_a, r_k, lnx_g, lnx_b):
    bsz, s, _ = p.shape
    p = p.astype(jnp.float32)
    p = p + (token_shift(p) - p) * mu
    c0, c1, c2 = A_WIDTH, 2 * A_WIDTH, 3 * A_WIDTH
    c3, c4 = c2 + DECAY_LORA, c2 + DECAY_LORA + AAA_LORA
    r, k, v = p[..., :c0], p[..., c0:c1], p[..., c1:c2]
    pw, pa, pg = p[..., c2:c3], p[..., c3:c4], p[..., c4:]
    w_log = -jax.nn.softplus(-(w0 + jnp.tanh(pw) @ w_up)) - 0.5
    decay = jnp.exp(-jnp.exp(w_log))
    a = jax.nn.sigmoid(a0 + pa @ a_up)
    g = jax.nn.sigmoid(pg) @ g_up
    kk = k * k_k
    k = k * (1.0 + (a - 1.0) * k_a)
    hs = lambda t: t.reshape(bsz, s, A_HEADS, A_HEAD_DIM)
    r, k, v, kk, a, decay = hs(r), hs(k), hs(v), hs(kk), hs(a), hs(decay)
    kk = kk / jnp.maximum(jnp.sqrt(jnp.sum(kk * kk, axis=-1, keepdims=True)), 1e-12)
    y = rwkv7_recurrence(r, decay, k, v, -kk, kk * a)
    mean = jnp.mean(y, axis=-1, keepdims=True)
    var = jnp.mean(jnp.square(y - mean), axis=-1, keepdims=True)
    y = ((y - mean) * lax.rsqrt(var + LNX_EPS)).reshape(bsz, s, A_WIDTH) * lnx_g + lnx_b
    bonus = jnp.sum(r * k * r_k, axis=-1, keepdims=True) * v
    return (y + bonus.reshape(bsz, s, A_WIDTH)) * g


def _lin_combine(c1, c2):
    a1, b1 = c1
    a2, b2 = c2
    return a1 * a2, a2 * b1 + b2


def rglru_branch(px, py, conv_w, conv_b, w_ga, b_ga, w_gx, b_gx, lam):
    bsz, s, _ = px.shape
    xb = causal_dwconv(px.astype(jnp.float32), conv_w, conv_b)
    xh = xb.reshape(bsz, s, B_BLOCKS, B_BLOCK_DIM)
    gate_a = jax.nn.sigmoid(jnp.einsum('bshi,hij->bshj', xh, w_ga).reshape(bsz, s, B_WIDTH) + b_ga)
    gate_x = jax.nn.sigmoid(jnp.einsum('bshi,hij->bshj', xh, w_gx).reshape(bsz, s, B_WIDTH) + b_gx)
    log_a = LRU_C * gate_a * jax.nn.log_sigmoid(lam)
    a = jnp.exp(log_a)
    mult = jnp.sqrt(-jnp.expm1(2.0 * log_a))
    pos = jnp.arange(s)[None, :, None]
    mult = jnp.where(pos == 0, 1.0, mult)
    u = xb * gate_x * mult
    _, h = lax.associative_scan(_lin_combine, (a, u), axis=1)
    return h * jax.nn.gelu(py.astype(jnp.float32))


def cross_attention(h, m, w_q, w_kv, w_o):
    bsz, s, _ = h.shape
    q = (h @ w_q).reshape(bsz, s, X_HEADS, X_HEAD_DIM)
    kv = m @ w_kv
    k = kv[..., :D_MODEL].reshape(bsz, -1, X_HEADS, X_HEAD_DIM)
    v = kv[..., D_MODEL:].reshape(bsz, -1, X_HEADS, X_HEAD_DIM)
    sc = jnp.einsum('bqhd,bkhd->bhqk', q, k).astype(jnp.float32) * (X_HEAD_DIM ** -0.5)
    pr = jax.nn.softmax(sc, axis=-1).astype(v.dtype)
    o = jnp.einsum('bhqk,bkhd->bqhd', pr, v).reshape(bsz, s, D_MODEL)
    return o @ w_o


def conv_ffn(h, w_in, conv_w, conv_b, w_out):
    u = h @ w_in
    gate = causal_dwconv(u[..., :D_FF], conv_w, conv_b)
    return (jax.nn.gelu(gate) * u[..., D_FF:]) @ w_out


def setup_inputs(seed: int = 0) -> dict:
    key = jax.random.key(seed)
    ks = iter(jax.random.split(key, 48))
    L = DEPTH
    f32 = jnp.float32

    def nrm(shape, scale):
        return jax.random.normal(next(ks), shape, f32) * scale

    u_lam = jax.random.uniform(next(ks), (L, B_WIDTH), f32, minval=0.9, maxval=0.999)
    return {
        "x": nrm((BATCH, SEQ, D_MODEL), 1.0),
        "mem": nrm((BATCH, N_MEM, D_MODEL), 1.0),
        "norm_mix_g": 1.0 + nrm((L, D_MODEL), 0.05),
        "w_in": nrm((L, D_MODEL, P_IN), D_MODEL ** -0.5),
        "b_in": nrm((L, P_IN), 0.02),
        "mu_shift": jax.random.uniform(next(ks), (L, RWKV_COLS), f32),
        "w0": nrm((L, A_WIDTH), 0.5) - 0.5,
        "w_lora_up": nrm((L, DECAY_LORA, A_WIDTH), 0.1),
        "a0": nrm((L, A_WIDTH), 0.5),
        "a_lora_up": nrm((L, AAA_LORA, A_WIDTH), AAA_LORA ** -0.5),
        "g_lora_up": nrm((L, GATE_LORA, A_WIDTH), GATE_LORA ** -0.5),
        "k_k": 0.85 + nrm((L, A_WIDTH), 0.05),
        "k_a": 1.0 + nrm((L, A_WIDTH), 0.05),
        "r_k": nrm((L, A_HEADS, A_HEAD_DIM), 0.1),
        "lnx_g": 1.0 + nrm((L, A_WIDTH), 0.05),
        "lnx_b": nrm((L, A_WIDTH), 0.02),
        "w_branch_a": nrm((L, A_WIDTH, D_MODEL), A_WIDTH ** -0.5),
        "conv_b_w": nrm((L, B_CONV, B_WIDTH), B_CONV ** -0.5),
        "conv_b_b": nrm((L, B_WIDTH), 0.02),
        "w_rg_a": nrm((L, B_BLOCKS, B_BLOCK_DIM, B_BLOCK_DIM), B_BLOCK_DIM ** -0.5),
        "b_rg_a": nrm((L, B_WIDTH), 0.02),
        "w_rg_x": nrm((L, B_BLOCKS, B_BLOCK_DIM, B_BLOCK_DIM), B_BLOCK_DIM ** -0.5),
        "b_rg_x": nrm((L, B_WIDTH), 0.02),
        "lru_lambda": jnp.log(u_lam) - jnp.log1p(-u_lam),
        "w_branch_b": nrm((L, B_WIDTH, D_MODEL), B_WIDTH ** -0.5),
        "w_mix_out": nrm((L, D_MODEL, D_MODEL), D_MODEL ** -0.5),
        "norm_x_g": 1.0 + nrm((L, D_MODEL), 0.05),
        "norm_mem_g": 1.0 + nrm((L, D_MODEL), 0.05),
        "w_cq": nrm((L, D_MODEL, D_MODEL), D_MODEL ** -0.5),
        "w_ckv": nrm((L, D_MODEL, 2 * D_MODEL), D_MODEL ** -0.5),
        "w_co": nrm((L, D_MODEL, D_MODEL), D_MODEL ** -0.5),
        "norm_ffn_g": 1.0 + nrm((L, D_MODEL), 0.05),
        "w_ffn_in": nrm((L, D_MODEL, 2 * D_FF), D_MODEL ** -0.5),
        "ffn_conv_w": nrm((L, FFN_CONV, D_FF), FFN_CONV ** -0.5),
        "ffn_conv_b": nrm((L, D_FF), 0.02),
        "w_ffn_out": nrm((L, D_FF, D_MODEL), D_FF ** -0.5),
        "norm_final_g": 1.0 + nrm((D_MODEL,), 0.05),
    }


def reference(x, mem, norm_mix_g, w_in, b_in, mu_shift, w0, w_lora_up, a0, a_lora_up,
              g_lora_up, k_k, k_a, r_k, lnx_g, lnx_b, w_branch_a, conv_b_w, conv_b_b,
              w_rg_a, b_rg_a, w_rg_x, b_rg_x, lru_lambda, w_branch_b, w_mix_out,
              norm_x_g, norm_mem_g, w_cq, w_ckv, w_co, norm_ffn_g, w_ffn_in,
              ffn_conv_w, ffn_conv_b, w_ffn_out, norm_final_g):
    dt = x.dtype
    cb0 = RWKV_COLS
    cb1 = cb0 + B_WIDTH
    cb2 = cb1 + B_WIDTH
    cg1 = cb2 + D_MODEL
    for l in range(DEPTH):
        h = rms_norm(x, norm_mix_g[l])
        proj = h @ w_in[l] + b_in[l]
        y_a = rwkv7_branch(proj[..., :cb0], mu_shift[l], w0[l], w_lora_up[l], a0[l],
                           a_lora_up[l], g_lora_up[l], k_k[l], k_a[l], r_k[l],
                           lnx_g[l], lnx_b[l]).astype(dt) @ w_branch_a[l]
        y_b = rglru_branch(proj[..., cb0:cb1], proj[..., cb1:cb2], conv_b_w[l], conv_b_b[l],
                           w_rg_a[l], b_rg_a[l], w_rg_x[l], b_rg_x[l],
                           lru_lambda[l]).astype(dt) @ w_branch_b[l]
        merged = (jax.nn.sigmoid(proj[..., cb2:cg1]) * y_a
                  + jax.nn.sigmoid(proj[..., cg1:]) * y_b)
        x = x + merged @ w_mix_out[l]
        x = x + cross_attention(rms_norm(x, norm_x_g[l]), rms_norm(mem, norm_mem_g[l]),
                                w_cq[l], w_ckv[l], w_co[l])
        x = x + conv_ffn(rms_norm(x, norm_ffn_g[l]), w_ffn_in[l], ffn_conv_w[l],
                         ffn_conv_b[l], w_ffn_out[l])
    return rms_norm(x, norm_final_g)
```

```cpp
#include <hip/hip_runtime.h>
#include <hip/hip_cooperative_groups.h>
#include <cstdio>
namespace cg = cooperative_groups;

#ifndef MK_SPLIT
#define MK_SPLIT 0
#endif

#define LAS __attribute__((address_space(3)))
typedef unsigned short bf16_t;
typedef short bf16x8 __attribute__((ext_vector_type(8)));
typedef float f32x4 __attribute__((ext_vector_type(4)));
typedef float f32x2 __attribute__((ext_vector_type(2)));
typedef unsigned u32x4 __attribute__((ext_vector_type(4)));
typedef unsigned u32x2 __attribute__((ext_vector_type(2)));

constexpr int T = 65536, D = 1024, SEQ = 2048, NB = 32, NMEM = 256, TM = NB * NMEM;
constexpr int AW = 512, RW = 1792, PIN = 4864, DFF = 2816;
constexpr float NORM_EPS = 1e-6f, LNX_EPS = 64e-5f;

constexpr size_t MiB = 1u << 20;
constexpr size_t WS_WIN = 0;
constexpr size_t WS_WFFI = 10 * MiB;
constexpr size_t WS_WFFO = 21 * MiB;
constexpr size_t WS_WMIX = 27 * MiB, WS_WCQ = 29 * MiB, WS_WK = 31 * MiB, WS_WV = 33 * MiB, WS_WCO = 35 * MiB;
constexpr size_t WS_WA = 37 * MiB, WS_WB = 38 * MiB;
constexpr size_t WS_WLORA = 39 * MiB;
constexpr size_t WS_WRG = 40 * MiB;
constexpr size_t WS_RSTDX = 48 * MiB;
constexpr size_t WS_SSP1 = 49 * MiB, WS_SSP2 = 53 * MiB, WS_SSP3 = 57 * MiB, WS_SSPA = 61 * MiB;
constexpr size_t WS_BON = 65 * MiB;
constexpr size_t WS_MEMN = 68 * MiB, WS_KM = 84 * MiB, WS_VT = 100 * MiB;
constexpr size_t WS_XB = 120 * MiB;
constexpr size_t WS_PR = 248 * MiB;
constexpr size_t WS_PX = 472 * MiB, WS_PY = 536 * MiB;
constexpr size_t WS_LIN = 600 * MiB, WS_XBC = 632 * MiB;
constexpr size_t WS_LOUT = 696 * MiB;
constexpr size_t WS_RGLA = 888 * MiB, WS_RGU = 952 * MiB;
constexpr size_t WS_YRAW = WS_PX, WS_YB = WS_LIN, WS_YA = WS_RGLA;
constexpr size_t WS_GAB = 248 * MiB;
constexpr size_t WS_MERGED = 696 * MiB;
constexpr size_t WS_X1B = WS_XB, WS_Q = 248 * MiB, WS_PEXP = 376 * MiB, WS_O = 504 * MiB, WS_X2B = WS_XB;
constexpr size_t WS_UG = 248 * MiB, WS_UU = 600 * MiB;
constexpr size_t WS_END = 1016 * MiB;

constexpr int LDS_BYTES = 147456;

__device__ __forceinline__ unsigned cvt_pk_bf16(float lo, float hi) { unsigned r; asm("v_cvt_pk_bf16_f32 %0, %1, %2" : "=v"(r) : "v"(lo), "v"(hi)); return r; }
__device__ __forceinline__ float bf_lo(unsigned w) { return __uint_as_float(w << 16); }
__device__ __forceinline__ float bf_hi(unsigned w) { return __uint_as_float(w & 0xffff0000u); }
__device__ __forceinline__ float bf1(bf16_t b) { return __uint_as_float(((unsigned)b) << 16); }
__device__ __forceinline__ bf16_t f2bf(float f) { return (bf16_t)(cvt_pk_bf16(f, 0.f) & 0xffffu); }
__device__ __forceinline__ float sigmoidf_(float x) { return __builtin_amdgcn_rcpf(1.0f + __expf(-x)); }
__device__ __forceinline__ float gelu_tanh(float x) { const float z = 1.5957691216057308f * (x + 0.044715f * x * x * x); return x * sigmoidf_(z); }
__device__ __forceinline__ int lane_id() { int l; asm volatile("v_mbcnt_lo_u32_b32 %0, -1, 0\n\tv_mbcnt_hi_u32_b32 %0, -1, %0" : "=v"(l)); return l; }
__device__ __forceinline__ float wave_sum(float v) {
#pragma unroll
    for (int o = 1; o < 64; o <<= 1) v += __shfl_xor(v, o);
    return v;
}
__device__ __forceinline__ void unpack8(const u32x4 w, float (&f)[8]) {
    f[0] = bf_lo(w.x); f[1] = bf_hi(w.x); f[2] = bf_lo(w.y); f[3] = bf_hi(w.y); f[4] = bf_lo(w.z); f[5] = bf_hi(w.z); f[6] = bf_lo(w.w); f[7] = bf_hi(w.w);
}
__device__ __forceinline__ u32x4 pack8(const float (&f)[8]) {
    u32x4 w; w.x = cvt_pk_bf16(f[0], f[1]); w.y = cvt_pk_bf16(f[2], f[3]); w.z = cvt_pk_bf16(f[4], f[5]); w.w = cvt_pk_bf16(f[6], f[7]); return w;
}

constexpr int BM = 256, BK = 64, HALF = 128, HTB = HALF * BK * 2, NXCD = 8, WGM = 8;
__device__ __forceinline__ int lds_byte(int r, int c) { const int st = (r >> 4) * 2 + (c >> 5), rr = r & 15, cc = c & 31, ob = rr * 64 + cc * 2; return st * 1024 + (ob ^ (((ob >> 9) & 1) << 5)); }
__device__ __forceinline__ void stage_rc(int b, int& R, int& C) { const int st = b / 1024, sb = b % 1024, swz = sb ^ (((sb >> 9) & 1) << 5); R = (st >> 1) * 16 + swz / 64; C = (st & 1) * 32 + (swz % 64) / 2; }
__device__ __forceinline__ int perm32(int rho) { const int n = rho >> 4, i = rho & 15; return 8 * (i >> 2) + 4 * n + (i & 3); }

struct Unit { int pm, pn; };
struct Gemm { const bf16_t* A; const bf16_t* Bt; int lda, ldb, K; size_t a_pm, a_pn, b_pn, b_pb; };
__device__ __forceinline__ Gemm plain_gemm(const bf16_t* A, const bf16_t* Bt, int K) { Gemm g; g.A = A; g.Bt = Bt; g.lda = K; g.ldb = K; g.K = K; g.a_pm = (size_t)BM * K * 2; g.a_pn = 0; g.b_pn = (size_t)BM * K * 2; g.b_pb = 0; return g; }

struct StaticOrder {
    int nM, nN, nwg, G, c;
    __device__ void init(int nM_, int nN_, int G_, int c_) { nM = nM_; nN = nN_; nwg = nM * nN; G = G_; c = c_; }
    __device__ bool next(int i, Unit& u) const {
        const long L = (long)i * G + c; if (L >= nwg) return false;
        int wgid = (int)L; { const int q = nwg / NXCD, r = nwg % NXCD, xcd = wgid % NXCD, off = wgid / NXCD; wgid = (xcd < r ? xcd * (q + 1) : r * (q + 1) + (xcd - r) * q) + off; }
        const int nig = WGM * nN, gid = wgid / nig, fm = gid * WGM, gsz = (nM - fm) < WGM ? (nM - fm) : WGM;
        u.pm = fm + ((wgid % nig) % gsz); u.pn = (wgid % nig) / gsz; return true;
    }
};

typedef f32x4 Acc[2][2][4][2];

template <class Epi>
__device__ __forceinline__ void gemm_phase(LAS unsigned char* lds, const int wid, const Gemm g, const StaticOrder& S, const Epi& E) {
    const int lane = lane_id(), tid = wid * 64 + lane, wr = wid >> 2, wc = wid & 3, fr = lane & 15, fq = lane >> 4;
    const int nt = g.K / BK;
    unsigned voffA[2], voffB[2];
#pragma unroll
    for (int i = 0; i < 2; ++i) { int R, C; stage_rc(tid * 16 + i * 8192, R, C); const int Rb = Epi::PERM ? ((R & ~31) + perm32(R & 31)) : R;
        voffA[i] = (unsigned)(R * g.lda + C) * 2u; voffB[i] = (unsigned)(Rb * g.ldb + C) * 2u; }
    const size_t kstep = (size_t)(BK * 2);
    const size_t hstepA = (size_t)HALF * g.lda * 2, hstepB = (size_t)HALF * g.ldb * 2;
    const unsigned ldsw = (unsigned)wid * 1024u;
    const int aoff = lds_byte(wr * 64 + fr, fq * 8), boff = lds_byte(wc * 32 + fr, fq * 8);
#define PG8_SA(b, h) (((b) * 2 + (h)) * HTB)
#define PG8_SB(b, h) ((4 + (b) * 2 + (h)) * HTB)
#define PG8_STAGE(bufoff, gbase, voff) do { _Pragma("unroll") for (int _i = 0; _i < 2; ++_i) \
        __builtin_amdgcn_global_load_lds((const unsigned*)((const char*)(gbase) + (voff)[_i]), (LAS unsigned*)(lds + (bufoff) + ldsw + _i * 8192), 16, 0, 0); } while (0)
#define PG8_LDA(dst, b, h) do { _Pragma("unroll") for (int m = 0; m < 4; ++m) _Pragma("unroll") for (int k = 0; k < 2; ++k) dst[m][k] = *(const LAS bf16x8*)(lds + PG8_SA(b, h) + aoff + m * 2048 + k * 1024); } while (0)
#define PG8_LDB(dst, b, h) do { _Pragma("unroll") for (int n = 0; n < 2; ++n) _Pragma("unroll") for (int k = 0; k < 2; ++k) dst[n][k] = *(const LAS bf16x8*)(lds + PG8_SB(b, h) + boff + n * 2048 + k * 1024); } while (0)
#define PG8_MMA(ai, bj, At, Bt) do { __builtin_amdgcn_s_setprio(1); _Pragma("unroll") for (int m = 0; m < 4; ++m) _Pragma("unroll") for (int n = 0; n < 2; ++n) _Pragma("unroll") for (int k = 0; k < 2; ++k) \
        acc[ai][bj][m][n] = __builtin_amdgcn_mfma_f32_16x16x32_bf16(Bt[n][k], At[m][k], acc[ai][bj][m][n], 0, 0, 0); __builtin_amdgcn_s_setprio(0); } while (0)
#define PG8_WAIT_V(n) asm volatile("s_waitcnt vmcnt(" #n ")" ::: "memory")
#define PG8_WAIT_L(n) asm volatile("s_waitcnt lgkmcnt(" #n ")" ::: "memory")
#define PG8_BAR __builtin_amdgcn_s_barrier()
#define PG8_SCHED __builtin_amdgcn_sched_barrier(0)
#define PG8_UA(u) ((const char*)g.A + (size_t)(u).pm * g.a_pm + (size_t)(u).pn * g.a_pn)
#define PG8_UB(u) ((const char*)g.Bt + (size_t)(u).pn * g.b_pn + (size_t)((u).pm >> 3) * g.b_pb)
    Unit cur, nxt; int ui = 0;
    if (!S.next(0, cur)) return;
    Acc acc;
#pragma unroll
    for (int a = 0; a < 2; ++a)
#pragma unroll
        for (int b = 0; b < 2; ++b)
#pragma unroll
            for (int m = 0; m < 4; ++m)
#pragma unroll
                for (int n = 0; n < 2; ++n) acc[a][b][m][n] = (f32x4){0.f, 0.f, 0.f, 0.f};
    bf16x8 At[4][2], B0[2][2], B1[2][2];
    const char* cA = PG8_UA(cur); const char* cB = PG8_UB(cur);
    PG8_STAGE(PG8_SB(0, 0), cB, voffB); PG8_STAGE(PG8_SA(0, 0), cA, voffA); PG8_STAGE(PG8_SB(0, 1), cB + hstepB, voffB); PG8_STAGE(PG8_SA(0, 1), cA + hstepA, voffA);
    if (wr == 1) PG8_BAR;
    PG8_WAIT_V(4); PG8_BAR;
    PG8_STAGE(PG8_SB(1, 0), cB + kstep, voffB); PG8_STAGE(PG8_SA(1, 0), cA + kstep, voffA); PG8_STAGE(PG8_SB(1, 1), cB + hstepB + kstep, voffB);
    PG8_WAIT_V(6); PG8_BAR;
    for (;;) {
        const bool has_next = S.next(ui + 1, nxt);
        const char* nA = has_next ? PG8_UA(nxt) : cA; const char* nB = has_next ? PG8_UB(nxt) : cB;
        for (int t = 0; t < nt; t += 2) {
            const bool last = (t == nt - 2);
            const char* a1 = cA + (size_t)(t + 1) * kstep;
            const char* a2 = last ? nA : cA + (size_t)(t + 2) * kstep; const char* b2 = last ? nB : cB + (size_t)(t + 2) * kstep;
            const char* a3 = a2 + kstep; const char* b3 = b2 + kstep;
            PG8_LDB(B0, 0, 0); PG8_SCHED; PG8_LDA(At, 0, 0); PG8_STAGE(PG8_SA(1, 1), a1 + hstepA, voffA);
            PG8_WAIT_L(8); PG8_BAR; PG8_WAIT_L(0); PG8_MMA(0, 0, At, B0); PG8_BAR; PG8_SCHED;
            PG8_LDB(B1, 0, 1); PG8_STAGE(PG8_SB(0, 0), b2, voffB);
            PG8_BAR; PG8_WAIT_L(0); PG8_MMA(0, 1, At, B1); PG8_BAR;
            PG8_LDA(At, 0, 1); PG8_STAGE(PG8_SA(0, 0), a2, voffA);
            PG8_BAR; PG8_WAIT_L(0); PG8_MMA(1, 0, At, B0); PG8_BAR; PG8_SCHED;
            PG8_STAGE(PG8_SB(0, 1), b2 + hstepB, voffB);
            PG8_WAIT_V(6); PG8_BAR; PG8_MMA(1, 1, At, B1); PG8_BAR;
            PG8_LDB(B0, 1, 0); PG8_SCHED; PG8_LDA(At, 1, 0); PG8_STAGE(PG8_SA(0, 1), a2 + hstepA, voffA);
            PG8_WAIT_L(8); PG8_BAR; PG8_WAIT_L(0); PG8_MMA(0, 0, At, B0); PG8_BAR; PG8_SCHED;
            PG8_LDB(B1, 1, 1); PG8_STAGE(PG8_SB(1, 0), b3, voffB);
            PG8_BAR; PG8_WAIT_L(0); PG8_MMA(0, 1, At, B1); PG8_BAR;
            PG8_LDA(At, 1, 1); PG8_STAGE(PG8_SA(1, 0), a3, voffA);
            PG8_BAR; PG8_WAIT_L(0); PG8_MMA(1, 0, At, B0); PG8_BAR; PG8_SCHED;
            PG8_STAGE(PG8_SB(1, 1), b3 + hstepB, voffB);
            PG8_WAIT_V(6); PG8_BAR; PG8_MMA(1, 1, At, B1); PG8_BAR;
        }
        E(acc, cur, wr, wc, fr, fq);
        if (!has_next) break;
#pragma unroll
        for (int a = 0; a < 2; ++a)
#pragma unroll
            for (int b = 0; b < 2; ++b)
#pragma unroll
                for (int m = 0; m < 4; ++m)
#pragma unroll
                    for (int n = 0; n < 2; ++n) acc[a][b][m][n] = (f32x4){0.f, 0.f, 0.f, 0.f};
        cur = nxt; cA = nA; cB = nB; ++ui;
    }
    PG8_WAIT_V(0);
    if (wr == 0) PG8_BAR;
    PG8_BAR;
#undef PG8_SA
#undef PG8_SB
#undef PG8_STAGE
#undef PG8_LDA
#undef PG8_LDB
#undef PG8_MMA
#undef PG8_WAIT_V
#undef PG8_WAIT_L
#undef PG8_BAR
#undef PG8_SCHED
#undef PG8_UA
#undef PG8_UB
}

#define EPI_ROWS_BEGIN for (int ai = 0; ai < 2; ++ai) { _Pragma("unroll") for (int m = 0; m < 4; ++m) { const int r = u.pm * BM + ai * HALF + wr * 64 + m * 16 + fr;
#define EPI_ROWS_END } }

__device__ __forceinline__ float rstd_from16(const float* ssp, int r) {
    const f32x4* p = (const f32x4*)(ssp + (size_t)r * 16); const f32x4 a = p[0], b = p[1], c = p[2], d = p[3];
    const float s = ((a.x + a.y) + (a.z + a.w)) + ((b.x + b.y) + (b.z + b.w)) + ((c.x + c.y) + (c.z + c.w)) + ((d.x + d.y) + (d.z + d.w));
    return rsqrtf(s * (1.0f / 1024.0f) + NORM_EPS);
}

struct EpiProj { static constexpr bool PERM = true;
    const float* rstd; const float* bias; bf16_t* PR; bf16_t* PX; bf16_t* PY;
    __device__ __forceinline__ void operator()(const Acc& acc, const Unit& u, int wr, int wc, int fr, int fq) const {
        bf16_t* base; int ld, colt;
        if (u.pn < 7) { base = PR; ld = RW; colt = u.pn * 256; } else if (u.pn < 9) { base = PX; ld = 512; colt = (u.pn - 7) * 256; } else { base = PY; ld = 512; colt = (u.pn - 9) * 256; }
        const int col0 = colt + wc * 32 + 8 * fq, bcol0 = u.pn * 256 + wc * 32 + 8 * fq;
        f32x4 bv[2][2];
#pragma unroll
        for (int bj = 0; bj < 2; ++bj)
#pragma unroll
            for (int n = 0; n < 2; ++n) bv[bj][n] = *(const f32x4*)(bias + bcol0 + bj * HALF + 4 * n);
#pragma unroll
        EPI_ROWS_BEGIN
            const float rs = rstd[r]; bf16_t* rowp = base + (size_t)r * ld + col0;
#pragma unroll
            for (int bj = 0; bj < 2; ++bj) { const f32x4 v0 = acc[ai][bj][m][0] * rs + bv[bj][0], v1 = acc[ai][bj][m][1] * rs + bv[bj][1];
                u32x4 w; w.x = cvt_pk_bf16(v0[0], v0[1]); w.y = cvt_pk_bf16(v0[2], v0[3]); w.z = cvt_pk_bf16(v1[0], v1[1]); w.w = cvt_pk_bf16(v1[2], v1[3]);
                *(u32x4*)(rowp + bj * HALF) = w; }
        EPI_ROWS_END
    }
};
struct EpiGab { static constexpr bool PERM = true;
    const float* rstd; const float* bias; bf16_t* O;
    __device__ __forceinline__ void operator()(const Acc& acc, const Unit& u, int wr, int wc, int fr, int fq) const {
        const int col0 = u.pn * 256 + wc * 32 + 8 * fq;
        f32x4 bv[2][2];
#pragma unroll
        for (int bj = 0; bj < 2; ++bj)
#pragma unroll
            for (int n = 0; n < 2; ++n) bv[bj][n] = *(const f32x4*)(bias + col0 + bj * HALF + 4 * n);
#pragma unroll
        EPI_ROWS_BEGIN
            const float rs = rstd[r]; bf16_t* rowp = O + (size_t)r * 2048 + col0;
#pragma unroll
            for (int bj = 0; bj < 2; ++bj) { f32x4 v0 = acc[ai][bj][m][0] * rs + bv[bj][0], v1 = acc[ai][bj][m][1] * rs + bv[bj][1];
#pragma unroll
                for (int j = 0; j < 4; ++j) { v0[j] = sigmoidf_(v0[j]); v1[j] = sigmoidf_(v1[j]); }
                u32x4 w; w.x = cvt_pk_bf16(v0[0], v0[1]); w.y = cvt_pk_bf16(v0[2], v0[3]); w.z = cvt_pk_bf16(v1[0], v1[1]); w.w = cvt_pk_bf16(v1[2], v1[3]);
                *(u32x4*)(rowp + bj * HALF) = w; }
        EPI_ROWS_END
    }
};
struct EpiPlain { static constexpr bool PERM = true;
    bf16_t* O; int ldc;
    __device__ __forceinline__ void operator()(const Acc& acc, const Unit& u, int wr, int wc, int fr, int fq) const {
        const int col0 = u.pn * 256 + wc * 32 + 8 * fq;
#pragma unroll
        EPI_ROWS_BEGIN
            bf16_t* rowp = O + (size_t)r * ldc + col0;
#pragma unroll
            for (int bj = 0; bj < 2; ++bj) { const f32x4 v0 = acc[ai][bj][m][0], v1 = acc[ai][bj][m][1];
                u32x4 w; w.x = cvt_pk_bf16(v0[0], v0[1]); w.y = cvt_pk_bf16(v0[2], v0[3]); w.z = cvt_pk_bf16(v1[0], v1[1]); w.w = cvt_pk_bf16(v1[2], v1[3]);
                *(u32x4*)(rowp + bj * HALF) = w; }
        EPI_ROWS_END
    }
};
struct EpiLora { static constexpr bool PERM = true;
    const float* w0; const float* a0; bf16_t* O;
    __device__ __forceinline__ void operator()(const Acc& acc, const Unit& u, int wr, int wc, int fr, int fq) const {
        const int kind = u.pn >> 1, ch0 = (u.pn & 1) * 256 + wc * 32 + 8 * fq, col0 = u.pn * 256 + wc * 32 + 8 * fq;
        const float* bsrc = kind == 0 ? w0 : a0;
        f32x4 bv[2][2];
#pragma unroll
        for (int bj = 0; bj < 2; ++bj)
#pragma unroll
            for (int n = 0; n < 2; ++n) bv[bj][n] = kind < 2 ? *(const f32x4*)(bsrc + ch0 + bj * HALF + 4 * n) : (f32x4){0.f, 0.f, 0.f, 0.f};
        const float sc = kind == 0 ? 0.6065306597126334f : 1.0f;
#pragma unroll
        EPI_ROWS_BEGIN
            bf16_t* rowp = O + (size_t)r * 1536 + col0;
#pragma unroll
            for (int bj = 0; bj < 2; ++bj) { f32x4 v0 = acc[ai][bj][m][0] + bv[bj][0], v1 = acc[ai][bj][m][1] + bv[bj][1];
                if (kind < 2) {
#pragma unroll
                    for (int j = 0; j < 4; ++j) { v0[j] = sc * sigmoidf_(v0[j]); v1[j] = sc * sigmoidf_(v1[j]); } }
                u32x4 w; w.x = cvt_pk_bf16(v0[0], v0[1]); w.y = cvt_pk_bf16(v0[2], v0[3]); w.z = cvt_pk_bf16(v1[0], v1[1]); w.w = cvt_pk_bf16(v1[2], v1[3]);
                *(u32x4*)(rowp + bj * HALF) = w; }
        EPI_ROWS_END
    }
};
struct EpiRg { static constexpr bool PERM = true;
    const float* ba; const float* bx; const float* lam; const bf16_t* XBC; bf16_t* LA; bf16_t* U;
    __device__ __forceinline__ void operator()(const Acc& acc, const Unit& u, int wr, int wc, int fr, int fq) const {
        const int ch0 = u.pn * 128 + wc * 32 + 8 * fq;
        float vba[8], vbx[8], vls[8];
#pragma unroll
        for (int j = 0; j < 8; ++j) { vba[j] = ba[ch0 + j]; vbx[j] = bx[ch0 + j]; vls[j] = -8.0f * log1pf(__expf(-lam[ch0 + j])); }
#pragma unroll
        EPI_ROWS_BEGIN
            const bool first = (r & (SEQ - 1)) == 0;
            float xb[8]; unpack8(*(const u32x4*)(XBC + (size_t)r * 512 + ch0), xb);
            float la[8], uu[8];
#pragma unroll
            for (int j = 0; j < 8; ++j) { const float ga = sigmoidf_(acc[ai][0][m][j >> 2][j & 3] + vba[j]), gx = sigmoidf_(acc[ai][1][m][j >> 2][j & 3] + vbx[j]);
                la[j] = vls[j] * ga; const float a = __expf(la[j]); const float mult = first ? 1.0f : sqrtf(fmaxf(1.0f - a * a, 0.f)); uu[j] = xb[j] * gx * mult; }
            *(u32x4*)(LA + (size_t)r * 512 + ch0) = pack8(la); *(u32x4*)(U + (size_t)r * 512 + ch0) = pack8(uu);
        EPI_ROWS_END
    }
};
template <bool FIRST> struct EpiBranch { static constexpr bool PERM = true;
    const bf16_t* G; bf16_t* M;
    __device__ __forceinline__ void operator()(const Acc& acc, const Unit& u, int wr, int wc, int fr, int fq) const {
        const int col0 = u.pn * 256 + wc * 32 + 8 * fq;
#pragma unroll
        EPI_ROWS_BEGIN
#pragma unroll
            for (int bj = 0; bj < 2; ++bj) { const int c = col0 + bj * HALF;
                float gv[8]; unpack8(*(const u32x4*)(G + (size_t)r * 2048 + (FIRST ? 0 : 1024) + c), gv);
                float o[8];
                if (!FIRST) unpack8(*(const u32x4*)(M + (size_t)r * 1024 + c), o);
#pragma unroll
                for (int j = 0; j < 8; ++j) { const float p = acc[ai][bj][m][j >> 2][j & 3] * gv[j]; o[j] = FIRST ? p : o[j] + p; }
                *(u32x4*)(M + (size_t)r * 1024 + c) = pack8(o); }
        EPI_ROWS_END
    }
};
template <bool WB> struct EpiRes { static constexpr bool PERM = false;
    const float* base; float* out; bf16_t* XB; float* ssp;
    __device__ __forceinline__ void operator()(const Acc& acc, const Unit& u, int wr, int wc, int fr, int fq) const {
        const int col0 = u.pn * 256 + wc * 32 + 4 * fq;
#pragma unroll
        EPI_ROWS_BEGIN
            const size_t off = (size_t)r * 1024 + col0; float s = 0.f;
#pragma unroll
            for (int bj = 0; bj < 2; ++bj)
#pragma unroll
                for (int n = 0; n < 2; ++n) { const f32x4 bs = *(const f32x4*)(base + off + bj * HALF + n * 16); const f32x4 o = bs + acc[ai][bj][m][n];
                    *(f32x4*)(out + off + bj * HALF + n * 16) = o; s += (o[0] * o[0] + o[1] * o[1]) + (o[2] * o[2] + o[3] * o[3]);
                    if (WB) { u32x2 w; w.x = cvt_pk_bf16(o[0], o[1]); w.y = cvt_pk_bf16(o[2], o[3]); *(u32x2*)(XB + off + bj * HALF + n * 16) = w; } }
            s += __shfl_xor(s, 16); s += __shfl_xor(s, 32);
            if (fq == 0) ssp[(size_t)r * 16 + u.pn * 4 + wc] = s;
        EPI_ROWS_END
    }
};
struct EpiQ { static constexpr bool PERM = true;
    const float* ssp; bf16_t* O;
    __device__ __forceinline__ void operator()(const Acc& acc, const Unit& u, int wr, int wc, int fr, int fq) const {
        const int col0 = u.pn * 256 + wc * 32 + 8 * fq;
#pragma unroll
        EPI_ROWS_BEGIN
            const float rs = rstd_from16(ssp, r) * 0.0625f; bf16_t* rowp = O + (size_t)r * 1024 + col0;
#pragma unroll
            for (int bj = 0; bj < 2; ++bj) { const f32x4 v0 = acc[ai][bj][m][0] * rs, v1 = acc[ai][bj][m][1] * rs;
                u32x4 w; w.x = cvt_pk_bf16(v0[0], v0[1]); w.y = cvt_pk_bf16(v0[2], v0[3]); w.z = cvt_pk_bf16(v1[0], v1[1]); w.w = cvt_pk_bf16(v1[2], v1[3]);
                *(u32x4*)(rowp + bj * HALF) = w; }
        EPI_ROWS_END
    }
};
struct EpiSc { static constexpr bool PERM = true;
    bf16_t* O; float* ssp;
    __device__ __forceinline__ void operator()(const Acc& acc, const Unit& u, int wr, int wc, int fr, int fq) const {
        const int col0 = u.pn * 256 + wc * 32 + 8 * fq;
#pragma unroll
        EPI_ROWS_BEGIN
            bf16_t* rowp = O + (size_t)r * 1024 + col0; float s = 0.f;
#pragma unroll
            for (int bj = 0; bj < 2; ++bj) { f32x4 v0 = acc[ai][bj][m][0], v1 = acc[ai][bj][m][1];
#pragma unroll
                for (int j = 0; j < 4; ++j) { v0[j] = __expf(v0[j]); v1[j] = __expf(v1[j]); }
                s += ((v0[0] + v0[1]) + (v0[2] + v0[3])) + ((v1[0] + v1[1]) + (v1[2] + v1[3]));
                u32x4 w; w.x = cvt_pk_bf16(v0[0], v0[1]); w.y = cvt_pk_bf16(v0[2], v0[3]); w.z = cvt_pk_bf16(v1[0], v1[1]); w.w = cvt_pk_bf16(v1[2], v1[3]);
                *(u32x4*)(rowp + bj * HALF) = w; }
            s += __shfl_xor(s, 16); s += __shfl_xor(s, 32);
            if (fq == 0) ssp[(size_t)r * 16 + u.pn * 4 + wc] = s;
        EPI_ROWS_END
    }
};
struct EpiPv { static constexpr bool PERM = true;
    const float* ssp; bf16_t* O;
    __device__ __forceinline__ void operator()(const Acc& acc, const Unit& u, int wr, int wc, int fr, int fq) const {
        const int col0 = u.pn * 256 + wc * 32 + 8 * fq;
#pragma unroll
        EPI_ROWS_BEGIN
            const f32x4 sp = *(const f32x4*)(ssp + (size_t)r * 16 + u.pn * 4); const float rs = 1.0f / ((sp.x + sp.y) + (sp.z + sp.w));
            bf16_t* rowp = O + (size_t)r * 1024 + col0;
#pragma unroll
            for (int bj = 0; bj < 2; ++bj) { const f32x4 v0 = acc[ai][bj][m][0] * rs, v1 = acc[ai][bj][m][1] * rs;
                u32x4 w; w.x = cvt_pk_bf16(v0[0], v0[1]); w.y = cvt_pk_bf16(v0[2], v0[3]); w.z = cvt_pk_bf16(v1[0], v1[1]); w.w = cvt_pk_bf16(v1[2], v1[3]);
                *(u32x4*)(rowp + bj * HALF) = w; }
        EPI_ROWS_END
    }
};
struct EpiFfnIn { static constexpr bool PERM = true;
    const float* ssp; bf16_t* UG; bf16_t* UU;
    __device__ __forceinline__ void operator()(const Acc& acc, const Unit& u, int wr, int wc, int fr, int fq) const {
        const int col0 = u.pn * 128 + wc * 32 + 8 * fq;
#pragma unroll
        EPI_ROWS_BEGIN
            const float rs = rstd_from16(ssp, r);
#pragma unroll
            for (int bj = 0; bj < 2; ++bj) { const f32x4 v0 = acc[ai][bj][m][0] * rs, v1 = acc[ai][bj][m][1] * rs;
                u32x4 w; w.x = cvt_pk_bf16(v0[0], v0[1]); w.y = cvt_pk_bf16(v0[2], v0[3]); w.z = cvt_pk_bf16(v1[0], v1[1]); w.w = cvt_pk_bf16(v1[2], v1[3]);
                *(u32x4*)((bj ? UU : UG) + (size_t)r * DFF + col0) = w; }
        EPI_ROWS_END
    }
};

struct Args { const float* in[37]; float* out; unsigned char* ws; int ph_lo, ph_hi; };
enum { I_X = 0, I_MEM, I_NMIXG, I_WIN, I_BIN, I_MU, I_W0, I_WUP, I_A0, I_AUP, I_GUP, I_KK, I_KA, I_RK, I_LNXG, I_LNXB, I_WBA, I_CBW, I_CBB, I_WRGA, I_BRGA, I_WRGX, I_BRGX,
       I_LAM, I_WBB, I_WMIX, I_NXG, I_NMEMG, I_WCQ, I_WCKV, I_WCO, I_NFFNG, I_WFFI, I_FCW, I_FCB, I_WFFO, I_NFING };

__device__ __forceinline__ void transpose_item(const float* W, int ldw, int K, bf16_t* WT, int ldd, const float* gain, int map, int srcofs, LAS float* scr, int item, int lane) {
    const int nkb = K / 64, nb = item / nkb, kb = item % nkb, k0 = 64 * kb, n0 = 32 * nb;
    int ns = n0 + srcofs;
    if (map == 1) { const int tile = n0 >> 8, c = n0 & 255; ns = c < 128 ? tile * 128 + c : DFF + tile * 128 + (c - 128); }
#pragma unroll 8
    for (int i = 0; i < 32; ++i) { const int kk = 2 * i + (lane >> 5); float v = W[(size_t)(k0 + kk) * ldw + ns + (lane & 31)]; if (gain) v *= gain[k0 + kk]; scr[kk * 33 + (lane & 31)] = v; }
    asm volatile("s_waitcnt lgkmcnt(0)" ::: "memory");
    const int c = lane & 7;
#pragma unroll
    for (int j = 0; j < 4; ++j) { const int n = (lane >> 3) + 8 * j; const LAS float* s = scr + (8 * c) * 33 + n;
        u32x4 o; o.x = cvt_pk_bf16(s[0 * 33], s[1 * 33]); o.y = cvt_pk_bf16(s[2 * 33], s[3 * 33]); o.z = cvt_pk_bf16(s[4 * 33], s[5 * 33]); o.w = cvt_pk_bf16(s[6 * 33], s[7 * 33]);
        *(u32x4*)(WT + (size_t)(n0 + n) * ldd + k0 + 8 * c) = o; }
    asm volatile("s_waitcnt lgkmcnt(0)" ::: "memory");
}

__device__ __forceinline__ void phase_prep(const Args& a, LAS unsigned char* lds, int wave, int G) {
    const int lane = lane_id();
    unsigned char* ws = a.ws;
    LAS float* scr = (LAS float*)(lds + wave * 16384);
    const int gw = blockIdx.x * 8 + wave, NGW = G * 8;
#define TJOB(W_, ldw_, K_, Nd_, dst_, gain_, map_, srcofs_) do { const int nitems = ((K_) / 64) * ((Nd_) / 32); \
        for (int it = gw; it < nitems; it += NGW) transpose_item((W_), (ldw_), (K_), (bf16_t*)(ws + (dst_)), (K_), (gain_), (map_), (srcofs_), scr, it, lane); } while (0)
    TJOB(a.in[I_WIN], PIN, 1024, PIN, WS_WIN, a.in[I_NMIXG], 0, 0);
    TJOB(a.in[I_WBA], 1024, 512, 1024, WS_WA, nullptr, 0, 0);
    TJOB(a.in[I_WBB], 1024, 512, 1024, WS_WB, nullptr, 0, 0);
    TJOB(a.in[I_WMIX], 1024, 1024, 1024, WS_WMIX, nullptr, 0, 0);
    TJOB(a.in[I_WCQ], 1024, 1024, 1024, WS_WCQ, a.in[I_NXG], 0, 0);
    TJOB(a.in[I_WCKV], 2048, 1024, 1024, WS_WK, nullptr, 0, 0);
    TJOB(a.in[I_WCKV], 2048, 1024, 1024, WS_WV, nullptr, 0, 1024);
    TJOB(a.in[I_WCO], 1024, 1024, 1024, WS_WCO, nullptr, 0, 0);
    TJOB(a.in[I_WFFI], 2 * DFF, 1024, 2 * DFF, WS_WFFI, a.in[I_NFFNG], 1, 0);
    TJOB(a.in[I_WFFO], 1024, DFF, 1024, WS_WFFO, nullptr, 0, 0);
#undef TJOB
    const int gid = blockIdx.x * 512 + wave * 64 + lane, NT = G * 512;
    { bf16_t* WL = (bf16_t*)(ws + WS_WLORA);
      for (int i = gid; i < 1536 * 256; i += NT) { const int n = i >> 8, k = i & 255, kind = n >> 9, c = n & 511; float v = 0.f;
          if (kind == 0 && k < 64) v = a.in[I_WUP][k * 512 + c]; else if (kind == 1 && k >= 64 && k < 128) v = a.in[I_AUP][(k - 64) * 512 + c]; else if (kind == 2 && k >= 128) v = a.in[I_GUP][(k - 128) * 512 + c];
          WL[i] = f2bf(v); } }
    { bf16_t* WR = (bf16_t*)(ws + WS_WRG);
      for (int i = gid; i < 1024 * 512; i += NT) { const int n = i >> 9, k = i & 511, pn = n >> 8, c = n & 255, ch = pn * 128 + (c & 127), hb = ch >> 6, j = ch & 63; float v = 0.f;
          if ((k >> 6) == hb) v = (c < 128 ? a.in[I_WRGA] : a.in[I_WRGX])[(hb * 64 + (k & 63)) * 64 + j];
          WR[i] = f2bf(v); } }
    { const float* x = a.in[I_X]; bf16_t* XB = (bf16_t*)(ws + WS_XB); float* rstd = (float*)(ws + WS_RSTDX);
      for (int r = gw; r < T; r += NGW) { const f32x4* xr = (const f32x4*)(x + (size_t)r * D) + lane; f32x4 v[4]; float s = 0.f;
#pragma unroll
          for (int j = 0; j < 4; ++j) { v[j] = xr[64 * j]; s += (v[j].x * v[j].x + v[j].y * v[j].y) + (v[j].z * v[j].z + v[j].w * v[j].w); }
          s = wave_sum(s); if (lane == 0) rstd[r] = rsqrtf(s * (1.0f / D) + NORM_EPS);
          u32x2* o = (u32x2*)(XB + (size_t)r * D) + lane;
#pragma unroll
          for (int j = 0; j < 4; ++j) { u32x2 w; w.x = cvt_pk_bf16(v[j].x, v[j].y); w.y = cvt_pk_bf16(v[j].z, v[j].w); o[64 * j] = w; } } }
    { const float* x = a.in[I_MEM]; bf16_t* XB = (bf16_t*)(ws + WS_MEMN); const float* g = a.in[I_NMEMG];
      for (int r = gw; r < TM; r += NGW) { const f32x4* xr = (const f32x4*)(x + (size_t)r * D) + lane; f32x4 v[4]; float s = 0.f;
#pragma unroll
          for (int j = 0; j < 4; ++j) { v[j] = xr[64 * j]; s += (v[j].x * v[j].x + v[j].y * v[j].y) + (v[j].z * v[j].z + v[j].w * v[j].w); }
          s = wave_sum(s); const float rs = rsqrtf(s * (1.0f / D) + NORM_EPS);
          u32x2* o = (u32x2*)(XB + (size_t)r * D) + lane;
#pragma unroll
          for (int j = 0; j < 4; ++j) { const f32x4 gg = ((const f32x4*)g)[lane + 64 * j]; u32x2 w; w.x = cvt_pk_bf16(v[j].x * rs * gg.x, v[j].y * rs * gg.y); w.y = cvt_pk_bf16(v[j].z * rs * gg.z, v[j].w * rs * gg.w); o[64 * j] = w; } } }
}

__device__ __forceinline__ void phase_elem2(const Args& a, int wave, int G) {
    unsigned char* ws = a.ws;
    const bf16_t* PR = (const bf16_t*)(ws + WS_PR); const bf16_t* PX = (const bf16_t*)(ws + WS_PX);
    bf16_t* LIN = (bf16_t*)(ws + WS_LIN); bf16_t* XBC = (bf16_t*)(ws + WS_XBC);
    const float* mu = a.in[I_MU]; const float* cw = a.in[I_CBW]; const float* cb = a.in[I_CBB];
    const size_t gid = (size_t)blockIdx.x * 512 + wave * 64 + lane_id(), NT = (size_t)G * 512;
    for (size_t i = gid; i < (size_t)T * 96; i += NT) {
        const int t = (int)(i / 96), q = (int)(i % 96), tl = t & (SEQ - 1);
        if (q < 32) { const int c = q * 8; float p[8], pp[8], o[8];
            unpack8(*(const u32x4*)(PR + (size_t)t * RW + 1536 + c), p);
            if (tl > 0) unpack8(*(const u32x4*)(PR + (size_t)(t - 1) * RW + 1536 + c), pp); else {
#pragma unroll
                for (int j = 0; j < 8; ++j) pp[j] = 0.f; }
#pragma unroll
            for (int j = 0; j < 8; ++j) { const float v = p[j] + (pp[j] - p[j]) * mu[1536 + c + j];
                o[j] = c < 64 ? tanhf(v) : (c < 128 ? v : sigmoidf_(v)); }
            *(u32x4*)(LIN + (size_t)t * 256 + c) = pack8(o);
        } else { const int c = (q - 32) * 8; float o[8];
#pragma unroll
            for (int j = 0; j < 8; ++j) o[j] = cb[c + j];
#pragma unroll
            for (int k = 0; k < 4; ++k) { const int dt = 3 - k; if (tl >= dt) { float p[8]; unpack8(*(const u32x4*)(PX + (size_t)(t - dt) * 512 + c), p);
#pragma unroll
                for (int j = 0; j < 8; ++j) o[j] += p[j] * cw[k * 512 + c + j]; } }
            *(u32x4*)(XBC + (size_t)t * 512 + c) = pack8(o);
        }
    }
}

#define DPP_BC(JJ) " row_newbcast:" #JJ " row_mask:0xf bank_mask:0xf"
#define RW_SA(JJ)  asm("v_fmac_f32_dpp %0, %1, %2" DPP_BC(JJ) : "+v"(sacc[JJ & 3]) : "v"(va), "v"(S[JJ]));
#define RW_UPD(JJ) { float t_; \
    asm("v_mul_f32_dpp %0, %1, %2" DPP_BC(JJ) : "=v"(t_) : "v"(vb), "v"(sa)); \
    asm("v_fmac_f32_dpp %0, %1, %2" DPP_BC(JJ) : "+v"(t_) : "v"(vk), "v"(vv)); \
    asm("v_fmac_f32_dpp %0, %1, %2" DPP_BC(JJ) : "+v"(t_) : "v"(vw), "v"(S[JJ])); \
    S[JJ] = t_; \
    asm("v_fmac_f32_dpp %0, %1, %2" DPP_BC(JJ) : "+v"(yacc[JJ & 3]) : "v"(vr), "v"(S[JJ])); }
#define RW_ALL16(M) M(0) M(1) M(2) M(3) M(4) M(5) M(6) M(7) M(8) M(9) M(10) M(11) M(12) M(13) M(14) M(15)

constexpr int RB = 16;
constexpr int RSTG = RB * 5 * 128;

__device__ __forceinline__ void rwkv_stage(LAS unsigned char* buf, const bf16_t* PR, const bf16_t* LOUT, int tok0, int h, int lane) {
    const int s = lane >> 3, ch = (lane & 7) * 8;
#pragma unroll
    for (int v = 0; v < 5; ++v) {
        const bf16_t* src = v < 3 ? PR + (size_t)tok0 * RW + v * 512 + h * 64 : LOUT + (size_t)tok0 * 1536 + (v - 3) * 512 + h * 64;
        const size_t ld = v < 3 ? RW : 1536;
#pragma unroll
        for (int hf = 0; hf < RB / 8; ++hf)
            __builtin_amdgcn_global_load_lds((const unsigned*)(src + (size_t)(hf * 8 + s) * ld + ch), (LAS unsigned*)(buf + v * (RB * 128) + hf * 1024), 16, 0, 0);
    }
}

__device__ __forceinline__ void phase_scan(const Args& a, LAS unsigned char* lds, int wave, int G) {
    const int lane = lane_id();
    unsigned char* ws = a.ws;
    const bf16_t* PR = (const bf16_t*)(ws + WS_PR); const bf16_t* LOUT = (const bf16_t*)(ws + WS_LOUT);
    for (int pair = blockIdx.x; pair < 256; pair += G) {
        const int b = pair >> 3, h = pair & 7;
        if (wave < 4) {
            const int wq = wave, il = lane & 15, irow = 16 * wq + il;
            const float mu_r = a.in[I_MU][h * 64 + lane], mu_k = a.in[I_MU][512 + h * 64 + lane], mu_v = a.in[I_MU][1024 + h * 64 + irow];
            const float ckk = a.in[I_KK][h * 64 + lane], cka = a.in[I_KA][h * 64 + lane], crk = a.in[I_RK][h * 64 + lane];
            bf16_t* YRAW = (bf16_t*)(ws + WS_YRAW); float* BON = (float*)(ws + WS_BON);
            LAS unsigned char* stg = lds + wave * (2 * RSTG);
            float S[16];
#pragma unroll
            for (int j = 0; j < 16; ++j) S[j] = 0.f;
            float pr_ = 0.f, pk_ = 0.f, pv_ = 0.f;
            const int tokb = b * SEQ;
            rwkv_stage(stg, PR, LOUT, tokb, h, lane);
            for (int blk = 0; blk < SEQ / RB; ++blk) {
                asm volatile("s_waitcnt vmcnt(0)" ::: "memory");
                LAS unsigned char* cur = stg + (blk & 1) * RSTG;
                if (blk + 1 < SEQ / RB) rwkv_stage(stg + ((blk + 1) & 1) * RSTG, PR, LOUT, tokb + (blk + 1) * RB, h, lane);
                asm volatile("" ::: "memory");
#pragma unroll 2
                for (int s = 0; s < RB; ++s) {
                    const LAS bf16_t* row = (const LAS bf16_t*)(cur + s * 128);
                    const float rr = bf1(row[lane]), kr = bf1(row[RB * 64 + lane]), vr_ = bf1(row[2 * RB * 64 + irow]), e = bf1(row[3 * RB * 64 + lane]), av = bf1(row[4 * RB * 64 + lane]);
                    float vr = rr + (pr_ - rr) * mu_r; const float k0 = kr + (pk_ - kr) * mu_k; const float vv = vr_ + (pv_ - vr_) * mu_v;
                    pr_ = rr; pk_ = kr; pv_ = vr_;
                    float vw = __expf(-e);
                    const float kk = k0 * ckk; const float n2 = wave_sum(kk * kk); const float kkn = kk / fmaxf(sqrtf(n2), 1e-12f);
                    float vk = k0 * (1.0f + (av - 1.0f) * cka);
                    float va = -kkn, vb = kkn * av;
                    const float bon = wave_sum(vr * vk * crk);
                    asm volatile("s_nop 1" : "+v"(va), "+v"(vb), "+v"(vk), "+v"(vw), "+v"(vr));
                    float sacc[4] = {0.f, 0.f, 0.f, 0.f}, yacc[4] = {0.f, 0.f, 0.f, 0.f};
                    RW_ALL16(RW_SA)
                    float sa = (sacc[0] + sacc[1]) + (sacc[2] + sacc[3]);
                    sa += __shfl_xor(sa, 16); sa += __shfl_xor(sa, 32);
                    RW_ALL16(RW_UPD)
                    float y = (yacc[0] + yacc[1]) + (yacc[2] + yacc[3]);
                    y += __shfl_xor(y, 16); y += __shfl_xor(y, 32);
                    const int tok = tokb + blk * RB + s;
                    if (lane < 16) YRAW[(size_t)tok * 512 + h * 64 + irow] = f2bf(y);
                    if (wq == 0 && lane == 0) BON[(size_t)tok * 8 + h] = bon;
                }
            }
            asm volatile("s_waitcnt vmcnt(0)" ::: "memory");
        } else if (wave == 4) {
            const int ch = h * 64 + lane; const size_t base = (size_t)b * SEQ * 512 + ch;
            const bf16_t* LA = (const bf16_t*)(ws + WS_RGLA) + base; const bf16_t* U = (const bf16_t*)(ws + WS_RGU) + base; const bf16_t* PY = (const bf16_t*)(ws + WS_PY) + base;
            bf16_t* YB = (bf16_t*)(ws + WS_YB) + base;
            constexpr int SB = 16;
            bf16_t cla[SB], cu[SB], cpy[SB], nla[SB], nu[SB], npy[SB];
#pragma unroll
            for (int s = 0; s < SB; ++s) { cla[s] = LA[(size_t)s * 512]; cu[s] = U[(size_t)s * 512]; cpy[s] = PY[(size_t)s * 512]; }
            float hh = 0.f;
            for (int t0 = 0; t0 < SEQ; t0 += SB) {
                const int tn = (t0 + SB < SEQ) ? t0 + SB : t0;
#pragma unroll
                for (int s = 0; s < SB; ++s) { nla[s] = LA[(size_t)(tn + s) * 512]; nu[s] = U[(size_t)(tn + s) * 512]; npy[s] = PY[(size_t)(tn + s) * 512]; }
#pragma unroll
                for (int s = 0; s < SB; ++s) { hh = __expf(bf1(cla[s])) * hh + bf1(cu[s]); YB[(size_t)(t0 + s) * 512] = f2bf(hh * gelu_tanh(bf1(cpy[s]))); }
#pragma unroll
                for (int s = 0; s < SB; ++s) { cla[s] = nla[s]; cu[s] = nu[s]; cpy[s] = npy[s]; }
            }
        }
    }
}

__device__ __forceinline__ void phase_post(const Args& a, int wave, int G) {
    unsigned char* ws = a.ws;
    const bf16_t* PR = (const bf16_t*)(ws + WS_PR); const bf16_t* LOUT = (const bf16_t*)(ws + WS_LOUT); const bf16_t* YRAW = (const bf16_t*)(ws + WS_YRAW);
    const float* BON = (const float*)(ws + WS_BON); bf16_t* YA = (bf16_t*)(ws + WS_YA);
    const float* mu = a.in[I_MU]; const float* lg = a.in[I_LNXG]; const float* lb = a.in[I_LNXB];
    const size_t gid = (size_t)blockIdx.x * 512 + wave * 64 + lane_id(), NT = (size_t)G * 512;
    for (size_t i = gid; i < (size_t)T * 64; i += NT) {
        const int t = (int)(i >> 6), c = (int)(i & 63) * 8, h = c >> 6, tl = t & (SEQ - 1);
        float y[8], v[8], vp[8], g[8], o[8];
        unpack8(*(const u32x4*)(YRAW + (size_t)t * 512 + c), y);
        unpack8(*(const u32x4*)(PR + (size_t)t * RW + 1024 + c), v);
        if (tl > 0) unpack8(*(const u32x4*)(PR + (size_t)(t - 1) * RW + 1024 + c), vp); else {
#pragma unroll
            for (int j = 0; j < 8; ++j) vp[j] = 0.f; }
        unpack8(*(const u32x4*)(LOUT + (size_t)t * 1536 + 1024 + c), g);
        float s = 0.f;
#pragma unroll
        for (int j = 0; j < 8; ++j) s += y[j];
        s += __shfl_xor(s, 1); s += __shfl_xor(s, 2); s += __shfl_xor(s, 4);
        const float mean = s * (1.0f / 64.0f); float q = 0.f;
#pragma unroll
        for (int j = 0; j < 8; ++j) { const float d = y[j] - mean; q += d * d; }
        q += __shfl_xor(q, 1); q += __shfl_xor(q, 2); q += __shfl_xor(q, 4);
        const float rs = rsqrtf(q * (1.0f / 64.0f) + LNX_EPS), bon = BON[(size_t)t * 8 + h];
#pragma unroll
        for (int j = 0; j < 8; ++j) { const float vv = v[j] + (vp[j] - v[j]) * mu[1024 + c + j];
            o[j] = ((y[j] - mean) * rs * lg[c + j] + lb[c + j] + bon * vv) * g[j]; }
        *(u32x4*)(YA + (size_t)t * 512 + c) = pack8(o);
    }
}

__device__ __forceinline__ void phase_ffnact(const Args& a, int wave, int G) {
    unsigned char* ws = a.ws;
    const bf16_t* UG = (const bf16_t*)(ws + WS_UG); bf16_t* UU = (bf16_t*)(ws + WS_UU);
    const float* cw = a.in[I_FCW]; const float* cb = a.in[I_FCB];
    const size_t gid = (size_t)blockIdx.x * 512 + wave * 64 + lane_id(), NT = (size_t)G * 512;
    constexpr int CPR = DFF / 8;
    for (size_t i = gid; i < (size_t)T * CPR; i += NT) {
        const int t = (int)(i / CPR), c = (int)(i % CPR) * 8, tl = t & (SEQ - 1);
        float o[8], p[8], uu[8];
#pragma unroll
        for (int j = 0; j < 8; ++j) o[j] = cb[c + j];
#pragma unroll
        for (int k = 0; k < 3; ++k) { const int dt = 2 - k; if (tl >= dt) { unpack8(*(const u32x4*)(UG + (size_t)(t - dt) * DFF + c), p);
#pragma unroll
            for (int j = 0; j < 8; ++j) o[j] += p[j] * cw[k * DFF + c + j]; } }
        unpack8(*(const u32x4*)(UU + (size_t)t * DFF + c), uu);
#pragma unroll
        for (int j = 0; j < 8; ++j) o[j] = gelu_tanh(o[j]) * uu[j];
        *(u32x4*)(UU + (size_t)t * DFF + c) = pack8(o);
    }
}

__device__ __forceinline__ void phase_final(const Args& a, int wave, int G) {
    const int lane = lane_id();
    const float* ssp = (const float*)(a.ws + WS_SSP3); const float* g = a.in[I_NFING];
    const int gw = blockIdx.x * 8 + wave, NGW = G * 8;
    for (int r = gw; r < T; r += NGW) { const float rs = rstd_from16(ssp, r); f32x4* xr = (f32x4*)(a.out + (size_t)r * D) + lane;
#pragma unroll
        for (int j = 0; j < 4; ++j) { const f32x4 gg = ((const f32x4*)g)[lane + 64 * j]; f32x4 v = xr[64 * j]; v = v * rs * gg; xr[64 * j] = v; } }
}

constexpr int NPHASE = 17;
__global__ void __launch_bounds__(512, 2) mega(Args a) {
    extern __shared__ __attribute__((aligned(16))) unsigned char lds_raw[];
    LAS unsigned char* lds = (LAS unsigned char*)lds_raw;
    cg::grid_group grid = cg::this_grid();
    const int wave = __builtin_amdgcn_readfirstlane((int)threadIdx.x >> 6), G = gridDim.x, bid = blockIdx.x;
    unsigned char* ws = a.ws;
    const int lo = a.ph_lo, hi = a.ph_hi;
#define IN(k) (lo <= (k) && (k) < hi)
#define SEAM(k) do { if (IN(k) && IN((k) + 1)) grid.sync(); } while (0)
    bf16_t* const XB = (bf16_t*)(ws + WS_XB);
    const float* rstdx = (const float*)(ws + WS_RSTDX);
    StaticOrder S;

    if (IN(0)) { phase_prep(a, lds, wave, G); __syncthreads(); } SEAM(0);

    if (IN(1)) {
        { Gemm g = plain_gemm(XB, (const bf16_t*)(ws + WS_WIN), 1024); S.init(T / BM, 11, G, bid);
          EpiProj E{rstdx, a.in[I_BIN], (bf16_t*)(ws + WS_PR), (bf16_t*)(ws + WS_PX), (bf16_t*)(ws + WS_PY)}; gemm_phase(lds, wave, g, S, E); }
        { Gemm g = plain_gemm((const bf16_t*)(ws + WS_MEMN), (const bf16_t*)(ws + WS_WK), 1024); S.init(TM / BM, 4, G, bid);
          EpiPlain E{(bf16_t*)(ws + WS_KM), 1024}; gemm_phase(lds, wave, g, S, E); }
        { Gemm g = plain_gemm((const bf16_t*)(ws + WS_WV), (const bf16_t*)(ws + WS_MEMN), 1024); S.init(4, TM / BM, G, bid);
          EpiPlain E{(bf16_t*)(ws + WS_VT), TM}; gemm_phase(lds, wave, g, S, E); }
    } SEAM(1);

    if (IN(2)) phase_elem2(a, wave, G); SEAM(2);

    if (IN(3)) {
        { Gemm g = plain_gemm((const bf16_t*)(ws + WS_LIN), (const bf16_t*)(ws + WS_WLORA), 256); S.init(T / BM, 6, G, bid);
          EpiLora E{a.in[I_W0], a.in[I_A0], (bf16_t*)(ws + WS_LOUT)}; gemm_phase(lds, wave, g, S, E); }
        { Gemm g = plain_gemm((const bf16_t*)(ws + WS_XBC), (const bf16_t*)(ws + WS_WRG), 512); S.init(T / BM, 4, G, bid);
          EpiRg E{a.in[I_BRGA], a.in[I_BRGX], a.in[I_LAM], (const bf16_t*)(ws + WS_XBC), (bf16_t*)(ws + WS_RGLA), (bf16_t*)(ws + WS_RGU)}; gemm_phase(lds, wave, g, S, E); }
    } SEAM(3);

    if (IN(4)) phase_scan(a, lds, wave, G); SEAM(4);
    if (IN(5)) phase_post(a, wave, G); SEAM(5);

    if (IN(6)) {
        Gemm g = plain_gemm(XB, (const bf16_t*)(ws + WS_WIN) + (size_t)2816 * 1024, 1024); S.init(T / BM, 8, G, bid);
        EpiGab E{rstdx, a.in[I_BIN] + 2816, (bf16_t*)(ws + WS_GAB)}; gemm_phase(lds, wave, g, S, E);
    } SEAM(6);
    if (IN(7)) { Gemm g = plain_gemm((const bf16_t*)(ws + WS_YA), (const bf16_t*)(ws + WS_WA), 512); S.init(T / BM, 4, G, bid);
        EpiBranch<true> E{(const bf16_t*)(ws + WS_GAB), (bf16_t*)(ws + WS_MERGED)}; gemm_phase(lds, wave, g, S, E); } SEAM(7);
    if (IN(8)) { Gemm g = plain_gemm((const bf16_t*)(ws + WS_YB), (const bf16_t*)(ws + WS_WB), 512); S.init(T / BM, 4, G, bid);
        EpiBranch<false> E{(const bf16_t*)(ws + WS_GAB), (bf16_t*)(ws + WS_MERGED)}; gemm_phase(lds, wave, g, S, E); } SEAM(8);
    if (IN(9)) { Gemm g = plain_gemm((const bf16_t*)(ws + WS_MERGED), (const bf16_t*)(ws + WS_WMIX), 1024); S.init(T / BM, 4, G, bid);
        EpiRes<true> E{a.in[I_X], a.out, (bf16_t*)(ws + WS_X1B), (float*)(ws + WS_SSP1)}; gemm_phase(lds, wave, g, S, E); } SEAM(9);
    if (IN(10)) { Gemm g = plain_gemm((const bf16_t*)(ws + WS_X1B), (const bf16_t*)(ws + WS_WCQ), 1024); S.init(T / BM, 4, G, bid);
        EpiQ E{(const float*)(ws + WS_SSP1), (bf16_t*)(ws + WS_Q)}; gemm_phase(lds, wave, g, S, E); } SEAM(10);
    if (IN(11)) {
        Gemm g; g.A = (const bf16_t*)(ws + WS_Q); g.Bt = (const bf16_t*)(ws + WS_KM); g.lda = 1024; g.ldb = 1024; g.K = 256;
        g.a_pm = (size_t)BM * 1024 * 2; g.a_pn = 512; g.b_pn = 512; g.b_pb = (size_t)NMEM * 1024 * 2; S.init(T / BM, 4, G, bid);
        EpiSc E{(bf16_t*)(ws + WS_PEXP), (float*)(ws + WS_SSPA)}; gemm_phase(lds, wave, g, S, E); } SEAM(11);
    if (IN(12)) {
        Gemm g; g.A = (const bf16_t*)(ws + WS_PEXP); g.Bt = (const bf16_t*)(ws + WS_VT); g.lda = 1024; g.ldb = TM; g.K = 256;
        g.a_pm = (size_t)BM * 1024 * 2; g.a_pn = 512; g.b_pn = (size_t)256 * TM * 2; g.b_pb = 512; S.init(T / BM, 4, G, bid);
        EpiPv E{(const float*)(ws + WS_SSPA), (bf16_t*)(ws + WS_O)}; gemm_phase(lds, wave, g, S, E); } SEAM(12);
    if (IN(13)) { Gemm g = plain_gemm((const bf16_t*)(ws + WS_O), (const bf16_t*)(ws + WS_WCO), 1024); S.init(T / BM, 4, G, bid);
        EpiRes<true> E{a.out, a.out, (bf16_t*)(ws + WS_X2B), (float*)(ws + WS_SSP2)}; gemm_phase(lds, wave, g, S, E); } SEAM(13);
    if (IN(14)) { Gemm g = plain_gemm((const bf16_t*)(ws + WS_X2B), (const bf16_t*)(ws + WS_WFFI), 1024); S.init(T / BM, 22, G, bid);
        EpiFfnIn E{(const float*)(ws + WS_SSP2), (bf16_t*)(ws + WS_UG), (bf16_t*)(ws + WS_UU)}; gemm_phase(lds, wave, g, S, E); } SEAM(14);
    if (IN(15)) phase_ffnact(a, wave, G); SEAM(15);
    if (IN(16)) { Gemm g = plain_gemm((const bf16_t*)(ws + WS_UU), (const bf16_t*)(ws + WS_WFFO), DFF); S.init(T / BM, 4, G, bid);
        EpiRes<false> E{a.out, a.out, nullptr, (float*)(ws + WS_SSP3)}; gemm_phase(lds, wave, g, S, E); } SEAM(16);
    if (IN(17)) phase_final(a, wave, G);
#undef IN
#undef SEAM
}

extern "C" void kernel_launch(void* const* d_in, const int* in_sizes, int n_in, void* d_out, int out_size, void* d_ws, size_t ws_size, hipStream_t stream) {
    static int grid = 0;
    if (grid == 0) {
        if (n_in != 37 || in_sizes[0] != T * D || out_size != T * D || ws_size < WS_END) {
            fprintf(stderr, "kernel_launch: unexpected shapes (n_in %d, in0 %d, out %d, ws %zu < %zu); nothing launched\n", n_in, n_in > 0 ? in_sizes[0] : -1, out_size, ws_size, (size_t)WS_END); grid = -1; return; }
        int dev = 0, cus = 0, per_cu = 0;
        if (hipGetDevice(&dev) != hipSuccess || hipDeviceGetAttribute(&cus, hipDeviceAttributeMultiprocessorCount, dev) != hipSuccess) { grid = -1; return; }
        if (hipFuncSetAttribute((const void*)mega, hipFuncAttributeMaxDynamicSharedMemorySize, LDS_BYTES) != hipSuccess) { fprintf(stderr, "kernel_launch: hipFuncSetAttribute failed\n"); grid = -1; return; }
        if (hipOccupancyMaxActiveBlocksPerMultiprocessor(&per_cu, (const void*)mega, 512, LDS_BYTES) != hipSuccess || per_cu < 1) { fprintf(stderr, "kernel_launch: occupancy query says %d\n", per_cu); per_cu = 1; }
        (void)hipGetLastError();
        grid = cus * 1;
    }
    if (grid < 0) return;
    Args a{};
    for (int i = 0; i < 37; ++i) a.in[i] = (const float*)d_in[i];
    a.out = (float*)d_out; a.ws = (unsigned char*)d_ws;
#if MK_SPLIT
    for (int ph = 0; ph <= NPHASE; ++ph) {
        a.ph_lo = ph; a.ph_hi = ph + 1; void* args[] = {&a};
        hipError_t e = hipLaunchCooperativeKernel((const void*)mega, dim3(grid), dim3(512), args, LDS_BYTES, stream);
        if (e != hipSuccess) { fprintf(stderr, "kernel_launch: launch of phase %d failed: %s\n", ph, hipGetErrorString(e)); break; }
    }
#else
    a.ph_lo = 0; a.ph_hi = NPHASE + 1; void* args[] = {&a};
    hipError_t e = hipLaunchCooperativeKernel((const void*)mega, dim3(grid), dim3(512), args, LDS_BYTES, stream);
    if (e != hipSuccess) fprintf(stderr, "kernel_launch: cooperative launch failed: %s (grid %d)\n", hipGetErrorString(e), grid);
#endif
}
```

```cpp
#include <hip/hip_runtime.h>
#include <hip/hip_cooperative_groups.h>
#include <cstdio>
namespace cg = cooperative_groups;

#ifndef MK_SPLIT
#define MK_SPLIT 0
#endif

#ifndef DUP_PHASE
#define DUP_PHASE -1
#endif
#define REPS(k) ((DUP_PHASE == (k)) ? 2 : 1)
#define LAS __attribute__((address_space(3)))
typedef unsigned short bf16_t;
typedef short bf16x8 __attribute__((ext_vector_type(8)));
typedef float f32x4 __attribute__((ext_vector_type(4)));
typedef float f32x2 __attribute__((ext_vector_type(2)));
typedef unsigned u32x4 __attribute__((ext_vector_type(4)));
typedef unsigned u32x2 __attribute__((ext_vector_type(2)));

constexpr int T = 65536, D = 1024, SEQ = 2048, NB = 32, NMEM = 256, TM = NB * NMEM;
constexpr int AW = 512, RW = 1792, PIN = 4864, DFF = 2816;
constexpr float NORM_EPS = 1e-6f, LNX_EPS = 64e-5f;

constexpr size_t MiB = 1u << 20;
constexpr size_t WS_WIN = 0;
constexpr size_t WS_WFFI = 10 * MiB;
constexpr size_t WS_WFFO = 21 * MiB;
constexpr size_t WS_WMIX = 27 * MiB, WS_WCQ = 29 * MiB, WS_WK = 31 * MiB, WS_WV = 33 * MiB, WS_WCO = 35 * MiB;
constexpr size_t WS_WA = 37 * MiB, WS_WB = 38 * MiB;
constexpr size_t WS_WLORA = 39 * MiB;
constexpr size_t WS_WRG = 40 * MiB;
constexpr size_t WS_RSTDX = 48 * MiB;
constexpr size_t WS_SSP1 = 49 * MiB, WS_SSP2 = 53 * MiB, WS_SSP3 = 57 * MiB, WS_SSPA = 61 * MiB;
constexpr size_t WS_BON = 65 * MiB;
constexpr size_t WS_MEMN = 68 * MiB, WS_KM = 84 * MiB, WS_VT = 100 * MiB;
constexpr size_t WS_XB = 120 * MiB;
constexpr size_t WS_PR = 248 * MiB;
constexpr size_t WS_PX = 472 * MiB, WS_PY = 536 * MiB;
constexpr size_t WS_LIN = 600 * MiB, WS_XBC = 632 * MiB;
constexpr size_t WS_LOUT = 696 * MiB;
constexpr size_t WS_RGLA = 888 * MiB, WS_RGU = 952 * MiB;
constexpr size_t WS_YRAW = WS_PX, WS_YB = WS_LIN, WS_YA = WS_RGLA;
constexpr size_t WS_GAB = 248 * MiB;
constexpr size_t WS_MERGED = 696 * MiB;
constexpr size_t WS_X1B = WS_XB, WS_Q = 248 * MiB, WS_PEXP = 376 * MiB, WS_O = 504 * MiB, WS_X2B = WS_XB;
constexpr size_t WS_UG = 248 * MiB, WS_UU = 600 * MiB;
constexpr size_t WS_END = 1016 * MiB;

constexpr int LDS_BYTES = 147456;

__device__ __forceinline__ unsigned cvt_pk_bf16(float lo, float hi) { unsigned r; asm("v_cvt_pk_bf16_f32 %0, %1, %2" : "=v"(r) : "v"(lo), "v"(hi)); return r; }
__device__ __forceinline__ float bf_lo(unsigned w) { return __uint_as_float(w << 16); }
__device__ __forceinline__ float bf_hi(unsigned w) { return __uint_as_float(w & 0xffff0000u); }
__device__ __forceinline__ float bf1(bf16_t b) { return __uint_as_float(((unsigned)b) << 16); }
__device__ __forceinline__ bf16_t f2bf(float f) { return (bf16_t)(cvt_pk_bf16(f, 0.f) & 0xffffu); }
__device__ __forceinline__ float sigmoidf_(float x) { return __builtin_amdgcn_rcpf(1.0f + __expf(-x)); }
__device__ __forceinline__ float gelu_tanh(float x) { const float z = 1.5957691216057308f * (x + 0.044715f * x * x * x); return x * sigmoidf_(z); }
__device__ __forceinline__ int lane_id() { int l; asm volatile("v_mbcnt_lo_u32_b32 %0, -1, 0\n\tv_mbcnt_hi_u32_b32 %0, -1, %0" : "=v"(l)); return l; }
__device__ __forceinline__ float wave_sum(float v) {
#pragma unroll
    for (int o = 1; o < 64; o <<= 1) v += __shfl_xor(v, o);
    return v;
}
__device__ __forceinline__ void unpack8(const u32x4 w, float (&f)[8]) {
    f[0] = bf_lo(w.x); f[1] = bf_hi(w.x); f[2] = bf_lo(w.y); f[3] = bf_hi(w.y); f[4] = bf_lo(w.z); f[5] = bf_hi(w.z); f[6] = bf_lo(w.w); f[7] = bf_hi(w.w);
}
__device__ __forceinline__ u32x4 pack8(const float (&f)[8]) {
    u32x4 w; w.x = cvt_pk_bf16(f[0], f[1]); w.y = cvt_pk_bf16(f[2], f[3]); w.z = cvt_pk_bf16(f[4], f[5]); w.w = cvt_pk_bf16(f[6], f[7]); return w;
}

constexpr int BM = 256, BK = 64, HALF = 128, HTB = HALF * BK * 2, NXCD = 8, WGM = 8;
__device__ __forceinline__ int lds_byte(int r, int c) { const int st = (r >> 4) * 2 + (c >> 5), rr = r & 15, cc = c & 31, ob = rr * 64 + cc * 2; return st * 1024 + (ob ^ (((ob >> 9) & 1) << 5)); }
__device__ __forceinline__ void stage_rc(int b, int& R, int& C) { const int st = b / 1024, sb = b % 1024, swz = sb ^ (((sb >> 9) & 1) << 5); R = (st >> 1) * 16 + swz / 64; C = (st & 1) * 32 + (swz % 64) / 2; }
__device__ __forceinline__ int perm32(int rho) { const int n = rho >> 4, i = rho & 15; return 8 * (i >> 2) + 4 * n + (i & 3); }

struct Unit { int pm, pn; };
struct Gemm { const bf16_t* A; const bf16_t* Bt; int lda, ldb, K; size_t a_pm, a_pn, b_pn, b_pb; };
__device__ __forceinline__ Gemm plain_gemm(const bf16_t* A, const bf16_t* Bt, int K) { Gemm g; g.A = A; g.Bt = Bt; g.lda = K; g.ldb = K; g.K = K; g.a_pm = (size_t)BM * K * 2; g.a_pn = 0; g.b_pn = (size_t)BM * K * 2; g.b_pb = 0; return g; }

struct StaticOrder {
    int nM, nN, nwg, G, c;
    __device__ void init(int nM_, int nN_, int G_, int c_) { nM = nM_; nN = nN_; nwg = nM * nN; G = G_; c = c_; }
    __device__ bool next(int i, Unit& u) const {
        const long L = (long)i * G + c; if (L >= nwg) return false;
        int wgid = (int)L; { const int q = nwg / NXCD, r = nwg % NXCD, xcd = wgid % NXCD, off = wgid / NXCD; wgid = (xcd < r ? xcd * (q + 1) : r * (q + 1) + (xcd - r) * q) + off; }
        const int nig = WGM * nN, gid = wgid / nig, fm = gid * WGM, gsz = (nM - fm) < WGM ? (nM - fm) : WGM;
        u.pm = fm + ((wgid % nig) % gsz); u.pn = (wgid % nig) / gsz; return true;
    }
};

typedef f32x4 Acc[2][2][4][2];

template <class Epi>
__device__ __forceinline__ void gemm_phase(LAS unsigned char* lds, const int wid, const Gemm g, const StaticOrder& S, const Epi& E) {
    const int lane = lane_id(), tid = wid * 64 + lane, wr = wid >> 2, wc = wid & 3, fr = lane & 15, fq = lane >> 4;
    const int nt = g.K / BK;
    unsigned voffA[2], voffB[2];
#pragma unroll
    for (int i = 0; i < 2; ++i) { int R, C; stage_rc(tid * 16 + i * 8192, R, C); const int Rb = Epi::PERM ? ((R & ~31) + perm32(R & 31)) : R;
        voffA[i] = (unsigned)(R * g.lda + C) * 2u; voffB[i] = (unsigned)(Rb * g.ldb + C) * 2u; }
    const size_t kstep = (size_t)(BK * 2);
    const size_t hstepA = (size_t)HALF * g.lda * 2, hstepB = (size_t)HALF * g.ldb * 2;
    const unsigned ldsw = (unsigned)wid * 1024u;
    const int aoff = lds_byte(wr * 64 + fr, fq * 8), boff = lds_byte(wc * 32 + fr, fq * 8);
#define PG8_SA(b, h) (((b) * 2 + (h)) * HTB)
#define PG8_SB(b, h) ((4 + (b) * 2 + (h)) * HTB)
#define PG8_STAGE(bufoff, gbase, voff) do { _Pragma("unroll") for (int _i = 0; _i < 2; ++_i) \
        __builtin_amdgcn_global_load_lds((const unsigned*)((const char*)(gbase) + (voff)[_i]), (LAS unsigned*)(lds + (bufoff) + ldsw + _i * 8192), 16, 0, 0); } while (0)
#define PG8_LDA(dst, b, h) do { _Pragma("unroll") for (int m = 0; m < 4; ++m) _Pragma("unroll") for (int k = 0; k < 2; ++k) dst[m][k] = *(const LAS bf16x8*)(lds + PG8_SA(b, h) + aoff + m * 2048 + k * 1024); } while (0)
#define PG8_LDB(dst, b, h) do { _Pragma("unroll") for (int n = 0; n < 2; ++n) _Pragma("unroll") for (int k = 0; k < 2; ++k) dst[n][k] = *(const LAS bf16x8*)(lds + PG8_SB(b, h) + boff + n * 2048 + k * 1024); } while (0)
#define PG8_MMA(ai, bj, At, Bt) do { __builtin_amdgcn_s_setprio(1); _Pragma("unroll") for (int m = 0; m < 4; ++m) _Pragma("unroll") for (int n = 0; n < 2; ++n) _Pragma("unroll") for (int k = 0; k < 2; ++k) \
        acc[ai][bj][m][n] = __builtin_amdgcn_mfma_f32_16x16x32_bf16(Bt[n][k], At[m][k], acc[ai][bj][m][n], 0, 0, 0); __builtin_amdgcn_s_setprio(0); } while (0)
#define PG8_WAIT_V(n) asm volatile("s_waitcnt vmcnt(" #n ")" ::: "memory")
#define PG8_WAIT_L(n) asm volatile("s_waitcnt lgkmcnt(" #n ")" ::: "memory")
#define PG8_BAR __builtin_amdgcn_s_barrier()
#define PG8_SCHED __builtin_amdgcn_sched_barrier(0)
#define PG8_UA(u) ((const char*)g.A + (size_t)(u).pm * g.a_pm + (size_t)(u).pn * g.a_pn)
#define PG8_UB(u) ((const char*)g.Bt + (size_t)(u).pn * g.b_pn + (size_t)((u).pm >> 3) * g.b_pb)
    Unit cur, nxt; int ui = 0;
    if (!S.next(0, cur)) return;
    Acc acc;
#pragma unroll
    for (int a = 0; a < 2; ++a)
#pragma unroll
        for (int b = 0; b < 2; ++b)
#pragma unroll
            for (int m = 0; m < 4; ++m)
#pragma unroll
                for (int n = 0; n < 2; ++n) acc[a][b][m][n] = (f32x4){0.f, 0.f, 0.f, 0.f};
    bf16x8 At[4][2], B0[2][2], B1[2][2];
    const char* cA = PG8_UA(cur); const char* cB = PG8_UB(cur);
    PG8_STAGE(PG8_SB(0, 0), cB, voffB); PG8_STAGE(PG8_SA(0, 0), cA, voffA); PG8_STAGE(PG8_SB(0, 1), cB + hstepB, voffB); PG8_STAGE(PG8_SA(0, 1), cA + hstepA, voffA);
    if (wr == 1) PG8_BAR;
    PG8_WAIT_V(4); PG8_BAR;
    PG8_STAGE(PG8_SB(1, 0), cB + kstep, voffB); PG8_STAGE(PG8_SA(1, 0), cA + kstep, voffA); PG8_STAGE(PG8_SB(1, 1), cB + hstepB + kstep, voffB);
    PG8_WAIT_V(6); PG8_BAR;
    for (;;) {
        const bool has_next = S.next(ui + 1, nxt);
        const char* nA = has_next ? PG8_UA(nxt) : cA; const char* nB = has_next ? PG8_UB(nxt) : cB;
        for (int t = 0; t < nt; t += 2) {
            const bool last = (t == nt - 2);
            const char* a1 = cA + (size_t)(t + 1) * kstep;
            const char* a2 = last ? nA : cA + (size_t)(t + 2) * kstep; const char* b2 = last ? nB : cB + (size_t)(t + 2) * kstep;
            const char* a3 = a2 + kstep; const char* b3 = b2 + kstep;
            PG8_LDB(B0, 0, 0); PG8_SCHED; PG8_LDA(At, 0, 0); PG8_STAGE(PG8_SA(1, 1), a1 + hstepA, voffA);
            PG8_WAIT_L(8); PG8_BAR; PG8_WAIT_L(0); PG8_MMA(0, 0, At, B0); PG8_BAR; PG8_SCHED;
            PG8_LDB(B1, 0, 1); PG8_STAGE(PG8_SB(0, 0), b2, voffB);
            PG8_BAR; PG8_WAIT_L(0); PG8_MMA(0, 1, At, B1); PG8_BAR;
            PG8_LDA(At, 0, 1); PG8_STAGE(PG8_SA(0, 0), a2, voffA);
            PG8_BAR; PG8_WAIT_L(0); PG8_MMA(1, 0, At, B0); PG8_BAR; PG8_SCHED;
            PG8_STAGE(PG8_SB(0, 1), b2 + hstepB, voffB);
            PG8_WAIT_V(6); PG8_BAR; PG8_MMA(1, 1, At, B1); PG8_BAR;
            PG8_LDB(B0, 1, 0); PG8_SCHED; PG8_LDA(At, 1, 0); PG8_STAGE(PG8_SA(0, 1), a2 + hstepA, voffA);
            PG8_WAIT_L(8); PG8_BAR; PG8_WAIT_L(0); PG8_MMA(0, 0, At, B0); PG8_BAR; PG8_SCHED;
            PG8_LDB(B1, 1, 1); PG8_STAGE(PG8_SB(1, 0), b3, voffB);
            PG8_BAR; PG8_WAIT_L(0); PG8_MMA(0, 1, At, B1); PG8_BAR;
            PG8_LDA(At, 1, 1); PG8_STAGE(PG8_SA(1, 0), a3, voffA);
            PG8_BAR; PG8_WAIT_L(0); PG8_MMA(1, 0, At, B0); PG8_BAR; PG8_SCHED;
            PG8_STAGE(PG8_SB(1, 1), b3 + hstepB, voffB);
            PG8_WAIT_V(6); PG8_BAR; PG8_MMA(1, 1, At, B1); PG8_BAR;
        }
        E(acc, cur, wr, wc, fr, fq);
        if (!has_next) break;
#pragma unroll
        for (int a = 0; a < 2; ++a)
#pragma unroll
            for (int b = 0; b < 2; ++b)
#pragma unroll
                for (int m = 0; m < 4; ++m)
#pragma unroll
                    for (int n = 0; n < 2; ++n) acc[a][b][m][n] = (f32x4){0.f, 0.f, 0.f, 0.f};
        cur = nxt; cA = nA; cB = nB; ++ui;
    }
    PG8_WAIT_V(0);
    if (wr == 0) PG8_BAR;
    PG8_BAR;
#undef PG8_SA
#undef PG8_SB
#undef PG8_STAGE
#undef PG8_LDA
#undef PG8_LDB
#undef PG8_MMA
#undef PG8_WAIT_V
#undef PG8_WAIT_L
#undef PG8_BAR
#undef PG8_SCHED
#undef PG8_UA
#undef PG8_UB
}

#define EPI_ROWS_BEGIN for (int ai = 0; ai < 2; ++ai) { _Pragma("unroll") for (int m = 0; m < 4; ++m) { const int r = u.pm * BM + ai * HALF + wr * 64 + m * 16 + fr;
#define EPI_ROWS_END } }

__device__ __forceinline__ float rstd_from16(const float* ssp, int r) {
    const f32x4* p = (const f32x4*)(ssp + (size_t)r * 16); const f32x4 a = p[0], b = p[1], c = p[2], d = p[3];
    const float s = ((a.x + a.y) + (a.z + a.w)) + ((b.x + b.y) + (b.z + b.w)) + ((c.x + c.y) + (c.z + c.w)) + ((d.x + d.y) + (d.z + d.w));
    return rsqrtf(s * (1.0f / 1024.0f) + NORM_EPS);
}

struct EpiProj { static constexpr bool PERM = true;
    const float* rstd; const float* bias; bf16_t* PR; bf16_t* PX; bf16_t* PY;
    __device__ __forceinline__ void operator()(const Acc& acc, const Unit& u, int wr, int wc, int fr, int fq) const {
        bf16_t* base; int ld, colt;
        if (u.pn < 7) { base = PR; ld = RW; colt = u.pn * 256; } else if (u.pn < 9) { base = PX; ld = 512; colt = (u.pn - 7) * 256; } else { base = PY; ld = 512; colt = (u.pn - 9) * 256; }
        const int col0 = colt + wc * 32 + 8 * fq, bcol0 = u.pn * 256 + wc * 32 + 8 * fq;
        f32x4 bv[2][2];
#pragma unroll
        for (int bj = 0; bj < 2; ++bj)
#pragma unroll
            for (int n = 0; n < 2; ++n) bv[bj][n] = *(const f32x4*)(bias + bcol0 + bj * HALF + 4 * n);
#pragma unroll
        EPI_ROWS_BEGIN
            const float rs = rstd[r]; bf16_t* rowp = base + (size_t)r * ld + col0;
#pragma unroll
            for (int bj = 0; bj < 2; ++bj) { const f32x4 v0 = acc[ai][bj][m][0] * rs + bv[bj][0], v1 = acc[ai][bj][m][1] * rs + bv[bj][1];
                u32x4 w; w.x = cvt_pk_bf16(v0[0], v0[1]); w.y = cvt_pk_bf16(v0[2], v0[3]); w.z = cvt_pk_bf16(v1[0], v1[1]); w.w = cvt_pk_bf16(v1[2], v1[3]);
                *(u32x4*)(rowp + bj * HALF) = w; }
        EPI_ROWS_END
    }
};
struct EpiGab { static constexpr bool PERM = true;
    const float* rstd; const float* bias; bf16_t* O;
    __device__ __forceinline__ void operator()(const Acc& acc, const Unit& u, int wr, int wc, int fr, int fq) const {
        const int col0 = u.pn * 256 + wc * 32 + 8 * fq;
        f32x4 bv[2][2];
#pragma unroll
        for (int bj = 0; bj < 2; ++bj)
#pragma unroll
            for (int n = 0; n < 2; ++n) bv[bj][n] = *(const f32x4*)(bias + col0 + bj * HALF + 4 * n);
#pragma unroll
        EPI_ROWS_BEGIN
            const float rs = rstd[r]; bf16_t* rowp = O + (size_t)r * 2048 + col0;
#pragma unroll
            for (int bj = 0; bj < 2; ++bj) { f32x4 v0 = acc[ai][bj][m][0] * rs + bv[bj][0], v1 = acc[ai][bj][m][1] * rs + bv[bj][1];
#pragma unroll
                for (int j = 0; j < 4; ++j) { v0[j] = sigmoidf_(v0[j]); v1[j] = sigmoidf_(v1[j]); }
                u32x4 w; w.x = cvt_pk_bf16(v0[0], v0[1]); w.y = cvt_pk_bf16(v0[2], v0[3]); w.z = cvt_pk_bf16(v1[0], v1[1]); w.w = cvt_pk_bf16(v1[2], v1[3]);
                *(u32x4*)(rowp + bj * HALF) = w; }
        EPI_ROWS_END
    }
};
struct EpiPlain { static constexpr bool PERM = true;
    bf16_t* O; int ldc;
    __device__ __forceinline__ void operator()(const Acc& acc, const Unit& u, int wr, int wc, int fr, int fq) const {
        const int col0 = u.pn * 256 + wc * 32 + 8 * fq;
#pragma unroll
        EPI_ROWS_BEGIN
            bf16_t* rowp = O + (size_t)r * ldc + col0;
#pragma unroll
            for (int bj = 0; bj < 2; ++bj) { const f32x4 v0 = acc[ai][bj][m][0], v1 = acc[ai][bj][m][1];
                u32x4 w; w.x = cvt_pk_bf16(v0[0], v0[1]); w.y = cvt_pk_bf16(v0[2], v0[3]); w.z = cvt_pk_bf16(v1[0], v1[1]); w.w = cvt_pk_bf16(v1[2], v1[3]);
                *(u32x4*)(rowp + bj * HALF) = w; }
        EPI_ROWS_END
    }
};
struct EpiLora { static constexpr bool PERM = true;
    const float* w0; const float* a0; bf16_t* O;
    __device__ __forceinline__ void operator()(const Acc& acc, const Unit& u, int wr, int wc, int fr, int fq) const {
        const int kind = u.pn >> 1, ch0 = (u.pn & 1) * 256 + wc * 32 + 8 * fq, col0 = u.pn * 256 + wc * 32 + 8 * fq;
        const float* bsrc = kind == 0 ? w0 : a0;
        f32x4 bv[2][2];
#pragma unroll
        for (int bj = 0; bj < 2; ++bj)
#pragma unroll
            for (int n = 0; n < 2; ++n) bv[bj][n] = kind < 2 ? *(const f32x4*)(bsrc + ch0 + bj * HALF + 4 * n) : (f32x4){0.f, 0.f, 0.f, 0.f};
        const float sc = kind == 0 ? 0.6065306597126334f : 1.0f;
#pragma unroll
        EPI_ROWS_BEGIN
            bf16_t* rowp = O + (size_t)r * 1536 + col0;
#pragma unroll
            for (int bj = 0; bj < 2; ++bj) { f32x4 v0 = acc[ai][bj][m][0] + bv[bj][0], v1 = acc[ai][bj][m][1] + bv[bj][1];
                if (kind < 2) {
#pragma unroll
                    for (int j = 0; j < 4; ++j) { v0[j] = sc * sigmoidf_(v0[j]); v1[j] = sc * sigmoidf_(v1[j]); } }
                u32x4 w; w.x = cvt_pk_bf16(v0[0], v0[1]); w.y = cvt_pk_bf16(v0[2], v0[3]); w.z = cvt_pk_bf16(v1[0], v1[1]); w.w = cvt_pk_bf16(v1[2], v1[3]);
                *(u32x4*)(rowp + bj * HALF) = w; }
        EPI_ROWS_END
    }
};
struct EpiRg { static constexpr bool PERM = true;
    const float* ba; const float* bx; const float* lam; const bf16_t* XBC; bf16_t* LA; bf16_t* U;
    __device__ __forceinline__ void operator()(const Acc& acc, const Unit& u, int wr, int wc, int fr, int fq) const {
        const int ch0 = u.pn * 128 + wc * 32 + 8 * fq;
        float vba[8], vbx[8], vls[8];
#pragma unroll
        for (int j = 0; j < 8; ++j) { vba[j] = ba[ch0 + j]; vbx[j] = bx[ch0 + j]; vls[j] = -8.0f * log1pf(__expf(-lam[ch0 + j])); }
#pragma unroll
        EPI_ROWS_BEGIN
            const bool first = (r & (SEQ - 1)) == 0;
            float xb[8]; unpack8(*(const u32x4*)(XBC + (size_t)r * 512 + ch0), xb);
            float la[8], uu[8];
#pragma unroll
            for (int j = 0; j < 8; ++j) { const float ga = sigmoidf_(acc[ai][0][m][j >> 2][j & 3] + vba[j]), gx = sigmoidf_(acc[ai][1][m][j >> 2][j & 3] + vbx[j]);
                la[j] = vls[j] * ga; const float a = __expf(la[j]); const float mult = first ? 1.0f : sqrtf(fmaxf(1.0f - a * a, 0.f)); uu[j] = xb[j] * gx * mult; }
            *(u32x4*)(LA + (size_t)r * 512 + ch0) = pack8(la); *(u32x4*)(U + (size_t)r * 512 + ch0) = pack8(uu);
        EPI_ROWS_END
    }
};
template <bool FIRST> struct EpiBranch { static constexpr bool PERM = true;
    const bf16_t* G; bf16_t* M;
    __device__ __forceinline__ void operator()(const Acc& acc, const Unit& u, int wr, int wc, int fr, int fq) const {
        const int col0 = u.pn * 256 + wc * 32 + 8 * fq;
#pragma unroll
        EPI_ROWS_BEGIN
#pragma unroll
            for (int bj = 0; bj < 2; ++bj) { const int c = col0 + bj * HALF;
                float gv[8]; unpack8(*(const u32x4*)(G + (size_t)r * 2048 + (FIRST ? 0 : 1024) + c), gv);
                float o[8];
                if (!FIRST) unpack8(*(const u32x4*)(M + (size_t)r * 1024 + c), o);
#pragma unroll
                for (int j = 0; j < 8; ++j) { const float p = acc[ai][bj][m][j >> 2][j & 3] * gv[j]; o[j] = FIRST ? p : o[j] + p; }
                *(u32x4*)(M + (size_t)r * 1024 + c) = pack8(o); }
        EPI_ROWS_END
    }
};
template <bool WB> struct EpiRes { static constexpr bool PERM = false;
    const float* base; float* out; bf16_t* XB; float* ssp;
    __device__ __forceinline__ void operator()(const Acc& acc, const Unit& u, int wr, int wc, int fr, int fq) const {
        const int col0 = u.pn * 256 + wc * 32 + 4 * fq;
#pragma unroll
        EPI_ROWS_BEGIN
            const size_t off = (size_t)r * 1024 + col0; float s = 0.f;
#pragma unroll
            for (int bj = 0; bj < 2; ++bj)
#pragma unroll
                for (int n = 0; n < 2; ++n) { const f32x4 bs = *(const f32x4*)(base + off + bj * HALF + n * 16); const f32x4 o = bs + acc[ai][bj][m][n];
                    *(f32x4*)(out + off + bj * HALF + n * 16) = o; s += (o[0] * o[0] + o[1] * o[1]) + (o[2] * o[2] + o[3] * o[3]);
                    if (WB) { u32x2 w; w.x = cvt_pk_bf16(o[0], o[1]); w.y = cvt_pk_bf16(o[2], o[3]); *(u32x2*)(XB + off + bj * HALF + n * 16) = w; } }
            s += __shfl_xor(s, 16); s += __shfl_xor(s, 32);
            if (fq == 0) ssp[(size_t)r * 16 + u.pn * 4 + wc] = s;
        EPI_ROWS_END
    }
};
struct EpiQ { static constexpr bool PERM = true;
    const float* ssp; bf16_t* O;
    __device__ __forceinline__ void operator()(const Acc& acc, const Unit& u, int wr, int wc, int fr, int fq) const {
        const int col0 = u.pn * 256 + wc * 32 + 8 * fq;
#pragma unroll
        EPI_ROWS_BEGIN
            const float rs = rstd_from16(ssp, r) * 0.0625f; bf16_t* rowp = O + (size_t)r * 1024 + col0;
#pragma unroll
            for (int bj = 0; bj < 2; ++bj) { const f32x4 v0 = acc[ai][bj][m][0] * rs, v1 = acc[ai][bj][m][1] * rs;
                u32x4 w; w.x = cvt_pk_bf16(v0[0], v0[1]); w.y = cvt_pk_bf16(v0[2], v0[3]); w.z = cvt_pk_bf16(v1[0], v1[1]); w.w = cvt_pk_bf16(v1[2], v1[3]);
                *(u32x4*)(rowp + bj * HALF) = w; }
        EPI_ROWS_END
    }
};
struct EpiSc { static constexpr bool PERM = true;
    bf16_t* O; float* ssp;
    __device__ __forceinline__ void operator()(const Acc& acc, const Unit& u, int wr, int wc, int fr, int fq) const {
        const int col0 = u.pn * 256 + wc * 32 + 8 * fq;
#pragma unroll
        EPI_ROWS_BEGIN
            bf16_t* rowp = O + (size_t)r * 1024 + col0; float s = 0.f;
#pragma unroll
            for (int bj = 0; bj < 2; ++bj) { f32x4 v0 = acc[ai][bj][m][0], v1 = acc[ai][bj][m][1];
#pragma unroll
                for (int j = 0; j < 4; ++j) { v0[j] = __expf(v0[j]); v1[j] = __expf(v1[j]); }
                s += ((v0[0] + v0[1]) + (v0[2] + v0[3])) + ((v1[0] + v1[1]) + (v1[2] + v1[3]));
                u32x4 w; w.x = cvt_pk_bf16(v0[0], v0[1]); w.y = cvt_pk_bf16(v0[2], v0[3]); w.z = cvt_pk_bf16(v1[0], v1[1]); w.w = cvt_pk_bf16(v1[2], v1[3]);
                *(u32x4*)(rowp + bj * HALF) = w; }
            s += __shfl_xor(s, 16); s += __shfl_xor(s, 32);
            if (fq == 0) ssp[(size_t)r * 16 + u.pn * 4 + wc] = s;
        EPI_ROWS_END
    }
};
struct EpiPv { static constexpr bool PERM = true;
    const float* ssp; bf16_t* O;
    __device__ __forceinline__ void operator()(const Acc& acc, const Unit& u, int wr, int wc, int fr, int fq) const {
        const int col0 = u.pn * 256 + wc * 32 + 8 * fq;
#pragma unroll
        EPI_ROWS_BEGIN
            const f32x4 sp = *(const f32x4*)(ssp + (size_t)r * 16 + u.pn * 4); const float rs = 1.0f / ((sp.x + sp.y) + (sp.z + sp.w));
            bf16_t* rowp = O + (size_t)r * 1024 + col0;
#pragma unroll
            for (int bj = 0; bj < 2; ++bj) { const f32x4 v0 = acc[ai][bj][m][0] * rs, v1 = acc[ai][bj][m][1] * rs;
                u32x4 w; w.x = cvt_pk_bf16(v0[0], v0[1]); w.y = cvt_pk_bf16(v0[2], v0[3]); w.z = cvt_pk_bf16(v1[0], v1[1]); w.w = cvt_pk_bf16(v1[2], v1[3]);
                *(u32x4*)(rowp + bj * HALF) = w; }
        EPI_ROWS_END
    }
};
struct EpiFfnIn { static constexpr bool PERM = true;
    const float* ssp; bf16_t* UG; bf16_t* UU;
    __device__ __forceinline__ void operator()(const Acc& acc, const Unit& u, int wr, int wc, int fr, int fq) const {
        const int col0 = u.pn * 128 + wc * 32 + 8 * fq;
#pragma unroll
        EPI_ROWS_BEGIN
            const float rs = rstd_from16(ssp, r);
#pragma unroll
            for (int bj = 0; bj < 2; ++bj) { const f32x4 v0 = acc[ai][bj][m][0] * rs, v1 = acc[ai][bj][m][1] * rs;
                u32x4 w; w.x = cvt_pk_bf16(v0[0], v0[1]); w.y = cvt_pk_bf16(v0[2], v0[3]); w.z = cvt_pk_bf16(v1[0], v1[1]); w.w = cvt_pk_bf16(v1[2], v1[3]);
                *(u32x4*)((bj ? UU : UG) + (size_t)r * DFF + col0) = w; }
        EPI_ROWS_END
    }
};

struct Args { const float* in[37]; float* out; unsigned char* ws; int ph_lo, ph_hi; };
enum { I_X = 0, I_MEM, I_NMIXG, I_WIN, I_BIN, I_MU, I_W0, I_WUP, I_A0, I_AUP, I_GUP, I_KK, I_KA, I_RK, I_LNXG, I_LNXB, I_WBA, I_CBW, I_CBB, I_WRGA, I_BRGA, I_WRGX, I_BRGX,
       I_LAM, I_WBB, I_WMIX, I_NXG, I_NMEMG, I_WCQ, I_WCKV, I_WCO, I_NFFNG, I_WFFI, I_FCW, I_FCB, I_WFFO, I_NFING };

__device__ __forceinline__ void transpose_item(const float* W, int ldw, int K, bf16_t* WT, int ldd, const float* gain, int map, int srcofs, LAS float* scr, int item, int lane) {
    const int nkb = K / 64, nb = item / nkb, kb = item % nkb, k0 = 64 * kb, n0 = 32 * nb;
    int ns = n0 + srcofs;
    if (map == 1) { const int tile = n0 >> 8, c = n0 & 255; ns = c < 128 ? tile * 128 + c : DFF + tile * 128 + (c - 128); }
#pragma unroll 8
    for (int i = 0; i < 32; ++i) { const int kk = 2 * i + (lane >> 5); float v = W[(size_t)(k0 + kk) * ldw + ns + (lane & 31)]; if (gain) v *= gain[k0 + kk]; scr[kk * 33 + (lane & 31)] = v; }
    asm volatile("s_waitcnt lgkmcnt(0)" ::: "memory");
    const int c = lane & 7;
#pragma unroll
    for (int j = 0; j < 4; ++j) { const int n = (lane >> 3) + 8 * j; const LAS float* s = scr + (8 * c) * 33 + n;
        u32x4 o; o.x = cvt_pk_bf16(s[0 * 33], s[1 * 33]); o.y = cvt_pk_bf16(s[2 * 33], s[3 * 33]); o.z = cvt_pk_bf16(s[4 * 33], s[5 * 33]); o.w = cvt_pk_bf16(s[6 * 33], s[7 * 33]);
        *(u32x4*)(WT + (size_t)(n0 + n) * ldd + k0 + 8 * c) = o; }
    asm volatile("s_waitcnt lgkmcnt(0)" ::: "memory");
}

__device__ __forceinline__ void phase_prep(const Args& a, LAS unsigned char* lds, int wave, int G) {
    const int lane = lane_id();
    unsigned char* ws = a.ws;
    LAS float* scr = (LAS float*)(lds + wave * 16384);
    const int gw = blockIdx.x * 8 + wave, NGW = G * 8;
#define TJOB(W_, ldw_, K_, Nd_, dst_, gain_, map_, srcofs_) do { const int nitems = ((K_) / 64) * ((Nd_) / 32); \
        for (int it = gw; it < nitems; it += NGW) transpose_item((W_), (ldw_), (K_), (bf16_t*)(ws + (dst_)), (K_), (gain_), (map_), (srcofs_), scr, it, lane); } while (0)
    TJOB(a.in[I_WIN], PIN, 1024, PIN, WS_WIN, a.in[I_NMIXG], 0, 0);
    TJOB(a.in[I_WBA], 1024, 512, 1024, WS_WA, nullptr, 0, 0);
    TJOB(a.in[I_WBB], 1024, 512, 1024, WS_WB, nullptr, 0, 0);
    TJOB(a.in[I_WMIX], 1024, 1024, 1024, WS_WMIX, nullptr, 0, 0);
    TJOB(a.in[I_WCQ], 1024, 1024, 1024, WS_WCQ, a.in[I_NXG], 0, 0);
    TJOB(a.in[I_WCKV], 2048, 1024, 1024, WS_WK, nullptr, 0, 0);
    TJOB(a.in[I_WCKV], 2048, 1024, 1024, WS_WV, nullptr, 0, 1024);
    TJOB(a.in[I_WCO], 1024, 1024, 1024, WS_WCO, nullptr, 0, 0);
    TJOB(a.in[I_WFFI], 2 * DFF, 1024, 2 * DFF, WS_WFFI, a.in[I_NFFNG], 1, 0);
    TJOB(a.in[I_WFFO], 1024, DFF, 1024, WS_WFFO, nullptr, 0, 0);
#undef TJOB
    const int gid = blockIdx.x * 512 + wave * 64 + lane, NT = G * 512;
    { bf16_t* WL = (bf16_t*)(ws + WS_WLORA);
      for (int i = gid; i < 1536 * 256; i += NT) { const int n = i >> 8, k = i & 255, kind = n >> 9, c = n & 511; float v = 0.f;
          if (kind == 0 && k < 64) v = a.in[I_WUP][k * 512 + c]; else if (kind == 1 && k >= 64 && k < 128) v = a.in[I_AUP][(k - 64) * 512 + c]; else if (kind == 2 && k >= 128) v = a.in[I_GUP][(k - 128) * 512 + c];
          WL[i] = f2bf(v); } }
    { bf16_t* WR = (bf16_t*)(ws + WS_WRG);
      for (int i = gid; i < 1024 * 512; i += NT) { const int n = i >> 9, k = i & 511, pn = n >> 8, c = n & 255, ch = pn * 128 + (c & 127), hb = ch >> 6, j = ch & 63; float v = 0.f;
          if ((k >> 6) == hb) v = (c < 128 ? a.in[I_WRGA] : a.in[I_WRGX])[(hb * 64 + (k & 63)) * 64 + j];
          WR[i] = f2bf(v); } }
    { const float* x = a.in[I_X]; bf16_t* XB = (bf16_t*)(ws + WS_XB); float* rstd = (float*)(ws + WS_RSTDX);
      for (int r = gw; r < T; r += NGW) { const f32x4* xr = (const f32x4*)(x + (size_t)r * D) + lane; f32x4 v[4]; float s = 0.f;
#pragma unroll
          for (int j = 0; j < 4; ++j) { v[j] = xr[64 * j]; s += (v[j].x * v[j].x + v[j].y * v[j].y) + (v[j].z * v[j].z + v[j].w * v[j].w); }
          s = wave_sum(s); if (lane == 0) rstd[r] = rsqrtf(s * (1.0f / D) + NORM_EPS);
          u32x2* o = (u32x2*)(XB + (size_t)r * D) + lane;
#pragma unroll
          for (int j = 0; j < 4; ++j) { u32x2 w; w.x = cvt_pk_bf16(v[j].x, v[j].y); w.y = cvt_pk_bf16(v[j].z, v[j].w); o[64 * j] = w; } } }
    { const float* x = a.in[I_MEM]; bf16_t* XB = (bf16_t*)(ws + WS_MEMN); const float* g = a.in[I_NMEMG];
      for (int r = gw; r < TM; r += NGW) { const f32x4* xr = (const f32x4*)(x + (size_t)r * D) + lane; f32x4 v[4]; float s = 0.f;
#pragma unroll
          for (int j = 0; j < 4; ++j) { v[j] = xr[64 * j]; s += (v[j].x * v[j].x + v[j].y * v[j].y) + (v[j].z * v[j].z + v[j].w * v[j].w); }
          s = wave_sum(s); const float rs = rsqrtf(s * (1.0f / D) + NORM_EPS);
          u32x2* o = (u32x2*)(XB + (size_t)r * D) + lane;
#pragma unroll
          for (int j = 0; j < 4; ++j) { const f32x4 gg = ((const f32x4*)g)[lane + 64 * j]; u32x2 w; w.x = cvt_pk_bf16(v[j].x * rs * gg.x, v[j].y * rs * gg.y); w.y = cvt_pk_bf16(v[j].z * rs * gg.z, v[j].w * rs * gg.w); o[64 * j] = w; } } }
}

__device__ __forceinline__ void phase_elem2(const Args& a, int wave, int G) {
    unsigned char* ws = a.ws;
    const bf16_t* PR = (const bf16_t*)(ws + WS_PR); const bf16_t* PX = (const bf16_t*)(ws + WS_PX);
    bf16_t* LIN = (bf16_t*)(ws + WS_LIN); bf16_t* XBC = (bf16_t*)(ws + WS_XBC);
    const float* mu = a.in[I_MU]; const float* cw = a.in[I_CBW]; const float* cb = a.in[I_CBB];
    const size_t gid = (size_t)blockIdx.x * 512 + wave * 64 + lane_id(), NT = (size_t)G * 512;
    for (size_t i = gid; i < (size_t)T * 96; i += NT) {
        const int t = (int)(i / 96), q = (int)(i % 96), tl = t & (SEQ - 1);
        if (q < 32) { const int c = q * 8; float p[8], pp[8], o[8];
            unpack8(*(const u32x4*)(PR + (size_t)t * RW + 1536 + c), p);
            if (tl > 0) unpack8(*(const u32x4*)(PR + (size_t)(t - 1) * RW + 1536 + c), pp); else {
#pragma unroll
                for (int j = 0; j < 8; ++j) pp[j] = 0.f; }
#pragma unroll
            for (int j = 0; j < 8; ++j) { const float v = p[j] + (pp[j] - p[j]) * mu[1536 + c + j];
                o[j] = c < 64 ? tanhf(v) : (c < 128 ? v : sigmoidf_(v)); }
            *(u32x4*)(LIN + (size_t)t * 256 + c) = pack8(o);
        } else { const int c = (q - 32) * 8; float o[8];
#pragma unroll
            for (int j = 0; j < 8; ++j) o[j] = cb[c + j];
#pragma unroll
            for (int k = 0; k < 4; ++k) { const int dt = 3 - k; if (tl >= dt) { float p[8]; unpack8(*(const u32x4*)(PX + (size_t)(t - dt) * 512 + c), p);
#pragma unroll
                for (int j = 0; j < 8; ++j) o[j] += p[j] * cw[k * 512 + c + j]; } }
            *(u32x4*)(XBC + (size_t)t * 512 + c) = pack8(o);
        }
    }
}

#define DPP_BC(JJ) " row_newbcast:" #JJ " row_mask:0xf bank_mask:0xf"
#define RW_SA(JJ)  asm("v_fmac_f32_dpp %0, %1, %2" DPP_BC(JJ) : "+v"(sacc[JJ & 3]) : "v"(va), "v"(S[JJ]));
#define RW_UPD(JJ) { float t_; \
    asm("v_mul_f32_dpp %0, %1, %2" DPP_BC(JJ) : "=v"(t_) : "v"(vb), "v"(sa)); \
    asm("v_fmac_f32_dpp %0, %1, %2" DPP_BC(JJ) : "+v"(t_) : "v"(vk), "v"(vv)); \
    asm("v_fmac_f32_dpp %0, %1, %2" DPP_BC(JJ) : "+v"(t_) : "v"(vw), "v"(S[JJ])); \
    S[JJ] = t_; \
    asm("v_fmac_f32_dpp %0, %1, %2" DPP_BC(JJ) : "+v"(yacc[JJ & 3]) : "v"(vr), "v"(S[JJ])); }
#define RW_ALL16(M) M(0) M(1) M(2) M(3) M(4) M(5) M(6) M(7) M(8) M(9) M(10) M(11) M(12) M(13) M(14) M(15)

constexpr int RB = 32;
constexpr int PSTEP = 6 * 64;
constexpr int PBUF = RB * PSTEP * 4;

__device__ __forceinline__ float dpp_ror_add(float v, const int ctrl_sel) {
    int t;
    switch (ctrl_sel) {
        case 8: t = __builtin_amdgcn_update_dpp(0, __float_as_int(v), 0x128, 0xf, 0xf, false); break;
        case 4: t = __builtin_amdgcn_update_dpp(0, __float_as_int(v), 0x124, 0xf, 0xf, false); break;
        case 2: t = __builtin_amdgcn_update_dpp(0, __float_as_int(v), 0x122, 0xf, 0xf, false); break;
        default: t = __builtin_amdgcn_update_dpp(0, __float_as_int(v), 0x121, 0xf, 0xf, false); break;
    }
    return v + __int_as_float(t);
}
__device__ __forceinline__ float cross_row_allsum(float v) {
    auto r = __builtin_amdgcn_permlane32_swap(__float_as_uint(v), __float_as_uint(v), false, false);
    v = __uint_as_float(r[0]) + __uint_as_float(r[1]);
    auto r2 = __builtin_amdgcn_permlane16_swap(__float_as_uint(v), __float_as_uint(v), false, false);
    return __uint_as_float(r2[0]) + __uint_as_float(r2[1]);
}
__device__ __forceinline__ float wave_allsum(float v) {
    v = dpp_ror_add(v, 8); v = dpp_ror_add(v, 4); v = dpp_ror_add(v, 2); v = dpp_ror_add(v, 1);
    return cross_row_allsum(v);
}
__device__ __forceinline__ void lds_barrier() { asm volatile("s_waitcnt lgkmcnt(0)" ::: "memory"); __builtin_amdgcn_s_barrier(); asm volatile("" ::: "memory"); }

__device__ __forceinline__ void rwkv_prep_block(const Args& a, LAS float* pb, int tok0, int h, int p, int lane, float mu_r, float mu_k, float mu_v, float ckk, float cka, float crk) {
    const bf16_t* PR = (const bf16_t*)(a.ws + WS_PR); const bf16_t* LOUT = (const bf16_t*)(a.ws + WS_LOUT); float* BON = (float*)(a.ws + WS_BON);
#pragma unroll
    for (int i = 0; i < RB / 4; ++i) {
        const int s = p * (RB / 4) + i; const int tok = tok0 + s; const bool has_prev = (tok & (SEQ - 1)) != 0;
        const bf16_t* prow = PR + (size_t)tok * RW + h * 64 + lane; const bf16_t* qrow = has_prev ? prow - RW : prow;
        const bf16_t* lrow = LOUT + (size_t)tok * 1536 + h * 64 + lane;
        const float rr = bf1(prow[0]), kr = bf1(prow[512]), vr_ = bf1(prow[1024]);
        const float rp = has_prev ? bf1(qrow[0]) : 0.f, kp = has_prev ? bf1(qrow[512]) : 0.f, vp = has_prev ? bf1(qrow[1024]) : 0.f;
        const float e = bf1(lrow[0]), av = bf1(lrow[512]);
        const float r = rr + (rp - rr) * mu_r, k0 = kr + (kp - kr) * mu_k, v = vr_ + (vp - vr_) * mu_v;
        const float w = __expf(-e);
        const float kk = k0 * ckk; const float n2 = wave_allsum(kk * kk); const float kkn = kk / fmaxf(sqrtf(n2), 1e-12f);
        const float k2 = k0 * (1.0f + (av - 1.0f) * cka);
        const float bon = wave_allsum(r * k2 * crk);
        LAS float* pp = pb + s * PSTEP;
        pp[lane] = -kkn; pp[64 + lane] = kkn * av; pp[128 + lane] = k2; pp[192 + lane] = w; pp[256 + lane] = r; pp[320 + lane] = v;
        if (lane == 0) BON[(size_t)tok * 8 + h] = bon;
    }
}

__device__ __forceinline__ void phase_scan(const Args& a, LAS unsigned char* lds, int wave, int G) {
    const int lane = lane_id();
    unsigned char* ws = a.ws;
    constexpr int SB = 16, NBLK = SEQ / RB;
    for (int pair = blockIdx.x; pair < 256; pair += G) {
        const int b = pair >> 3, h = pair & 7, tokb = b * SEQ;
        const int il = lane & 15, irow = 16 * (wave & 3) + il;
        float S[16];
#pragma unroll
        for (int j = 0; j < 16; ++j) S[j] = 0.f;
        const float mu_r = a.in[I_MU][h * 64 + lane], mu_k = a.in[I_MU][512 + h * 64 + lane], mu_v = a.in[I_MU][1024 + h * 64 + lane];
        const float ckk = a.in[I_KK][h * 64 + lane], cka = a.in[I_KA][h * 64 + lane], crk = a.in[I_RK][h * 64 + lane];
        bf16_t* YRAW = (bf16_t*)(ws + WS_YRAW);
        const size_t base = (size_t)tokb * 512 + h * 64 + lane;
        const bf16_t* LA = (const bf16_t*)(ws + WS_RGLA) + base; const bf16_t* U = (const bf16_t*)(ws + WS_RGU) + base; const bf16_t* PY = (const bf16_t*)(ws + WS_PY) + base;
        bf16_t* YB = (bf16_t*)(ws + WS_YB) + base;
        bf16_t cla[SB], cu[SB], cpy[SB]; float hh = 0.f;
        if (wave == 4) {
#pragma unroll
            for (int s = 0; s < SB; ++s) { cla[s] = LA[(size_t)s * 512]; cu[s] = U[(size_t)s * 512]; cpy[s] = PY[(size_t)s * 512]; }
        } else {
#pragma unroll
            for (int s = 0; s < SB; ++s) { cla[s] = 0; cu[s] = 0; cpy[s] = 0; }
        }
        if (wave >= 4) rwkv_prep_block(a, (LAS float*)lds, tokb, h, wave - 4, lane, mu_r, mu_k, mu_v, ckk, cka, crk);
        lds_barrier();
        for (int blk = 0; blk < NBLK; ++blk) {
            if (wave < 4) {
                const LAS float* pb = (const LAS float*)(lds + (blk & 1) * PBUF);
#pragma unroll 2
                for (int s = 0; s < RB; ++s) {
                    const LAS float* pp = pb + s * PSTEP;
                    float va = pp[lane], vb = pp[64 + lane], vk = pp[128 + lane], vw = pp[192 + lane], vr = pp[256 + lane]; const float vv = pp[320 + irow];
                    asm volatile("s_nop 1" : "+v"(va), "+v"(vb), "+v"(vk), "+v"(vw), "+v"(vr));
                    float sacc[4] = {0.f, 0.f, 0.f, 0.f}, yacc[4] = {0.f, 0.f, 0.f, 0.f};
                    RW_ALL16(RW_SA)
                    float sa = (sacc[0] + sacc[1]) + (sacc[2] + sacc[3]);
                    sa = cross_row_allsum(sa);
                    RW_ALL16(RW_UPD)
                    float y = (yacc[0] + yacc[1]) + (yacc[2] + yacc[3]);
                    y = cross_row_allsum(y);
                    const int tok = tokb + blk * RB + s;
                    if (lane < 16) YRAW[(size_t)tok * 512 + h * 64 + irow] = f2bf(y);
                }
            } else {
                if (blk + 1 < NBLK) rwkv_prep_block(a, (LAS float*)(lds + ((blk + 1) & 1) * PBUF), tokb + (blk + 1) * RB, h, wave - 4, lane, mu_r, mu_k, mu_v, ckk, cka, crk);
                if (wave == 4) {
                    for (int sub = 0; sub < RB / SB; ++sub) {
                        const int t0 = blk * RB + sub * SB, tn = (t0 + SB < SEQ) ? t0 + SB : t0;
                        bf16_t nla[SB], nu[SB], npy[SB];
#pragma unroll
                        for (int s = 0; s < SB; ++s) { nla[s] = LA[(size_t)(tn + s) * 512]; nu[s] = U[(size_t)(tn + s) * 512]; npy[s] = PY[(size_t)(tn + s) * 512]; }
#pragma unroll
                        for (int s = 0; s < SB; ++s) { hh = __expf(bf1(cla[s])) * hh + bf1(cu[s]); YB[(size_t)(t0 + s) * 512] = f2bf(hh * gelu_tanh(bf1(cpy[s]))); }
#pragma unroll
                        for (int s = 0; s < SB; ++s) { cla[s] = nla[s]; cu[s] = nu[s]; cpy[s] = npy[s]; }
                    }
                }
            }
            lds_barrier();
        }
    }
    asm volatile("s_waitcnt vmcnt(0)" ::: "memory");
}

__device__ __forceinline__ void phase_post(const Args& a, int wave, int G) {
    unsigned char* ws = a.ws;
    const bf16_t* PR = (const bf16_t*)(ws + WS_PR); const bf16_t* LOUT = (const bf16_t*)(ws + WS_LOUT); const bf16_t* YRAW = (const bf16_t*)(ws + WS_YRAW);
    const float* BON = (const float*)(ws + WS_BON); bf16_t* YA = (bf16_t*)(ws + WS_YA);
    const float* mu = a.in[I_MU]; const float* lg = a.in[I_LNXG]; const float* lb = a.in[I_LNXB];
    const size_t gid = (size_t)blockIdx.x * 512 + wave * 64 + lane_id(), NT = (size_t)G * 512;
    for (size_t i = gid; i < (size_t)T * 64; i += NT) {
        const int t = (int)(i >> 6), c = (int)(i & 63) * 8, h = c >> 6, tl = t & (SEQ - 1);
        float y[8], v[8], vp[8], g[8], o[8];
        unpack8(*(const u32x4*)(YRAW + (size_t)t * 512 + c), y);
        unpack8(*(const u32x4*)(PR + (size_t)t * RW + 1024 + c), v);
        if (tl > 0) unpack8(*(const u32x4*)(PR + (size_t)(t - 1) * RW + 1024 + c), vp); else {
#pragma unroll
            for (int j = 0; j < 8; ++j) vp[j] = 0.f; }
        unpack8(*(const u32x4*)(LOUT + (size_t)t * 1536 + 1024 + c), g);
        float s = 0.f;
#pragma unroll
        for (int j = 0; j < 8; ++j) s += y[j];
        s += __shfl_xor(s, 1); s += __shfl_xor(s, 2); s += __shfl_xor(s, 4);
        const float mean = s * (1.0f / 64.0f); float q = 0.f;
#pragma unroll
        for (int j = 0; j < 8; ++j) { const float d = y[j] - mean; q += d * d; }
        q += __shfl_xor(q, 1); q += __shfl_xor(q, 2); q += __shfl_xor(q, 4);
        const float rs = rsqrtf(q * (1.0f / 64.0f) + LNX_EPS), bon = BON[(size_t)t * 8 + h];
#pragma unroll
        for (int j = 0; j < 8; ++j) { const float vv = v[j] + (vp[j] - v[j]) * mu[1024 + c + j];
            o[j] = ((y[j] - mean) * rs * lg[c + j] + lb[c + j] + bon * vv) * g[j]; }
        *(u32x4*)(YA + (size_t)t * 512 + c) = pack8(o);
    }
}

__device__ __forceinline__ void phase_ffnact(const Args& a, int wave, int G) {
    unsigned char* ws = a.ws;
    const bf16_t* UG = (const bf16_t*)(ws + WS_UG); bf16_t* UU = (bf16_t*)(ws + WS_UU);
    const float* cw = a.in[I_FCW]; const float* cb = a.in[I_FCB];
    const size_t gid = (size_t)blockIdx.x * 512 + wave * 64 + lane_id(), NT = (size_t)G * 512;
    constexpr int CPR = DFF / 8;
    for (size_t i = gid; i < (size_t)T * CPR; i += NT) {
        const int t = (int)(i / CPR), c = (int)(i % CPR) * 8, tl = t & (SEQ - 1);
        float o[8], p[8], uu[8];
#pragma unroll
        for (int j = 0; j < 8; ++j) o[j] = cb[c + j];
#pragma unroll
        for (int k = 0; k < 3; ++k) { const int dt = 2 - k; if (tl >= dt) { unpack8(*(const u32x4*)(UG + (size_t)(t - dt) * DFF + c), p);
#pragma unroll
            for (int j = 0; j < 8; ++j) o[j] += p[j] * cw[k * DFF + c + j]; } }
        unpack8(*(const u32x4*)(UU + (size_t)t * DFF + c), uu);
#pragma unroll
        for (int j = 0; j < 8; ++j) o[j] = gelu_tanh(o[j]) * uu[j];
        *(u32x4*)(UU + (size_t)t * DFF + c) = pack8(o);
    }
}

__device__ __forceinline__ void phase_final(const Args& a, int wave, int G) {
    const int lane = lane_id();
    const float* ssp = (const float*)(a.ws + WS_SSP3); const float* g = a.in[I_NFING];
    const int gw = blockIdx.x * 8 + wave, NGW = G * 8;
    for (int r = gw; r < T; r += NGW) { const float rs = rstd_from16(ssp, r); f32x4* xr = (f32x4*)(a.out + (size_t)r * D) + lane;
#pragma unroll
        for (int j = 0; j < 4; ++j) { const f32x4 gg = ((const f32x4*)g)[lane + 64 * j]; f32x4 v = xr[64 * j]; v = v * rs * gg; xr[64 * j] = v; } }
}

constexpr int NPHASE = 17;
__global__ void __launch_bounds__(512, 2) mega(Args a) {
    extern __shared__ __attribute__((aligned(16))) unsigned char lds_raw[];
    LAS unsigned char* lds = (LAS unsigned char*)lds_raw;
    cg::grid_group grid = cg::this_grid();
    const int wave = __builtin_amdgcn_readfirstlane((int)threadIdx.x >> 6), G = gridDim.x, bid = blockIdx.x;
    unsigned char* ws = a.ws;
    const int lo = a.ph_lo, hi = a.ph_hi;
#define IN(k) (lo <= (k) && (k) < hi)
#define SEAM(k) do { if (IN(k) && IN((k) + 1)) grid.sync(); } while (0)
    bf16_t* const XB = (bf16_t*)(ws + WS_XB);
    const float* rstdx = (const float*)(ws + WS_RSTDX);
    StaticOrder S;

    if (IN(0)) for (int rep_ = 0; rep_ < REPS(0); ++rep_) { phase_prep(a, lds, wave, G); __syncthreads(); } SEAM(0);

    if (IN(1)) for (int rep_ = 0; rep_ < REPS(1); ++rep_) {
        { Gemm g = plain_gemm(XB, (const bf16_t*)(ws + WS_WIN), 1024); S.init(T / BM, 11, G, bid);
          EpiProj E{rstdx, a.in[I_BIN], (bf16_t*)(ws + WS_PR), (bf16_t*)(ws + WS_PX), (bf16_t*)(ws + WS_PY)}; gemm_phase(lds, wave, g, S, E); }
        { Gemm g = plain_gemm((const bf16_t*)(ws + WS_MEMN), (const bf16_t*)(ws + WS_WK), 1024); S.init(TM / BM, 4, G, bid);
          EpiPlain E{(bf16_t*)(ws + WS_KM), 1024}; gemm_phase(lds, wave, g, S, E); }
        { Gemm g = plain_gemm((const bf16_t*)(ws + WS_WV), (const bf16_t*)(ws + WS_MEMN), 1024); S.init(4, TM / BM, G, bid);
          EpiPlain E{(bf16_t*)(ws + WS_VT), TM}; gemm_phase(lds, wave, g, S, E); }
    } SEAM(1);

    if (IN(2)) for (int rep_ = 0; rep_ < REPS(2); ++rep_) phase_elem2(a, wave, G); SEAM(2);

    if (IN(3)) for (int rep_ = 0; rep_ < REPS(3); ++rep_) {
        { Gemm g = plain_gemm((const bf16_t*)(ws + WS_LIN), (const bf16_t*)(ws + WS_WLORA), 256); S.init(T / BM, 6, G, bid);
          EpiLora E{a.in[I_W0], a.in[I_A0], (bf16_t*)(ws + WS_LOUT)}; gemm_phase(lds, wave, g, S, E); }
        { Gemm g = plain_gemm((const bf16_t*)(ws + WS_XBC), (const bf16_t*)(ws + WS_WRG), 512); S.init(T / BM, 4, G, bid);
          EpiRg E{a.in[I_BRGA], a.in[I_BRGX], a.in[I_LAM], (const bf16_t*)(ws + WS_XBC), (bf16_t*)(ws + WS_RGLA), (bf16_t*)(ws + WS_RGU)}; gemm_phase(lds, wave, g, S, E); }
    } SEAM(3);

    if (IN(4)) for (int rep_ = 0; rep_ < REPS(4); ++rep_) phase_scan(a, lds, wave, G); SEAM(4);
    if (IN(5)) for (int rep_ = 0; rep_ < REPS(5); ++rep_) phase_post(a, wave, G); SEAM(5);

    if (IN(6)) for (int rep_ = 0; rep_ < REPS(6); ++rep_) {
        Gemm g = plain_gemm(XB, (const bf16_t*)(ws + WS_WIN) + (size_t)2816 * 1024, 1024); S.init(T / BM, 8, G, bid);
        EpiGab E{rstdx, a.in[I_BIN] + 2816, (bf16_t*)(ws + WS_GAB)}; gemm_phase(lds, wave, g, S, E);
    } SEAM(6);
    if (IN(7)) for (int rep_ = 0; rep_ < REPS(7); ++rep_) { Gemm g = plain_gemm((const bf16_t*)(ws + WS_YA), (const bf16_t*)(ws + WS_WA), 512); S.init(T / BM, 4, G, bid);
        EpiBranch<true> E{(const bf16_t*)(ws + WS_GAB), (bf16_t*)(ws + WS_MERGED)}; gemm_phase(lds, wave, g, S, E); } SEAM(7);
    if (IN(8)) for (int rep_ = 0; rep_ < REPS(8); ++rep_) { Gemm g = plain_gemm((const bf16_t*)(ws + WS_YB), (const bf16_t*)(ws + WS_WB), 512); S.init(T / BM, 4, G, bid);
        EpiBranch<false> E{(const bf16_t*)(ws + WS_GAB), (bf16_t*)(ws + WS_MERGED)}; gemm_phase(lds, wave, g, S, E); } SEAM(8);
    if (IN(9)) for (int rep_ = 0; rep_ < REPS(9); ++rep_) { Gemm g = plain_gemm((const bf16_t*)(ws + WS_MERGED), (const bf16_t*)(ws + WS_WMIX), 1024); S.init(T / BM, 4, G, bid);
        EpiRes<true> E{a.in[I_X], a.out, (bf16_t*)(ws + WS_X1B), (float*)(ws + WS_SSP1)}; gemm_phase(lds, wave, g, S, E); } SEAM(9);
    if (IN(10)) for (int rep_ = 0; rep_ < REPS(10); ++rep_) { Gemm g = plain_gemm((const bf16_t*)(ws + WS_X1B), (const bf16_t*)(ws + WS_WCQ), 1024); S.init(T / BM, 4, G, bid);
        EpiQ E{(const float*)(ws + WS_SSP1), (bf16_t*)(ws + WS_Q)}; gemm_phase(lds, wave, g, S, E); } SEAM(10);
    if (IN(11)) for (int rep_ = 0; rep_ < REPS(11); ++rep_) {
        Gemm g; g.A = (const bf16_t*)(ws + WS_Q); g.Bt = (const bf16_t*)(ws + WS_KM); g.lda = 1024; g.ldb = 1024; g.K = 256;
        g.a_pm = (size_t)BM * 1024 * 2; g.a_pn = 512; g.b_pn = 512; g.b_pb = (size_t)NMEM * 1024 * 2; S.init(T / BM, 4, G, bid);
        EpiSc E{(bf16_t*)(ws + WS_PEXP), (float*)(ws + WS_SSPA)}; gemm_phase(lds, wave, g, S, E); } SEAM(11);
    if (IN(12)) for (int rep_ = 0; rep_ < REPS(12); ++rep_) {
        Gemm g; g.A = (const bf16_t*)(ws + WS_PEXP); g.Bt = (const bf16_t*)(ws + WS_VT); g.lda = 1024; g.ldb = TM; g.K = 256;
        g.a_pm = (size_t)BM * 1024 * 2; g.a_pn = 512; g.b_pn = (size_t)256 * TM * 2; g.b_pb = 512; S.init(T / BM, 4, G, bid);
        EpiPv E{(const float*)(ws + WS_SSPA), (bf16_t*)(ws + WS_O)}; gemm_phase(lds, wave, g, S, E); } SEAM(12);
    if (IN(13)) for (int rep_ = 0; rep_ < REPS(13); ++rep_) { Gemm g = plain_gemm((const bf16_t*)(ws + WS_O), (const bf16_t*)(ws + WS_WCO), 1024); S.init(T / BM, 4, G, bid);
        EpiRes<true> E{a.out, a.out, (bf16_t*)(ws + WS_X2B), (float*)(ws + WS_SSP2)}; gemm_phase(lds, wave, g, S, E); } SEAM(13);
    if (IN(14)) for (int rep_ = 0; rep_ < REPS(14); ++rep_) { Gemm g = plain_gemm((const bf16_t*)(ws + WS_X2B), (const bf16_t*)(ws + WS_WFFI), 1024); S.init(T / BM, 22, G, bid);
        EpiFfnIn E{(const float*)(ws + WS_SSP2), (bf16_t*)(ws + WS_UG), (bf16_t*)(ws + WS_UU)}; gemm_phase(lds, wave, g, S, E); } SEAM(14);
    if (IN(15)) for (int rep_ = 0; rep_ < REPS(15); ++rep_) phase_ffnact(a, wave, G); SEAM(15);
    if (IN(16)) for (int rep_ = 0; rep_ < REPS(16); ++rep_) { Gemm g = plain_gemm((const bf16_t*)(ws + WS_UU), (const bf16_t*)(ws + WS_WFFO), DFF); S.init(T / BM, 4, G, bid);
        EpiRes<false> E{a.out, a.out, nullptr, (float*)(ws + WS_SSP3)}; gemm_phase(lds, wave, g, S, E); } SEAM(16);
    if (IN(17)) for (int rep_ = 0; rep_ < REPS(17); ++rep_) phase_final(a, wave, G);
#undef IN
#undef SEAM
}

extern "C" void kernel_launch(void* const* d_in, const int* in_sizes, int n_in, void* d_out, int out_size, void* d_ws, size_t ws_size, hipStream_t stream) {
    static int grid = 0;
    if (grid == 0) {
        if (n_in != 37 || in_sizes[0] != T * D || out_size != T * D || ws_size < WS_END) {
            fprintf(stderr, "kernel_launch: unexpected shapes (n_in %d, in0 %d, out %d, ws %zu < %zu); nothing launched\n", n_in, n_in > 0 ? in_sizes[0] : -1, out_size, ws_size, (size_t)WS_END); grid = -1; return; }
        int dev = 0, cus = 0, per_cu = 0;
        if (hipGetDevice(&dev) != hipSuccess || hipDeviceGetAttribute(&cus, hipDeviceAttributeMultiprocessorCount, dev) != hipSuccess) { grid = -1; return; }
        if (hipFuncSetAttribute((const void*)mega, hipFuncAttributeMaxDynamicSharedMemorySize, LDS_BYTES) != hipSuccess) { fprintf(stderr, "kernel_launch: hipFuncSetAttribute failed\n"); grid = -1; return; }
        if (hipOccupancyMaxActiveBlocksPerMultiprocessor(&per_cu, (const void*)mega, 512, LDS_BYTES) != hipSuccess || per_cu < 1) { fprintf(stderr, "kernel_launch: occupancy query says %d\n", per_cu); per_cu = 1; }
        (void)hipGetLastError();
        grid = cus * 1;
    }
    if (grid < 0) return;
    Args a{};
    for (int i = 0; i < 37; ++i) a.in[i] = (const float*)d_in[i];
    a.out = (float*)d_out; a.ws = (unsigned char*)d_ws;
#if MK_SPLIT
    for (int ph = 0; ph <= NPHASE; ++ph) {
        a.ph_lo = ph; a.ph_hi = ph + 1; void* args[] = {&a};
        hipError_t e = hipLaunchCooperativeKernel((const void*)mega, dim3(grid), dim3(512), args, LDS_BYTES, stream);
        if (e != hipSuccess) { fprintf(stderr, "kernel_launch: launch of phase %d failed: %s\n", ph, hipGetErrorString(e)); break; }
    }
#else
    a.ph_lo = 0; a.ph_hi = NPHASE + 1; void* args[] = {&a};
    hipError_t e = hipLaunchCooperativeKernel((const void*)mega, dim3(grid), dim3(512), args, LDS_BYTES, stream);
    if (e != hipSuccess) fprintf(stderr, "kernel_launch: cooperative launch failed: %s (grid %d)\n", hipGetErrorString(e), grid);
#endif
}
```

```cpp
#include <hip/hip_runtime.h>
#include <hip/hip_cooperative_groups.h>
#include <cstdio>
namespace cg = cooperative_groups;

#ifndef MK_SPLIT
#define MK_SPLIT 0
#endif

#ifndef DUP_PHASE
#define DUP_PHASE -1
#endif
#define REPS(k) ((DUP_PHASE == (k)) ? 2 : 1)
#define LAS __attribute__((address_space(3)))
typedef unsigned short bf16_t;
typedef short bf16x8 __attribute__((ext_vector_type(8)));
typedef float f32x4 __attribute__((ext_vector_type(4)));
typedef float f32x2 __attribute__((ext_vector_type(2)));
typedef unsigned u32x4 __attribute__((ext_vector_type(4)));
typedef unsigned u32x2 __attribute__((ext_vector_type(2)));

constexpr int T = 65536, D = 1024, SEQ = 2048, NB = 32, NMEM = 256, TM = NB * NMEM;
constexpr int AW = 512, RW = 1792, PIN = 4864, DFF = 2816;
constexpr float NORM_EPS = 1e-6f, LNX_EPS = 64e-5f;

constexpr size_t MiB = 1u << 20;
constexpr size_t WS_WIN = 0;
constexpr size_t WS_WFFI = 10 * MiB;
constexpr size_t WS_WFFO = 21 * MiB;
constexpr size_t WS_WMIX = 27 * MiB, WS_WCQ = 29 * MiB, WS_WK = 31 * MiB, WS_WV = 33 * MiB, WS_WCO = 35 * MiB;
constexpr size_t WS_WA = 37 * MiB, WS_WB = 38 * MiB;
constexpr size_t WS_WLORA = 39 * MiB;
constexpr size_t WS_WRG = 40 * MiB;
constexpr size_t WS_CTL = 46 * MiB, CTL_BYTES = 16384;
constexpr size_t WS_RSTDX = 48 * MiB;
constexpr size_t WS_SSP1 = 49 * MiB, WS_SSP2 = 53 * MiB, WS_SSP3 = 57 * MiB, WS_SSPA = 61 * MiB;
constexpr size_t WS_BON = 65 * MiB;
constexpr size_t WS_MEMN = 68 * MiB, WS_KM = 84 * MiB, WS_VT = 100 * MiB;
constexpr size_t WS_XB = 120 * MiB;
constexpr size_t WS_PR = 248 * MiB;
constexpr size_t WS_PX = 472 * MiB, WS_PY = 536 * MiB;
constexpr size_t WS_LIN = 600 * MiB, WS_XBC = 632 * MiB;
constexpr size_t WS_LOUT = 696 * MiB;
constexpr size_t WS_RGLA = 888 * MiB, WS_RGU = 952 * MiB;
constexpr size_t WS_YRAW = WS_PX, WS_YB = WS_LIN, WS_YA = WS_RGLA;
constexpr size_t WS_GAB = 248 * MiB;
constexpr size_t WS_MERGED = 696 * MiB;
constexpr size_t WS_X1B = WS_XB, WS_Q = 248 * MiB, WS_PEXP = 376 * MiB, WS_O = 504 * MiB, WS_X2B = WS_XB;
constexpr size_t WS_HG = 248 * MiB, WS_UU = 600 * MiB;
constexpr size_t WS_END = 1016 * MiB;

constexpr int LDS_BYTES = 147456;

__device__ __forceinline__ unsigned cvt_pk_bf16(float lo, float hi) { unsigned r; asm("v_cvt_pk_bf16_f32 %0, %1, %2" : "=v"(r) : "v"(lo), "v"(hi)); return r; }
__device__ __forceinline__ float bf_lo(unsigned w) { return __uint_as_float(w << 16); }
__device__ __forceinline__ float bf_hi(unsigned w) { return __uint_as_float(w & 0xffff0000u); }
__device__ __forceinline__ float bf1(bf16_t b) { return __uint_as_float(((unsigned)b) << 16); }
__device__ __forceinline__ bf16_t f2bf(float f) { return (bf16_t)(cvt_pk_bf16(f, 0.f) & 0xffffu); }
__device__ __forceinline__ float sigmoidf_(float x) { return __builtin_amdgcn_rcpf(1.0f + __expf(-x)); }
__device__ __forceinline__ float gelu_tanh(float x) { const float z = 1.5957691216057308f * (x + 0.044715f * x * x * x); return x * sigmoidf_(z); }
__device__ __forceinline__ int lane_id() { int l; asm volatile("v_mbcnt_lo_u32_b32 %0, -1, 0\n\tv_mbcnt_hi_u32_b32 %0, -1, %0" : "=v"(l)); return l; }
__device__ __forceinline__ float wave_sum(float v) {
#pragma unroll
    for (int o = 1; o < 64; o <<= 1) v += __shfl_xor(v, o);
    return v;
}
__device__ __forceinline__ void unpack8(const u32x4 w, float (&f)[8]) {
    f[0] = bf_lo(w.x); f[1] = bf_hi(w.x); f[2] = bf_lo(w.y); f[3] = bf_hi(w.y); f[4] = bf_lo(w.z); f[5] = bf_hi(w.z); f[6] = bf_lo(w.w); f[7] = bf_hi(w.w);
}
__device__ __forceinline__ u32x4 pack8(const float (&f)[8]) {
    u32x4 w; w.x = cvt_pk_bf16(f[0], f[1]); w.y = cvt_pk_bf16(f[2], f[3]); w.z = cvt_pk_bf16(f[4], f[5]); w.w = cvt_pk_bf16(f[6], f[7]); return w;
}


#define XB_TMO      128
#define XB_XCNT(j)  (256  + 64 * (j))
#define XB_XSUB(j)  (1280 + 64 * (j))
#define XB_XGEN(j)  (2304 + 64 * (j))
#define XB_TOP      3328
#define XB_TOPGEN   3392
#define XCD_BAR_WORDS 3456
#define XB_SPIN_CAP (1u << 22)
__device__ __forceinline__ unsigned xb_ld(unsigned* p)              { return __hip_atomic_load(p, __ATOMIC_RELAXED, __HIP_MEMORY_SCOPE_AGENT); }
__device__ __forceinline__ unsigned xb_add(unsigned* p, unsigned v) { return __hip_atomic_fetch_add(p, v, __ATOMIC_RELAXED, __HIP_MEMORY_SCOPE_AGENT); }
__device__ __forceinline__ unsigned xb_xcc_id() { return (unsigned)__builtin_amdgcn_s_getreg((3 << 11) | 20) & 0xFu; }
#define XB_SPIN(cond, bar) do { unsigned _sp = 0; while (cond) { __builtin_amdgcn_s_sleep(1); \
    if ((++_sp & 255u) == 0u) { if (xb_ld(&(bar)[XB_TMO])) break; if (_sp > XB_SPIN_CAP) { atomicAdd(&(bar)[XB_TMO], 1u); break; } } } } while (0)
struct XcdBarrier { unsigned* bar; unsigned x; volatile LAS unsigned* st; };
__device__ __forceinline__ XcdBarrier xcd_barrier_post(unsigned* bar, volatile LAS unsigned* st, bool t0) {
    XcdBarrier b; b.bar = bar; b.x = xb_xcc_id(); b.st = st;
    if (t0) (void)xb_add(&bar[XB_XCNT(b.x)], 1u);
    return b;
}
__device__ __forceinline__ void xcd_barrier_complete(unsigned* bar, unsigned x, unsigned& nloc, unsigned& nx) {
    const unsigned G = gridDim.x * gridDim.y * gridDim.z;
    unsigned sum, cnt, mine, sp = 0u;
    for (;;) {
        sum = 0u; cnt = 0u; mine = 0u;
#pragma unroll
        for (unsigned j = 0; j < 16; ++j) { const unsigned c = xb_ld(&bar[XB_XCNT(j)]); sum += c; cnt += (c > 0u) ? 1u : 0u; mine = (j == x) ? c : mine; }
        if (sum == G) break;
        __builtin_amdgcn_s_sleep(1);
        if ((++sp & 255u) == 0u) { if (xb_ld(&bar[XB_TMO])) break; if (sp > XB_SPIN_CAP) { atomicAdd(&bar[XB_TMO], 1u); break; } }
    }
    nloc = mine > 0u ? mine : 1u; nx = cnt > 0u ? cnt : 1u;
}
__device__ __forceinline__ void xcd_barrier(const XcdBarrier& b, bool t0) {
    asm volatile("s_waitcnt vmcnt(0)" ::: "memory");
    __syncthreads();
    if (t0) {
        unsigned* bar = b.bar;
        __builtin_amdgcn_s_waitcnt(0);
        unsigned nloc = b.st[0], nx = b.st[1];
        if (nloc == 0u) { xcd_barrier_complete(bar, b.x, nloc, nx); b.st[0] = nloc; b.st[1] = nx; }
        const unsigned old = xb_add(&bar[XB_XSUB(b.x)], 1u);
        const unsigned gen = old / nloc;
        if (old + 1u == (gen + 1u) * nloc) {
            __builtin_amdgcn_fence(__ATOMIC_RELEASE, "agent");
            asm volatile("s_waitcnt vmcnt(0)" ::: "memory");
            const unsigned og = xb_add(&bar[XB_TOP], 1u);
            const unsigned tg = og / nx;
            if (og + 1u == (tg + 1u) * nx) xb_add(&bar[XB_TOPGEN], 1u);
            else XB_SPIN(xb_ld(&bar[XB_TOPGEN]) == tg, bar);
            __builtin_amdgcn_fence(__ATOMIC_ACQUIRE, "agent");
            xb_add(&bar[XB_XGEN(b.x)], 1u);
            asm volatile("s_waitcnt vmcnt(0)" ::: "memory");
        } else {
            XB_SPIN(xb_ld(&bar[XB_XGEN(b.x)]) == gen, bar);
            __builtin_amdgcn_fence(__ATOMIC_ACQUIRE, "agent");
            asm volatile("s_waitcnt vmcnt(0)" ::: "memory");
        }
    }
    __syncthreads();
}

constexpr int BM = 256, BK = 64, HALF = 128, HTB = HALF * BK * 2, NXCD = 8, WGM = 8;
__device__ __forceinline__ int lds_byte(int r, int c) { const int st = (r >> 4) * 2 + (c >> 5), rr = r & 15, cc = c & 31, ob = rr * 64 + cc * 2; return st * 1024 + (ob ^ (((ob >> 9) & 1) << 5)); }
__device__ __forceinline__ void stage_rc(int b, int& R, int& C) { const int st = b / 1024, sb = b % 1024, swz = sb ^ (((sb >> 9) & 1) << 5); R = (st >> 1) * 16 + swz / 64; C = (st & 1) * 32 + (swz % 64) / 2; }
__device__ __forceinline__ int perm32(int rho) { const int n = rho >> 4, i = rho & 15; return 8 * (i >> 2) + 4 * n + (i & 3); }

struct Unit { int pm, pn; };
struct Gemm { const bf16_t* A; const bf16_t* Bt; int lda, ldb, K; size_t a_pm, a_pn, b_pn, b_pb; };
__device__ __forceinline__ Gemm plain_gemm(const bf16_t* A, const bf16_t* Bt, int K) { Gemm g; g.A = A; g.Bt = Bt; g.lda = K; g.ldb = K; g.K = K; g.a_pm = (size_t)BM * K * 2; g.a_pn = 0; g.b_pn = (size_t)BM * K * 2; g.b_pb = 0; return g; }

struct StaticOrder {
    int nM, nN, nwg, G, c;
    __device__ void init(int nM_, int nN_, int G_, int c_) { nM = nM_; nN = nN_; nwg = nM * nN; G = G_; c = c_; }
    __device__ bool next(int i, Unit& u) const {
        const long L = (long)i * G + c; if (L >= nwg) return false;
        int wgid = (int)L; { const int q = nwg / NXCD, r = nwg % NXCD, xcd = wgid % NXCD, off = wgid / NXCD; wgid = (xcd < r ? xcd * (q + 1) : r * (q + 1) + (xcd - r) * q) + off; }
        const int nig = WGM * nN, gid = wgid / nig, fm = gid * WGM, gsz = (nM - fm) < WGM ? (nM - fm) : WGM;
        u.pm = fm + ((wgid % nig) % gsz); u.pn = (wgid % nig) / gsz; return true;
    }
};

typedef f32x4 Acc[2][2][4][2];

template <class Epi>
__device__ __forceinline__ void gemm_phase(LAS unsigned char* lds, const int wid, const Gemm g, const StaticOrder& S, const Epi& E) {
    const int lane = lane_id(), tid = wid * 64 + lane, wr = wid >> 2, wc = wid & 3, fr = lane & 15, fq = lane >> 4;
    const int nt = g.K / BK;
    unsigned voffA[2], voffB[2];
#pragma unroll
    for (int i = 0; i < 2; ++i) { int R, C; stage_rc(tid * 16 + i * 8192, R, C); const int Rb = Epi::PERM ? ((R & ~31) + perm32(R & 31)) : R;
        voffA[i] = (unsigned)(R * g.lda + C) * 2u; voffB[i] = (unsigned)(Rb * g.ldb + C) * 2u; }
    const size_t kstep = (size_t)(BK * 2);
    const size_t hstepA = (size_t)HALF * g.lda * 2, hstepB = (size_t)HALF * g.ldb * 2;
    const unsigned ldsw = (unsigned)wid * 1024u;
    const int aoff = lds_byte(wr * 64 + fr, fq * 8), boff = lds_byte(wc * 32 + fr, fq * 8);
#define PG8_SA(b, h) (((b) * 2 + (h)) * HTB)
#define PG8_SB(b, h) ((4 + (b) * 2 + (h)) * HTB)
#define PG8_STAGE(bufoff, gbase, voff) do { _Pragma("unroll") for (int _i = 0; _i < 2; ++_i) \
        __builtin_amdgcn_global_load_lds((const unsigned*)((const char*)(gbase) + (voff)[_i]), (LAS unsigned*)(lds + (bufoff) + ldsw + _i * 8192), 16, 0, 0); } while (0)
#define PG8_LDA(dst, b, h) do { _Pragma("unroll") for (int m = 0; m < 4; ++m) _Pragma("unroll") for (int k = 0; k < 2; ++k) dst[m][k] = *(const LAS bf16x8*)(lds + PG8_SA(b, h) + aoff + m * 2048 + k * 1024); } while (0)
#define PG8_LDB(dst, b, h) do { _Pragma("unroll") for (int n = 0; n < 2; ++n) _Pragma("unroll") for (int k = 0; k < 2; ++k) dst[n][k] = *(const LAS bf16x8*)(lds + PG8_SB(b, h) + boff + n * 2048 + k * 1024); } while (0)
#define PG8_MMA(ai, bj, At, Bt) do { __builtin_amdgcn_s_setprio(1); _Pragma("unroll") for (int m = 0; m < 4; ++m) _Pragma("unroll") for (int n = 0; n < 2; ++n) _Pragma("unroll") for (int k = 0; k < 2; ++k) \
        acc[ai][bj][m][n] = __builtin_amdgcn_mfma_f32_16x16x32_bf16(Bt[n][k], At[m][k], acc[ai][bj][m][n], 0, 0, 0); __builtin_amdgcn_s_setprio(0); } while (0)
#define PG8_WAIT_V(n) asm volatile("s_waitcnt vmcnt(" #n ")" ::: "memory")
#define PG8_WAIT_L(n) asm volatile("s_waitcnt lgkmcnt(" #n ")" ::: "memory")
#define PG8_BAR __builtin_amdgcn_s_barrier()
#define PG8_SCHED __builtin_amdgcn_sched_barrier(0)
#define PG8_UA(u) ((const char*)g.A + (size_t)(u).pm * g.a_pm + (size_t)(u).pn * g.a_pn)
#define PG8_UB(u) ((const char*)g.Bt + (size_t)(u).pn * g.b_pn + (size_t)((u).pm >> 3) * g.b_pb)
    Unit cur, nxt; int ui = 0;
    if (!S.next(0, cur)) return;
    Acc acc;
#pragma unroll
    for (int a = 0; a < 2; ++a)
#pragma unroll
        for (int b = 0; b < 2; ++b)
#pragma unroll
            for (int m = 0; m < 4; ++m)
#pragma unroll
                for (int n = 0; n < 2; ++n) acc[a][b][m][n] = (f32x4){0.f, 0.f, 0.f, 0.f};
    bf16x8 At[4][2], B0[2][2], B1[2][2];
    const char* cA = PG8_UA(cur); const char* cB = PG8_UB(cur);
    PG8_STAGE(PG8_SB(0, 0), cB, voffB); PG8_STAGE(PG8_SA(0, 0), cA, voffA); PG8_STAGE(PG8_SB(0, 1), cB + hstepB, voffB); PG8_STAGE(PG8_SA(0, 1), cA + hstepA, voffA);
    if (wr == 1) PG8_BAR;
    PG8_WAIT_V(4); PG8_BAR;
    PG8_STAGE(PG8_SB(1, 0), cB + kstep, voffB); PG8_STAGE(PG8_SA(1, 0), cA + kstep, voffA); PG8_STAGE(PG8_SB(1, 1), cB + hstepB + kstep, voffB);
    PG8_WAIT_V(6); PG8_BAR;
    for (;;) {
        const bool has_next = S.next(ui + 1, nxt);
        const char* nA = has_next ? PG8_UA(nxt) : cA; const char* nB = has_next ? PG8_UB(nxt) : cB;
        for (int t = 0; t < nt; t += 2) {
            const bool last = (t == nt - 2);
            const char* a1 = cA + (size_t)(t + 1) * kstep;
            const char* a2 = last ? nA : cA + (size_t)(t + 2) * kstep; const char* b2 = last ? nB : cB + (size_t)(t + 2) * kstep;
            const char* a3 = a2 + kstep; const char* b3 = b2 + kstep;
            PG8_LDB(B0, 0, 0); PG8_SCHED; PG8_LDA(At, 0, 0); PG8_STAGE(PG8_SA(1, 1), a1 + hstepA, voffA);
            PG8_WAIT_L(8); PG8_BAR; PG8_WAIT_L(0); PG8_MMA(0, 0, At, B0); PG8_BAR; PG8_SCHED;
            PG8_LDB(B1, 0, 1); PG8_STAGE(PG8_SB(0, 0), b2, voffB);
            PG8_BAR; PG8_WAIT_L(0); PG8_MMA(0, 1, At, B1); PG8_BAR;
            PG8_LDA(At, 0, 1); PG8_STAGE(PG8_SA(0, 0), a2, voffA);
            PG8_BAR; PG8_WAIT_L(0); PG8_MMA(1, 0, At, B0); PG8_BAR; PG8_SCHED;
            PG8_STAGE(PG8_SB(0, 1), b2 + hstepB, voffB);
            PG8_WAIT_V(6); PG8_BAR; PG8_MMA(1, 1, At, B1); PG8_BAR;
            PG8_LDB(B0, 1, 0); PG8_SCHED; PG8_LDA(At, 1, 0); PG8_STAGE(PG8_SA(0, 1), a2 + hstepA, voffA);
            PG8_WAIT_L(8); PG8_BAR; PG8_WAIT_L(0); PG8_MMA(0, 0, At, B0); PG8_BAR; PG8_SCHED;
            PG8_LDB(B1, 1, 1); PG8_STAGE(PG8_SB(1, 0), b3, voffB);
            PG8_BAR; PG8_WAIT_L(0); PG8_MMA(0, 1, At, B1); PG8_BAR;
            PG8_LDA(At, 1, 1); PG8_STAGE(PG8_SA(1, 0), a3, voffA);
            PG8_BAR; PG8_WAIT_L(0); PG8_MMA(1, 0, At, B0); PG8_BAR; PG8_SCHED;
            PG8_STAGE(PG8_SB(1, 1), b3 + hstepB, voffB);
            PG8_WAIT_V(6); PG8_BAR; PG8_MMA(1, 1, At, B1); PG8_BAR;
        }
        E(acc, cur, wr, wc, fr, fq);
        if (!has_next) break;
#pragma unroll
        for (int a = 0; a < 2; ++a)
#pragma unroll
            for (int b = 0; b < 2; ++b)
#pragma unroll
                for (int m = 0; m < 4; ++m)
#pragma unroll
                    for (int n = 0; n < 2; ++n) acc[a][b][m][n] = (f32x4){0.f, 0.f, 0.f, 0.f};
        cur = nxt; cA = nA; cB = nB; ++ui;
    }
    PG8_WAIT_V(0);
    if (wr == 0) PG8_BAR;
    PG8_BAR;
#undef PG8_SA
#undef PG8_SB
#undef PG8_STAGE
#undef PG8_LDA
#undef PG8_LDB
#undef PG8_MMA
#undef PG8_WAIT_V
#undef PG8_WAIT_L
#undef PG8_BAR
#undef PG8_SCHED
#undef PG8_UA
#undef PG8_UB
}

#define EPI_ROWS_BEGIN for (int ai = 0; ai < 2; ++ai) { _Pragma("unroll") for (int m = 0; m < 4; ++m) { const int r = u.pm * BM + ai * HALF + wr * 64 + m * 16 + fr;
#define EPI_ROWS_END } }

__device__ __forceinline__ float rstd_from16(const float* ss, int r) { return rsqrtf(ss[r] * (1.0f / 1024.0f) + NORM_EPS); }

struct EpiProj { static constexpr bool PERM = true;
    const float* rstd; const float* bias; bf16_t* PR; bf16_t* PX; bf16_t* PY;
    __device__ __forceinline__ void operator()(Acc& acc, const Unit& u, int wr, int wc, int fr, int fq) const {
        bf16_t* base; int ld, colt;
        if (u.pn < 7) { base = PR; ld = RW; colt = u.pn * 256; } else if (u.pn < 9) { base = PX; ld = 512; colt = (u.pn - 7) * 256; } else { base = PY; ld = 512; colt = (u.pn - 9) * 256; }
        const int col0 = colt + wc * 32 + 8 * fq, bcol0 = u.pn * 256 + wc * 32 + 8 * fq;
        f32x4 bv[2][2];
#pragma unroll
        for (int bj = 0; bj < 2; ++bj)
#pragma unroll
            for (int n = 0; n < 2; ++n) bv[bj][n] = *(const f32x4*)(bias + bcol0 + bj * HALF + 4 * n);
#pragma unroll
        EPI_ROWS_BEGIN
            const float rs = rstd[r]; bf16_t* rowp = base + (size_t)r * ld + col0;
#pragma unroll
            for (int bj = 0; bj < 2; ++bj) { const f32x4 v0 = acc[ai][bj][m][0] * rs + bv[bj][0], v1 = acc[ai][bj][m][1] * rs + bv[bj][1];
                u32x4 w; w.x = cvt_pk_bf16(v0[0], v0[1]); w.y = cvt_pk_bf16(v0[2], v0[3]); w.z = cvt_pk_bf16(v1[0], v1[1]); w.w = cvt_pk_bf16(v1[2], v1[3]);
                *(u32x4*)(rowp + bj * HALF) = w; }
        EPI_ROWS_END
    }
};
struct EpiGab { static constexpr bool PERM = true;
    const float* rstd; const float* bias; bf16_t* O; int cofs;
    __device__ __forceinline__ void operator()(Acc& acc, const Unit& u, int wr, int wc, int fr, int fq) const {
        const int col0 = cofs + u.pn * 256 + wc * 32 + 8 * fq;
        f32x4 bv[2][2];
#pragma unroll
        for (int bj = 0; bj < 2; ++bj)
#pragma unroll
            for (int n = 0; n < 2; ++n) bv[bj][n] = *(const f32x4*)(bias + col0 + bj * HALF + 4 * n);
#pragma unroll
        EPI_ROWS_BEGIN
            const float rs = rstd[r]; bf16_t* rowp = O + (size_t)r * 2048 + col0;
#pragma unroll
            for (int bj = 0; bj < 2; ++bj) { f32x4 v0 = acc[ai][bj][m][0] * rs + bv[bj][0], v1 = acc[ai][bj][m][1] * rs + bv[bj][1];
#pragma unroll
                for (int j = 0; j < 4; ++j) { v0[j] = sigmoidf_(v0[j]); v1[j] = sigmoidf_(v1[j]); }
                u32x4 w; w.x = cvt_pk_bf16(v0[0], v0[1]); w.y = cvt_pk_bf16(v0[2], v0[3]); w.z = cvt_pk_bf16(v1[0], v1[1]); w.w = cvt_pk_bf16(v1[2], v1[3]);
                *(u32x4*)(rowp + bj * HALF) = w; }
        EPI_ROWS_END
    }
};
struct EpiPlain { static constexpr bool PERM = true;
    bf16_t* O; int ldc;
    __device__ __forceinline__ void operator()(Acc& acc, const Unit& u, int wr, int wc, int fr, int fq) const {
        const int col0 = u.pn * 256 + wc * 32 + 8 * fq;
#pragma unroll
        EPI_ROWS_BEGIN
            bf16_t* rowp = O + (size_t)r * ldc + col0;
#pragma unroll
            for (int bj = 0; bj < 2; ++bj) { const f32x4 v0 = acc[ai][bj][m][0], v1 = acc[ai][bj][m][1];
                u32x4 w; w.x = cvt_pk_bf16(v0[0], v0[1]); w.y = cvt_pk_bf16(v0[2], v0[3]); w.z = cvt_pk_bf16(v1[0], v1[1]); w.w = cvt_pk_bf16(v1[2], v1[3]);
                *(u32x4*)(rowp + bj * HALF) = w; }
        EPI_ROWS_END
    }
};
struct EpiLora { static constexpr bool PERM = true;
    const float* w0; const float* a0; bf16_t* O;
    __device__ __forceinline__ void operator()(Acc& acc, const Unit& u, int wr, int wc, int fr, int fq) const {
        const int kind = u.pn >> 1, ch0 = (u.pn & 1) * 256 + wc * 32 + 8 * fq, col0 = u.pn * 256 + wc * 32 + 8 * fq;
        const float* bsrc = kind == 0 ? w0 : a0;
        f32x4 bv[2][2];
#pragma unroll
        for (int bj = 0; bj < 2; ++bj)
#pragma unroll
            for (int n = 0; n < 2; ++n) bv[bj][n] = kind < 2 ? *(const f32x4*)(bsrc + ch0 + bj * HALF + 4 * n) : (f32x4){0.f, 0.f, 0.f, 0.f};
        const float sc = kind == 0 ? 0.6065306597126334f : 1.0f;
#pragma unroll
        EPI_ROWS_BEGIN
            bf16_t* rowp = O + (size_t)r * 1536 + col0;
#pragma unroll
            for (int bj = 0; bj < 2; ++bj) { f32x4 v0 = acc[ai][bj][m][0] + bv[bj][0], v1 = acc[ai][bj][m][1] + bv[bj][1];
                if (kind < 2) {
#pragma unroll
                    for (int j = 0; j < 4; ++j) { v0[j] = sc * sigmoidf_(v0[j]); v1[j] = sc * sigmoidf_(v1[j]); } }
                u32x4 w; w.x = cvt_pk_bf16(v0[0], v0[1]); w.y = cvt_pk_bf16(v0[2], v0[3]); w.z = cvt_pk_bf16(v1[0], v1[1]); w.w = cvt_pk_bf16(v1[2], v1[3]);
                *(u32x4*)(rowp + bj * HALF) = w; }
        EPI_ROWS_END
    }
};
struct EpiRg { static constexpr bool PERM = true;
    const float* ba; const float* bx; const float* lam; const bf16_t* XBC; bf16_t* LA; bf16_t* U;
    __device__ __forceinline__ void operator()(Acc& acc, const Unit& u, int wr, int wc, int fr, int fq) const {
        const int ch0 = u.pn * 128 + wc * 32 + 8 * fq;
        float vba[8], vbx[8], vls[8];
#pragma unroll
        for (int j = 0; j < 8; ++j) { vba[j] = ba[ch0 + j]; vbx[j] = bx[ch0 + j]; vls[j] = -8.0f * log1pf(__expf(-lam[ch0 + j])); }
#pragma unroll
        EPI_ROWS_BEGIN
            const bool first = (r & (SEQ - 1)) == 0;
            float xb[8]; unpack8(*(const u32x4*)(XBC + (size_t)r * 512 + ch0), xb);
            float la[8], uu[8];
#pragma unroll
            for (int j = 0; j < 8; ++j) { const float ga = sigmoidf_(acc[ai][0][m][j >> 2][j & 3] + vba[j]), gx = sigmoidf_(acc[ai][1][m][j >> 2][j & 3] + vbx[j]);
                la[j] = vls[j] * ga; const float a = __expf(la[j]); const float mult = first ? 1.0f : sqrtf(fmaxf(1.0f - a * a, 0.f)); uu[j] = xb[j] * gx * mult; }
            *(u32x4*)(LA + (size_t)r * 512 + ch0) = pack8(la); *(u32x4*)(U + (size_t)r * 512 + ch0) = pack8(uu);
        EPI_ROWS_END
    }
};
template <bool FIRST> struct EpiBranch { static constexpr bool PERM = true;
    const bf16_t* G; bf16_t* M;
    __device__ __forceinline__ void operator()(Acc& acc, const Unit& u, int wr, int wc, int fr, int fq) const {
        const int col0 = u.pn * 256 + wc * 32 + 8 * fq;
#pragma unroll
        EPI_ROWS_BEGIN
#pragma unroll
            for (int bj = 0; bj < 2; ++bj) { const int c = col0 + bj * HALF;
                float gv[8]; unpack8(*(const u32x4*)(G + (size_t)r * 2048 + (FIRST ? 0 : 1024) + c), gv);
                float o[8];
                if (!FIRST) unpack8(*(const u32x4*)(M + (size_t)r * 1024 + c), o);
#pragma unroll
                for (int j = 0; j < 8; ++j) { const float p = acc[ai][bj][m][j >> 2][j & 3] * gv[j]; o[j] = FIRST ? p : o[j] + p; }
                *(u32x4*)(M + (size_t)r * 1024 + c) = pack8(o); }
        EPI_ROWS_END
    }
};
template <bool WB> struct EpiRes { static constexpr bool PERM = false;
    const float* base; float* out; bf16_t* XB; float* ssp;
    __device__ __forceinline__ void operator()(Acc& acc, const Unit& u, int wr, int wc, int fr, int fq) const {
        const int col0 = u.pn * 256 + wc * 32 + 4 * fq;
#pragma unroll
        EPI_ROWS_BEGIN
            const size_t off = (size_t)r * 1024 + col0; float s = 0.f;
#pragma unroll
            for (int bj = 0; bj < 2; ++bj)
#pragma unroll
                for (int n = 0; n < 2; ++n) { const f32x4 bs = *(const f32x4*)(base + off + bj * HALF + n * 16); const f32x4 o = bs + acc[ai][bj][m][n];
                    *(f32x4*)(out + off + bj * HALF + n * 16) = o; s += (o[0] * o[0] + o[1] * o[1]) + (o[2] * o[2] + o[3] * o[3]);
                    if (WB) { u32x2 w; w.x = cvt_pk_bf16(o[0], o[1]); w.y = cvt_pk_bf16(o[2], o[3]); *(u32x2*)(XB + off + bj * HALF + n * 16) = w; } }
            s += __shfl_xor(s, 16); s += __shfl_xor(s, 32);
            if (fq == 0) atomicAdd(ssp + r, s);
        EPI_ROWS_END
    }
};
struct EpiQ { static constexpr bool PERM = true;
    const float* ssp; bf16_t* O;
    __device__ __forceinline__ void operator()(Acc& acc, const Unit& u, int wr, int wc, int fr, int fq) const {
        const int col0 = u.pn * 256 + wc * 32 + 8 * fq;
#pragma unroll
        EPI_ROWS_BEGIN
            const float rs = rstd_from16(ssp, r) * 0.0625f; bf16_t* rowp = O + (size_t)r * 1024 + col0;
#pragma unroll
            for (int bj = 0; bj < 2; ++bj) { const f32x4 v0 = acc[ai][bj][m][0] * rs, v1 = acc[ai][bj][m][1] * rs;
                u32x4 w; w.x = cvt_pk_bf16(v0[0], v0[1]); w.y = cvt_pk_bf16(v0[2], v0[3]); w.z = cvt_pk_bf16(v1[0], v1[1]); w.w = cvt_pk_bf16(v1[2], v1[3]);
                *(u32x4*)(rowp + bj * HALF) = w; }
        EPI_ROWS_END
    }
};
struct EpiSc { static constexpr bool PERM = true;
    bf16_t* O; float* ssp;
    __device__ __forceinline__ void operator()(Acc& acc, const Unit& u, int wr, int wc, int fr, int fq) const {
        const int col0 = u.pn * 256 + wc * 32 + 8 * fq;
#pragma unroll
        EPI_ROWS_BEGIN
            bf16_t* rowp = O + (size_t)r * 1024 + col0; float s = 0.f;
#pragma unroll
            for (int bj = 0; bj < 2; ++bj) { f32x4 v0 = acc[ai][bj][m][0], v1 = acc[ai][bj][m][1];
#pragma unroll
                for (int j = 0; j < 4; ++j) { v0[j] = __expf(v0[j]); v1[j] = __expf(v1[j]); }
                s += ((v0[0] + v0[1]) + (v0[2] + v0[3])) + ((v1[0] + v1[1]) + (v1[2] + v1[3]));
                u32x4 w; w.x = cvt_pk_bf16(v0[0], v0[1]); w.y = cvt_pk_bf16(v0[2], v0[3]); w.z = cvt_pk_bf16(v1[0], v1[1]); w.w = cvt_pk_bf16(v1[2], v1[3]);
                *(u32x4*)(rowp + bj * HALF) = w; }
            s += __shfl_xor(s, 16); s += __shfl_xor(s, 32);
            if (fq == 0) ssp[(size_t)r * 16 + u.pn * 4 + wc] = s;
        EPI_ROWS_END
    }
};
struct EpiPv { static constexpr bool PERM = true;
    const float* ssp; bf16_t* O;
    __device__ __forceinline__ void operator()(Acc& acc, const Unit& u, int wr, int wc, int fr, int fq) const {
        const int col0 = u.pn * 256 + wc * 32 + 8 * fq;
#pragma unroll
        EPI_ROWS_BEGIN
            const f32x4 sp = *(const f32x4*)(ssp + (size_t)r * 16 + u.pn * 4); const float rs = 1.0f / ((sp.x + sp.y) + (sp.z + sp.w));
            bf16_t* rowp = O + (size_t)r * 1024 + col0;
#pragma unroll
            for (int bj = 0; bj < 2; ++bj) { const f32x4 v0 = acc[ai][bj][m][0] * rs, v1 = acc[ai][bj][m][1] * rs;
                u32x4 w; w.x = cvt_pk_bf16(v0[0], v0[1]); w.y = cvt_pk_bf16(v0[2], v0[3]); w.z = cvt_pk_bf16(v1[0], v1[1]); w.w = cvt_pk_bf16(v1[2], v1[3]);
                *(u32x4*)(rowp + bj * HALF) = w; }
        EPI_ROWS_END
    }
};
__device__ __forceinline__ float dpp_ror1(float v) { return __int_as_float(__builtin_amdgcn_update_dpp(0, __float_as_int(v), 0x121, 0xf, 0xf, false)); }
__device__ __forceinline__ float dpp_ror2(float v) { return __int_as_float(__builtin_amdgcn_update_dpp(0, __float_as_int(v), 0x122, 0xf, 0xf, false)); }
struct EpiFfnAct { static constexpr bool PERM = true;
    const float* ssp; const float* cw; const float* cb; bf16_t* ACT; bf16_t* HG;
    __device__ __forceinline__ void operator()(Acc& acc, const Unit& u, int wr, int wc, int fr_, int fq_) const {
        const int l_ = lane_id(), fr = l_ & 15, fq = l_ >> 4;
        const int col0 = u.pn * 128 + wc * 32 + 8 * fq;
#pragma unroll
        for (int ai = 0; ai < 2; ++ai) {
            const int rbase = u.pm * BM + ai * HALF + wr * 64 + fr;
            float rs[4];
#pragma unroll
            for (int m = 0; m < 4; ++m) rs[m] = rstd_from16(ssp, rbase + m * 16);
            const size_t grp = (size_t)(rbase >> 6);
            if (fr < 2) { float t[8];
#pragma unroll
                for (int j = 0; j < 8; ++j) t[j] = acc[ai][0][0][j >> 2][j & 3] * rs[0];
                *(u32x4*)(HG + (grp * 4 + 2 + fr) * DFF + col0) = pack8(t); }
            if (fr >= 14) { float t[8];
#pragma unroll
                for (int j = 0; j < 8; ++j) t[j] = acc[ai][0][3][j >> 2][j & 3] * rs[3];
                *(u32x4*)(HG + (grp * 4 + (fr - 14)) * DFF + col0) = pack8(t); }
#pragma unroll
            for (int j = 0; j < 8; ++j) {
                const float w0 = cw[col0 + j], w1 = cw[DFF + col0 + j], w2 = cw[2 * DFF + col0 + j], b0 = cb[col0 + j];
                float g[4], r1[4], r2[4];
#pragma unroll
                for (int m = 0; m < 4; ++m) { g[m] = acc[ai][0][m][j >> 2][j & 3] * rs[m]; r1[m] = dpp_ror1(g[m]); r2[m] = dpp_ror2(g[m]); }
#pragma unroll
                for (int m = 0; m < 4; ++m) {
                    const float p1 = fr >= 1 ? r1[m] : r1[m > 0 ? m - 1 : 0], p2 = fr >= 2 ? r2[m] : r2[m > 0 ? m - 1 : 0];
                    const float up = acc[ai][1][m][j >> 2][j & 3] * rs[m];
                    const float gate = b0 + w0 * p2 + w1 * p1 + w2 * g[m];
                    acc[ai][1][m][j >> 2][j & 3] = (m == 0 && fr < 2) ? up : gelu_tanh(gate) * up;
                }
            }
#pragma unroll
            for (int m = 0; m < 4; ++m) { const f32x4 v0 = acc[ai][1][m][0], v1 = acc[ai][1][m][1];
                u32x4 w; w.x = cvt_pk_bf16(v0[0], v0[1]); w.y = cvt_pk_bf16(v0[2], v0[3]); w.z = cvt_pk_bf16(v1[0], v1[1]); w.w = cvt_pk_bf16(v1[2], v1[3]);
                *(u32x4*)(ACT + (size_t)(rbase + m * 16) * DFF + col0) = w; }
        }
    }
};

struct Args { const float* in[37]; float* out; unsigned char* ws; int ph_lo, ph_hi; };
enum { I_X = 0, I_MEM, I_NMIXG, I_WIN, I_BIN, I_MU, I_W0, I_WUP, I_A0, I_AUP, I_GUP, I_KK, I_KA, I_RK, I_LNXG, I_LNXB, I_WBA, I_CBW, I_CBB, I_WRGA, I_BRGA, I_WRGX, I_BRGX,
       I_LAM, I_WBB, I_WMIX, I_NXG, I_NMEMG, I_WCQ, I_WCKV, I_WCO, I_NFFNG, I_WFFI, I_FCW, I_FCB, I_WFFO, I_NFING };

__device__ __forceinline__ void transpose_item(const float* W, int ldw, int K, bf16_t* WT, int ldd, const float* gain, int map, int srcofs, LAS float* scr, int item, int lane) {
    const int nkb = K / 64, nb = item / nkb, kb = item % nkb, k0 = 64 * kb, n0 = 32 * nb;
    int ns = n0 + srcofs;
    if (map == 1) { const int tile = n0 >> 8, c = n0 & 255; ns = c < 128 ? tile * 128 + c : DFF + tile * 128 + (c - 128); }
#pragma unroll 8
    for (int i = 0; i < 32; ++i) { const int kk = 2 * i + (lane >> 5); float v = W[(size_t)(k0 + kk) * ldw + ns + (lane & 31)]; if (gain) v *= gain[k0 + kk]; scr[kk * 33 + (lane & 31)] = v; }
    asm volatile("s_waitcnt lgkmcnt(0)" ::: "memory");
    const int c = lane & 7;
#pragma unroll
    for (int j = 0; j < 4; ++j) { const int n = (lane >> 3) + 8 * j; const LAS float* s = scr + (8 * c) * 33 + n;
        u32x4 o; o.x = cvt_pk_bf16(s[0 * 33], s[1 * 33]); o.y = cvt_pk_bf16(s[2 * 33], s[3 * 33]); o.z = cvt_pk_bf16(s[4 * 33], s[5 * 33]); o.w = cvt_pk_bf16(s[6 * 33], s[7 * 33]);
        *(u32x4*)(WT + (size_t)(n0 + n) * ldd + k0 + 8 * c) = o; }
    asm volatile("s_waitcnt lgkmcnt(0)" ::: "memory");
}

__device__ __forceinline__ void phase_prep(const Args& a, LAS unsigned char* lds, int wave, int G) {
    const int lane = lane_id();
    unsigned char* ws = a.ws;
    LAS float* scr = (LAS float*)(lds + wave * 16384);
    const int gw = blockIdx.x * 8 + wave, NGW = G * 8;
#define TJOB(W_, ldw_, K_, Nd_, dst_, gain_, map_, srcofs_) do { const int nitems = ((K_) / 64) * ((Nd_) / 32); \
        for (int it = gw; it < nitems; it += NGW) transpose_item((W_), (ldw_), (K_), (bf16_t*)(ws + (dst_)), (K_), (gain_), (map_), (srcofs_), scr, it, lane); } while (0)
    TJOB(a.in[I_WIN], PIN, 1024, PIN, WS_WIN, a.in[I_NMIXG], 0, 0);
    TJOB(a.in[I_WBA], 1024, 512, 1024, WS_WA, nullptr, 0, 0);
    TJOB(a.in[I_WBB], 1024, 512, 1024, WS_WB, nullptr, 0, 0);
    TJOB(a.in[I_WMIX], 1024, 1024, 1024, WS_WMIX, nullptr, 0, 0);
    TJOB(a.in[I_WCQ], 1024, 1024, 1024, WS_WCQ, a.in[I_NXG], 0, 0);
    TJOB(a.in[I_WCKV], 2048, 1024, 1024, WS_WK, nullptr, 0, 0);
    TJOB(a.in[I_WCKV], 2048, 1024, 1024, WS_WV, nullptr, 0, 1024);
    TJOB(a.in[I_WCO], 1024, 1024, 1024, WS_WCO, nullptr, 0, 0);
    TJOB(a.in[I_WFFI], 2 * DFF, 1024, 2 * DFF, WS_WFFI, a.in[I_NFFNG], 1, 0);
    TJOB(a.in[I_WFFO], 1024, DFF, 1024, WS_WFFO, nullptr, 0, 0);
#undef TJOB
    { float* z1 = (float*)(ws + WS_SSP1); float* z2 = (float*)(ws + WS_SSP2); float* z3 = (float*)(ws + WS_SSP3);
      for (int i = blockIdx.x * 512 + wave * 64 + lane; i < T; i += G * 512) { z1[i] = 0.f; z2[i] = 0.f; z3[i] = 0.f; } }
    const int gid = blockIdx.x * 512 + wave * 64 + lane, NT = G * 512;
    { bf16_t* WL = (bf16_t*)(ws + WS_WLORA);
      for (int i = gid; i < 1536 * 256; i += NT) { const int n = i >> 8, k = i & 255, kind = n >> 9, c = n & 511; float v = 0.f;
          if (kind == 0 && k < 64) v = a.in[I_WUP][k * 512 + c]; else if (kind == 1 && k >= 64 && k < 128) v = a.in[I_AUP][(k - 64) * 512 + c]; else if (kind == 2 && k >= 128) v = a.in[I_GUP][(k - 128) * 512 + c];
          WL[i] = f2bf(v); } }
    { bf16_t* WR = (bf16_t*)(ws + WS_WRG);
      for (int i = gid; i < 1024 * 512; i += NT) { const int n = i >> 9, k = i & 511, pn = n >> 8, c = n & 255, ch = pn * 128 + (c & 127), hb = ch >> 6, j = ch & 63; float v = 0.f;
          if ((k >> 6) == hb) v = (c < 128 ? a.in[I_WRGA] : a.in[I_WRGX])[(hb * 64 + (k & 63)) * 64 + j];
          WR[i] = f2bf(v); } }
    { const float* x = a.in[I_X]; bf16_t* XB = (bf16_t*)(ws + WS_XB); float* rstd = (float*)(ws + WS_RSTDX);
      for (int r = gw; r < T; r += NGW) { const f32x4* xr = (const f32x4*)(x + (size_t)r * D) + lane; f32x4 v[4]; float s = 0.f;
#pragma unroll
          for (int j = 0; j < 4; ++j) { v[j] = xr[64 * j]; s += (v[j].x * v[j].x + v[j].y * v[j].y) + (v[j].z * v[j].z + v[j].w * v[j].w); }
          s = wave_sum(s); if (lane == 0) rstd[r] = rsqrtf(s * (1.0f / D) + NORM_EPS);
          u32x2* o = (u32x2*)(XB + (size_t)r * D) + lane;
#pragma unroll
          for (int j = 0; j < 4; ++j) { u32x2 w; w.x = cvt_pk_bf16(v[j].x, v[j].y); w.y = cvt_pk_bf16(v[j].z, v[j].w); o[64 * j] = w; } } }
    { const float* x = a.in[I_MEM]; bf16_t* XB = (bf16_t*)(ws + WS_MEMN); const float* g = a.in[I_NMEMG];
      for (int r = gw; r < TM; r += NGW) { const f32x4* xr = (const f32x4*)(x + (size_t)r * D) + lane; f32x4 v[4]; float s = 0.f;
#pragma unroll
          for (int j = 0; j < 4; ++j) { v[j] = xr[64 * j]; s += (v[j].x * v[j].x + v[j].y * v[j].y) + (v[j].z * v[j].z + v[j].w * v[j].w); }
          s = wave_sum(s); const float rs = rsqrtf(s * (1.0f / D) + NORM_EPS);
          u32x2* o = (u32x2*)(XB + (size_t)r * D) + lane;
#pragma unroll
          for (int j = 0; j < 4; ++j) { const f32x4 gg = ((const f32x4*)g)[lane + 64 * j]; u32x2 w; w.x = cvt_pk_bf16(v[j].x * rs * gg.x, v[j].y * rs * gg.y); w.y = cvt_pk_bf16(v[j].z * rs * gg.z, v[j].w * rs * gg.w); o[64 * j] = w; } } }
}

__device__ __forceinline__ void phase_elem2(const Args& a, int wave, int G) {
    unsigned char* ws = a.ws;
    const bf16_t* PR = (const bf16_t*)(ws + WS_PR); const bf16_t* PX = (const bf16_t*)(ws + WS_PX);
    bf16_t* LIN = (bf16_t*)(ws + WS_LIN); bf16_t* XBC = (bf16_t*)(ws + WS_XBC);
    const float* mu = a.in[I_MU]; const float* cw = a.in[I_CBW]; const float* cb = a.in[I_CBB];
    const size_t gid = (size_t)blockIdx.x * 512 + wave * 64 + lane_id(), NT = (size_t)G * 512;
    for (size_t i = gid; i < (size_t)T * 96; i += NT) {
        const int t = (int)(i / 96), q = (int)(i % 96), tl = t & (SEQ - 1);
        if (q < 32) { const int c = q * 8; float p[8], pp[8], o[8];
            unpack8(*(const u32x4*)(PR + (size_t)t * RW + 1536 + c), p);
            if (tl > 0) unpack8(*(const u32x4*)(PR + (size_t)(t - 1) * RW + 1536 + c), pp); else {
#pragma unroll
                for (int j = 0; j < 8; ++j) pp[j] = 0.f; }
#pragma unroll
            for (int j = 0; j < 8; ++j) { const float v = p[j] + (pp[j] - p[j]) * mu[1536 + c + j];
                o[j] = c < 64 ? tanhf(v) : (c < 128 ? v : sigmoidf_(v)); }
            *(u32x4*)(LIN + (size_t)t * 256 + c) = pack8(o);
        } else { const int c = (q - 32) * 8; float o[8];
#pragma unroll
            for (int j = 0; j < 8; ++j) o[j] = cb[c + j];
#pragma unroll
            for (int k = 0; k < 4; ++k) { const int dt = 3 - k; if (tl >= dt) { float p[8]; unpack8(*(const u32x4*)(PX + (size_t)(t - dt) * 512 + c), p);
#pragma unroll
                for (int j = 0; j < 8; ++j) o[j] += p[j] * cw[k * 512 + c + j]; } }
            *(u32x4*)(XBC + (size_t)t * 512 + c) = pack8(o);
        }
    }
}

#define DPP_BC(JJ) " row_newbcast:" #JJ " row_mask:0xf bank_mask:0xf"
#define RW_SA(JJ)  asm("v_fmac_f32_dpp %0, %1, %2" DPP_BC(JJ) : "+v"(sacc[JJ & 3]) : "v"(va), "v"(S[JJ]));
#define RW_UPD(JJ) { float t_; \
    asm("v_mul_f32_dpp %0, %1, %2" DPP_BC(JJ) : "=v"(t_) : "v"(vb), "v"(sa)); \
    asm("v_fmac_f32_dpp %0, %1, %2" DPP_BC(JJ) : "+v"(t_) : "v"(vk), "v"(vv)); \
    asm("v_fmac_f32_dpp %0, %1, %2" DPP_BC(JJ) : "+v"(t_) : "v"(vw), "v"(S[JJ])); \
    S[JJ] = t_; \
    asm("v_fmac_f32_dpp %0, %1, %2" DPP_BC(JJ) : "+v"(yacc[JJ & 3]) : "v"(vr), "v"(S[JJ])); }
#define RW_ALL16(M) M(0) M(1) M(2) M(3) M(4) M(5) M(6) M(7) M(8) M(9) M(10) M(11) M(12) M(13) M(14) M(15)

constexpr int RB = 32;
constexpr int PSTEP = 6 * 64;
constexpr int PBUF = RB * PSTEP * 4;

__device__ __forceinline__ float dpp_ror_add(float v, const int ctrl_sel) {
    int t;
    switch (ctrl_sel) {
        case 8: t = __builtin_amdgcn_update_dpp(0, __float_as_int(v), 0x128, 0xf, 0xf, false); break;
        case 4: t = __builtin_amdgcn_update_dpp(0, __float_as_int(v), 0x124, 0xf, 0xf, false); break;
        case 2: t = __builtin_amdgcn_update_dpp(0, __float_as_int(v), 0x122, 0xf, 0xf, false); break;
        default: t = __builtin_amdgcn_update_dpp(0, __float_as_int(v), 0x121, 0xf, 0xf, false); break;
    }
    return v + __int_as_float(t);
}
__device__ __forceinline__ float cross_row_allsum(float v) {
    auto r = __builtin_amdgcn_permlane32_swap(__float_as_uint(v), __float_as_uint(v), false, false);
    v = __uint_as_float(r[0]) + __uint_as_float(r[1]);
    auto r2 = __builtin_amdgcn_permlane16_swap(__float_as_uint(v), __float_as_uint(v), false, false);
    return __uint_as_float(r2[0]) + __uint_as_float(r2[1]);
}
__device__ __forceinline__ float wave_allsum(float v) {
    v = dpp_ror_add(v, 8); v = dpp_ror_add(v, 4); v = dpp_ror_add(v, 2); v = dpp_ror_add(v, 1);
    return cross_row_allsum(v);
}
__device__ __forceinline__ void lds_barrier() { asm volatile("s_waitcnt lgkmcnt(0)" ::: "memory"); __builtin_amdgcn_s_barrier(); asm volatile("" ::: "memory"); }

__device__ __forceinline__ void rwkv_prep_block(const Args& a, LAS float* pb, int tok0, int h, int p, int lane, float mu_r, float mu_k, float mu_v, float ckk, float cka, float crk) {
    const bf16_t* PR = (const bf16_t*)(a.ws + WS_PR); const bf16_t* LOUT = (const bf16_t*)(a.ws + WS_LOUT); float* BON = (float*)(a.ws + WS_BON);
#pragma unroll
    for (int i = 0; i < RB / 4; ++i) {
        const int s = p * (RB / 4) + i; const int tok = tok0 + s; const bool has_prev = (tok & (SEQ - 1)) != 0;
        const bf16_t* prow = PR + (size_t)tok * RW + h * 64 + lane; const bf16_t* qrow = has_prev ? prow - RW : prow;
        const bf16_t* lrow = LOUT + (size_t)tok * 1536 + h * 64 + lane;
        const float rr = bf1(prow[0]), kr = bf1(prow[512]), vr_ = bf1(prow[1024]);
        const float rp = has_prev ? bf1(qrow[0]) : 0.f, kp = has_prev ? bf1(qrow[512]) : 0.f, vp = has_prev ? bf1(qrow[1024]) : 0.f;
        const float e = bf1(lrow[0]), av = bf1(lrow[512]);
        const float r = rr + (rp - rr) * mu_r, k0 = kr + (kp - kr) * mu_k, v = vr_ + (vp - vr_) * mu_v;
        const float w = __expf(-e);
        const float kk = k0 * ckk; const float n2 = wave_allsum(kk * kk); const float kkn = kk / fmaxf(sqrtf(n2), 1e-12f);
        const float k2 = k0 * (1.0f + (av - 1.0f) * cka);
        const float bon = wave_allsum(r * k2 * crk);
        LAS float* pp = pb + s * PSTEP;
        pp[lane] = -kkn; pp[64 + lane] = kkn * av; pp[128 + lane] = k2; pp[192 + lane] = w; pp[256 + lane] = r; pp[320 + lane] = v;
        if (lane == 0) BON[(size_t)tok * 8 + h] = bon;
    }
}

__device__ __forceinline__ void phase_scan(const Args& a, LAS unsigned char* lds, int wave, int G) {
    const int lane = lane_id();
    unsigned char* ws = a.ws;
    constexpr int SB = 16, NBLK = SEQ / RB;
    for (int pair = blockIdx.x; pair < 256; pair += G) {
        const int b = pair >> 3, h = pair & 7, tokb = b * SEQ;
        const int il = lane & 15, irow = 16 * (wave & 3) + il;
        float S[16];
#pragma unroll
        for (int j = 0; j < 16; ++j) S[j] = 0.f;
        const float mu_r = a.in[I_MU][h * 64 + lane], mu_k = a.in[I_MU][512 + h * 64 + lane], mu_v = a.in[I_MU][1024 + h * 64 + lane];
        const float ckk = a.in[I_KK][h * 64 + lane], cka = a.in[I_KA][h * 64 + lane], crk = a.in[I_RK][h * 64 + lane];
        bf16_t* YRAW = (bf16_t*)(ws + WS_YRAW);
        const size_t base = (size_t)tokb * 512 + h * 64 + lane;
        const bf16_t* LA = (const bf16_t*)(ws + WS_RGLA) + base; const bf16_t* U = (const bf16_t*)(ws + WS_RGU) + base; const bf16_t* PY = (const bf16_t*)(ws + WS_PY) + base;
        bf16_t* YB = (bf16_t*)(ws + WS_YB) + base;
        bf16_t cla[SB], cu[SB], cpy[SB]; float hh = 0.f;
        if (wave == 4) {
#pragma unroll
            for (int s = 0; s < SB; ++s) { cla[s] = LA[(size_t)s * 512]; cu[s] = U[(size_t)s * 512]; cpy[s] = PY[(size_t)s * 512]; }
        } else {
#pragma unroll
            for (int s = 0; s < SB; ++s) { cla[s] = 0; cu[s] = 0; cpy[s] = 0; }
        }
        if (wave >= 4) rwkv_prep_block(a, (LAS float*)lds, tokb, h, wave - 4, lane, mu_r, mu_k, mu_v, ckk, cka, crk);
        lds_barrier();
        for (int blk = 0; blk < NBLK; ++blk) {
            if (wave < 4) {
                const LAS float* pb = (const LAS float*)(lds + (blk & 1) * PBUF);
#pragma unroll 2
                for (int s = 0; s < RB; ++s) {
                    const LAS float* pp = pb + s * PSTEP;
                    float va = pp[lane], vb = pp[64 + lane], vk = pp[128 + lane], vw = pp[192 + lane], vr = pp[256 + lane]; const float vv = pp[320 + irow];
                    asm volatile("s_nop 1" : "+v"(va), "+v"(vb), "+v"(vk), "+v"(vw), "+v"(vr));
                    float sacc[4] = {0.f, 0.f, 0.f, 0.f}, yacc[4] = {0.f, 0.f, 0.f, 0.f};
                    RW_ALL16(RW_SA)
                    float sa = (sacc[0] + sacc[1]) + (sacc[2] + sacc[3]);
                    sa = cross_row_allsum(sa);
                    RW_ALL16(RW_UPD)
                    float y = (yacc[0] + yacc[1]) + (yacc[2] + yacc[3]);
                    y = cross_row_allsum(y);
                    const int tok = tokb + blk * RB + s;
                    if (lane < 16) YRAW[(size_t)tok * 512 + h * 64 + irow] = f2bf(y);
                }
            } else {
                if (blk + 1 < NBLK) rwkv_prep_block(a, (LAS float*)(lds + ((blk + 1) & 1) * PBUF), tokb + (blk + 1) * RB, h, wave - 4, lane, mu_r, mu_k, mu_v, ckk, cka, crk);
                if (wave == 4) {
                    for (int sub = 0; sub < RB / SB; ++sub) {
                        const int t0 = blk * RB + sub * SB, tn = (t0 + SB < SEQ) ? t0 + SB : t0;
                        bf16_t nla[SB], nu[SB], npy[SB];
#pragma unroll
                        for (int s = 0; s < SB; ++s) { nla[s] = LA[(size_t)(tn + s) * 512]; nu[s] = U[(size_t)(tn + s) * 512]; npy[s] = PY[(size_t)(tn + s) * 512]; }
#pragma unroll
                        for (int s = 0; s < SB; ++s) { hh = __expf(bf1(cla[s])) * hh + bf1(cu[s]); YB[(size_t)(t0 + s) * 512] = f2bf(hh * gelu_tanh(bf1(cpy[s]))); }
#pragma unroll
                        for (int s = 0; s < SB; ++s) { cla[s] = nla[s]; cu[s] = nu[s]; cpy[s] = npy[s]; }
                    }
                }
            }
            lds_barrier();
        }
    }
    asm volatile("s_waitcnt vmcnt(0)" ::: "memory");
}

__device__ __forceinline__ void phase_post(const Args& a, int wave, int G) {
    unsigned char* ws = a.ws;
    const bf16_t* PR = (const bf16_t*)(ws + WS_PR); const bf16_t* LOUT = (const bf16_t*)(ws + WS_LOUT); const bf16_t* YRAW = (const bf16_t*)(ws + WS_YRAW);
    const float* BON = (const float*)(ws + WS_BON); bf16_t* YA = (bf16_t*)(ws + WS_YA);
    const float* mu = a.in[I_MU]; const float* lg = a.in[I_LNXG]; const float* lb = a.in[I_LNXB];
    const size_t gid = (size_t)blockIdx.x * 512 + wave * 64 + lane_id(), NT = (size_t)G * 512;
    for (size_t i = gid; i < (size_t)T * 64; i += NT) {
        const int t = (int)(i >> 6), c = (int)(i & 63) * 8, h = c >> 6, tl = t & (SEQ - 1);
        float y[8], v[8], vp[8], g[8], o[8];
        unpack8(*(const u32x4*)(YRAW + (size_t)t * 512 + c), y);
        unpack8(*(const u32x4*)(PR + (size_t)t * RW + 1024 + c), v);
        if (tl > 0) unpack8(*(const u32x4*)(PR + (size_t)(t - 1) * RW + 1024 + c), vp); else {
#pragma unroll
            for (int j = 0; j < 8; ++j) vp[j] = 0.f; }
        unpack8(*(const u32x4*)(LOUT + (size_t)t * 1536 + 1024 + c), g);
        float s = 0.f;
#pragma unroll
        for (int j = 0; j < 8; ++j) s += y[j];
        s += __shfl_xor(s, 1); s += __shfl_xor(s, 2); s += __shfl_xor(s, 4);
        const float mean = s * (1.0f / 64.0f); float q = 0.f;
#pragma unroll
        for (int j = 0; j < 8; ++j) { const float d = y[j] - mean; q += d * d; }
        q += __shfl_xor(q, 1); q += __shfl_xor(q, 2); q += __shfl_xor(q, 4);
        const float rs = rsqrtf(q * (1.0f / 64.0f) + LNX_EPS), bon = BON[(size_t)t * 8 + h];
#pragma unroll
        for (int j = 0; j < 8; ++j) { const float vv = v[j] + (vp[j] - v[j]) * mu[1024 + c + j];
            o[j] = ((y[j] - mean) * rs * lg[c + j] + lb[c + j] + bon * vv) * g[j]; }
        *(u32x4*)(YA + (size_t)t * 512 + c) = pack8(o);
    }
}

__device__ __forceinline__ void phase_ffnfix(const Args& a, int wave, int G) {
    unsigned char* ws = a.ws;
    const bf16_t* HG = (const bf16_t*)(ws + WS_HG); bf16_t* ACT = (bf16_t*)(ws + WS_UU);
    const float* cw = a.in[I_FCW]; const float* cb = a.in[I_FCB];
    const size_t gid = (size_t)blockIdx.x * 512 + wave * 64 + lane_id(), NT = (size_t)G * 512;
    constexpr int CPR = DFF / 8;
    for (size_t i = gid; i < (size_t)(T / 64) * 2 * CPR; i += NT) {
        const int c = (int)(i % CPR) * 8, rho = (int)((i / CPR) & 1), grp = (int)(i / (2 * CPR)); const int t = grp * 64 + rho; const bool first = (grp & 31) == 0;
        float p2[8], p1[8], cur[8], up[8], o[8];
#pragma unroll
        for (int j = 0; j < 8; ++j) { p2[j] = 0.f; p1[j] = 0.f; }
        if (rho == 0) { if (!first) { unpack8(*(const u32x4*)(HG + ((size_t)(grp - 1) * 4 + 0) * DFF + c), p2); unpack8(*(const u32x4*)(HG + ((size_t)(grp - 1) * 4 + 1) * DFF + c), p1); } }
        else { if (!first) unpack8(*(const u32x4*)(HG + ((size_t)(grp - 1) * 4 + 1) * DFF + c), p2); unpack8(*(const u32x4*)(HG + ((size_t)grp * 4 + 2) * DFF + c), p1); }
        unpack8(*(const u32x4*)(HG + ((size_t)grp * 4 + 2 + rho) * DFF + c), cur);
        unpack8(*(const u32x4*)(ACT + (size_t)t * DFF + c), up);
#pragma unroll
        for (int j = 0; j < 8; ++j) o[j] = gelu_tanh(cb[c + j] + cw[c + j] * p2[j] + cw[DFF + c + j] * p1[j] + cw[2 * DFF + c + j] * cur[j]) * up[j];
        *(u32x4*)(ACT + (size_t)t * DFF + c) = pack8(o);
    }
}

__device__ __forceinline__ void phase_final(const Args& a, int wave, int G) {
    const int lane = lane_id();
    const float* ssp = (const float*)(a.ws + WS_SSP3); const float* g = a.in[I_NFING];
    const int gw = blockIdx.x * 8 + wave, NGW = G * 8;
    for (int r = gw; r < T; r += NGW) { const float rs = rstd_from16(ssp, r); f32x4* xr = (f32x4*)(a.out + (size_t)r * D) + lane;
#pragma unroll
        for (int j = 0; j < 4; ++j) { const f32x4 gg = ((const f32x4*)g)[lane + 64 * j]; f32x4 v = xr[64 * j]; v = v * rs * gg; xr[64 * j] = v; } }
}

constexpr int NPHASE = 13;
__global__ void __launch_bounds__(512, 2) mega(Args a) {
    extern __shared__ __attribute__((aligned(16))) unsigned char lds_raw[];
    LAS unsigned char* lds = (LAS unsigned char*)lds_raw;
    cg::grid_group grid = cg::this_grid();
    const int wave = __builtin_amdgcn_readfirstlane((int)threadIdx.x >> 6), G = gridDim.x, bid = blockIdx.x;
    unsigned char* ws = a.ws;
    const int lo = a.ph_lo, hi = a.ph_hi;
    const bool t0 = (wave == 0) && (lane_id() == 0);
    volatile LAS unsigned* misc = (volatile LAS unsigned*)(lds + 131072 + 320);
    if (t0) { misc[0] = 0u; misc[1] = 0u; }
    __syncthreads();
    XcdBarrier xb = xcd_barrier_post((unsigned*)(ws + WS_CTL), misc, t0);
#define IN(k) (lo <= (k) && (k) < hi)
#define SEAM(k) do { if (IN(k) && IN((k) + 1)) { if ((k) == 0) grid.sync(); else xcd_barrier(xb, t0); } } while (0)
    bf16_t* const XB = (bf16_t*)(ws + WS_XB);
    const float* rstdx = (const float*)(ws + WS_RSTDX);
    StaticOrder S;

    if (IN(0)) for (int rep_ = 0; rep_ < REPS(0); ++rep_) { phase_prep(a, lds, wave, G); __syncthreads(); } SEAM(0);

    if (IN(1)) for (int rep_ = 0; rep_ < REPS(1); ++rep_) {
        { Gemm g = plain_gemm(XB, (const bf16_t*)(ws + WS_WIN), 1024); S.init(T / BM, 11, G, bid);
          EpiProj E{rstdx, a.in[I_BIN], (bf16_t*)(ws + WS_PR), (bf16_t*)(ws + WS_PX), (bf16_t*)(ws + WS_PY)}; gemm_phase(lds, wave, g, S, E); }
        { Gemm g = plain_gemm((const bf16_t*)(ws + WS_MEMN), (const bf16_t*)(ws + WS_WK), 1024); S.init(TM / BM, 4, G, bid);
          EpiPlain E{(bf16_t*)(ws + WS_KM), 1024}; gemm_phase(lds, wave, g, S, E); }
        { Gemm g = plain_gemm((const bf16_t*)(ws + WS_WV), (const bf16_t*)(ws + WS_MEMN), 1024); S.init(4, TM / BM, G, bid);
          EpiPlain E{(bf16_t*)(ws + WS_VT), TM}; gemm_phase(lds, wave, g, S, E); }
    } SEAM(1);

    if (IN(2)) for (int rep_ = 0; rep_ < REPS(2); ++rep_) phase_elem2(a, wave, G); SEAM(2);
#ifdef PROBE_SYNC
    for (int i_ = 0; i_ < 16; ++i_) grid.sync();
#endif

    if (IN(3)) for (int rep_ = 0; rep_ < REPS(3); ++rep_) {
        { Gemm g = plain_gemm((const bf16_t*)(ws + WS_LIN), (const bf16_t*)(ws + WS_WLORA), 256); S.init(T / BM, 6, G, bid);
          EpiLora E{a.in[I_W0], a.in[I_A0], (bf16_t*)(ws + WS_LOUT)}; gemm_phase(lds, wave, g, S, E); }
        { Gemm g = plain_gemm((const bf16_t*)(ws + WS_XBC), (const bf16_t*)(ws + WS_WRG), 512); S.init(T / BM, 4, G, bid);
          EpiRg E{a.in[I_BRGA], a.in[I_BRGX], a.in[I_LAM], (const bf16_t*)(ws + WS_XBC), (bf16_t*)(ws + WS_RGLA), (bf16_t*)(ws + WS_RGU)}; gemm_phase(lds, wave, g, S, E); }
    } SEAM(3);

    if (IN(4)) for (int rep_ = 0; rep_ < REPS(4); ++rep_) phase_scan(a, lds, wave, G); SEAM(4);
    if (IN(5)) for (int rep_ = 0; rep_ < REPS(5); ++rep_) phase_post(a, wave, G); SEAM(5);

    if (IN(6)) for (int rep_ = 0; rep_ < REPS(6); ++rep_) {
        S.init(T / BM, 4, G, bid);
        { Gemm g = plain_gemm(XB, (const bf16_t*)(ws + WS_WIN) + (size_t)2816 * 1024, 1024); EpiGab E{rstdx, a.in[I_BIN] + 2816, (bf16_t*)(ws + WS_GAB), 0}; gemm_phase(lds, wave, g, S, E); }
        { Gemm g = plain_gemm((const bf16_t*)(ws + WS_YA), (const bf16_t*)(ws + WS_WA), 512); EpiBranch<true> E{(const bf16_t*)(ws + WS_GAB), (bf16_t*)(ws + WS_MERGED)}; gemm_phase(lds, wave, g, S, E); }
        { Gemm g = plain_gemm(XB, (const bf16_t*)(ws + WS_WIN) + (size_t)3840 * 1024, 1024); EpiGab E{rstdx, a.in[I_BIN] + 2816, (bf16_t*)(ws + WS_GAB), 1024}; gemm_phase(lds, wave, g, S, E); }
        { Gemm g = plain_gemm((const bf16_t*)(ws + WS_YB), (const bf16_t*)(ws + WS_WB), 512); EpiBranch<false> E{(const bf16_t*)(ws + WS_GAB), (bf16_t*)(ws + WS_MERGED)}; gemm_phase(lds, wave, g, S, E); }
    } SEAM(6);
    if (IN(7)) for (int rep_ = 0; rep_ < REPS(7); ++rep_) { Gemm g = plain_gemm((const bf16_t*)(ws + WS_MERGED), (const bf16_t*)(ws + WS_WMIX), 1024); S.init(T / BM, 4, G, bid);
        EpiRes<true> E{a.in[I_X], a.out, (bf16_t*)(ws + WS_X1B), (float*)(ws + WS_SSP1)}; gemm_phase(lds, wave, g, S, E); } SEAM(7);
    if (IN(8)) for (int rep_ = 0; rep_ < REPS(8); ++rep_) {
        S.init(T / BM, 4, G, bid);
        { Gemm g = plain_gemm((const bf16_t*)(ws + WS_X1B), (const bf16_t*)(ws + WS_WCQ), 1024);
          EpiQ E{(const float*)(ws + WS_SSP1), (bf16_t*)(ws + WS_Q)}; gemm_phase(lds, wave, g, S, E); }
        { Gemm g; g.A = (const bf16_t*)(ws + WS_Q); g.Bt = (const bf16_t*)(ws + WS_KM); g.lda = 1024; g.ldb = 1024; g.K = 256;
          g.a_pm = (size_t)BM * 1024 * 2; g.a_pn = 512; g.b_pn = 512; g.b_pb = (size_t)NMEM * 1024 * 2;
          EpiSc E{(bf16_t*)(ws + WS_PEXP), (float*)(ws + WS_SSPA)}; gemm_phase(lds, wave, g, S, E); }
        { Gemm g; g.A = (const bf16_t*)(ws + WS_PEXP); g.Bt = (const bf16_t*)(ws + WS_VT); g.lda = 1024; g.ldb = TM; g.K = 256;
          g.a_pm = (size_t)BM * 1024 * 2; g.a_pn = 512; g.b_pn = (size_t)256 * TM * 2; g.b_pb = 512;
          EpiPv E{(const float*)(ws + WS_SSPA), (bf16_t*)(ws + WS_O)}; gemm_phase(lds, wave, g, S, E); }
    } SEAM(8);
    if (IN(9)) for (int rep_ = 0; rep_ < REPS(9); ++rep_) { Gemm g = plain_gemm((const bf16_t*)(ws + WS_O), (const bf16_t*)(ws + WS_WCO), 1024); S.init(T / BM, 4, G, bid);
        EpiRes<true> E{a.out, a.out, (bf16_t*)(ws + WS_X2B), (float*)(ws + WS_SSP2)}; gemm_phase(lds, wave, g, S, E); } SEAM(9);
    if (IN(10)) for (int rep_ = 0; rep_ < REPS(10); ++rep_) { Gemm g = plain_gemm((const bf16_t*)(ws + WS_X2B), (const bf16_t*)(ws + WS_WFFI), 1024); S.init(T / BM, 22, G, bid);
        EpiFfnAct E{(const float*)(ws + WS_SSP2), a.in[I_FCW], a.in[I_FCB], (bf16_t*)(ws + WS_UU), (bf16_t*)(ws + WS_HG)}; gemm_phase(lds, wave, g, S, E); } SEAM(10);
    if (IN(11)) for (int rep_ = 0; rep_ < REPS(11); ++rep_) phase_ffnfix(a, wave, G); SEAM(11);
    if (IN(12)) for (int rep_ = 0; rep_ < REPS(12); ++rep_) { Gemm g = plain_gemm((const bf16_t*)(ws + WS_UU), (const bf16_t*)(ws + WS_WFFO), DFF); S.init(T / BM, 4, G, bid);
        EpiRes<false> E{a.out, a.out, nullptr, (float*)(ws + WS_SSP3)}; gemm_phase(lds, wave, g, S, E); } SEAM(12);
    if (IN(13)) for (int rep_ = 0; rep_ < REPS(13); ++rep_) phase_final(a, wave, G);
#undef IN
#undef SEAM
}

extern "C" void kernel_launch(void* const* d_in, const int* in_sizes, int n_in, void* d_out, int out_size, void* d_ws, size_t ws_size, hipStream_t stream) {
    static int grid = 0;
    if (grid == 0) {
        if (n_in != 37 || in_sizes[0] != T * D || out_size != T * D || ws_size < WS_END) {
            fprintf(stderr, "kernel_launch: unexpected shapes (n_in %d, in0 %d, out %d, ws %zu < %zu); nothing launched\n", n_in, n_in > 0 ? in_sizes[0] : -1, out_size, ws_size, (size_t)WS_END); grid = -1; return; }
        int dev = 0, cus = 0, per_cu = 0;
        if (hipGetDevice(&dev) != hipSuccess || hipDeviceGetAttribute(&cus, hipDeviceAttributeMultiprocessorCount, dev) != hipSuccess) { grid = -1; return; }
        if (hipFuncSetAttribute((const void*)mega, hipFuncAttributeMaxDynamicSharedMemorySize, LDS_BYTES) != hipSuccess) { fprintf(stderr, "kernel_launch: hipFuncSetAttribute failed\n"); grid = -1; return; }
        if (hipOccupancyMaxActiveBlocksPerMultiprocessor(&per_cu, (const void*)mega, 512, LDS_BYTES) != hipSuccess || per_cu < 1) { fprintf(stderr, "kernel_launch: occupancy query says %d\n", per_cu); per_cu = 1; }
        (void)hipGetLastError();
        grid = cus * 1;
    }
    if (grid < 0) return;
    if (hipMemsetAsync((char*)d_ws + WS_CTL, 0, CTL_BYTES, stream) != hipSuccess) { fprintf(stderr, "kernel_launch: memset failed\n"); return; }
    Args a{};
    for (int i = 0; i < 37; ++i) a.in[i] = (const float*)d_in[i];
    a.out = (float*)d_out; a.ws = (unsigned char*)d_ws;
#if MK_SPLIT
    for (int ph = 0; ph <= NPHASE; ++ph) {
        a.ph_lo = ph; a.ph_hi = ph + 1; void* args[] = {&a};
        hipError_t e = hipLaunchCooperativeKernel((const void*)mega, dim3(grid), dim3(512), args, LDS_BYTES, stream);
        if (e != hipSuccess) { fprintf(stderr, "kernel_launch: launch of phase %d failed: %s\n", ph, hipGetErrorString(e)); break; }
    }
#else
    a.ph_lo = 0; a.ph_hi = NPHASE + 1; void* args[] = {&a};
    hipError_t e = hipLaunchCooperativeKernel((const void*)mega, dim3(grid), dim3(512), args, LDS_BYTES, stream);
    if (e != hipSuccess) fprintf(stderr, "kernel_launch: cooperative launch failed: %s (grid %d)\n", hipGetErrorString(e), grid);
#endif
}
```

```cpp
#include <hip/hip_runtime.h>
#include <hip/hip_cooperative_groups.h>
#include <cstdio>
namespace cg = cooperative_groups;

#ifndef MK_SPLIT
#define MK_SPLIT 0
#endif

#ifndef DUP_PHASE
#define DUP_PHASE -1
#endif
#define REPS(k) ((DUP_PHASE == (k)) ? 2 : 1)
#define LAS __attribute__((address_space(3)))
typedef unsigned short bf16_t;
typedef short bf16x8 __attribute__((ext_vector_type(8)));
typedef float f32x4 __attribute__((ext_vector_type(4)));
typedef float f32x2 __attribute__((ext_vector_type(2)));
typedef unsigned u32x4 __attribute__((ext_vector_type(4)));
typedef unsigned u32x2 __attribute__((ext_vector_type(2)));

constexpr int T = 65536, D = 1024, SEQ = 2048, NB = 32, NMEM = 256, TM = NB * NMEM;
constexpr int AW = 512, RW = 1792, PIN = 4864, DFF = 2816;
constexpr float NORM_EPS = 1e-6f, LNX_EPS = 64e-5f;

constexpr size_t MiB = 1u << 20;
constexpr size_t WS_WIN = 0;
constexpr size_t WS_WFFI = 10 * MiB;
constexpr size_t WS_WFFO = 21 * MiB;
constexpr size_t WS_WMIX = 27 * MiB, WS_WCQ = 29 * MiB, WS_WK = 31 * MiB, WS_WV = 33 * MiB, WS_WCO = 35 * MiB;
constexpr size_t WS_WA = 37 * MiB, WS_WB = 38 * MiB;
constexpr size_t WS_WLORA = 39 * MiB;
constexpr size_t WS_WRG = 40 * MiB;
constexpr size_t WS_CTL = 46 * MiB, CTL_BYTES = 16384;
constexpr size_t WS_RSTDX = 48 * MiB;
constexpr size_t WS_SSP1 = 49 * MiB, WS_SSP2 = 53 * MiB, WS_SSP3 = 57 * MiB, WS_SSPA = 61 * MiB;
constexpr size_t WS_BON = 65 * MiB;
constexpr size_t WS_MEMN = 68 * MiB, WS_KM = 84 * MiB, WS_VT = 100 * MiB;
constexpr size_t WS_XB = 120 * MiB;
constexpr size_t WS_PR = 248 * MiB;
constexpr size_t WS_PX = 472 * MiB, WS_PY = 536 * MiB;
constexpr size_t WS_LIN = 600 * MiB, WS_XBC = 632 * MiB;
constexpr size_t WS_LOUT = 696 * MiB;
constexpr size_t WS_RGLA = 888 * MiB, WS_RGU = 952 * MiB;
constexpr size_t WS_YRAW = WS_PX, WS_YB = WS_LIN, WS_YA = WS_RGLA;
constexpr size_t WS_GAB = 248 * MiB;
constexpr size_t WS_MERGED = 696 * MiB;
constexpr size_t WS_X1B = WS_XB, WS_Q = 248 * MiB, WS_PEXP = 376 * MiB, WS_O = 504 * MiB, WS_X2B = WS_XB;
constexpr size_t WS_HG = 248 * MiB, WS_UU = 600 * MiB;
constexpr size_t WS_END = 1016 * MiB;

constexpr int LDS_BYTES = 147456;

__device__ __forceinline__ unsigned cvt_pk_bf16(float lo, float hi) { unsigned r; asm("v_cvt_pk_bf16_f32 %0, %1, %2" : "=v"(r) : "v"(lo), "v"(hi)); return r; }
__device__ __forceinline__ float bf_lo(unsigned w) { return __uint_as_float(w << 16); }
__device__ __forceinline__ float bf_hi(unsigned w) { return __uint_as_float(w & 0xffff0000u); }
__device__ __forceinline__ float bf1(bf16_t b) { return __uint_as_float(((unsigned)b) << 16); }
__device__ __forceinline__ bf16_t f2bf(float f) { return (bf16_t)(cvt_pk_bf16(f, 0.f) & 0xffffu); }
__device__ __forceinline__ float sigmoidf_(float x) { return __builtin_amdgcn_rcpf(1.0f + __expf(-x)); }
__device__ __forceinline__ float gelu_tanh(float x) { const float z = 1.5957691216057308f * (x + 0.044715f * x * x * x); return x * sigmoidf_(z); }
__device__ __forceinline__ int lane_id() { int l; asm volatile("v_mbcnt_lo_u32_b32 %0, -1, 0\n\tv_mbcnt_hi_u32_b32 %0, -1, %0" : "=v"(l)); return l; }
__device__ __forceinline__ float wave_sum(float v) {
#pragma unroll
    for (int o = 1; o < 64; o <<= 1) v += __shfl_xor(v, o);
    return v;
}
__device__ __forceinline__ void unpack8(const u32x4 w, float (&f)[8]) {
    f[0] = bf_lo(w.x); f[1] = bf_hi(w.x); f[2] = bf_lo(w.y); f[3] = bf_hi(w.y); f[4] = bf_lo(w.z); f[5] = bf_hi(w.z); f[6] = bf_lo(w.w); f[7] = bf_hi(w.w);
}
__device__ __forceinline__ u32x4 pack8(const float (&f)[8]) {
    u32x4 w; w.x = cvt_pk_bf16(f[0], f[1]); w.y = cvt_pk_bf16(f[2], f[3]); w.z = cvt_pk_bf16(f[4], f[5]); w.w = cvt_pk_bf16(f[6], f[7]); return w;
}


#define XB_TMO      128
#define XB_XCNT(j)  (256  + 64 * (j))
#define XB_XSUB(j)  (1280 + 64 * (j))
#define XB_XGEN(j)  (2304 + 64 * (j))
#define XB_TOP      3328
#define XB_TOPGEN   3392
#define XCD_BAR_WORDS 3456
#define XB_SPIN_CAP (1u << 22)
__device__ __forceinline__ unsigned xb_ld(unsigned* p)              { return __hip_atomic_load(p, __ATOMIC_RELAXED, __HIP_MEMORY_SCOPE_AGENT); }
__device__ __forceinline__ unsigned xb_add(unsigned* p, unsigned v) { return __hip_atomic_fetch_add(p, v, __ATOMIC_RELAXED, __HIP_MEMORY_SCOPE_AGENT); }
__device__ __forceinline__ unsigned xb_xcc_id() { return (unsigned)__builtin_amdgcn_s_getreg((3 << 11) | 20) & 0xFu; }
#define XB_SPIN(cond, bar) do { unsigned _sp = 0; while (cond) { __builtin_amdgcn_s_sleep(1); \
    if ((++_sp & 255u) == 0u) { if (xb_ld(&(bar)[XB_TMO])) break; if (_sp > XB_SPIN_CAP) { atomicAdd(&(bar)[XB_TMO], 1u); break; } } } } while (0)
struct XcdBarrier { unsigned* bar; unsigned x; volatile LAS unsigned* st; };
__device__ __forceinline__ XcdBarrier xcd_barrier_post(unsigned* bar, volatile LAS unsigned* st, bool t0) {
    XcdBarrier b; b.bar = bar; b.x = xb_xcc_id(); b.st = st;
    if (t0) (void)xb_add(&bar[XB_XCNT(b.x)], 1u);
    return b;
}
__device__ __forceinline__ void xcd_barrier_complete(unsigned* bar, unsigned x, unsigned& nloc, unsigned& nx) {
    const unsigned G = gridDim.x * gridDim.y * gridDim.z;
    unsigned sum, cnt, mine, sp = 0u;
    for (;;) {
        sum = 0u; cnt = 0u; mine = 0u;
#pragma unroll
        for (unsigned j = 0; j < 16; ++j) { const unsigned c = xb_ld(&bar[XB_XCNT(j)]); sum += c; cnt += (c > 0u) ? 1u : 0u; mine = (j == x) ? c : mine; }
        if (sum == G) break;
        __builtin_amdgcn_s_sleep(1);
        if ((++sp & 255u) == 0u) { if (xb_ld(&bar[XB_TMO])) break; if (sp > XB_SPIN_CAP) { atomicAdd(&bar[XB_TMO], 1u); break; } }
    }
    nloc = mine > 0u ? mine : 1u; nx = cnt > 0u ? cnt : 1u;
}
__device__ __forceinline__ void xcd_barrier(const XcdBarrier& b, bool t0) {
    asm volatile("s_waitcnt vmcnt(0)" ::: "memory");
    __syncthreads();
    if (t0) {
        unsigned* bar = b.bar;
        __builtin_amdgcn_s_waitcnt(0);
        unsigned nloc = b.st[0], nx = b.st[1];
        if (nloc == 0u) { xcd_barrier_complete(bar, b.x, nloc, nx); b.st[0] = nloc; b.st[1] = nx; }
        const unsigned old = xb_add(&bar[XB_XSUB(b.x)], 1u);
        const unsigned gen = old / nloc;
        if (old + 1u == (gen + 1u) * nloc) {
            __builtin_amdgcn_fence(__ATOMIC_RELEASE, "agent");
            asm volatile("s_waitcnt vmcnt(0)" ::: "memory");
            const unsigned og = xb_add(&bar[XB_TOP], 1u);
            const unsigned tg = og / nx;
            if (og + 1u == (tg + 1u) * nx) xb_add(&bar[XB_TOPGEN], 1u);
            else XB_SPIN(xb_ld(&bar[XB_TOPGEN]) == tg, bar);
            __builtin_amdgcn_fence(__ATOMIC_ACQUIRE, "agent");
            xb_add(&bar[XB_XGEN(b.x)], 1u);
            asm volatile("s_waitcnt vmcnt(0)" ::: "memory");
        } else {
            XB_SPIN(xb_ld(&bar[XB_XGEN(b.x)]) == gen, bar);
            __builtin_amdgcn_fence(__ATOMIC_ACQUIRE, "agent");
            asm volatile("s_waitcnt vmcnt(0)" ::: "memory");
        }
    }
    __syncthreads();
}

constexpr int BM = 256, BK = 64, HALF = 128, HTB = HALF * BK * 2, NXCD = 8, WGM = 8;
__device__ __forceinline__ int lds_byte(int r, int c) { const int st = (r >> 4) * 2 + (c >> 5), rr = r & 15, cc = c & 31, ob = rr * 64 + cc * 2; return st * 1024 + (ob ^ (((ob >> 9) & 1) << 5)); }
__device__ __forceinline__ void stage_rc(int b, int& R, int& C) { const int st = b / 1024, sb = b % 1024, swz = sb ^ (((sb >> 9) & 1) << 5); R = (st >> 1) * 16 + swz / 64; C = (st & 1) * 32 + (swz % 64) / 2; }
__device__ __forceinline__ int perm32(int rho) { const int n = rho >> 4, i = rho & 15; return 8 * (i >> 2) + 4 * n + (i & 3); }

struct Unit { int pm, pn; };
struct Gemm { const bf16_t* A; const bf16_t* Bt; int lda, ldb, K; size_t a_pm, a_pn, b_pn, b_pb; };
__device__ __forceinline__ Gemm plain_gemm(const bf16_t* A, const bf16_t* Bt, int K) { Gemm g; g.A = A; g.Bt = Bt; g.lda = K; g.ldb = K; g.K = K; g.a_pm = (size_t)BM * K * 2; g.a_pn = 0; g.b_pn = (size_t)BM * K * 2; g.b_pb = 0; return g; }

struct StaticOrder {
    int nM, nN, nwg, G, c;
    __device__ void init(int nM_, int nN_, int G_, int c_) { nM = nM_; nN = nN_; nwg = nM * nN; G = G_; c = c_; }
    __device__ bool next(int i, Unit& u) const {
        const long L = (long)i * G + c; if (L >= nwg) return false;
        int wgid = (int)L; { const int q = nwg / NXCD, r = nwg % NXCD, xcd = wgid % NXCD, off = wgid / NXCD; wgid = (xcd < r ? xcd * (q + 1) : r * (q + 1) + (xcd - r) * q) + off; }
        const int nig = WGM * nN, gid = wgid / nig, fm = gid * WGM, gsz = (nM - fm) < WGM ? (nM - fm) : WGM;
        u.pm = fm + ((wgid % nig) % gsz); u.pn = (wgid % nig) / gsz; return true;
    }
};

typedef f32x4 Acc[2][2][4][2];

template <class Epi>
__device__ __forceinline__ void gemm_phase(LAS unsigned char* lds, const int wid, const Gemm g, const StaticOrder& S, const Epi& E) {
    const int lane = lane_id(), tid = wid * 64 + lane, wr = wid >> 2, wc = wid & 3, fr = lane & 15, fq = lane >> 4;
    const int nt = g.K / BK;
    unsigned voffA[2], voffB[2];
#pragma unroll
    for (int i = 0; i < 2; ++i) { int R, C; stage_rc(tid * 16 + i * 8192, R, C); const int Rb = Epi::PERM ? ((R & ~31) + perm32(R & 31)) : R;
        voffA[i] = (unsigned)(R * g.lda + C) * 2u; voffB[i] = (unsigned)(Rb * g.ldb + C) * 2u; }
    const size_t kstep = (size_t)(BK * 2);
    const size_t hstepA = (size_t)HALF * g.lda * 2, hstepB = (size_t)HALF * g.ldb * 2;
    const unsigned ldsw = (unsigned)wid * 1024u;
    const int aoff = lds_byte(wr * 64 + fr, fq * 8), boff = lds_byte(wc * 32 + fr, fq * 8);
#define PG8_SA(b, h) (((b) * 2 + (h)) * HTB)
#define PG8_SB(b, h) ((4 + (b) * 2 + (h)) * HTB)
#define PG8_STAGE(bufoff, gbase, voff) do { _Pragma("unroll") for (int _i = 0; _i < 2; ++_i) \
        __builtin_amdgcn_global_load_lds((const unsigned*)((const char*)(gbase) + (voff)[_i]), (LAS unsigned*)(lds + (bufoff) + ldsw + _i * 8192), 16, 0, 0); } while (0)
#define PG8_LDA(dst, b, h) do { _Pragma("unroll") for (int m = 0; m < 4; ++m) _Pragma("unroll") for (int k = 0; k < 2; ++k) dst[m][k] = *(const LAS bf16x8*)(lds + PG8_SA(b, h) + aoff + m * 2048 + k * 1024); } while (0)
#define PG8_LDB(dst, b, h) do { _Pragma("unroll") for (int n = 0; n < 2; ++n) _Pragma("unroll") for (int k = 0; k < 2; ++k) dst[n][k] = *(const LAS bf16x8*)(lds + PG8_SB(b, h) + boff + n * 2048 + k * 1024); } while (0)
#define PG8_MMA(ai, bj, At, Bt) do { __builtin_amdgcn_s_setprio(1); _Pragma("unroll") for (int m = 0; m < 4; ++m) _Pragma("unroll") for (int n = 0; n < 2; ++n) _Pragma("unroll") for (int k = 0; k < 2; ++k) \
        acc[ai][bj][m][n] = __builtin_amdgcn_mfma_f32_16x16x32_bf16(Bt[n][k], At[m][k], acc[ai][bj][m][n], 0, 0, 0); __builtin_amdgcn_s_setprio(0); } while (0)
#define PG8_WAIT_V(n) asm volatile("s_waitcnt vmcnt(" #n ")" ::: "memory")
#define PG8_WAIT_L(n) asm volatile("s_waitcnt lgkmcnt(" #n ")" ::: "memory")
#define PG8_BAR __builtin_amdgcn_s_barrier()
#define PG8_SCHED __builtin_amdgcn_sched_barrier(0)
#define PG8_UA(u) ((const char*)g.A + (size_t)(u).pm * g.a_pm + (size_t)(u).pn * g.a_pn)
#define PG8_UB(u) ((const char*)g.Bt + (size_t)(u).pn * g.b_pn + (size_t)((u).pm >> 3) * g.b_pb)
    Unit cur, nxt; int ui = 0;
    if (!S.next(0, cur)) return;
    Acc acc;
#pragma unroll
    for (int a = 0; a < 2; ++a)
#pragma unroll
        for (int b = 0; b < 2; ++b)
#pragma unroll
            for (int m = 0; m < 4; ++m)
#pragma unroll
                for (int n = 0; n < 2; ++n) acc[a][b][m][n] = (f32x4){0.f, 0.f, 0.f, 0.f};
    bf16x8 At[4][2], B0[2][2], B1[2][2];
    const char* cA = PG8_UA(cur); const char* cB = PG8_UB(cur);
    PG8_STAGE(PG8_SB(0, 0), cB, voffB); PG8_STAGE(PG8_SB(0, 1), cB + hstepB, voffB); PG8_STAGE(PG8_SA(0, 0), cA, voffA); PG8_STAGE(PG8_SA(0, 1), cA + hstepA, voffA);
    if (wr == 1) PG8_BAR;
    PG8_WAIT_V(2); PG8_BAR;
    PG8_STAGE(PG8_SB(1, 0), cB + kstep, voffB); PG8_STAGE(PG8_SA(1, 0), cA + kstep, voffA); PG8_STAGE(PG8_SB(1, 1), cB + hstepB + kstep, voffB);
    PG8_WAIT_V(6); PG8_BAR;
    for (;;) {
        const bool has_next = S.next(ui + 1, nxt);
        const char* nA = has_next ? PG8_UA(nxt) : cA; const char* nB = has_next ? PG8_UB(nxt) : cB;
        for (int t = 0; t < nt; t += 2) {
            const bool last = (t == nt - 2);
            const char* a1 = cA + (size_t)(t + 1) * kstep;
            const char* a2 = last ? nA : cA + (size_t)(t + 2) * kstep; const char* b2 = last ? nB : cB + (size_t)(t + 2) * kstep;
            const char* a3 = a2 + kstep; const char* b3 = b2 + kstep;
            PG8_LDB(B0, 0, 0); PG8_LDB(B1, 0, 1); PG8_SCHED; PG8_LDA(At, 0, 0); PG8_STAGE(PG8_SA(1, 1), a1 + hstepA, voffA);
            PG8_WAIT_V(8); PG8_WAIT_L(0); PG8_BAR; PG8_MMA(0, 0, At, B0); PG8_MMA(0, 1, At, B1); PG8_BAR; PG8_SCHED;
            PG8_LDA(At, 0, 1); PG8_STAGE(PG8_SB(0, 0), b2, voffB); PG8_STAGE(PG8_SB(0, 1), b2 + hstepB, voffB); PG8_STAGE(PG8_SA(0, 0), a2, voffA);
            PG8_WAIT_V(8); PG8_WAIT_L(0); PG8_BAR; PG8_MMA(1, 0, At, B0); PG8_MMA(1, 1, At, B1); PG8_BAR; PG8_SCHED;
            PG8_LDB(B0, 1, 0); PG8_LDB(B1, 1, 1); PG8_SCHED; PG8_LDA(At, 1, 0); PG8_STAGE(PG8_SA(0, 1), a2 + hstepA, voffA);
            PG8_WAIT_V(8); PG8_WAIT_L(0); PG8_BAR; PG8_MMA(0, 0, At, B0); PG8_MMA(0, 1, At, B1); PG8_BAR; PG8_SCHED;
            PG8_LDA(At, 1, 1); PG8_STAGE(PG8_SB(1, 0), b3, voffB); PG8_STAGE(PG8_SB(1, 1), b3 + hstepB, voffB); PG8_STAGE(PG8_SA(1, 0), a3, voffA);
            PG8_WAIT_V(8); PG8_WAIT_L(0); PG8_BAR; PG8_MMA(1, 0, At, B0); PG8_MMA(1, 1, At, B1); PG8_BAR; PG8_SCHED;
        }
        if (wr == 0) PG8_BAR;
        E(acc, cur, wr, wc, fr, fq);
        if (!has_next) break;
#pragma unroll
        for (int a = 0; a < 2; ++a)
#pragma unroll
            for (int b = 0; b < 2; ++b)
#pragma unroll
                for (int m = 0; m < 4; ++m)
#pragma unroll
                    for (int n = 0; n < 2; ++n) acc[a][b][m][n] = (f32x4){0.f, 0.f, 0.f, 0.f};
        cur = nxt; cA = nA; cB = nB; ++ui;
        if (wr == 1) PG8_BAR;
    }
    PG8_WAIT_V(0);
    PG8_BAR;
#undef PG8_SA
#undef PG8_SB
#undef PG8_STAGE
#undef PG8_LDA
#undef PG8_LDB
#undef PG8_MMA
#undef PG8_WAIT_V
#undef PG8_WAIT_L
#undef PG8_BAR
#undef PG8_SCHED
#undef PG8_UA
#undef PG8_UB
}

#define EPI_ROWS_BEGIN for (int ai = 0; ai < 2; ++ai) { _Pragma("unroll") for (int m = 0; m < 4; ++m) { const int r = u.pm * BM + ai * HALF + wr * 64 + m * 16 + fr;
#define EPI_ROWS_END } }

__device__ __forceinline__ float rstd_from16(const float* ss, int r) { return rsqrtf(ss[r] * (1.0f / 1024.0f) + NORM_EPS); }

struct EpiProj { static constexpr bool PERM = true;
    const float* rstd; const float* bias; bf16_t* PR; bf16_t* PX; bf16_t* PY;
    __device__ __forceinline__ void operator()(Acc& acc, const Unit& u, int wr, int wc, int fr, int fq) const {
        bf16_t* base; int ld, colt;
        if (u.pn < 7) { base = PR; ld = RW; colt = u.pn * 256; } else if (u.pn < 9) { base = PX; ld = 512; colt = (u.pn - 7) * 256; } else { base = PY; ld = 512; colt = (u.pn - 9) * 256; }
        const int col0 = colt + wc * 32 + 8 * fq, bcol0 = u.pn * 256 + wc * 32 + 8 * fq;
        f32x4 bv[2][2];
#pragma unroll
        for (int bj = 0; bj < 2; ++bj)
#pragma unroll
            for (int n = 0; n < 2; ++n) bv[bj][n] = *(const f32x4*)(bias + bcol0 + bj * HALF + 4 * n);
#pragma unroll
        EPI_ROWS_BEGIN
            const float rs = rstd[r]; bf16_t* rowp = base + (size_t)r * ld + col0;
#pragma unroll
            for (int bj = 0; bj < 2; ++bj) { const f32x4 v0 = acc[ai][bj][m][0] * rs + bv[bj][0], v1 = acc[ai][bj][m][1] * rs + bv[bj][1];
                u32x4 w; w.x = cvt_pk_bf16(v0[0], v0[1]); w.y = cvt_pk_bf16(v0[2], v0[3]); w.z = cvt_pk_bf16(v1[0], v1[1]); w.w = cvt_pk_bf16(v1[2], v1[3]);
                *(u32x4*)(rowp + bj * HALF) = w; }
        EPI_ROWS_END
    }
};
struct EpiGab { static constexpr bool PERM = true;
    const float* rstd; const float* bias; bf16_t* O; int cofs;
    __device__ __forceinline__ void operator()(Acc& acc, const Unit& u, int wr, int wc, int fr, int fq) const {
        const int col0 = cofs + u.pn * 256 + wc * 32 + 8 * fq;
        f32x4 bv[2][2];
#pragma unroll
        for (int bj = 0; bj < 2; ++bj)
#pragma unroll
            for (int n = 0; n < 2; ++n) bv[bj][n] = *(const f32x4*)(bias + col0 + bj * HALF + 4 * n);
#pragma unroll
        EPI_ROWS_BEGIN
            const float rs = rstd[r]; bf16_t* rowp = O + (size_t)r * 2048 + col0;
#pragma unroll
            for (int bj = 0; bj < 2; ++bj) { f32x4 v0 = acc[ai][bj][m][0] * rs + bv[bj][0], v1 = acc[ai][bj][m][1] * rs + bv[bj][1];
#pragma unroll
                for (int j = 0; j < 4; ++j) { v0[j] = sigmoidf_(v0[j]); v1[j] = sigmoidf_(v1[j]); }
                u32x4 w; w.x = cvt_pk_bf16(v0[0], v0[1]); w.y = cvt_pk_bf16(v0[2], v0[3]); w.z = cvt_pk_bf16(v1[0], v1[1]); w.w = cvt_pk_bf16(v1[2], v1[3]);
                *(u32x4*)(rowp + bj * HALF) = w; }
        EPI_ROWS_END
    }
};
struct EpiPlain { static constexpr bool PERM = true;
    bf16_t* O; int ldc;
    __device__ __forceinline__ void operator()(Acc& acc, const Unit& u, int wr, int wc, int fr, int fq) const {
        const int col0 = u.pn * 256 + wc * 32 + 8 * fq;
#pragma unroll
        EPI_ROWS_BEGIN
            bf16_t* rowp = O + (size_t)r * ldc + col0;
#pragma unroll
            for (int bj = 0; bj < 2; ++bj) { const f32x4 v0 = acc[ai][bj][m][0], v1 = acc[ai][bj][m][1];
                u32x4 w; w.x = cvt_pk_bf16(v0[0], v0[1]); w.y = cvt_pk_bf16(v0[2], v0[3]); w.z = cvt_pk_bf16(v1[0], v1[1]); w.w = cvt_pk_bf16(v1[2], v1[3]);
                *(u32x4*)(rowp + bj * HALF) = w; }
        EPI_ROWS_END
    }
};
struct EpiLora { static constexpr bool PERM = true;
    const float* w0; const float* a0; bf16_t* O;
    __device__ __forceinline__ void operator()(Acc& acc, const Unit& u, int wr, int wc, int fr, int fq) const {
        const int kind = u.pn >> 1, ch0 = (u.pn & 1) * 256 + wc * 32 + 8 * fq, col0 = u.pn * 256 + wc * 32 + 8 * fq;
        const float* bsrc = kind == 0 ? w0 : a0;
        f32x4 bv[2][2];
#pragma unroll
        for (int bj = 0; bj < 2; ++bj)
#pragma unroll
            for (int n = 0; n < 2; ++n) bv[bj][n] = kind < 2 ? *(const f32x4*)(bsrc + ch0 + bj * HALF + 4 * n) : (f32x4){0.f, 0.f, 0.f, 0.f};
        const float sc = kind == 0 ? 0.6065306597126334f : 1.0f;
#pragma unroll
        EPI_ROWS_BEGIN
            bf16_t* rowp = O + (size_t)r * 1536 + col0;
#pragma unroll
            for (int bj = 0; bj < 2; ++bj) { f32x4 v0 = acc[ai][bj][m][0] + bv[bj][0], v1 = acc[ai][bj][m][1] + bv[bj][1];
                if (kind < 2) {
#pragma unroll
                    for (int j = 0; j < 4; ++j) { v0[j] = sc * sigmoidf_(v0[j]); v1[j] = sc * sigmoidf_(v1[j]); } }
                u32x4 w; w.x = cvt_pk_bf16(v0[0], v0[1]); w.y = cvt_pk_bf16(v0[2], v0[3]); w.z = cvt_pk_bf16(v1[0], v1[1]); w.w = cvt_pk_bf16(v1[2], v1[3]);
                *(u32x4*)(rowp + bj * HALF) = w; }
        EPI_ROWS_END
    }
};
struct EpiRg { static constexpr bool PERM = true;
    const float* ba; const float* bx; const float* lam; const bf16_t* XBC; bf16_t* LA; bf16_t* U;
    __device__ __forceinline__ void operator()(Acc& acc, const Unit& u, int wr, int wc, int fr, int fq) const {
        const int ch0 = u.pn * 128 + wc * 32 + 8 * fq;
        float vba[8], vbx[8], vls[8];
#pragma unroll
        for (int j = 0; j < 8; ++j) { vba[j] = ba[ch0 + j]; vbx[j] = bx[ch0 + j]; vls[j] = -8.0f * log1pf(__expf(-lam[ch0 + j])); }
#pragma unroll
        EPI_ROWS_BEGIN
            const bool first = (r & (SEQ - 1)) == 0;
            float xb[8]; unpack8(*(const u32x4*)(XBC + (size_t)r * 512 + ch0), xb);
            float la[8], uu[8];
#pragma unroll
            for (int j = 0; j < 8; ++j) { const float ga = sigmoidf_(acc[ai][0][m][j >> 2][j & 3] + vba[j]), gx = sigmoidf_(acc[ai][1][m][j >> 2][j & 3] + vbx[j]);
                la[j] = vls[j] * ga; const float a = __expf(la[j]); const float mult = first ? 1.0f : sqrtf(fmaxf(1.0f - a * a, 0.f)); uu[j] = xb[j] * gx * mult; }
            *(u32x4*)(LA + (size_t)r * 512 + ch0) = pack8(la); *(u32x4*)(U + (size_t)r * 512 + ch0) = pack8(uu);
        EPI_ROWS_END
    }
};
template <bool FIRST> struct EpiBranch { static constexpr bool PERM = true;
    const bf16_t* G; bf16_t* M;
    __device__ __forceinline__ void operator()(Acc& acc, const Unit& u, int wr, int wc, int fr, int fq) const {
        const int col0 = u.pn * 256 + wc * 32 + 8 * fq;
#pragma unroll
        EPI_ROWS_BEGIN
#pragma unroll
            for (int bj = 0; bj < 2; ++bj) { const int c = col0 + bj * HALF;
                float gv[8]; unpack8(*(const u32x4*)(G + (size_t)r * 2048 + (FIRST ? 0 : 1024) + c), gv);
                float o[8];
                if (!FIRST) unpack8(*(const u32x4*)(M + (size_t)r * 1024 + c), o);
#pragma unroll
                for (int j = 0; j < 8; ++j) { const float p = acc[ai][bj][m][j >> 2][j & 3] * gv[j]; o[j] = FIRST ? p : o[j] + p; }
                *(u32x4*)(M + (size_t)r * 1024 + c) = pack8(o); }
        EPI_ROWS_END
    }
};
template <bool WB> struct EpiRes { static constexpr bool PERM = false;
    const float* base; float* out; bf16_t* XB; float* ssp;
    __device__ __forceinline__ void operator()(Acc& acc, const Unit& u, int wr, int wc, int fr, int fq) const {
        const int col0 = u.pn * 256 + wc * 32 + 4 * fq;
#pragma unroll
        EPI_ROWS_BEGIN
            const size_t off = (size_t)r * 1024 + col0; float s = 0.f;
#pragma unroll
            for (int bj = 0; bj < 2; ++bj)
#pragma unroll
                for (int n = 0; n < 2; ++n) { const f32x4 bs = *(const f32x4*)(base + off + bj * HALF + n * 16); const f32x4 o = bs + acc[ai][bj][m][n];
                    *(f32x4*)(out + off + bj * HALF + n * 16) = o; s += (o[0] * o[0] + o[1] * o[1]) + (o[2] * o[2] + o[3] * o[3]);
                    if (WB) { u32x2 w; w.x = cvt_pk_bf16(o[0], o[1]); w.y = cvt_pk_bf16(o[2], o[3]); *(u32x2*)(XB + off + bj * HALF + n * 16) = w; } }
            s += __shfl_xor(s, 16); s += __shfl_xor(s, 32);
            if (fq == 0) atomicAdd(ssp + r, s);
        EPI_ROWS_END
    }
};
struct EpiQ { static constexpr bool PERM = true;
    const float* ssp; bf16_t* O;
    __device__ __forceinline__ void operator()(Acc& acc, const Unit& u, int wr, int wc, int fr, int fq) const {
        const int col0 = u.pn * 256 + wc * 32 + 8 * fq;
#pragma unroll
        EPI_ROWS_BEGIN
            const float rs = rstd_from16(ssp, r) * 0.0625f; bf16_t* rowp = O + (size_t)r * 1024 + col0;
#pragma unroll
            for (int bj = 0; bj < 2; ++bj) { const f32x4 v0 = acc[ai][bj][m][0] * rs, v1 = acc[ai][bj][m][1] * rs;
                u32x4 w; w.x = cvt_pk_bf16(v0[0], v0[1]); w.y = cvt_pk_bf16(v0[2], v0[3]); w.z = cvt_pk_bf16(v1[0], v1[1]); w.w = cvt_pk_bf16(v1[2], v1[3]);
                *(u32x4*)(rowp + bj * HALF) = w; }
        EPI_ROWS_END
    }
};
struct EpiSc { static constexpr bool PERM = true;
    bf16_t* O; float* ssp;
    __device__ __forceinline__ void operator()(Acc& acc, const Unit& u, int wr, int wc, int fr, int fq) const {
        const int col0 = u.pn * 256 + wc * 32 + 8 * fq;
#pragma unroll
        EPI_ROWS_BEGIN
            bf16_t* rowp = O + (size_t)r * 1024 + col0; float s = 0.f;
#pragma unroll
            for (int bj = 0; bj < 2; ++bj) { f32x4 v0 = acc[ai][bj][m][0], v1 = acc[ai][bj][m][1];
#pragma unroll
                for (int j = 0; j < 4; ++j) { v0[j] = __expf(v0[j]); v1[j] = __expf(v1[j]); }
                s += ((v0[0] + v0[1]) + (v0[2] + v0[3])) + ((v1[0] + v1[1]) + (v1[2] + v1[3]));
                u32x4 w; w.x = cvt_pk_bf16(v0[0], v0[1]); w.y = cvt_pk_bf16(v0[2], v0[3]); w.z = cvt_pk_bf16(v1[0], v1[1]); w.w = cvt_pk_bf16(v1[2], v1[3]);
                *(u32x4*)(rowp + bj * HALF) = w; }
            s += __shfl_xor(s, 16); s += __shfl_xor(s, 32);
            if (fq == 0) ssp[(size_t)r * 16 + u.pn * 4 + wc] = s;
        EPI_ROWS_END
    }
};
struct EpiPv { static constexpr bool PERM = true;
    const float* ssp; bf16_t* O;
    __device__ __forceinline__ void operator()(Acc& acc, const Unit& u, int wr, int wc, int fr, int fq) const {
        const int col0 = u.pn * 256 + wc * 32 + 8 * fq;
#pragma unroll
        EPI_ROWS_BEGIN
            const f32x4 sp = *(const f32x4*)(ssp + (size_t)r * 16 + u.pn * 4); const float rs = 1.0f / ((sp.x + sp.y) + (sp.z + sp.w));
            bf16_t* rowp = O + (size_t)r * 1024 + col0;
#pragma unroll
            for (int bj = 0; bj < 2; ++bj) { const f32x4 v0 = acc[ai][bj][m][0] * rs, v1 = acc[ai][bj][m][1] * rs;
                u32x4 w; w.x = cvt_pk_bf16(v0[0], v0[1]); w.y = cvt_pk_bf16(v0[2], v0[3]); w.z = cvt_pk_bf16(v1[0], v1[1]); w.w = cvt_pk_bf16(v1[2], v1[3]);
                *(u32x4*)(rowp + bj * HALF) = w; }
        EPI_ROWS_END
    }
};
__device__ __forceinline__ float dpp_ror1(float v) { return __int_as_float(__builtin_amdgcn_update_dpp(0, __float_as_int(v), 0x121, 0xf, 0xf, false)); }
__device__ __forceinline__ float dpp_ror2(float v) { return __int_as_float(__builtin_amdgcn_update_dpp(0, __float_as_int(v), 0x122, 0xf, 0xf, false)); }
struct EpiFfnAct { static constexpr bool PERM = true;
    const float* ssp; const float* cw; const float* cb; bf16_t* ACT; bf16_t* HG;
    __device__ __forceinline__ void operator()(Acc& acc, const Unit& u, int wr, int wc, int fr_, int fq_) const {
        const int l_ = lane_id(), fr = l_ & 15, fq = l_ >> 4;
        const int col0 = u.pn * 128 + wc * 32 + 8 * fq;
#pragma unroll
        for (int ai = 0; ai < 2; ++ai) {
            const int rbase = u.pm * BM + ai * HALF + wr * 64 + fr;
            float rs[4];
#pragma unroll
            for (int m = 0; m < 4; ++m) rs[m] = rstd_from16(ssp, rbase + m * 16);
            const size_t grp = (size_t)(rbase >> 6);
            if (fr < 2) { float t[8];
#pragma unroll
                for (int j = 0; j < 8; ++j) t[j] = acc[ai][0][0][j >> 2][j & 3] * rs[0];
                *(u32x4*)(HG + (grp * 4 + 2 + fr) * DFF + col0) = pack8(t); }
            if (fr >= 14) { float t[8];
#pragma unroll
                for (int j = 0; j < 8; ++j) t[j] = acc[ai][0][3][j >> 2][j & 3] * rs[3];
                *(u32x4*)(HG + (grp * 4 + (fr - 14)) * DFF + col0) = pack8(t); }
#pragma unroll
            for (int j = 0; j < 8; ++j) {
                const float w0 = cw[col0 + j], w1 = cw[DFF + col0 + j], w2 = cw[2 * DFF + col0 + j], b0 = cb[col0 + j];
                float g[4], r1[4], r2[4];
#pragma unroll
                for (int m = 0; m < 4; ++m) { g[m] = acc[ai][0][m][j >> 2][j & 3] * rs[m]; r1[m] = dpp_ror1(g[m]); r2[m] = dpp_ror2(g[m]); }
#pragma unroll
                for (int m = 0; m < 4; ++m) {
                    const float p1 = fr >= 1 ? r1[m] : r1[m > 0 ? m - 1 : 0], p2 = fr >= 2 ? r2[m] : r2[m > 0 ? m - 1 : 0];
                    const float up = acc[ai][1][m][j >> 2][j & 3] * rs[m];
                    const float gate = b0 + w0 * p2 + w1 * p1 + w2 * g[m];
                    acc[ai][1][m][j >> 2][j & 3] = (m == 0 && fr < 2) ? up : gelu_tanh(gate) * up;
                }
            }
#pragma unroll
            for (int m = 0; m < 4; ++m) { const f32x4 v0 = acc[ai][1][m][0], v1 = acc[ai][1][m][1];
                u32x4 w; w.x = cvt_pk_bf16(v0[0], v0[1]); w.y = cvt_pk_bf16(v0[2], v0[3]); w.z = cvt_pk_bf16(v1[0], v1[1]); w.w = cvt_pk_bf16(v1[2], v1[3]);
                *(u32x4*)(ACT + (size_t)(rbase + m * 16) * DFF + col0) = w; }
        }
    }
};

struct Args { const float* in[37]; float* out; unsigned char* ws; int ph_lo, ph_hi; };
enum { I_X = 0, I_MEM, I_NMIXG, I_WIN, I_BIN, I_MU, I_W0, I_WUP, I_A0, I_AUP, I_GUP, I_KK, I_KA, I_RK, I_LNXG, I_LNXB, I_WBA, I_CBW, I_CBB, I_WRGA, I_BRGA, I_WRGX, I_BRGX,
       I_LAM, I_WBB, I_WMIX, I_NXG, I_NMEMG, I_WCQ, I_WCKV, I_WCO, I_NFFNG, I_WFFI, I_FCW, I_FCB, I_WFFO, I_NFING };

__device__ __forceinline__ void transpose_item(const float* W, int ldw, int K, bf16_t* WT, int ldd, const float* gain, int map, int srcofs, LAS float* scr, int item, int lane) {
    const int nkb = K / 64, nb = item / nkb, kb = item % nkb, k0 = 64 * kb, n0 = 32 * nb;
    int ns = n0 + srcofs;
    if (map == 1) { const int tile = n0 >> 8, c = n0 & 255; ns = c < 128 ? tile * 128 + c : DFF + tile * 128 + (c - 128); }
#pragma unroll 8
    for (int i = 0; i < 32; ++i) { const int kk = 2 * i + (lane >> 5); float v = W[(size_t)(k0 + kk) * ldw + ns + (lane & 31)]; if (gain) v *= gain[k0 + kk]; scr[kk * 33 + (lane & 31)] = v; }
    asm volatile("s_waitcnt lgkmcnt(0)" ::: "memory");
    const int c = lane & 7;
#pragma unroll
    for (int j = 0; j < 4; ++j) { const int n = (lane >> 3) + 8 * j; const LAS float* s = scr + (8 * c) * 33 + n;
        u32x4 o; o.x = cvt_pk_bf16(s[0 * 33], s[1 * 33]); o.y = cvt_pk_bf16(s[2 * 33], s[3 * 33]); o.z = cvt_pk_bf16(s[4 * 33], s[5 * 33]); o.w = cvt_pk_bf16(s[6 * 33], s[7 * 33]);
        *(u32x4*)(WT + (size_t)(n0 + n) * ldd + k0 + 8 * c) = o; }
    asm volatile("s_waitcnt lgkmcnt(0)" ::: "memory");
}

__device__ __forceinline__ void phase_prep(const Args& a, LAS unsigned char* lds, int wave, int G) {
    const int lane = lane_id();
    unsigned char* ws = a.ws;
    LAS float* scr = (LAS float*)(lds + wave * 16384);
    const int gw = blockIdx.x * 8 + wave, NGW = G * 8;
#define TJOB(W_, ldw_, K_, Nd_, dst_, gain_, map_, srcofs_) do { const int nitems = ((K_) / 64) * ((Nd_) / 32); \
        for (int it = gw; it < nitems; it += NGW) transpose_item((W_), (ldw_), (K_), (bf16_t*)(ws + (dst_)), (K_), (gain_), (map_), (srcofs_), scr, it, lane); } while (0)
    TJOB(a.in[I_WIN], PIN, 1024, PIN, WS_WIN, a.in[I_NMIXG], 0, 0);
    TJOB(a.in[I_WBA], 1024, 512, 1024, WS_WA, nullptr, 0, 0);
    TJOB(a.in[I_WBB], 1024, 512, 1024, WS_WB, nullptr, 0, 0);
    TJOB(a.in[I_WMIX], 1024, 1024, 1024, WS_WMIX, nullptr, 0, 0);
    TJOB(a.in[I_WCQ], 1024, 1024, 1024, WS_WCQ, a.in[I_NXG], 0, 0);
    TJOB(a.in[I_WCKV], 2048, 1024, 1024, WS_WK, nullptr, 0, 0);
    TJOB(a.in[I_WCKV], 2048, 1024, 1024, WS_WV, nullptr, 0, 1024);
    TJOB(a.in[I_WCO], 1024, 1024, 1024, WS_WCO, nullptr, 0, 0);
    TJOB(a.in[I_WFFI], 2 * DFF, 1024, 2 * DFF, WS_WFFI, a.in[I_NFFNG], 1, 0);
    TJOB(a.in[I_WFFO], 1024, DFF, 1024, WS_WFFO, nullptr, 0, 0);
#undef TJOB
    { float* z1 = (float*)(ws + WS_SSP1); float* z2 = (float*)(ws + WS_SSP2); float* z3 = (float*)(ws + WS_SSP3);
      for (int i = blockIdx.x * 512 + wave * 64 + lane; i < T; i += G * 512) { z1[i] = 0.f; z2[i] = 0.f; z3[i] = 0.f; } }
    const int gid = blockIdx.x * 512 + wave * 64 + lane, NT = G * 512;
    { bf16_t* WL = (bf16_t*)(ws + WS_WLORA);
      for (int i = gid; i < 1536 * 256; i += NT) { const int n = i >> 8, k = i & 255, kind = n >> 9, c = n & 511; float v = 0.f;
          if (kind == 0 && k < 64) v = a.in[I_WUP][k * 512 + c]; else if (kind == 1 && k >= 64 && k < 128) v = a.in[I_AUP][(k - 64) * 512 + c]; else if (kind == 2 && k >= 128) v = a.in[I_GUP][(k - 128) * 512 + c];
          WL[i] = f2bf(v); } }
    { bf16_t* WR = (bf16_t*)(ws + WS_WRG);
      for (int i = gid; i < 1024 * 512; i += NT) { const int n = i >> 9, k = i & 511, pn = n >> 8, c = n & 255, ch = pn * 128 + (c & 127), hb = ch >> 6, j = ch & 63; float v = 0.f;
          if ((k >> 6) == hb) v = (c < 128 ? a.in[I_WRGA] : a.in[I_WRGX])[(hb * 64 + (k & 63)) * 64 + j];
          WR[i] = f2bf(v); } }
    { const float* x = a.in[I_X]; bf16_t* XB = (bf16_t*)(ws + WS_XB); float* rstd = (float*)(ws + WS_RSTDX);
      for (int r0 = gw; r0 < T; r0 += 4 * NGW) {
          f32x4 v[4][4]; float s[4];
#pragma unroll
          for (int q = 0; q < 4; ++q) { const int r = r0 + q * NGW; s[q] = 0.f; if (r < T) { const f32x4* xr = (const f32x4*)(x + (size_t)r * D) + lane;
#pragma unroll
              for (int j = 0; j < 4; ++j) v[q][j] = xr[64 * j]; } else {
#pragma unroll
              for (int j = 0; j < 4; ++j) v[q][j] = (f32x4){0.f, 0.f, 0.f, 0.f}; } }
#pragma unroll
          for (int q = 0; q < 4; ++q) {
#pragma unroll
              for (int j = 0; j < 4; ++j) s[q] += (v[q][j].x * v[q][j].x + v[q][j].y * v[q][j].y) + (v[q][j].z * v[q][j].z + v[q][j].w * v[q][j].w);
              s[q] = wave_sum(s[q]); }
#pragma unroll
          for (int q = 0; q < 4; ++q) { const int r = r0 + q * NGW; if (r < T) { if (lane == 0) rstd[r] = rsqrtf(s[q] * (1.0f / D) + NORM_EPS);
              u32x2* o = (u32x2*)(XB + (size_t)r * D) + lane;
#pragma unroll
              for (int j = 0; j < 4; ++j) { u32x2 w; w.x = cvt_pk_bf16(v[q][j].x, v[q][j].y); w.y = cvt_pk_bf16(v[q][j].z, v[q][j].w); o[64 * j] = w; } } } } }
    { const float* x = a.in[I_MEM]; bf16_t* XB = (bf16_t*)(ws + WS_MEMN); const float* g = a.in[I_NMEMG];
      for (int r = gw; r < TM; r += NGW) { const f32x4* xr = (const f32x4*)(x + (size_t)r * D) + lane; f32x4 v[4]; float s = 0.f;
#pragma unroll
          for (int j = 0; j < 4; ++j) { v[j] = xr[64 * j]; s += (v[j].x * v[j].x + v[j].y * v[j].y) + (v[j].z * v[j].z + v[j].w * v[j].w); }
          s = wave_sum(s); const float rs = rsqrtf(s * (1.0f / D) + NORM_EPS);
          u32x2* o = (u32x2*)(XB + (size_t)r * D) + lane;
#pragma unroll
          for (int j = 0; j < 4; ++j) { const f32x4 gg = ((const f32x4*)g)[lane + 64 * j]; u32x2 w; w.x = cvt_pk_bf16(v[j].x * rs * gg.x, v[j].y * rs * gg.y); w.y = cvt_pk_bf16(v[j].z * rs * gg.z, v[j].w * rs * gg.w); o[64 * j] = w; } } }
}

__device__ __forceinline__ void phase_elem2(const Args& a, int wave, int G) {
    unsigned char* ws = a.ws;
    const bf16_t* PR = (const bf16_t*)(ws + WS_PR); const bf16_t* PX = (const bf16_t*)(ws + WS_PX);
    bf16_t* LIN = (bf16_t*)(ws + WS_LIN); bf16_t* XBC = (bf16_t*)(ws + WS_XBC);
    const float* mu = a.in[I_MU]; const float* cw = a.in[I_CBW]; const float* cb = a.in[I_CBB];
    const size_t gid = (size_t)blockIdx.x * 512 + wave * 64 + lane_id(), NT = (size_t)G * 512;
    for (size_t i = gid; i < (size_t)T * 96; i += NT) {
        const int t = (int)(i / 96), q = (int)(i % 96), tl = t & (SEQ - 1);
        if (q < 32) { const int c = q * 8; float p[8], pp[8], o[8];
            unpack8(*(const u32x4*)(PR + (size_t)t * RW + 1536 + c), p);
            if (tl > 0) unpack8(*(const u32x4*)(PR + (size_t)(t - 1) * RW + 1536 + c), pp); else {
#pragma unroll
                for (int j = 0; j < 8; ++j) pp[j] = 0.f; }
#pragma unroll
            for (int j = 0; j < 8; ++j) { const float v = p[j] + (pp[j] - p[j]) * mu[1536 + c + j];
                o[j] = c < 64 ? tanhf(v) : (c < 128 ? v : sigmoidf_(v)); }
            *(u32x4*)(LIN + (size_t)t * 256 + c) = pack8(o);
        } else { const int c = (q - 32) * 8; float o[8];
#pragma unroll
            for (int j = 0; j < 8; ++j) o[j] = cb[c + j];
#pragma unroll
            for (int k = 0; k < 4; ++k) { const int dt = 3 - k; if (tl >= dt) { float p[8]; unpack8(*(const u32x4*)(PX + (size_t)(t - dt) * 512 + c), p);
#pragma unroll
                for (int j = 0; j < 8; ++j) o[j] += p[j] * cw[k * 512 + c + j]; } }
            *(u32x4*)(XBC + (size_t)t * 512 + c) = pack8(o);
        }
    }
}

#define DPP_BC(JJ) " row_newbcast:" #JJ " row_mask:0xf bank_mask:0xf"
#define RW_SA(JJ)  asm("v_fmac_f32_dpp %0, %1, %2" DPP_BC(JJ) : "+v"(sacc[JJ & 3]) : "v"(va), "v"(S[JJ]));
#define RW_UPD(JJ) { float t_; \
    asm("v_mul_f32_dpp %0, %1, %2" DPP_BC(JJ) : "=v"(t_) : "v"(vb), "v"(sa)); \
    asm("v_fmac_f32_dpp %0, %1, %2" DPP_BC(JJ) : "+v"(t_) : "v"(vk), "v"(vv)); \
    asm("v_fmac_f32_dpp %0, %1, %2" DPP_BC(JJ) : "+v"(t_) : "v"(vw), "v"(S[JJ])); \
    S[JJ] = t_; \
    asm("v_fmac_f32_dpp %0, %1, %2" DPP_BC(JJ) : "+v"(yacc[JJ & 3]) : "v"(vr), "v"(S[JJ])); }
#define RW_ALL16(M) M(0) M(1) M(2) M(3) M(4) M(5) M(6) M(7) M(8) M(9) M(10) M(11) M(12) M(13) M(14) M(15)

constexpr int RB = 32;
constexpr int PSTEP = 6 * 64;
constexpr int PBUF = RB * PSTEP * 4;

__device__ __forceinline__ float dpp_ror_add(float v, const int ctrl_sel) {
    int t;
    switch (ctrl_sel) {
        case 8: t = __builtin_amdgcn_update_dpp(0, __float_as_int(v), 0x128, 0xf, 0xf, false); break;
        case 4: t = __builtin_amdgcn_update_dpp(0, __float_as_int(v), 0x124, 0xf, 0xf, false); break;
        case 2: t = __builtin_amdgcn_update_dpp(0, __float_as_int(v), 0x122, 0xf, 0xf, false); break;
        default: t = __builtin_amdgcn_update_dpp(0, __float_as_int(v), 0x121, 0xf, 0xf, false); break;
    }
    return v + __int_as_float(t);
}
__device__ __forceinline__ float cross_row_allsum(float v) {
    auto r = __builtin_amdgcn_permlane32_swap(__float_as_uint(v), __float_as_uint(v), false, false);
    v = __uint_as_float(r[0]) + __uint_as_float(r[1]);
    auto r2 = __builtin_amdgcn_permlane16_swap(__float_as_uint(v), __float_as_uint(v), false, false);
    return __uint_as_float(r2[0]) + __uint_as_float(r2[1]);
}
__device__ __forceinline__ float wave_allsum(float v) {
    v = dpp_ror_add(v, 8); v = dpp_ror_add(v, 4); v = dpp_ror_add(v, 2); v = dpp_ror_add(v, 1);
    return cross_row_allsum(v);
}
__device__ __forceinline__ void lds_barrier() { asm volatile("s_waitcnt lgkmcnt(0)" ::: "memory"); __builtin_amdgcn_s_barrier(); asm volatile("" ::: "memory"); }

__device__ __forceinline__ void rwkv_prep_block(const Args& a, LAS float* pb, int tok0, int h, int p, int lane, float mu_r, float mu_k, float mu_v, float ckk, float cka, float crk) {
    const bf16_t* PR = (const bf16_t*)(a.ws + WS_PR); const bf16_t* LOUT = (const bf16_t*)(a.ws + WS_LOUT); float* BON = (float*)(a.ws + WS_BON);
#pragma unroll
    for (int i = 0; i < RB / 4; ++i) {
        const int s = p * (RB / 4) + i; const int tok = tok0 + s; const bool has_prev = (tok & (SEQ - 1)) != 0;
        const bf16_t* prow = PR + (size_t)tok * RW + h * 64 + lane; const bf16_t* qrow = has_prev ? prow - RW : prow;
        const bf16_t* lrow = LOUT + (size_t)tok * 1536 + h * 64 + lane;
        const float rr = bf1(prow[0]), kr = bf1(prow[512]), vr_ = bf1(prow[1024]);
        const float rp = has_prev ? bf1(qrow[0]) : 0.f, kp = has_prev ? bf1(qrow[512]) : 0.f, vp = has_prev ? bf1(qrow[1024]) : 0.f;
        const float e = bf1(lrow[0]), av = bf1(lrow[512]);
        const float r = rr + (rp - rr) * mu_r, k0 = kr + (kp - kr) * mu_k, v = vr_ + (vp - vr_) * mu_v;
        const float w = __expf(-e);
        const float kk = k0 * ckk; const float n2 = wave_allsum(kk * kk); const float kkn = kk / fmaxf(sqrtf(n2), 1e-12f);
        const float k2 = k0 * (1.0f + (av - 1.0f) * cka);
        const float bon = wave_allsum(r * k2 * crk);
        LAS float* pp = pb + s * PSTEP;
        pp[lane] = -kkn; pp[64 + lane] = kkn * av; pp[128 + lane] = k2; pp[192 + lane] = w; pp[256 + lane] = r; pp[320 + lane] = v;
        if (lane == 0) BON[(size_t)tok * 8 + h] = bon;
    }
}

__device__ __forceinline__ void phase_scan(const Args& a, LAS unsigned char* lds, int wave, int G) {
    const int lane = lane_id();
    unsigned char* ws = a.ws;
    constexpr int SB = 16, NBLK = SEQ / RB;
    for (int pair = blockIdx.x; pair < 256; pair += G) {
        const int b = pair >> 3, h = pair & 7, tokb = b * SEQ;
        const int il = lane & 15, irow = 16 * (wave & 3) + il;
        float S[16];
#pragma unroll
        for (int j = 0; j < 16; ++j) S[j] = 0.f;
        const float mu_r = a.in[I_MU][h * 64 + lane], mu_k = a.in[I_MU][512 + h * 64 + lane], mu_v = a.in[I_MU][1024 + h * 64 + lane];
        const float ckk = a.in[I_KK][h * 64 + lane], cka = a.in[I_KA][h * 64 + lane], crk = a.in[I_RK][h * 64 + lane];
        bf16_t* YRAW = (bf16_t*)(ws + WS_YRAW);
        const size_t base = (size_t)tokb * 512 + h * 64 + lane;
        const bf16_t* LA = (const bf16_t*)(ws + WS_RGLA) + base; const bf16_t* U = (const bf16_t*)(ws + WS_RGU) + base; const bf16_t* PY = (const bf16_t*)(ws + WS_PY) + base;
        bf16_t* YB = (bf16_t*)(ws + WS_YB) + base;
        bf16_t cla[SB], cu[SB], cpy[SB]; float hh = 0.f;
        if (wave == 4) {
#pragma unroll
            for (int s = 0; s < SB; ++s) { cla[s] = LA[(size_t)s * 512]; cu[s] = U[(size_t)s * 512]; cpy[s] = PY[(size_t)s * 512]; }
        } else {
#pragma unroll
            for (int s = 0; s < SB; ++s) { cla[s] = 0; cu[s] = 0; cpy[s] = 0; }
        }
        if (wave >= 4) rwkv_prep_block(a, (LAS float*)lds, tokb, h, wave - 4, lane, mu_r, mu_k, mu_v, ckk, cka, crk);
        lds_barrier();
        for (int blk = 0; blk < NBLK; ++blk) {
            if (wave < 4) {
                const LAS float* pb = (const LAS float*)(lds + (blk & 1) * PBUF);
#pragma unroll 2
                for (int s = 0; s < RB; ++s) {
                    const LAS float* pp = pb + s * PSTEP;
                    float va = pp[lane], vb = pp[64 + lane], vk = pp[128 + lane], vw = pp[192 + lane], vr = pp[256 + lane]; const float vv = pp[320 + irow];
                    asm volatile("s_nop 1" : "+v"(va), "+v"(vb), "+v"(vk), "+v"(vw), "+v"(vr));
                    float sacc[4] = {0.f, 0.f, 0.f, 0.f}, yacc[4] = {0.f, 0.f, 0.f, 0.f};
                    RW_ALL16(RW_SA)
                    float sa = (sacc[0] + sacc[1]) + (sacc[2] + sacc[3]);
                    sa = cross_row_allsum(sa);
                    RW_ALL16(RW_UPD)
                    float y = (yacc[0] + yacc[1]) + (yacc[2] + yacc[3]);
                    y = cross_row_allsum(y);
                    const int tok = tokb + blk * RB + s;
                    if (lane < 16) YRAW[(size_t)tok * 512 + h * 64 + irow] = f2bf(y);
                }
            } else {
                if (blk + 1 < NBLK) rwkv_prep_block(a, (LAS float*)(lds + ((blk + 1) & 1) * PBUF), tokb + (blk + 1) * RB, h, wave - 4, lane, mu_r, mu_k, mu_v, ckk, cka, crk);
                if (wave == 4) {
                    for (int sub = 0; sub < RB / SB; ++sub) {
                        const int t0 = blk * RB + sub * SB, tn = (t0 + SB < SEQ) ? t0 + SB : t0;
                        bf16_t nla[SB], nu[SB], npy[SB];
#pragma unroll
                        for (int s = 0; s < SB; ++s) { nla[s] = LA[(size_t)(tn + s) * 512]; nu[s] = U[(size_t)(tn + s) * 512]; npy[s] = PY[(size_t)(tn + s) * 512]; }
#pragma unroll
                        for (int s = 0; s < SB; ++s) { hh = __expf(bf1(cla[s])) * hh + bf1(cu[s]); YB[(size_t)(t0 + s) * 512] = f2bf(hh * gelu_tanh(bf1(cpy[s]))); }
#pragma unroll
                        for (int s = 0; s < SB; ++s) { cla[s] = nla[s]; cu[s] = nu[s]; cpy[s] = npy[s]; }
                    }
                }
            }
            lds_barrier();
        }
    }
    asm volatile("s_waitcnt vmcnt(0)" ::: "memory");
}

__device__ __forceinline__ void phase_post(const Args& a, int wave, int G) {
    unsigned char* ws = a.ws;
    const bf16_t* PR = (const bf16_t*)(ws + WS_PR); const bf16_t* LOUT = (const bf16_t*)(ws + WS_LOUT); const bf16_t* YRAW = (const bf16_t*)(ws + WS_YRAW);
    const float* BON = (const float*)(ws + WS_BON); bf16_t* YA = (bf16_t*)(ws + WS_YA);
    const float* mu = a.in[I_MU]; const float* lg = a.in[I_LNXG]; const float* lb = a.in[I_LNXB];
    const size_t gid = (size_t)blockIdx.x * 512 + wave * 64 + lane_id(), NT = (size_t)G * 512;
    for (size_t i = gid; i < (size_t)T * 64; i += NT) {
        const int t = (int)(i >> 6), c = (int)(i & 63) * 8, h = c >> 6, tl = t & (SEQ - 1);
        float y[8], v[8], vp[8], g[8], o[8];
        unpack8(*(const u32x4*)(YRAW + (size_t)t * 512 + c), y);
        unpack8(*(const u32x4*)(PR + (size_t)t * RW + 1024 + c), v);
        if (tl > 0) unpack8(*(const u32x4*)(PR + (size_t)(t - 1) * RW + 1024 + c), vp); else {
#pragma unroll
            for (int j = 0; j < 8; ++j) vp[j] = 0.f; }
        unpack8(*(const u32x4*)(LOUT + (size_t)t * 1536 + 1024 + c), g);
        float s = 0.f;
#pragma unroll
        for (int j = 0; j < 8; ++j) s += y[j];
        s += __shfl_xor(s, 1); s += __shfl_xor(s, 2); s += __shfl_xor(s, 4);
        const float mean = s * (1.0f / 64.0f); float q = 0.f;
#pragma unroll
        for (int j = 0; j < 8; ++j) { const float d = y[j] - mean; q += d * d; }
        q += __shfl_xor(q, 1); q += __shfl_xor(q, 2); q += __shfl_xor(q, 4);
        const float rs = rsqrtf(q * (1.0f / 64.0f) + LNX_EPS), bon = BON[(size_t)t * 8 + h];
#pragma unroll
        for (int j = 0; j < 8; ++j) { const float vv = v[j] + (vp[j] - v[j]) * mu[1024 + c + j];
            o[j] = ((y[j] - mean) * rs * lg[c + j] + lb[c + j] + bon * vv) * g[j]; }
        *(u32x4*)(YA + (size_t)t * 512 + c) = pack8(o);
    }
}

__device__ __forceinline__ void phase_ffnfix(const Args& a, int wave, int G) {
    unsigned char* ws = a.ws;
    const bf16_t* HG = (const bf16_t*)(ws + WS_HG); bf16_t* ACT = (bf16_t*)(ws + WS_UU);
    const float* cw = a.in[I_FCW]; const float* cb = a.in[I_FCB];
    const size_t gid = (size_t)blockIdx.x * 512 + wave * 64 + lane_id(), NT = (size_t)G * 512;
    constexpr int CPR = DFF / 8;
    for (size_t i = gid; i < (size_t)(T / 64) * 2 * CPR; i += NT) {
        const int c = (int)(i % CPR) * 8, rho = (int)((i / CPR) & 1), grp = (int)(i / (2 * CPR)); const int t = grp * 64 + rho; const bool first = (grp & 31) == 0;
        float p2[8], p1[8], cur[8], up[8], o[8];
#pragma unroll
        for (int j = 0; j < 8; ++j) { p2[j] = 0.f; p1[j] = 0.f; }
        if (rho == 0) { if (!first) { unpack8(*(const u32x4*)(HG + ((size_t)(grp - 1) * 4 + 0) * DFF + c), p2); unpack8(*(const u32x4*)(HG + ((size_t)(grp - 1) * 4 + 1) * DFF + c), p1); } }
        else { if (!first) unpack8(*(const u32x4*)(HG + ((size_t)(grp - 1) * 4 + 1) * DFF + c), p2); unpack8(*(const u32x4*)(HG + ((size_t)grp * 4 + 2) * DFF + c), p1); }
        unpack8(*(const u32x4*)(HG + ((size_t)grp * 4 + 2 + rho) * DFF + c), cur);
        unpack8(*(const u32x4*)(ACT + (size_t)t * DFF + c), up);
#pragma unroll
        for (int j = 0; j < 8; ++j) o[j] = gelu_tanh(cb[c + j] + cw[c + j] * p2[j] + cw[DFF + c + j] * p1[j] + cw[2 * DFF + c + j] * cur[j]) * up[j];
        *(u32x4*)(ACT + (size_t)t * DFF + c) = pack8(o);
    }
}

__device__ __forceinline__ void phase_final(const Args& a, int wave, int G) {
    const int lane = lane_id();
    const float* ssp = (const float*)(a.ws + WS_SSP3); const float* g = a.in[I_NFING];
    const int gw = blockIdx.x * 8 + wave, NGW = G * 8;
    for (int r0 = gw; r0 < T; r0 += 4 * NGW) {
        f32x4 v[4][4]; float rs[4];
#pragma unroll
        for (int q = 0; q < 4; ++q) { const int r = r0 + q * NGW; if (r < T) { rs[q] = rstd_from16(ssp, r); const f32x4* xr = (const f32x4*)(a.out + (size_t)r * D) + lane;
#pragma unroll
            for (int j = 0; j < 4; ++j) v[q][j] = xr[64 * j]; } }
#pragma unroll
        for (int q = 0; q < 4; ++q) { const int r = r0 + q * NGW; if (r < T) { f32x4* xr = (f32x4*)(a.out + (size_t)r * D) + lane;
#pragma unroll
            for (int j = 0; j < 4; ++j) { const f32x4 gg = ((const f32x4*)g)[lane + 64 * j]; xr[64 * j] = v[q][j] * rs[q] * gg; } } }
    }
}

constexpr int NPHASE = 13;
__global__ void __launch_bounds__(512, 2) mega(Args a) {
    extern __shared__ __attribute__((aligned(16))) unsigned char lds_raw[];
    LAS unsigned char* lds = (LAS unsigned char*)lds_raw;
    cg::grid_group grid = cg::this_grid();
    const int wave = __builtin_amdgcn_readfirstlane((int)threadIdx.x >> 6), G = gridDim.x, bid = blockIdx.x;
    unsigned char* ws = a.ws;
    const int lo = a.ph_lo, hi = a.ph_hi;
    const bool t0 = (wave == 0) && (lane_id() == 0);
    volatile LAS unsigned* misc = (volatile LAS unsigned*)(lds + 131072 + 320);
    if (t0) { misc[0] = 0u; misc[1] = 0u; }
    __syncthreads();
    XcdBarrier xb = xcd_barrier_post((unsigned*)(ws + WS_CTL), misc, t0);
#define IN(k) (lo <= (k) && (k) < hi)
#define SEAM(k) do { if (IN(k) && IN((k) + 1)) { if ((k) == 0) grid.sync(); else xcd_barrier(xb, t0); } } while (0)
    bf16_t* const XB = (bf16_t*)(ws + WS_XB);
    const float* rstdx = (const float*)(ws + WS_RSTDX);
    StaticOrder S;

    if (IN(0)) for (int rep_ = 0; rep_ < REPS(0); ++rep_) { phase_prep(a, lds, wave, G); __syncthreads(); } SEAM(0);

    if (IN(1)) for (int rep_ = 0; rep_ < REPS(1); ++rep_) {
        { Gemm g = plain_gemm(XB, (const bf16_t*)(ws + WS_WIN), 1024); S.init(T / BM, 11, G, bid);
          EpiProj E{rstdx, a.in[I_BIN], (bf16_t*)(ws + WS_PR), (bf16_t*)(ws + WS_PX), (bf16_t*)(ws + WS_PY)}; gemm_phase(lds, wave, g, S, E); }
        { Gemm g = plain_gemm((const bf16_t*)(ws + WS_MEMN), (const bf16_t*)(ws + WS_WK), 1024); S.init(TM / BM, 4, G, bid);
          EpiPlain E{(bf16_t*)(ws + WS_KM), 1024}; gemm_phase(lds, wave, g, S, E); }
        { Gemm g = plain_gemm((const bf16_t*)(ws + WS_WV), (const bf16_t*)(ws + WS_MEMN), 1024); S.init(4, TM / BM, G, bid);
          EpiPlain E{(bf16_t*)(ws + WS_VT), TM}; gemm_phase(lds, wave, g, S, E); }
    } SEAM(1);

    if (IN(2)) for (int rep_ = 0; rep_ < REPS(2); ++rep_) phase_elem2(a, wave, G); SEAM(2);
#ifdef PROBE_SYNC
    for (int i_ = 0; i_ < 16; ++i_) grid.sync();
#endif

    if (IN(3)) for (int rep_ = 0; rep_ < REPS(3); ++rep_) {
        { Gemm g = plain_gemm((const bf16_t*)(ws + WS_LIN), (const bf16_t*)(ws + WS_WLORA), 256); S.init(T / BM, 6, G, bid);
          EpiLora E{a.in[I_W0], a.in[I_A0], (bf16_t*)(ws + WS_LOUT)}; gemm_phase(lds, wave, g, S, E); }
        { Gemm g = plain_gemm((const bf16_t*)(ws + WS_XBC), (const bf16_t*)(ws + WS_WRG), 512); S.init(T / BM, 4, G, bid);
          EpiRg E{a.in[I_BRGA], a.in[I_BRGX], a.in[I_LAM], (const bf16_t*)(ws + WS_XBC), (bf16_t*)(ws + WS_RGLA), (bf16_t*)(ws + WS_RGU)}; gemm_phase(lds, wave, g, S, E); }
    } SEAM(3);

    if (IN(4)) for (int rep_ = 0; rep_ < REPS(4); ++rep_) phase_scan(a, lds, wave, G); SEAM(4);
    if (IN(5)) for (int rep_ = 0; rep_ < REPS(5); ++rep_) phase_post(a, wave, G); SEAM(5);

    if (IN(6)) for (int rep_ = 0; rep_ < REPS(6); ++rep_) {
        S.init(T / BM, 4, G, bid);
        { Gemm g = plain_gemm(XB, (const bf16_t*)(ws + WS_WIN) + (size_t)2816 * 1024, 1024); EpiGab E{rstdx, a.in[I_BIN] + 2816, (bf16_t*)(ws + WS_GAB), 0}; gemm_phase(lds, wave, g, S, E); }
        { Gemm g = plain_gemm((const bf16_t*)(ws + WS_YA), (const bf16_t*)(ws + WS_WA), 512); EpiBranch<true> E{(const bf16_t*)(ws + WS_GAB), (bf16_t*)(ws + WS_MERGED)}; gemm_phase(lds, wave, g, S, E); }
        { Gemm g = plain_gemm(XB, (const bf16_t*)(ws + WS_WIN) + (size_t)3840 * 1024, 1024); EpiGab E{rstdx, a.in[I_BIN] + 2816, (bf16_t*)(ws + WS_GAB), 1024}; gemm_phase(lds, wave, g, S, E); }
        { Gemm g = plain_gemm((const bf16_t*)(ws + WS_YB), (const bf16_t*)(ws + WS_WB), 512); EpiBranch<false> E{(const bf16_t*)(ws + WS_GAB), (bf16_t*)(ws + WS_MERGED)}; gemm_phase(lds, wave, g, S, E); }
    } SEAM(6);
    if (IN(7)) for (int rep_ = 0; rep_ < REPS(7); ++rep_) { Gemm g = plain_gemm((const bf16_t*)(ws + WS_MERGED), (const bf16_t*)(ws + WS_WMIX), 1024); S.init(T / BM, 4, G, bid);
        EpiRes<true> E{a.in[I_X], a.out, (bf16_t*)(ws + WS_X1B), (float*)(ws + WS_SSP1)}; gemm_phase(lds, wave, g, S, E); } SEAM(7);
    if (IN(8)) for (int rep_ = 0; rep_ < REPS(8); ++rep_) {
        S.init(T / BM, 4, G, bid);
        { Gemm g = plain_gemm((const bf16_t*)(ws + WS_X1B), (const bf16_t*)(ws + WS_WCQ), 1024);
          EpiQ E{(const float*)(ws + WS_SSP1), (bf16_t*)(ws + WS_Q)}; gemm_phase(lds, wave, g, S, E); }
        { Gemm g; g.A = (const bf16_t*)(ws + WS_Q); g.Bt = (const bf16_t*)(ws + WS_KM); g.lda = 1024; g.ldb = 1024; g.K = 256;
          g.a_pm = (size_t)BM * 1024 * 2; g.a_pn = 512; g.b_pn = 512; g.b_pb = (size_t)NMEM * 1024 * 2;
          EpiSc E{(bf16_t*)(ws + WS_PEXP), (float*)(ws + WS_SSPA)}; gemm_phase(lds, wave, g, S, E); }
        { Gemm g; g.A = (const bf16_t*)(ws + WS_PEXP); g.Bt = (const bf16_t*)(ws + WS_VT); g.lda = 1024; g.ldb = TM; g.K = 256;
          g.a_pm = (size_t)BM * 1024 * 2; g.a_pn = 512; g.b_pn = (size_t)256 * TM * 2; g.b_pb = 512;
          EpiPv E{(const float*)(ws + WS_SSPA), (bf16_t*)(ws + WS_O)}; gemm_phase(lds, wave, g, S, E); }
    } SEAM(8);
    if (IN(9)) for (int rep_ = 0; rep_ < REPS(9); ++rep_) { Gemm g = plain_gemm((const bf16_t*)(ws + WS_O), (const bf16_t*)(ws + WS_WCO), 1024); S.init(T / BM, 4, G, bid);
        EpiRes<true> E{a.out, a.out, (bf16_t*)(ws + WS_X2B), (float*)(ws + WS_SSP2)}; gemm_phase(lds, wave, g, S, E); } SEAM(9);
    if (IN(10)) for (int rep_ = 0; rep_ < REPS(10); ++rep_) { Gemm g = plain_gemm((const bf16_t*)(ws + WS_X2B), (const bf16_t*)(ws + WS_WFFI), 1024); S.init(T / BM, 22, G, bid);
        EpiFfnAct E{(const float*)(ws + WS_SSP2), a.in[I_FCW], a.in[I_FCB], (bf16_t*)(ws + WS_UU), (bf16_t*)(ws + WS_HG)}; gemm_phase(lds, wave, g, S, E); } SEAM(10);
    if (IN(11)) for (int rep_ = 0; rep_ < REPS(11); ++rep_) phase_ffnfix(a, wave, G); SEAM(11);
    if (IN(12)) for (int rep_ = 0; rep_ < REPS(12); ++rep_) { Gemm g = plain_gemm((const bf16_t*)(ws + WS_UU), (const bf16_t*)(ws + WS_WFFO), DFF); S.init(T / BM, 4, G, bid);
        EpiRes<false> E{a.out, a.out, nullptr, (float*)(ws + WS_SSP3)}; gemm_phase(lds, wave, g, S, E); } SEAM(12);
    if (IN(13)) for (int rep_ = 0; rep_ < REPS(13); ++rep_) phase_final(a, wave, G);
#undef IN
#undef SEAM
}

extern "C" void kernel_launch(void* const* d_in, const int* in_sizes, int n_in, void* d_out, int out_size, void* d_ws, size_t ws_size, hipStream_t stream) {
    static int grid = 0;
    if (grid == 0) {
        if (n_in != 37 || in_sizes[0] != T * D || out_size != T * D || ws_size < WS_END) {
            fprintf(stderr, "kernel_launch: unexpected shapes (n_in %d, in0 %d, out %d, ws %zu < %zu); nothing launched\n", n_in, n_in > 0 ? in_sizes[0] : -1, out_size, ws_size, (size_t)WS_END); grid = -1; return; }
        int dev = 0, cus = 0, per_cu = 0;
        if (hipGetDevice(&dev) != hipSuccess || hipDeviceGetAttribute(&cus, hipDeviceAttributeMultiprocessorCount, dev) != hipSuccess) { grid = -1; return; }
        if (hipFuncSetAttribute((const void*)mega, hipFuncAttributeMaxDynamicSharedMemorySize, LDS_BYTES) != hipSuccess) { fprintf(stderr, "kernel_launch: hipFuncSetAttribute failed\n"); grid = -1; return; }
        if (hipOccupancyMaxActiveBlocksPerMultiprocessor(&per_cu, (const void*)mega, 512, LDS_BYTES) != hipSuccess || per_cu < 1) { fprintf(stderr, "kernel_launch: occupancy query says %d\n", per_cu); per_cu = 1; }
        (void)hipGetLastError();
        grid = cus * 1;
    }
    if (grid < 0) return;
    if (hipMemsetAsync((char*)d_ws + WS_CTL, 0, CTL_BYTES, stream) != hipSuccess) { fprintf(stderr, "kernel_launch: memset failed\n"); return; }
    Args a{};
    for (int i = 0; i < 37; ++i) a.in[i] = (const float*)d_in[i];
    a.out = (float*)d_out; a.ws = (unsigned char*)d_ws;
#if MK_SPLIT
    for (int ph = 0; ph <= NPHASE; ++ph) {
        a.ph_lo = ph; a.ph_hi = ph + 1; void* args[] = {&a};
        hipError_t e = hipLaunchCooperativeKernel((const void*)mega, dim3(grid), dim3(512), args, LDS_BYTES, stream);
        if (e != hipSuccess) { fprintf(stderr, "kernel_launch: launch of phase %d failed: %s\n", ph, hipGetErrorString(e)); break; }
    }
#else
    a.ph_lo = 0; a.ph_hi = NPHASE + 1; void* args[] = {&a};
    hipError_t e = hipLaunchCooperativeKernel((const void*)mega, dim3(grid), dim3(512), args, LDS_BYTES, stream);
    if (e != hipSuccess) fprintf(stderr, "kernel_launch: cooperative launch failed: %s (grid %d)\n", hipGetErrorString(e), grid);
#endif
}
```

```cpp
#include <hip/hip_runtime.h>
#include <hip/hip_cooperative_groups.h>
#include <cstdio>
namespace cg = cooperative_groups;

#ifndef MK_SPLIT
#define MK_SPLIT 0
#endif

#ifndef DUP_PHASE
#define DUP_PHASE -1
#endif
#define REPS(k) ((DUP_PHASE == (k)) ? 2 : 1)
#define LAS __attribute__((address_space(3)))
typedef unsigned short bf16_t;
typedef short bf16x8 __attribute__((ext_vector_type(8)));
typedef float f32x4 __attribute__((ext_vector_type(4)));
typedef float f32x2 __attribute__((ext_vector_type(2)));
typedef unsigned u32x4 __attribute__((ext_vector_type(4)));
typedef unsigned u32x2 __attribute__((ext_vector_type(2)));

constexpr int T = 65536, D = 1024, SEQ = 2048, NB = 32, NMEM = 256, TM = NB * NMEM;
constexpr int AW = 512, RW = 1792, PIN = 4864, DFF = 2816;
constexpr float NORM_EPS = 1e-6f, LNX_EPS = 64e-5f;

constexpr size_t MiB = 1u << 20;
constexpr size_t WS_WIN = 0;
constexpr size_t WS_WFFI = 10 * MiB;
constexpr size_t WS_WFFO = 21 * MiB;
constexpr size_t WS_WMIX = 27 * MiB, WS_WCQ = 29 * MiB, WS_WK = 31 * MiB, WS_WV = 33 * MiB, WS_WCO = 35 * MiB;
constexpr size_t WS_WA = 37 * MiB, WS_WB = 38 * MiB;
constexpr size_t WS_WLORA = 39 * MiB;
constexpr size_t WS_WRG = 40 * MiB;
constexpr size_t WS_CTL = 46 * MiB, CTL_BYTES = 16384;
constexpr size_t WS_RSTDX = 48 * MiB;
constexpr size_t WS_SSP1 = 49 * MiB, WS_SSP2 = 53 * MiB, WS_SSP3 = 57 * MiB, WS_SSPA = 61 * MiB;
constexpr size_t WS_BON = 65 * MiB;
constexpr size_t WS_MEMN = 68 * MiB, WS_KM = 84 * MiB, WS_VT = 100 * MiB;
constexpr size_t WS_XB = 120 * MiB;
constexpr size_t WS_PR = 248 * MiB;
constexpr size_t WS_PX = 472 * MiB, WS_PY = 536 * MiB;
constexpr size_t WS_LIN = 600 * MiB, WS_XBC = 632 * MiB;
constexpr size_t WS_LOUT = 696 * MiB;
constexpr size_t WS_RGLA = 888 * MiB, WS_RGU = 952 * MiB;
constexpr size_t WS_YRAW = WS_PX, WS_YB = WS_LIN, WS_YA = WS_RGLA;
constexpr size_t WS_GAB = 248 * MiB;
constexpr size_t WS_MERGED = 696 * MiB;
constexpr size_t WS_X1B = WS_XB, WS_Q = 248 * MiB, WS_PEXP = 376 * MiB, WS_O = 504 * MiB, WS_X2B = WS_XB;
constexpr size_t WS_HG = 248 * MiB, WS_UU = 600 * MiB;
constexpr size_t WS_END = 1016 * MiB;

constexpr int LDS_BYTES = 147456;

__device__ __forceinline__ unsigned cvt_pk_bf16(float lo, float hi) { unsigned r; asm("v_cvt_pk_bf16_f32 %0, %1, %2" : "=v"(r) : "v"(lo), "v"(hi)); return r; }
__device__ __forceinline__ float bf_lo(unsigned w) { return __uint_as_float(w << 16); }
__device__ __forceinline__ float bf_hi(unsigned w) { return __uint_as_float(w & 0xffff0000u); }
__device__ __forceinline__ float bf1(bf16_t b) { return __uint_as_float(((unsigned)b) << 16); }
__device__ __forceinline__ bf16_t f2bf(float f) { return (bf16_t)(cvt_pk_bf16(f, 0.f) & 0xffffu); }
__device__ __forceinline__ float sigmoidf_(float x) { return __builtin_amdgcn_rcpf(1.0f + __expf(-x)); }
__device__ __forceinline__ float gelu_tanh(float x) { const float z = 1.5957691216057308f * (x + 0.044715f * x * x * x); return x * sigmoidf_(z); }
__device__ __forceinline__ int lane_id() { int l; asm volatile("v_mbcnt_lo_u32_b32 %0, -1, 0\n\tv_mbcnt_hi_u32_b32 %0, -1, %0" : "=v"(l)); return l; }
__device__ __forceinline__ float wave_sum(float v) {
#pragma unroll
    for (int o = 1; o < 64; o <<= 1) v += __shfl_xor(v, o);
    return v;
}
__device__ __forceinline__ void unpack8(const u32x4 w, float (&f)[8]) {
    f[0] = bf_lo(w.x); f[1] = bf_hi(w.x); f[2] = bf_lo(w.y); f[3] = bf_hi(w.y); f[4] = bf_lo(w.z); f[5] = bf_hi(w.z); f[6] = bf_lo(w.w); f[7] = bf_hi(w.w);
}
__device__ __forceinline__ u32x4 pack8(const float (&f)[8]) {
    u32x4 w; w.x = cvt_pk_bf16(f[0], f[1]); w.y = cvt_pk_bf16(f[2], f[3]); w.z = cvt_pk_bf16(f[4], f[5]); w.w = cvt_pk_bf16(f[6], f[7]); return w;
}


#define XB_TMO      128
#define XB_XCNT(j)  (256  + 64 * (j))
#define XB_XSUB(j)  (1280 + 64 * (j))
#define XB_XGEN(j)  (2304 + 64 * (j))
#define XB_TOP      3328
#define XB_TOPGEN   3392
#define XCD_BAR_WORDS 3456
#define XB_SPIN_CAP (1u << 22)
__device__ __forceinline__ unsigned xb_ld(unsigned* p)              { return __hip_atomic_load(p, __ATOMIC_RELAXED, __HIP_MEMORY_SCOPE_AGENT); }
__device__ __forceinline__ unsigned xb_add(unsigned* p, unsigned v) { return __hip_atomic_fetch_add(p, v, __ATOMIC_RELAXED, __HIP_MEMORY_SCOPE_AGENT); }
__device__ __forceinline__ unsigned xb_xcc_id() { return (unsigned)__builtin_amdgcn_s_getreg((3 << 11) | 20) & 0xFu; }
#define XB_SPIN(cond, bar) do { unsigned _sp = 0; while (cond) { __builtin_amdgcn_s_sleep(1); \
    if ((++_sp & 255u) == 0u) { if (xb_ld(&(bar)[XB_TMO])) break; if (_sp > XB_SPIN_CAP) { atomicAdd(&(bar)[XB_TMO], 1u); break; } } } } while (0)
struct XcdBarrier { unsigned* bar; unsigned x; volatile LAS unsigned* st; };
__device__ __forceinline__ XcdBarrier xcd_barrier_post(unsigned* bar, volatile LAS unsigned* st, bool t0) {
    XcdBarrier b; b.bar = bar; b.x = xb_xcc_id(); b.st = st;
    if (t0) (void)xb_add(&bar[XB_XCNT(b.x)], 1u);
    return b;
}
__device__ __forceinline__ void xcd_barrier_complete(unsigned* bar, unsigned x, unsigned& nloc, unsigned& nx) {
    const unsigned G = gridDim.x * gridDim.y * gridDim.z;
    unsigned sum, cnt, mine, sp = 0u;
    for (;;) {
        sum = 0u; cnt = 0u; mine = 0u;
#pragma unroll
        for (unsigned j = 0; j < 16; ++j) { const unsigned c = xb_ld(&bar[XB_XCNT(j)]); sum += c; cnt += (c > 0u) ? 1u : 0u; mine = (j == x) ? c : mine; }
        if (sum == G) break;
        __builtin_amdgcn_s_sleep(1);
        if ((++sp & 255u) == 0u) { if (xb_ld(&bar[XB_TMO])) break; if (sp > XB_SPIN_CAP) { atomicAdd(&bar[XB_TMO], 1u); break; } }
    }
    nloc = mine > 0u ? mine : 1u; nx = cnt > 0u ? cnt : 1u;
}
__device__ __forceinline__ void xcd_barrier(const XcdBarrier& b, bool t0) {
    asm volatile("s_waitcnt vmcnt(0)" ::: "memory");
    __syncthreads();
    if (t0) {
        unsigned* bar = b.bar;
        __builtin_amdgcn_s_waitcnt(0);
        unsigned nloc = b.st[0], nx = b.st[1];
        if (nloc == 0u) { xcd_barrier_complete(bar, b.x, nloc, nx); b.st[0] = nloc; b.st[1] = nx; }
        const unsigned old = xb_add(&bar[XB_XSUB(b.x)], 1u);
        const unsigned gen = old / nloc;
        if (old + 1u == (gen + 1u) * nloc) {
            __builtin_amdgcn_fence(__ATOMIC_RELEASE, "agent");
            asm volatile("s_waitcnt vmcnt(0)" ::: "memory");
            const unsigned og = xb_add(&bar[XB_TOP], 1u);
            const unsigned tg = og / nx;
            if (og + 1u == (tg + 1u) * nx) xb_add(&bar[XB_TOPGEN], 1u);
            else XB_SPIN(xb_ld(&bar[XB_TOPGEN]) == tg, bar);
            __builtin_amdgcn_fence(__ATOMIC_ACQUIRE, "agent");
            xb_add(&bar[XB_XGEN(b.x)], 1u);
            asm volatile("s_waitcnt vmcnt(0)" ::: "memory");
        } else {
            XB_SPIN(xb_ld(&bar[XB_XGEN(b.x)]) == gen, bar);
            __builtin_amdgcn_fence(__ATOMIC_ACQUIRE, "agent");
            asm volatile("s_waitcnt vmcnt(0)" ::: "memory");
        }
    }
    __syncthreads();
}

constexpr int BM = 256, BK = 64, HALF = 128, HTB = HALF * BK * 2, NXCD = 8, WGM = 8;
__device__ __forceinline__ int lds_byte(int r, int c) { const int st = (r >> 4) * 2 + (c >> 5), rr = r & 15, cc = c & 31, ob = rr * 64 + cc * 2; return st * 1024 + (ob ^ (((ob >> 9) & 1) << 5)); }
__device__ __forceinline__ void stage_rc(int b, int& R, int& C) { const int st = b / 1024, sb = b % 1024, swz = sb ^ (((sb >> 9) & 1) << 5); R = (st >> 1) * 16 + swz / 64; C = (st & 1) * 32 + (swz % 64) / 2; }
__device__ __forceinline__ int perm32(int rho) { const int n = rho >> 4, i = rho & 15; return 8 * (i >> 2) + 4 * n + (i & 3); }

struct Unit { int pm, pn; };
struct Gemm { const bf16_t* A; const bf16_t* Bt; int lda, ldb, K; size_t a_pm, a_pn, b_pn, b_pb, a_pn2; };
__device__ __forceinline__ Gemm plain_gemm(const bf16_t* A, const bf16_t* Bt, int K) { Gemm g; g.A = A; g.Bt = Bt; g.lda = K; g.ldb = K; g.K = K; g.a_pm = (size_t)BM * K * 2; g.a_pn = 0; g.b_pn = (size_t)BM * K * 2; g.b_pb = 0; g.a_pn2 = 0; return g; }

struct StaticOrder {
    int nM, nN, nwg, G, c;
    __device__ void init(int nM_, int nN_, int G_, int c_) { nM = nM_; nN = nN_; nwg = nM * nN; G = G_; c = c_; }
    __device__ bool next(int i, Unit& u) const {
        const long L = (long)i * G + c; if (L >= nwg) return false;
        int wgid = (int)L; { const int q = nwg / NXCD, r = nwg % NXCD, xcd = wgid % NXCD, off = wgid / NXCD; wgid = (xcd < r ? xcd * (q + 1) : r * (q + 1) + (xcd - r) * q) + off; }
        const int nig = WGM * nN, gid = wgid / nig, fm = gid * WGM, gsz = (nM - fm) < WGM ? (nM - fm) : WGM;
        u.pm = fm + ((wgid % nig) % gsz); u.pn = (wgid % nig) / gsz; return true;
    }
};

typedef f32x4 Acc[2][2][4][2];

template <class Epi>
__device__ __forceinline__ void gemm_phase(LAS unsigned char* lds, const int wid, const Gemm g, const StaticOrder& S, const Epi& E) {
    const int lane = lane_id(), tid = wid * 64 + lane, wr = wid >> 2, wc = wid & 3, fr = lane & 15, fq = lane >> 4;
    const int nt = g.K / BK;
    unsigned voffA[2], voffB[2];
#pragma unroll
    for (int i = 0; i < 2; ++i) { int R, C; stage_rc(tid * 16 + i * 8192, R, C); const int Rb = Epi::PERM ? ((R & ~31) + perm32(R & 31)) : R;
        voffA[i] = (unsigned)(R * g.lda + C) * 2u; voffB[i] = (unsigned)(Rb * g.ldb + C) * 2u; }
    const size_t kstep = (size_t)(BK * 2);
    const size_t hstepA = (size_t)HALF * g.lda * 2, hstepB = (size_t)HALF * g.ldb * 2;
    const unsigned ldsw = (unsigned)wid * 1024u;
    const int aoff = lds_byte(wr * 64 + fr, fq * 8), boff = lds_byte(wc * 32 + fr, fq * 8);
#define PG8_SA(b, h) (((b) * 2 + (h)) * HTB)
#define PG8_SB(b, h) ((4 + (b) * 2 + (h)) * HTB)
#define PG8_STAGE(bufoff, gbase, voff) do { _Pragma("unroll") for (int _i = 0; _i < 2; ++_i) \
        __builtin_amdgcn_global_load_lds((const unsigned*)((const char*)(gbase) + (voff)[_i]), (LAS unsigned*)(lds + (bufoff) + ldsw + _i * 8192), 16, 0, 0); } while (0)
#define PG8_LDA(dst, b, h) do { _Pragma("unroll") for (int m = 0; m < 4; ++m) _Pragma("unroll") for (int k = 0; k < 2; ++k) dst[m][k] = *(const LAS bf16x8*)(lds + PG8_SA(b, h) + aoff + m * 2048 + k * 1024); } while (0)
#define PG8_LDB(dst, b, h) do { _Pragma("unroll") for (int n = 0; n < 2; ++n) _Pragma("unroll") for (int k = 0; k < 2; ++k) dst[n][k] = *(const LAS bf16x8*)(lds + PG8_SB(b, h) + boff + n * 2048 + k * 1024); } while (0)
#define PG8_MMA(ai, bj, At, Bt) do { __builtin_amdgcn_s_setprio(1); _Pragma("unroll") for (int m = 0; m < 4; ++m) _Pragma("unroll") for (int n = 0; n < 2; ++n) _Pragma("unroll") for (int k = 0; k < 2; ++k) \
        acc[ai][bj][m][n] = __builtin_amdgcn_mfma_f32_16x16x32_bf16(Bt[n][k], At[m][k], acc[ai][bj][m][n], 0, 0, 0); __builtin_amdgcn_s_setprio(0); } while (0)
#define PG8_WAIT_V(n) asm volatile("s_waitcnt vmcnt(" #n ")" ::: "memory")
#define PG8_WAIT_L(n) asm volatile("s_waitcnt lgkmcnt(" #n ")" ::: "memory")
#define PG8_BAR __builtin_amdgcn_s_barrier()
#define PG8_SCHED __builtin_amdgcn_sched_barrier(0)
#define PG8_UA(u) ((const char*)g.A + (size_t)(u).pm * g.a_pm + (size_t)(u).pn * g.a_pn + (size_t)((u).pn >> 1) * g.a_pn2)
#define PG8_UB(u) ((const char*)g.Bt + (size_t)(u).pn * g.b_pn + (size_t)((u).pm >> 3) * g.b_pb)
    Unit cur, nxt; int ui = 0;
    if (!S.next(0, cur)) return;
    Acc acc;
#pragma unroll
    for (int a = 0; a < 2; ++a)
#pragma unroll
        for (int b = 0; b < 2; ++b)
#pragma unroll
            for (int m = 0; m < 4; ++m)
#pragma unroll
                for (int n = 0; n < 2; ++n) acc[a][b][m][n] = (f32x4){0.f, 0.f, 0.f, 0.f};
    bf16x8 At[4][2], B0[2][2], B1[2][2];
    const char* cA = PG8_UA(cur); const char* cB = PG8_UB(cur);
    PG8_STAGE(PG8_SB(0, 0), cB, voffB); PG8_STAGE(PG8_SB(0, 1), cB + hstepB, voffB); PG8_STAGE(PG8_SA(0, 0), cA, voffA); PG8_STAGE(PG8_SA(0, 1), cA + hstepA, voffA);
    if (wr == 1) PG8_BAR;
    PG8_WAIT_V(2); PG8_BAR;
    PG8_STAGE(PG8_SB(1, 0), cB + kstep, voffB); PG8_STAGE(PG8_SA(1, 0), cA + kstep, voffA); PG8_STAGE(PG8_SB(1, 1), cB + hstepB + kstep, voffB);
    PG8_WAIT_V(6); PG8_BAR;
    for (;;) {
        const bool has_next = S.next(ui + 1, nxt);
        const char* nA = has_next ? PG8_UA(nxt) : cA; const char* nB = has_next ? PG8_UB(nxt) : cB;
        for (int t = 0; t < nt; t += 2) {
            const bool last = (t == nt - 2);
            const char* a1 = cA + (size_t)(t + 1) * kstep;
            const char* a2 = last ? nA : cA + (size_t)(t + 2) * kstep; const char* b2 = last ? nB : cB + (size_t)(t + 2) * kstep;
            const char* a3 = a2 + kstep; const char* b3 = b2 + kstep;
            PG8_LDB(B0, 0, 0); PG8_LDB(B1, 0, 1); PG8_SCHED; PG8_LDA(At, 0, 0); PG8_STAGE(PG8_SA(1, 1), a1 + hstepA, voffA);
            PG8_WAIT_V(8); PG8_WAIT_L(0); PG8_BAR; PG8_MMA(0, 0, At, B0); PG8_MMA(0, 1, At, B1); PG8_BAR; PG8_SCHED;
            PG8_LDA(At, 0, 1); PG8_STAGE(PG8_SB(0, 0), b2, voffB); PG8_STAGE(PG8_SB(0, 1), b2 + hstepB, voffB); PG8_STAGE(PG8_SA(0, 0), a2, voffA);
            PG8_WAIT_V(8); PG8_WAIT_L(0); PG8_BAR; PG8_MMA(1, 0, At, B0); PG8_MMA(1, 1, At, B1); PG8_BAR; PG8_SCHED;
            PG8_LDB(B0, 1, 0); PG8_LDB(B1, 1, 1); PG8_SCHED; PG8_LDA(At, 1, 0); PG8_STAGE(PG8_SA(0, 1), a2 + hstepA, voffA);
            PG8_WAIT_V(8); PG8_WAIT_L(0); PG8_BAR; PG8_MMA(0, 0, At, B0); PG8_MMA(0, 1, At, B1); PG8_BAR; PG8_SCHED;
            PG8_LDA(At, 1, 1); PG8_STAGE(PG8_SB(1, 0), b3, voffB); PG8_STAGE(PG8_SB(1, 1), b3 + hstepB, voffB); PG8_STAGE(PG8_SA(1, 0), a3, voffA);
            PG8_WAIT_V(8); PG8_WAIT_L(0); PG8_BAR; PG8_MMA(1, 0, At, B0); PG8_MMA(1, 1, At, B1); PG8_BAR; PG8_SCHED;
        }
        if (wr == 0) PG8_BAR;
        E(acc, cur, wr, wc, fr, fq);
        if (!has_next) break;
#pragma unroll
        for (int a = 0; a < 2; ++a)
#pragma unroll
            for (int b = 0; b < 2; ++b)
#pragma unroll
                for (int m = 0; m < 4; ++m)
#pragma unroll
                    for (int n = 0; n < 2; ++n) acc[a][b][m][n] = (f32x4){0.f, 0.f, 0.f, 0.f};
        cur = nxt; cA = nA; cB = nB; ++ui;
        if (wr == 1) PG8_BAR;
    }
    PG8_WAIT_V(0);
    PG8_BAR;
#undef PG8_SA
#undef PG8_SB
#undef PG8_STAGE
#undef PG8_LDA
#undef PG8_LDB
#undef PG8_MMA
#undef PG8_WAIT_V
#undef PG8_WAIT_L
#undef PG8_BAR
#undef PG8_SCHED
#undef PG8_UA
#undef PG8_UB
}

#define EPI_ROWS_BEGIN for (int ai = 0; ai < 2; ++ai) { _Pragma("unroll") for (int m = 0; m < 4; ++m) { const int r = u.pm * BM + ai * HALF + wr * 64 + m * 16 + fr;
#define EPI_ROWS_END } }

__device__ __forceinline__ float rstd_from16(const float* ss, int r) { return rsqrtf(ss[r] * (1.0f / 1024.0f) + NORM_EPS); }

struct EpiProj { static constexpr bool PERM = true;
    const float* rstd; const float* bias; bf16_t* PR; bf16_t* PX; bf16_t* PY;
    __device__ __forceinline__ void operator()(Acc& acc, const Unit& u, int wr, int wc, int fr, int fq) const {
        bf16_t* base; int ld, colt;
        if (u.pn < 7) { base = PR; ld = RW; colt = u.pn * 256; } else if (u.pn < 9) { base = PX; ld = 512; colt = (u.pn - 7) * 256; } else { base = PY; ld = 512; colt = (u.pn - 9) * 256; }
        const int col0 = colt + wc * 32 + 8 * fq, bcol0 = u.pn * 256 + wc * 32 + 8 * fq;
        f32x4 bv[2][2];
#pragma unroll
        for (int bj = 0; bj < 2; ++bj)
#pragma unroll
            for (int n = 0; n < 2; ++n) bv[bj][n] = *(const f32x4*)(bias + bcol0 + bj * HALF + 4 * n);
#pragma unroll
        EPI_ROWS_BEGIN
            const float rs = rstd[r]; bf16_t* rowp = base + (size_t)r * ld + col0;
#pragma unroll
            for (int bj = 0; bj < 2; ++bj) { const f32x4 v0 = acc[ai][bj][m][0] * rs + bv[bj][0], v1 = acc[ai][bj][m][1] * rs + bv[bj][1];
                u32x4 w; w.x = cvt_pk_bf16(v0[0], v0[1]); w.y = cvt_pk_bf16(v0[2], v0[3]); w.z = cvt_pk_bf16(v1[0], v1[1]); w.w = cvt_pk_bf16(v1[2], v1[3]);
                *(u32x4*)(rowp + bj * HALF) = w; }
        EPI_ROWS_END
    }
};
struct EpiGab { static constexpr bool PERM = true;
    const float* rstd; const float* bias; bf16_t* O; int cofs;
    __device__ __forceinline__ void operator()(Acc& acc, const Unit& u, int wr, int wc, int fr, int fq) const {
        const int col0 = cofs + u.pn * 256 + wc * 32 + 8 * fq;
        f32x4 bv[2][2];
#pragma unroll
        for (int bj = 0; bj < 2; ++bj)
#pragma unroll
            for (int n = 0; n < 2; ++n) bv[bj][n] = *(const f32x4*)(bias + col0 + bj * HALF + 4 * n);
#pragma unroll
        EPI_ROWS_BEGIN
            const float rs = rstd[r]; bf16_t* rowp = O + (size_t)r * 2048 + col0;
#pragma unroll
            for (int bj = 0; bj < 2; ++bj) { f32x4 v0 = acc[ai][bj][m][0] * rs + bv[bj][0], v1 = acc[ai][bj][m][1] * rs + bv[bj][1];
#pragma unroll
                for (int j = 0; j < 4; ++j) { v0[j] = sigmoidf_(v0[j]); v1[j] = sigmoidf_(v1[j]); }
                u32x4 w; w.x = cvt_pk_bf16(v0[0], v0[1]); w.y = cvt_pk_bf16(v0[2], v0[3]); w.z = cvt_pk_bf16(v1[0], v1[1]); w.w = cvt_pk_bf16(v1[2], v1[3]);
                *(u32x4*)(rowp + bj * HALF) = w; }
        EPI_ROWS_END
    }
};
struct EpiPlain { static constexpr bool PERM = true;
    bf16_t* O; int ldc;
    __device__ __forceinline__ void operator()(Acc& acc, const Unit& u, int wr, int wc, int fr, int fq) const {
        const int col0 = u.pn * 256 + wc * 32 + 8 * fq;
#pragma unroll
        EPI_ROWS_BEGIN
            bf16_t* rowp = O + (size_t)r * ldc + col0;
#pragma unroll
            for (int bj = 0; bj < 2; ++bj) { const f32x4 v0 = acc[ai][bj][m][0], v1 = acc[ai][bj][m][1];
                u32x4 w; w.x = cvt_pk_bf16(v0[0], v0[1]); w.y = cvt_pk_bf16(v0[2], v0[3]); w.z = cvt_pk_bf16(v1[0], v1[1]); w.w = cvt_pk_bf16(v1[2], v1[3]);
                *(u32x4*)(rowp + bj * HALF) = w; }
        EPI_ROWS_END
    }
};
struct EpiLora { static constexpr bool PERM = true;
    const float* w0; const float* a0; bf16_t* O;
    __device__ __forceinline__ void operator()(Acc& acc, const Unit& u, int wr, int wc, int fr, int fq) const {
        const int kind = u.pn >> 1, ch0 = (u.pn & 1) * 256 + wc * 32 + 8 * fq, col0 = u.pn * 256 + wc * 32 + 8 * fq;
        const float* bsrc = kind == 0 ? w0 : a0;
        f32x4 bv[2][2];
#pragma unroll
        for (int bj = 0; bj < 2; ++bj)
#pragma unroll
            for (int n = 0; n < 2; ++n) bv[bj][n] = kind < 2 ? *(const f32x4*)(bsrc + ch0 + bj * HALF + 4 * n) : (f32x4){0.f, 0.f, 0.f, 0.f};
        const float sc = kind == 0 ? 0.6065306597126334f : 1.0f;
#pragma unroll
        EPI_ROWS_BEGIN
            bf16_t* rowp = O + (size_t)r * 1536 + col0;
#pragma unroll
            for (int bj = 0; bj < 2; ++bj) { f32x4 v0 = acc[ai][bj][m][0] + bv[bj][0], v1 = acc[ai][bj][m][1] + bv[bj][1];
                if (kind < 2) {
#pragma unroll
                    for (int j = 0; j < 4; ++j) { v0[j] = sc * sigmoidf_(v0[j]); v1[j] = sc * sigmoidf_(v1[j]); } }
                u32x4 w; w.x = cvt_pk_bf16(v0[0], v0[1]); w.y = cvt_pk_bf16(v0[2], v0[3]); w.z = cvt_pk_bf16(v1[0], v1[1]); w.w = cvt_pk_bf16(v1[2], v1[3]);
                *(u32x4*)(rowp + bj * HALF) = w; }
        EPI_ROWS_END
    }
};
struct EpiRg { static constexpr bool PERM = true;
    const float* ba; const float* bx; const float* lam; const bf16_t* XBC; bf16_t* LA; bf16_t* U;
    __device__ __forceinline__ void operator()(Acc& acc, const Unit& u, int wr, int wc, int fr, int fq) const {
        const int ch0 = u.pn * 128 + wc * 32 + 8 * fq;
        float vba[8], vbx[8], vls[8];
#pragma unroll
        for (int j = 0; j < 8; ++j) { vba[j] = ba[ch0 + j]; vbx[j] = bx[ch0 + j]; vls[j] = -8.0f * log1pf(__expf(-lam[ch0 + j])); }
#pragma unroll
        EPI_ROWS_BEGIN
            const bool first = (r & (SEQ - 1)) == 0;
            float xb[8]; unpack8(*(const u32x4*)(XBC + (size_t)r * 512 + ch0), xb);
            float la[8], uu[8];
#pragma unroll
            for (int j = 0; j < 8; ++j) { const float ga = sigmoidf_(acc[ai][0][m][j >> 2][j & 3] + vba[j]), gx = sigmoidf_(acc[ai][1][m][j >> 2][j & 3] + vbx[j]);
                la[j] = vls[j] * ga; const float a = __expf(la[j]); const float mult = first ? 1.0f : sqrtf(fmaxf(1.0f - a * a, 0.f)); uu[j] = xb[j] * gx * mult; }
            *(u32x4*)(LA + (size_t)r * 512 + ch0) = pack8(la); *(u32x4*)(U + (size_t)r * 512 + ch0) = pack8(uu);
        EPI_ROWS_END
    }
};
template <bool FIRST> struct EpiBranch { static constexpr bool PERM = true;
    const bf16_t* G; bf16_t* M;
    __device__ __forceinline__ void operator()(Acc& acc, const Unit& u, int wr, int wc, int fr, int fq) const {
        const int col0 = u.pn * 256 + wc * 32 + 8 * fq;
#pragma unroll
        EPI_ROWS_BEGIN
#pragma unroll
            for (int bj = 0; bj < 2; ++bj) { const int c = col0 + bj * HALF;
                float gv[8]; unpack8(*(const u32x4*)(G + (size_t)r * 2048 + (FIRST ? 0 : 1024) + c), gv);
                float o[8];
                if (!FIRST) unpack8(*(const u32x4*)(M + (size_t)r * 1024 + c), o);
#pragma unroll
                for (int j = 0; j < 8; ++j) { const float p = acc[ai][bj][m][j >> 2][j & 3] * gv[j]; o[j] = FIRST ? p : o[j] + p; }
                *(u32x4*)(M + (size_t)r * 1024 + c) = pack8(o); }
        EPI_ROWS_END
    }
};
template <bool WB> struct EpiRes { static constexpr bool PERM = false;
    const float* base; float* out; bf16_t* XB; float* ssp;
    __device__ __forceinline__ void operator()(Acc& acc, const Unit& u, int wr, int wc, int fr, int fq) const {
        const int col0 = u.pn * 256 + wc * 32 + 4 * fq;
#pragma unroll
        EPI_ROWS_BEGIN
            const size_t off = (size_t)r * 1024 + col0; float s = 0.f;
#pragma unroll
            for (int bj = 0; bj < 2; ++bj)
#pragma unroll
                for (int n = 0; n < 2; ++n) { const f32x4 bs = *(const f32x4*)(base + off + bj * HALF + n * 16); const f32x4 o = bs + acc[ai][bj][m][n];
                    *(f32x4*)(out + off + bj * HALF + n * 16) = o; s += (o[0] * o[0] + o[1] * o[1]) + (o[2] * o[2] + o[3] * o[3]);
                    if (WB) { u32x2 w; w.x = cvt_pk_bf16(o[0], o[1]); w.y = cvt_pk_bf16(o[2], o[3]); *(u32x2*)(XB + off + bj * HALF + n * 16) = w; } }
            s += __shfl_xor(s, 16); s += __shfl_xor(s, 32);
            if (fq == 0) atomicAdd(ssp + r, s);
        EPI_ROWS_END
    }
};
struct EpiQ { static constexpr bool PERM = true;
    const float* ssp; bf16_t* O;
    __device__ __forceinline__ void operator()(Acc& acc, const Unit& u, int wr, int wc, int fr, int fq) const {
        const int col0 = u.pn * 256 + wc * 32 + 8 * fq;
#pragma unroll
        EPI_ROWS_BEGIN
            const float rs = rstd_from16(ssp, r) * 0.0625f; bf16_t* rowp = O + (size_t)r * 1024 + col0;
#pragma unroll
            for (int bj = 0; bj < 2; ++bj) { const f32x4 v0 = acc[ai][bj][m][0] * rs, v1 = acc[ai][bj][m][1] * rs;
                u32x4 w; w.x = cvt_pk_bf16(v0[0], v0[1]); w.y = cvt_pk_bf16(v0[2], v0[3]); w.z = cvt_pk_bf16(v1[0], v1[1]); w.w = cvt_pk_bf16(v1[2], v1[3]);
                *(u32x4*)(rowp + bj * HALF) = w; }
        EPI_ROWS_END
    }
};
struct EpiSc { static constexpr bool PERM = true;
    bf16_t* O; float* ssp;
    __device__ __forceinline__ void operator()(Acc& acc, const Unit& u, int wr, int wc, int fr, int fq) const {
        const int col0 = u.pn * 256 + wc * 32 + 8 * fq;
#pragma unroll
        EPI_ROWS_BEGIN
            bf16_t* rowp = O + (size_t)r * 1024 + col0; float s = 0.f;
#pragma unroll
            for (int bj = 0; bj < 2; ++bj) { f32x4 v0 = acc[ai][bj][m][0], v1 = acc[ai][bj][m][1];
#pragma unroll
                for (int j = 0; j < 4; ++j) { v0[j] = __expf(v0[j]); v1[j] = __expf(v1[j]); }
                s += ((v0[0] + v0[1]) + (v0[2] + v0[3])) + ((v1[0] + v1[1]) + (v1[2] + v1[3]));
                u32x4 w; w.x = cvt_pk_bf16(v0[0], v0[1]); w.y = cvt_pk_bf16(v0[2], v0[3]); w.z = cvt_pk_bf16(v1[0], v1[1]); w.w = cvt_pk_bf16(v1[2], v1[3]);
                *(u32x4*)(rowp + bj * HALF) = w; }
            s += __shfl_xor(s, 16); s += __shfl_xor(s, 32);
            if (fq == 0) ssp[(size_t)r * 16 + u.pn * 4 + wc] = s;
        EPI_ROWS_END
    }
};
struct EpiPv { static constexpr bool PERM = true;
    const float* ssp; bf16_t* O;
    __device__ __forceinline__ void operator()(Acc& acc, const Unit& u, int wr, int wc, int fr, int fq) const {
        const int col0 = u.pn * 256 + wc * 32 + 8 * fq;
#pragma unroll
        EPI_ROWS_BEGIN
            const f32x4 sp = *(const f32x4*)(ssp + (size_t)r * 16 + u.pn * 4); const float rs = 1.0f / ((sp.x + sp.y) + (sp.z + sp.w));
            bf16_t* rowp = O + (size_t)r * 1024 + col0;
#pragma unroll
            for (int bj = 0; bj < 2; ++bj) { const f32x4 v0 = acc[ai][bj][m][0] * rs, v1 = acc[ai][bj][m][1] * rs;
                u32x4 w; w.x = cvt_pk_bf16(v0[0], v0[1]); w.y = cvt_pk_bf16(v0[2], v0[3]); w.z = cvt_pk_bf16(v1[0], v1[1]); w.w = cvt_pk_bf16(v1[2], v1[3]);
                *(u32x4*)(rowp + bj * HALF) = w; }
        EPI_ROWS_END
    }
};
__device__ __forceinline__ float dpp_ror1(float v) { return __int_as_float(__builtin_amdgcn_update_dpp(0, __float_as_int(v), 0x121, 0xf, 0xf, false)); }
__device__ __forceinline__ float dpp_ror2(float v) { return __int_as_float(__builtin_amdgcn_update_dpp(0, __float_as_int(v), 0x122, 0xf, 0xf, false)); }
struct EpiFfnAct { static constexpr bool PERM = true;
    const float* ssp; const float* cw; const float* cb; bf16_t* ACT; bf16_t* HG;
    __device__ __forceinline__ void operator()(Acc& acc, const Unit& u, int wr, int wc, int fr_, int fq_) const {
        const int l_ = lane_id(), fr = l_ & 15, fq = l_ >> 4;
        const int col0 = u.pn * 128 + wc * 32 + 8 * fq;
#pragma unroll
        for (int ai = 0; ai < 2; ++ai) {
            const int rbase = u.pm * BM + ai * HALF + wr * 64 + fr;
            float rs[4];
#pragma unroll
            for (int m = 0; m < 4; ++m) rs[m] = rstd_from16(ssp, rbase + m * 16);
            const size_t grp = (size_t)(rbase >> 6);
            if (fr < 2) { float t[8];
#pragma unroll
                for (int j = 0; j < 8; ++j) t[j] = acc[ai][0][0][j >> 2][j & 3] * rs[0];
                *(u32x4*)(HG + (grp * 4 + 2 + fr) * DFF + col0) = pack8(t); }
            if (fr >= 14) { float t[8];
#pragma unroll
                for (int j = 0; j < 8; ++j) t[j] = acc[ai][0][3][j >> 2][j & 3] * rs[3];
                *(u32x4*)(HG + (grp * 4 + (fr - 14)) * DFF + col0) = pack8(t); }
#pragma unroll
            for (int j = 0; j < 8; ++j) {
                const float w0 = cw[col0 + j], w1 = cw[DFF + col0 + j], w2 = cw[2 * DFF + col0 + j], b0 = cb[col0 + j];
                float g[4], r1[4], r2[4];
#pragma unroll
                for (int m = 0; m < 4; ++m) { g[m] = acc[ai][0][m][j >> 2][j & 3] * rs[m]; r1[m] = dpp_ror1(g[m]); r2[m] = dpp_ror2(g[m]); }
#pragma unroll
                for (int m = 0; m < 4; ++m) {
                    const float p1 = fr >= 1 ? r1[m] : r1[m > 0 ? m - 1 : 0], p2 = fr >= 2 ? r2[m] : r2[m > 0 ? m - 1 : 0];
                    const float up = acc[ai][1][m][j >> 2][j & 3] * rs[m];
                    const float gate = b0 + w0 * p2 + w1 * p1 + w2 * g[m];
                    acc[ai][1][m][j >> 2][j & 3] = (m == 0 && fr < 2) ? up : gelu_tanh(gate) * up;
                }
            }
#pragma unroll
            for (int m = 0; m < 4; ++m) { const f32x4 v0 = acc[ai][1][m][0], v1 = acc[ai][1][m][1];
                u32x4 w; w.x = cvt_pk_bf16(v0[0], v0[1]); w.y = cvt_pk_bf16(v0[2], v0[3]); w.z = cvt_pk_bf16(v1[0], v1[1]); w.w = cvt_pk_bf16(v1[2], v1[3]);
                *(u32x4*)(ACT + (size_t)(rbase + m * 16) * DFF + col0) = w; }
        }
    }
};

struct Args { const float* in[37]; float* out; unsigned char* ws; int ph_lo, ph_hi; };
enum { I_X = 0, I_MEM, I_NMIXG, I_WIN, I_BIN, I_MU, I_W0, I_WUP, I_A0, I_AUP, I_GUP, I_KK, I_KA, I_RK, I_LNXG, I_LNXB, I_WBA, I_CBW, I_CBB, I_WRGA, I_BRGA, I_WRGX, I_BRGX,
       I_LAM, I_WBB, I_WMIX, I_NXG, I_NMEMG, I_WCQ, I_WCKV, I_WCO, I_NFFNG, I_WFFI, I_FCW, I_FCB, I_WFFO, I_NFING };

__device__ __forceinline__ void transpose_item(const float* W, int ldw, int K, bf16_t* WT, int ldd, const float* gain, int map, int srcofs, LAS float* scr, int item, int lane) {
    const int nkb = K / 64, nb = item / nkb, kb = item % nkb, k0 = 64 * kb, n0 = 32 * nb;
    int ns = n0 + srcofs;
    if (map == 1) { const int tile = n0 >> 8, c = n0 & 255; ns = c < 128 ? tile * 128 + c : DFF + tile * 128 + (c - 128); }
#pragma unroll 8
    for (int i = 0; i < 32; ++i) { const int kk = 2 * i + (lane >> 5); float v = W[(size_t)(k0 + kk) * ldw + ns + (lane & 31)]; if (gain) v *= gain[k0 + kk]; scr[kk * 33 + (lane & 31)] = v; }
    asm volatile("s_waitcnt lgkmcnt(0)" ::: "memory");
    const int c = lane & 7;
#pragma unroll
    for (int j = 0; j < 4; ++j) { const int n = (lane >> 3) + 8 * j; const LAS float* s = scr + (8 * c) * 33 + n;
        u32x4 o; o.x = cvt_pk_bf16(s[0 * 33], s[1 * 33]); o.y = cvt_pk_bf16(s[2 * 33], s[3 * 33]); o.z = cvt_pk_bf16(s[4 * 33], s[5 * 33]); o.w = cvt_pk_bf16(s[6 * 33], s[7 * 33]);
        *(u32x4*)(WT + (size_t)(n0 + n) * ldd + k0 + 8 * c) = o; }
    asm volatile("s_waitcnt lgkmcnt(0)" ::: "memory");
}

__device__ __forceinline__ void phase_prep(const Args& a, LAS unsigned char* lds, int wave, int G) {
    const int lane = lane_id();
    unsigned char* ws = a.ws;
    LAS float* scr = (LAS float*)(lds + wave * 16384);
    const int gw = blockIdx.x * 8 + wave, NGW = G * 8;
#define TJOB(W_, ldw_, K_, Nd_, dst_, gain_, map_, srcofs_) do { const int nitems = ((K_) / 64) * ((Nd_) / 32); \
        for (int it = gw; it < nitems; it += NGW) transpose_item((W_), (ldw_), (K_), (bf16_t*)(ws + (dst_)), (K_), (gain_), (map_), (srcofs_), scr, it, lane); } while (0)
    TJOB(a.in[I_WIN], PIN, 1024, PIN, WS_WIN, a.in[I_NMIXG], 0, 0);
    TJOB(a.in[I_WBA], 1024, 512, 1024, WS_WA, nullptr, 0, 0);
    TJOB(a.in[I_WBB], 1024, 512, 1024, WS_WB, nullptr, 0, 0);
    TJOB(a.in[I_WMIX], 1024, 1024, 1024, WS_WMIX, nullptr, 0, 0);
    TJOB(a.in[I_WCQ], 1024, 1024, 1024, WS_WCQ, a.in[I_NXG], 0, 0);
    TJOB(a.in[I_WCKV], 2048, 1024, 1024, WS_WK, nullptr, 0, 0);
    TJOB(a.in[I_WCKV], 2048, 1024, 1024, WS_WV, nullptr, 0, 1024);
    TJOB(a.in[I_WCO], 1024, 1024, 1024, WS_WCO, nullptr, 0, 0);
    TJOB(a.in[I_WFFI], 2 * DFF, 1024, 2 * DFF, WS_WFFI, a.in[I_NFFNG], 1, 0);
    TJOB(a.in[I_WFFO], 1024, DFF, 1024, WS_WFFO, nullptr, 0, 0);
#undef TJOB
    { float* z1 = (float*)(ws + WS_SSP1); float* z2 = (float*)(ws + WS_SSP2); float* z3 = (float*)(ws + WS_SSP3);
      for (int i = blockIdx.x * 512 + wave * 64 + lane; i < T; i += G * 512) { z1[i] = 0.f; z2[i] = 0.f; z3[i] = 0.f; } }
    const int gid = blockIdx.x * 512 + wave * 64 + lane, NT = G * 512;
    { bf16_t* WL = (bf16_t*)(ws + WS_WLORA);
      for (int i = gid; i < 1536 * 256; i += NT) { const int n = i >> 8, k = i & 255, kind = n >> 9, c = n & 511; float v = 0.f;
          if (kind == 0 && k < 64) v = a.in[I_WUP][k * 512 + c]; else if (kind == 1 && k >= 64 && k < 128) v = a.in[I_AUP][(k - 64) * 512 + c]; else if (kind == 2 && k >= 128) v = a.in[I_GUP][(k - 128) * 512 + c];
          WL[i] = f2bf(v); } }
    { bf16_t* WR = (bf16_t*)(ws + WS_WRG);
      for (int i = gid; i < 1024 * 256; i += NT) { const int n = i >> 8, kk = i & 255, pn = n >> 8, c = n & 255, ch = pn * 128 + (c & 127), hb = ch >> 6, j = ch & 63, k = 256 * (pn >> 1) + kk; float v = 0.f;
          if ((k >> 6) == hb) v = (c < 128 ? a.in[I_WRGA] : a.in[I_WRGX])[(hb * 64 + (k & 63)) * 64 + j];
          WR[i] = f2bf(v); } }
    { const float* x = a.in[I_X]; bf16_t* XB = (bf16_t*)(ws + WS_XB); float* rstd = (float*)(ws + WS_RSTDX);
      for (int r0 = gw; r0 < T; r0 += 4 * NGW) {
          f32x4 v[4][4]; float s[4];
#pragma unroll
          for (int q = 0; q < 4; ++q) { const int r = r0 + q * NGW; s[q] = 0.f; if (r < T) { const f32x4* xr = (const f32x4*)(x + (size_t)r * D) + lane;
#pragma unroll
              for (int j = 0; j < 4; ++j) v[q][j] = xr[64 * j]; } else {
#pragma unroll
              for (int j = 0; j < 4; ++j) v[q][j] = (f32x4){0.f, 0.f, 0.f, 0.f}; } }
#pragma unroll
          for (int q = 0; q < 4; ++q) {
#pragma unroll
              for (int j = 0; j < 4; ++j) s[q] += (v[q][j].x * v[q][j].x + v[q][j].y * v[q][j].y) + (v[q][j].z * v[q][j].z + v[q][j].w * v[q][j].w);
              s[q] = wave_sum(s[q]); }
#pragma unroll
          for (int q = 0; q < 4; ++q) { const int r = r0 + q * NGW; if (r < T) { if (lane == 0) rstd[r] = rsqrtf(s[q] * (1.0f / D) + NORM_EPS);
              u32x2* o = (u32x2*)(XB + (size_t)r * D) + lane;
#pragma unroll
              for (int j = 0; j < 4; ++j) { u32x2 w; w.x = cvt_pk_bf16(v[q][j].x, v[q][j].y); w.y = cvt_pk_bf16(v[q][j].z, v[q][j].w); o[64 * j] = w; } } } } }
    { const float* x = a.in[I_MEM]; bf16_t* XB = (bf16_t*)(ws + WS_MEMN); const float* g = a.in[I_NMEMG];
      for (int r = gw; r < TM; r += NGW) { const f32x4* xr = (const f32x4*)(x + (size_t)r * D) + lane; f32x4 v[4]; float s = 0.f;
#pragma unroll
          for (int j = 0; j < 4; ++j) { v[j] = xr[64 * j]; s += (v[j].x * v[j].x + v[j].y * v[j].y) + (v[j].z * v[j].z + v[j].w * v[j].w); }
          s = wave_sum(s); const float rs = rsqrtf(s * (1.0f / D) + NORM_EPS);
          u32x2* o = (u32x2*)(XB + (size_t)r * D) + lane;
#pragma unroll
          for (int j = 0; j < 4; ++j) { const f32x4 gg = ((const f32x4*)g)[lane + 64 * j]; u32x2 w; w.x = cvt_pk_bf16(v[j].x * rs * gg.x, v[j].y * rs * gg.y); w.y = cvt_pk_bf16(v[j].z * rs * gg.z, v[j].w * rs * gg.w); o[64 * j] = w; } } }
}

__device__ __forceinline__ void phase_elem2(const Args& a, int wave, int G) {
    unsigned char* ws = a.ws;
    const bf16_t* PR = (const bf16_t*)(ws + WS_PR); const bf16_t* PX = (const bf16_t*)(ws + WS_PX);
    bf16_t* LIN = (bf16_t*)(ws + WS_LIN); bf16_t* XBC = (bf16_t*)(ws + WS_XBC);
    const float* mu = a.in[I_MU]; const float* cw = a.in[I_CBW]; const float* cb = a.in[I_CBB];
    const size_t gid = (size_t)blockIdx.x * 512 + wave * 64 + lane_id(), NT = (size_t)G * 512;
    for (size_t i = gid; i < (size_t)T * 96; i += NT) {
        const int t = (int)(i / 96), q = (int)(i % 96), tl = t & (SEQ - 1);
        if (q < 32) { const int c = q * 8; float p[8], pp[8], o[8];
            unpack8(*(const u32x4*)(PR + (size_t)t * RW + 1536 + c), p);
            if (tl > 0) unpack8(*(const u32x4*)(PR + (size_t)(t - 1) * RW + 1536 + c), pp); else {
#pragma unroll
                for (int j = 0; j < 8; ++j) pp[j] = 0.f; }
#pragma unroll
            for (int j = 0; j < 8; ++j) { const float v = p[j] + (pp[j] - p[j]) * mu[1536 + c + j];
                o[j] = c < 64 ? tanhf(v) : (c < 128 ? v : sigmoidf_(v)); }
            *(u32x4*)(LIN + (size_t)t * 256 + c) = pack8(o);
        } else { const int c = (q - 32) * 8; float o[8];
#pragma unroll
            for (int j = 0; j < 8; ++j) o[j] = cb[c + j];
#pragma unroll
            for (int k = 0; k < 4; ++k) { const int dt = 3 - k; if (tl >= dt) { float p[8]; unpack8(*(const u32x4*)(PX + (size_t)(t - dt) * 512 + c), p);
#pragma unroll
                for (int j = 0; j < 8; ++j) o[j] += p[j] * cw[k * 512 + c + j]; } }
            *(u32x4*)(XBC + (size_t)t * 512 + c) = pack8(o);
        }
    }
}

#define DPP_BC(JJ) " row_newbcast:" #JJ " row_mask:0xf bank_mask:0xf"
#define RW_SA(JJ)  asm("v_fmac_f32_dpp %0, %1, %2" DPP_BC(JJ) : "+v"(sacc[JJ & 3]) : "v"(va), "v"(S[JJ]));
#define RW_UPD(JJ) { float t_; \
    asm("v_mul_f32_dpp %0, %1, %2" DPP_BC(JJ) : "=v"(t_) : "v"(vb), "v"(sa)); \
    asm("v_fmac_f32_dpp %0, %1, %2" DPP_BC(JJ) : "+v"(t_) : "v"(vk), "v"(vv)); \
    asm("v_fmac_f32_dpp %0, %1, %2" DPP_BC(JJ) : "+v"(t_) : "v"(vw), "v"(S[JJ])); \
    S[JJ] = t_; \
    asm("v_fmac_f32_dpp %0, %1, %2" DPP_BC(JJ) : "+v"(yacc[JJ & 3]) : "v"(vr), "v"(S[JJ])); }
#define RW_ALL16(M) M(0) M(1) M(2) M(3) M(4) M(5) M(6) M(7) M(8) M(9) M(10) M(11) M(12) M(13) M(14) M(15)

constexpr int RB = 32;
constexpr int PSTEP = 6 * 64;
constexpr int PBUF = RB * PSTEP * 4;

__device__ __forceinline__ float dpp_ror_add(float v, const int ctrl_sel) {
    int t;
    switch (ctrl_sel) {
        case 8: t = __builtin_amdgcn_update_dpp(0, __float_as_int(v), 0x128, 0xf, 0xf, false); break;
        case 4: t = __builtin_amdgcn_update_dpp(0, __float_as_int(v), 0x124, 0xf, 0xf, false); break;
        case 2: t = __builtin_amdgcn_update_dpp(0, __float_as_int(v), 0x122, 0xf, 0xf, false); break;
        default: t = __builtin_amdgcn_update_dpp(0, __float_as_int(v), 0x121, 0xf, 0xf, false); break;
    }
    return v + __int_as_float(t);
}
__device__ __forceinline__ float cross_row_allsum(float v) {
    auto r = __builtin_amdgcn_permlane32_swap(__float_as_uint(v), __float_as_uint(v), false, false);
    v = __uint_as_float(r[0]) + __uint_as_float(r[1]);
    auto r2 = __builtin_amdgcn_permlane16_swap(__float_as_uint(v), __float_as_uint(v), false, false);
    return __uint_as_float(r2[0]) + __uint_as_float(r2[1]);
}
__device__ __forceinline__ float wave_allsum(float v) {
    v = dpp_ror_add(v, 8); v = dpp_ror_add(v, 4); v = dpp_ror_add(v, 2); v = dpp_ror_add(v, 1);
    return cross_row_allsum(v);
}
__device__ __forceinline__ void lds_barrier() { asm volatile("s_waitcnt lgkmcnt(0)" ::: "memory"); __builtin_amdgcn_s_barrier(); asm volatile("" ::: "memory"); }

__device__ __forceinline__ void rwkv_prep_block(const Args& a, LAS float* pb, int tok0, int h, int p, int lane, float mu_r, float mu_k, float mu_v, float ckk, float cka, float crk) {
    const bf16_t* PR = (const bf16_t*)(a.ws + WS_PR); const bf16_t* LOUT = (const bf16_t*)(a.ws + WS_LOUT); float* BON = (float*)(a.ws + WS_BON);
#pragma unroll
    for (int i = 0; i < RB / 4; ++i) {
        const int s = p * (RB / 4) + i; const int tok = tok0 + s; const bool has_prev = (tok & (SEQ - 1)) != 0;
        const bf16_t* prow = PR + (size_t)tok * RW + h * 64 + lane; const bf16_t* qrow = has_prev ? prow - RW : prow;
        const bf16_t* lrow = LOUT + (size_t)tok * 1536 + h * 64 + lane;
        const float rr = bf1(prow[0]), kr = bf1(prow[512]), vr_ = bf1(prow[1024]);
        const float rp = has_prev ? bf1(qrow[0]) : 0.f, kp = has_prev ? bf1(qrow[512]) : 0.f, vp = has_prev ? bf1(qrow[1024]) : 0.f;
        const float e = bf1(lrow[0]), av = bf1(lrow[512]);
        const float r = rr + (rp - rr) * mu_r, k0 = kr + (kp - kr) * mu_k, v = vr_ + (vp - vr_) * mu_v;
        const float w = __expf(-e);
        const float kk = k0 * ckk; const float n2 = wave_allsum(kk * kk); const float kkn = kk / fmaxf(sqrtf(n2), 1e-12f);
        const float k2 = k0 * (1.0f + (av - 1.0f) * cka);
        const float bon = wave_allsum(r * k2 * crk);
        LAS float* pp = pb + s * PSTEP;
        pp[lane] = -kkn; pp[64 + lane] = kkn * av; pp[128 + lane] = k2; pp[192 + lane] = w; pp[256 + lane] = r; pp[320 + lane] = v;
        if (lane == 0) BON[(size_t)tok * 8 + h] = bon;
    }
}

__device__ __forceinline__ void phase_scan(const Args& a, LAS unsigned char* lds, int wave, int G) {
    const int lane = lane_id();
    unsigned char* ws = a.ws;
    constexpr int SB = 16, NBLK = SEQ / RB;
    for (int pair = blockIdx.x; pair < 256; pair += G) {
        const int b = pair >> 3, h = pair & 7, tokb = b * SEQ;
        const int il = lane & 15, irow = 16 * (wave & 3) + il;
        float S[16];
#pragma unroll
        for (int j = 0; j < 16; ++j) S[j] = 0.f;
        const float mu_r = a.in[I_MU][h * 64 + lane], mu_k = a.in[I_MU][512 + h * 64 + lane], mu_v = a.in[I_MU][1024 + h * 64 + lane];
        const float ckk = a.in[I_KK][h * 64 + lane], cka = a.in[I_KA][h * 64 + lane], crk = a.in[I_RK][h * 64 + lane];
        bf16_t* YRAW = (bf16_t*)(ws + WS_YRAW);
        const size_t base = (size_t)tokb * 512 + h * 64 + lane;
        const bf16_t* LA = (const bf16_t*)(ws + WS_RGLA) + base; const bf16_t* U = (const bf16_t*)(ws + WS_RGU) + base; const bf16_t* PY = (const bf16_t*)(ws + WS_PY) + base;
        bf16_t* YB = (bf16_t*)(ws + WS_YB) + base;
        bf16_t cla[SB], cu[SB], cpy[SB]; float hh = 0.f;
        if (wave == 4) {
#pragma unroll
            for (int s = 0; s < SB; ++s) { cla[s] = LA[(size_t)s * 512]; cu[s] = U[(size_t)s * 512]; cpy[s] = PY[(size_t)s * 512]; }
        } else {
#pragma unroll
            for (int s = 0; s < SB; ++s) { cla[s] = 0; cu[s] = 0; cpy[s] = 0; }
        }
        if (wave >= 4) rwkv_prep_block(a, (LAS float*)lds, tokb, h, wave - 4, lane, mu_r, mu_k, mu_v, ckk, cka, crk);
        lds_barrier();
        for (int blk = 0; blk < NBLK; ++blk) {
            if (wave < 4) {
                const LAS float* pb = (const LAS float*)(lds + (blk & 1) * PBUF);
#pragma unroll 2
                for (int s = 0; s < RB; ++s) {
                    const LAS float* pp = pb + s * PSTEP;
                    float va = pp[lane], vb = pp[64 + lane], vk = pp[128 + lane], vw = pp[192 + lane], vr = pp[256 + lane]; const float vv = pp[320 + irow];
                    asm volatile("s_nop 1" : "+v"(va), "+v"(vb), "+v"(vk), "+v"(vw), "+v"(vr));
                    float sacc[4] = {0.f, 0.f, 0.f, 0.f}, yacc[4] = {0.f, 0.f, 0.f, 0.f};
                    RW_ALL16(RW_SA)
                    float sa = (sacc[0] + sacc[1]) + (sacc[2] + sacc[3]);
                    sa = cross_row_allsum(sa);
                    RW_ALL16(RW_UPD)
                    float y = (yacc[0] + yacc[1]) + (yacc[2] + yacc[3]);
                    y = cross_row_allsum(y);
                    const int tok = tokb + blk * RB + s;
                    if (lane < 16) YRAW[(size_t)tok * 512 + h * 64 + irow] = f2bf(y);
                }
            } else {
                if (blk + 1 < NBLK) rwkv_prep_block(a, (LAS float*)(lds + ((blk + 1) & 1) * PBUF), tokb + (blk + 1) * RB, h, wave - 4, lane, mu_r, mu_k, mu_v, ckk, cka, crk);
                if (wave == 4) {
                    for (int sub = 0; sub < RB / SB; ++sub) {
                        const int t0 = blk * RB + sub * SB, tn = (t0 + SB < SEQ) ? t0 + SB : t0;
                        bf16_t nla[SB], nu[SB], npy[SB];
#pragma unroll
                        for (int s = 0; s < SB; ++s) { nla[s] = LA[(size_t)(tn + s) * 512]; nu[s] = U[(size_t)(tn + s) * 512]; npy[s] = PY[(size_t)(tn + s) * 512]; }
#pragma unroll
                        for (int s = 0; s < SB; ++s) { hh = __expf(bf1(cla[s])) * hh + bf1(cu[s]); YB[(size_t)(t0 + s) * 512] = f2bf(hh * gelu_tanh(bf1(cpy[s]))); }
#pragma unroll
                        for (int s = 0; s < SB; ++s) { cla[s] = nla[s]; cu[s] = nu[s]; cpy[s] = npy[s]; }
                    }
                }
            }
            lds_barrier();
        }
    }
    asm volatile("s_waitcnt vmcnt(0)" ::: "memory");
}

__device__ __forceinline__ void phase_post(const Args& a, int wave, int G) {
    unsigned char* ws = a.ws;
    const bf16_t* PR = (const bf16_t*)(ws + WS_PR); const bf16_t* LOUT = (const bf16_t*)(ws + WS_LOUT); const bf16_t* YRAW = (const bf16_t*)(ws + WS_YRAW);
    const float* BON = (const float*)(ws + WS_BON); bf16_t* YA = (bf16_t*)(ws + WS_YA);
    const float* mu = a.in[I_MU]; const float* lg = a.in[I_LNXG]; const float* lb = a.in[I_LNXB];
    const size_t gid = (size_t)blockIdx.x * 512 + wave * 64 + lane_id(), NT = (size_t)G * 512;
    for (size_t i = gid; i < (size_t)T * 64; i += NT) {
        const int t = (int)(i >> 6), c = (int)(i & 63) * 8, h = c >> 6, tl = t & (SEQ - 1);
        float y[8], v[8], vp[8], g[8], o[8];
        unpack8(*(const u32x4*)(YRAW + (size_t)t * 512 + c), y);
        unpack8(*(const u32x4*)(PR + (size_t)t * RW + 1024 + c), v);
        if (tl > 0) unpack8(*(const u32x4*)(PR + (size_t)(t - 1) * RW + 1024 + c), vp); else {
#pragma unroll
            for (int j = 0; j < 8; ++j) vp[j] = 0.f; }
        unpack8(*(const u32x4*)(LOUT + (size_t)t * 1536 + 1024 + c), g);
        float s = 0.f;
#pragma unroll
        for (int j = 0; j < 8; ++j) s += y[j];
        s += __shfl_xor(s, 1); s += __shfl_xor(s, 2); s += __shfl_xor(s, 4);
        const float mean = s * (1.0f / 64.0f); float q = 0.f;
#pragma unroll
        for (int j = 0; j < 8; ++j) { const float d = y[j] - mean; q += d * d; }
        q += __shfl_xor(q, 1); q += __shfl_xor(q, 2); q += __shfl_xor(q, 4);
        const float rs = rsqrtf(q * (1.0f / 64.0f) + LNX_EPS), bon = BON[(size_t)t * 8 + h];
#pragma unroll
        for (int j = 0; j < 8; ++j) { const float vv = v[j] + (vp[j] - v[j]) * mu[1024 + c + j];
            o[j] = ((y[j] - mean) * rs * lg[c + j] + lb[c + j] + bon * vv) * g[j]; }
        *(u32x4*)(YA + (size_t)t * 512 + c) = pack8(o);
    }
}

__device__ __forceinline__ void phase_ffnfix(const Args& a, int wave, int G) {
    unsigned char* ws = a.ws;
    const bf16_t* HG = (const bf16_t*)(ws + WS_HG); bf16_t* ACT = (bf16_t*)(ws + WS_UU);
    const float* cw = a.in[I_FCW]; const float* cb = a.in[I_FCB];
    const size_t gid = (size_t)blockIdx.x * 512 + wave * 64 + lane_id(), NT = (size_t)G * 512;
    constexpr int CPR = DFF / 8;
    for (size_t i = gid; i < (size_t)(T / 64) * 2 * CPR; i += NT) {
        const int c = (int)(i % CPR) * 8, rho = (int)((i / CPR) & 1), grp = (int)(i / (2 * CPR)); const int t = grp * 64 + rho; const bool first = (grp & 31) == 0;
        float p2[8], p1[8], cur[8], up[8], o[8];
#pragma unroll
        for (int j = 0; j < 8; ++j) { p2[j] = 0.f; p1[j] = 0.f; }
        if (rho == 0) { if (!first) { unpack8(*(const u32x4*)(HG + ((size_t)(grp - 1) * 4 + 0) * DFF + c), p2); unpack8(*(const u32x4*)(HG + ((size_t)(grp - 1) * 4 + 1) * DFF + c), p1); } }
        else { if (!first) unpack8(*(const u32x4*)(HG + ((size_t)(grp - 1) * 4 + 1) * DFF + c), p2); unpack8(*(const u32x4*)(HG + ((size_t)grp * 4 + 2) * DFF + c), p1); }
        unpack8(*(const u32x4*)(HG + ((size_t)grp * 4 + 2 + rho) * DFF + c), cur);
        unpack8(*(const u32x4*)(ACT + (size_t)t * DFF + c), up);
#pragma unroll
        for (int j = 0; j < 8; ++j) o[j] = gelu_tanh(cb[c + j] + cw[c + j] * p2[j] + cw[DFF + c + j] * p1[j] + cw[2 * DFF + c + j] * cur[j]) * up[j];
        *(u32x4*)(ACT + (size_t)t * DFF + c) = pack8(o);
    }
}

__device__ __forceinline__ void phase_final(const Args& a, int wave, int G) {
    const int lane = lane_id();
    const float* ssp = (const float*)(a.ws + WS_SSP3); const float* g = a.in[I_NFING];
    const int gw = blockIdx.x * 8 + wave, NGW = G * 8;
    for (int r0 = gw; r0 < T; r0 += 4 * NGW) {
        f32x4 v[4][4]; float rs[4];
#pragma unroll
        for (int q = 0; q < 4; ++q) { const int r = r0 + q * NGW; if (r < T) { rs[q] = rstd_from16(ssp, r); const f32x4* xr = (const f32x4*)(a.out + (size_t)r * D) + lane;
#pragma unroll
            for (int j = 0; j < 4; ++j) v[q][j] = xr[64 * j]; } }
#pragma unroll
        for (int q = 0; q < 4; ++q) { const int r = r0 + q * NGW; if (r < T) { f32x4* xr = (f32x4*)(a.out + (size_t)r * D) + lane;
#pragma unroll
            for (int j = 0; j < 4; ++j) { const f32x4 gg = ((const f32x4*)g)[lane + 64 * j]; xr[64 * j] = v[q][j] * rs[q] * gg; } } }
    }
}

constexpr int NPHASE = 13;
__global__ void __launch_bounds__(512, 2) mega(Args a) {
    extern __shared__ __attribute__((aligned(16))) unsigned char lds_raw[];
    LAS unsigned char* lds = (LAS unsigned char*)lds_raw;
    cg::grid_group grid = cg::this_grid();
    const int wave = __builtin_amdgcn_readfirstlane((int)threadIdx.x >> 6), G = gridDim.x, bid = blockIdx.x;
    unsigned char* ws = a.ws;
    const int lo = a.ph_lo, hi = a.ph_hi;
    const bool t0 = (wave == 0) && (lane_id() == 0);
    volatile LAS unsigned* misc = (volatile LAS unsigned*)(lds + 131072 + 320);
    if (t0) { misc[0] = 0u; misc[1] = 0u; }
    __syncthreads();
    XcdBarrier xb = xcd_barrier_post((unsigned*)(ws + WS_CTL), misc, t0);
#define IN(k) (lo <= (k) && (k) < hi)
#define SEAM(k) do { if (IN(k) && IN((k) + 1)) { if ((k) == 0) grid.sync(); else xcd_barrier(xb, t0); } } while (0)
    bf16_t* const XB = (bf16_t*)(ws + WS_XB);
    const float* rstdx = (const float*)(ws + WS_RSTDX);
    StaticOrder S;

    if (IN(0)) for (int rep_ = 0; rep_ < REPS(0); ++rep_) { phase_prep(a, lds, wave, G); __syncthreads(); } SEAM(0);

    if (IN(1)) for (int rep_ = 0; rep_ < REPS(1); ++rep_) {
        { Gemm g = plain_gemm(XB, (const bf16_t*)(ws + WS_WIN), 1024); S.init(T / BM, 11, G, bid);
          EpiProj E{rstdx, a.in[I_BIN], (bf16_t*)(ws + WS_PR), (bf16_t*)(ws + WS_PX), (bf16_t*)(ws + WS_PY)}; gemm_phase(lds, wave, g, S, E); }
        if ((G & 15) == 0) {
            const int hg = G >> 1, hb_ = (bid >> 4) * 8 + (bid & 7);
            if (((bid >> 3) & 1) == 0) { Gemm g = plain_gemm((const bf16_t*)(ws + WS_MEMN), (const bf16_t*)(ws + WS_WK), 1024); S.init(TM / BM, 4, hg, hb_);
                EpiPlain E{(bf16_t*)(ws + WS_KM), 1024}; gemm_phase(lds, wave, g, S, E); }
            else { Gemm g = plain_gemm((const bf16_t*)(ws + WS_WV), (const bf16_t*)(ws + WS_MEMN), 1024); S.init(4, TM / BM, hg, hb_);
                EpiPlain E{(bf16_t*)(ws + WS_VT), TM}; gemm_phase(lds, wave, g, S, E); }
        } else {
            { Gemm g = plain_gemm((const bf16_t*)(ws + WS_MEMN), (const bf16_t*)(ws + WS_WK), 1024); S.init(TM / BM, 4, G, bid);
              EpiPlain E{(bf16_t*)(ws + WS_KM), 1024}; gemm_phase(lds, wave, g, S, E); }
            { Gemm g = plain_gemm((const bf16_t*)(ws + WS_WV), (const bf16_t*)(ws + WS_MEMN), 1024); S.init(4, TM / BM, G, bid);
              EpiPlain E{(bf16_t*)(ws + WS_VT), TM}; gemm_phase(lds, wave, g, S, E); }
        }
    } SEAM(1);

    if (IN(2)) for (int rep_ = 0; rep_ < REPS(2); ++rep_) phase_elem2(a, wave, G); SEAM(2);
#ifdef PROBE_SYNC
    for (int i_ = 0; i_ < 16; ++i_) grid.sync();
#endif

    if (IN(3)) for (int rep_ = 0; rep_ < REPS(3); ++rep_) {
        { Gemm g = plain_gemm((const bf16_t*)(ws + WS_LIN), (const bf16_t*)(ws + WS_WLORA), 256); S.init(T / BM, 6, G, bid);
          EpiLora E{a.in[I_W0], a.in[I_A0], (bf16_t*)(ws + WS_LOUT)}; gemm_phase(lds, wave, g, S, E); }
        { Gemm g = plain_gemm((const bf16_t*)(ws + WS_XBC), (const bf16_t*)(ws + WS_WRG), 256); g.lda = 512; g.a_pm = (size_t)BM * 512 * 2; g.a_pn2 = 512; S.init(T / BM, 4, G, bid);
          EpiRg E{a.in[I_BRGA], a.in[I_BRGX], a.in[I_LAM], (const bf16_t*)(ws + WS_XBC), (bf16_t*)(ws + WS_RGLA), (bf16_t*)(ws + WS_RGU)}; gemm_phase(lds, wave, g, S, E); }
    } SEAM(3);

    if (IN(4)) for (int rep_ = 0; rep_ < REPS(4); ++rep_) phase_scan(a, lds, wave, G); SEAM(4);
    if (IN(5)) for (int rep_ = 0; rep_ < REPS(5); ++rep_) phase_post(a, wave, G); SEAM(5);

    if (IN(6)) for (int rep_ = 0; rep_ < REPS(6); ++rep_) {
        S.init(T / BM, 4, G, bid);
        { Gemm g = plain_gemm(XB, (const bf16_t*)(ws + WS_WIN) + (size_t)2816 * 1024, 1024); EpiGab E{rstdx, a.in[I_BIN] + 2816, (bf16_t*)(ws + WS_GAB), 0}; gemm_phase(lds, wave, g, S, E); }
        { Gemm g = plain_gemm((const bf16_t*)(ws + WS_YA), (const bf16_t*)(ws + WS_WA), 512); EpiBranch<true> E{(const bf16_t*)(ws + WS_GAB), (bf16_t*)(ws + WS_MERGED)}; gemm_phase(lds, wave, g, S, E); }
        { Gemm g = plain_gemm(XB, (const bf16_t*)(ws + WS_WIN) + (size_t)3840 * 1024, 1024); EpiGab E{rstdx, a.in[I_BIN] + 2816, (bf16_t*)(ws + WS_GAB), 1024}; gemm_phase(lds, wave, g, S, E); }
        { Gemm g = plain_gemm((const bf16_t*)(ws + WS_YB), (const bf16_t*)(ws + WS_WB), 512); EpiBranch<false> E{(const bf16_t*)(ws + WS_GAB), (bf16_t*)(ws + WS_MERGED)}; gemm_phase(lds, wave, g, S, E); }
    } SEAM(6);
    if (IN(7)) for (int rep_ = 0; rep_ < REPS(7); ++rep_) { Gemm g = plain_gemm((const bf16_t*)(ws + WS_MERGED), (const bf16_t*)(ws + WS_WMIX), 1024); S.init(T / BM, 4, G, bid);
        EpiRes<true> E{a.in[I_X], a.out, (bf16_t*)(ws + WS_X1B), (float*)(ws + WS_SSP1)}; gemm_phase(lds, wave, g, S, E); } SEAM(7);
    if (IN(8)) for (int rep_ = 0; rep_ < REPS(8); ++rep_) {
        S.init(T / BM, 4, G, bid);
        { Gemm g = plain_gemm((const bf16_t*)(ws + WS_X1B), (const bf16_t*)(ws + WS_WCQ), 1024);
          EpiQ E{(const float*)(ws + WS_SSP1), (bf16_t*)(ws + WS_Q)}; gemm_phase(lds, wave, g, S, E); }
        { Gemm g; g.A = (const bf16_t*)(ws + WS_Q); g.Bt = (const bf16_t*)(ws + WS_KM); g.lda = 1024; g.ldb = 1024; g.K = 256;
          g.a_pm = (size_t)BM * 1024 * 2; g.a_pn = 512; g.b_pn = 512; g.b_pb = (size_t)NMEM * 1024 * 2; g.a_pn2 = 0;
          EpiSc E{(bf16_t*)(ws + WS_PEXP), (float*)(ws + WS_SSPA)}; gemm_phase(lds, wave, g, S, E); }
        { Gemm g; g.A = (const bf16_t*)(ws + WS_PEXP); g.Bt = (const bf16_t*)(ws + WS_VT); g.lda = 1024; g.ldb = TM; g.K = 256;
          g.a_pm = (size_t)BM * 1024 * 2; g.a_pn = 512; g.b_pn = (size_t)256 * TM * 2; g.b_pb = 512; g.a_pn2 = 0;
          EpiPv E{(const float*)(ws + WS_SSPA), (bf16_t*)(ws + WS_O)}; gemm_phase(lds, wave, g, S, E); }
    } SEAM(8);
    if (IN(9)) for (int rep_ = 0; rep_ < REPS(9); ++rep_) { Gemm g = plain_gemm((const bf16_t*)(ws + WS_O), (const bf16_t*)(ws + WS_WCO), 1024); S.init(T / BM, 4, G, bid);
        EpiRes<true> E{a.out, a.out, (bf16_t*)(ws + WS_X2B), (float*)(ws + WS_SSP2)}; gemm_phase(lds, wave, g, S, E); } SEAM(9);
    if (IN(10)) for (int rep_ = 0; rep_ < REPS(10); ++rep_) { Gemm g = plain_gemm((const bf16_t*)(ws + WS_X2B), (const bf16_t*)(ws + WS_WFFI), 1024); S.init(T / BM, 22, G, bid);
        EpiFfnAct E{(const float*)(ws + WS_SSP2), a.in[I_FCW], a.in[I_FCB], (bf16_t*)(ws + WS_UU), (bf16_t*)(ws + WS_HG)}; gemm_phase(lds, wave, g, S, E); } SEAM(10);
    if (IN(11)) for (int rep_ = 0; rep_ < REPS(11); ++rep_) phase_ffnfix(a, wave, G); SEAM(11);
    if (IN(12)) for (int rep_ = 0; rep_ < REPS(12); ++rep_) { Gemm g = plain_gemm((const bf16_t*)(ws + WS_UU), (const bf16_t*)(ws + WS_WFFO), DFF); S.init(T / BM, 4, G, bid);
        EpiRes<false> E{a.out, a.out, nullptr, (float*)(ws + WS_SSP3)}; gemm_phase(lds, wave, g, S, E); } SEAM(12);
    if (IN(13)) for (int rep_ = 0; rep_ < REPS(13); ++rep_) phase_final(a, wave, G);
#undef IN
#undef SEAM
}

extern "C" void kernel_launch(void* const* d_in, const int* in_sizes, int n_in, void* d_out, int out_size, void* d_ws, size_t ws_size, hipStream_t stream) {
    static int grid = 0;
    if (grid == 0) {
        if (n_in != 37 || in_sizes[0] != T * D || out_size != T * D || ws_size < WS_END) {
            fprintf(stderr, "kernel_launch: unexpected shapes (n_in %d, in0 %d, out %d, ws %zu < %zu); nothing launched\n", n_in, n_in > 0 ? in_sizes[0] : -1, out_size, ws_size, (size_t)WS_END); grid = -1; return; }
        int dev = 0, cus = 0, per_cu = 0;
        if (hipGetDevice(&dev) != hipSuccess || hipDeviceGetAttribute(&cus, hipDeviceAttributeMultiprocessorCount, dev) != hipSuccess) { grid = -1; return; }
        if (hipFuncSetAttribute((const void*)mega, hipFuncAttributeMaxDynamicSharedMemorySize, LDS_BYTES) != hipSuccess) { fprintf(stderr, "kernel_launch: hipFuncSetAttribute failed\n"); grid = -1; return; }
        if (hipOccupancyMaxActiveBlocksPerMultiprocessor(&per_cu, (const void*)mega, 512, LDS_BYTES) != hipSuccess || per_cu < 1) { fprintf(stderr, "kernel_launch: occupancy query says %d\n", per_cu); per_cu = 1; }
        (void)hipGetLastError();
        grid = cus * 1;
    }
    if (grid < 0) return;
    if (hipMemsetAsync((char*)d_ws + WS_CTL, 0, CTL_BYTES, stream) != hipSuccess) { fprintf(stderr, "kernel_launch: memset failed\n"); return; }
    Args a{};
    for (int i = 0; i < 37; ++i) a.in[i] = (const float*)d_in[i];
    a.out = (float*)d_out; a.ws = (unsigned char*)d_ws;
#if MK_SPLIT
    for (int ph = 0; ph <= NPHASE; ++ph) {
        a.ph_lo = ph; a.ph_hi = ph + 1; void* args[] = {&a};
        hipError_t e = hipLaunchCooperativeKernel((const void*)mega, dim3(grid), dim3(512), args, LDS_BYTES, stream);
        if (e != hipSuccess) { fprintf(stderr, "kernel_launch: launch of phase %d failed: %s\n", ph, hipGetErrorString(e)); break; }
    }
#else
    a.ph_lo = 0; a.ph_hi = NPHASE + 1; void* args[] = {&a};
    hipError_t e = hipLaunchCooperativeKernel((const void*)mega, dim3(grid), dim3(512), args, LDS_BYTES, stream);
    if (e != hipSuccess) fprintf(stderr, "kernel_launch: cooperative launch failed: %s (grid %d)\n", hipGetErrorString(e), grid);
#endif
}
```

```cpp
#include <hip/hip_runtime.h>
#include <hip/hip_cooperative_groups.h>
#include <cstdio>
namespace cg = cooperative_groups;

#ifndef MK_SPLIT
#define MK_SPLIT 0
#endif

#ifndef DUP_PHASE
#define DUP_PHASE -1
#endif
#define REPS(k) ((DUP_PHASE == (k)) ? 2 : 1)
#define LAS __attribute__((address_space(3)))
typedef unsigned short bf16_t;
typedef short bf16x8 __attribute__((ext_vector_type(8)));
typedef float f32x4 __attribute__((ext_vector_type(4)));
typedef float f32x2 __attribute__((ext_vector_type(2)));
typedef unsigned u32x4 __attribute__((ext_vector_type(4)));
typedef unsigned u32x2 __attribute__((ext_vector_type(2)));

constexpr int T = 65536, D = 1024, SEQ = 2048, NB = 32, NMEM = 256, TM = NB * NMEM;
constexpr int AW = 512, RW = 1792, PIN = 4864, DFF = 2816;
constexpr float NORM_EPS = 1e-6f, LNX_EPS = 64e-5f;

constexpr size_t MiB = 1u << 20;
constexpr size_t WS_WIN = 0;
constexpr size_t WS_WFFI = 10 * MiB;
constexpr size_t WS_WFFO = 21 * MiB;
constexpr size_t WS_WMIX = 27 * MiB, WS_WCQ = 29 * MiB, WS_WK = 31 * MiB, WS_WV = 33 * MiB, WS_WCO = 35 * MiB;
constexpr size_t WS_WA = 37 * MiB, WS_WB = 38 * MiB;
constexpr size_t WS_WLORA = 39 * MiB;
constexpr size_t WS_WRG = 40 * MiB;
constexpr size_t WS_CTL = 46 * MiB, CTL_BYTES = 16384;
constexpr size_t WS_RSTDX = 48 * MiB;
constexpr size_t WS_SSP1 = 49 * MiB, WS_SSP2 = 53 * MiB, WS_SSP3 = 57 * MiB, WS_SSPA = 61 * MiB;
constexpr size_t WS_BON = 65 * MiB;
constexpr size_t WS_MEMN = 68 * MiB, WS_KM = 84 * MiB, WS_VT = 100 * MiB;
constexpr size_t WS_XB = 120 * MiB;
constexpr size_t WS_PR = 248 * MiB;
constexpr size_t WS_PX = 472 * MiB, WS_PY = 536 * MiB;
constexpr size_t WS_LIN = 600 * MiB, WS_XBC = 632 * MiB;
constexpr size_t WS_LOUT = 696 * MiB;
constexpr size_t WS_RGLA = 888 * MiB, WS_RGU = 952 * MiB;
constexpr size_t WS_YRAW = WS_PX, WS_YB = WS_LIN, WS_YA = WS_RGLA;
constexpr size_t WS_GAB = 248 * MiB;
constexpr size_t WS_MERGED = 696 * MiB;
constexpr size_t WS_X1B = WS_XB, WS_Q = 248 * MiB, WS_PEXP = 376 * MiB, WS_O = 504 * MiB, WS_X2B = WS_XB;
constexpr size_t WS_X3B = 376 * MiB;
constexpr size_t WS_HG = 248 * MiB, WS_UU = 600 * MiB;
constexpr size_t WS_END = 1016 * MiB;

constexpr int LDS_BYTES = 147456;

__device__ __forceinline__ unsigned cvt_pk_bf16(float lo, float hi) { unsigned r; asm("v_cvt_pk_bf16_f32 %0, %1, %2" : "=v"(r) : "v"(lo), "v"(hi)); return r; }
__device__ __forceinline__ float bf_lo(unsigned w) { return __uint_as_float(w << 16); }
__device__ __forceinline__ float bf_hi(unsigned w) { return __uint_as_float(w & 0xffff0000u); }
__device__ __forceinline__ float bf1(bf16_t b) { return __uint_as_float(((unsigned)b) << 16); }
__device__ __forceinline__ bf16_t f2bf(float f) { return (bf16_t)(cvt_pk_bf16(f, 0.f) & 0xffffu); }
__device__ __forceinline__ float sigmoidf_(float x) { return __builtin_amdgcn_rcpf(1.0f + __expf(-x)); }
__device__ __forceinline__ float gelu_tanh(float x) { const float z = 1.5957691216057308f * (x + 0.044715f * x * x * x); return x * sigmoidf_(z); }
__device__ __forceinline__ int lane_id() { int l; asm volatile("v_mbcnt_lo_u32_b32 %0, -1, 0\n\tv_mbcnt_hi_u32_b32 %0, -1, %0" : "=v"(l)); return l; }
__device__ __forceinline__ float wave_sum(float v) {
#pragma unroll
    for (int o = 1; o < 64; o <<= 1) v += __shfl_xor(v, o);
    return v;
}
__device__ __forceinline__ void unpack8(const u32x4 w, float (&f)[8]) {
    f[0] = bf_lo(w.x); f[1] = bf_hi(w.x); f[2] = bf_lo(w.y); f[3] = bf_hi(w.y); f[4] = bf_lo(w.z); f[5] = bf_hi(w.z); f[6] = bf_lo(w.w); f[7] = bf_hi(w.w);
}
__device__ __forceinline__ u32x4 pack8(const float (&f)[8]) {
    u32x4 w; w.x = cvt_pk_bf16(f[0], f[1]); w.y = cvt_pk_bf16(f[2], f[3]); w.z = cvt_pk_bf16(f[4], f[5]); w.w = cvt_pk_bf16(f[6], f[7]); return w;
}


#define XB_TMO      128
#define XB_XCNT(j)  (256  + 64 * (j))
#define XB_XSUB(j)  (1280 + 64 * (j))
#define XB_XGEN(j)  (2304 + 64 * (j))
#define XB_TOP      3328
#define XB_TOPGEN   3392
#define XCD_BAR_WORDS 3456
#define XB_SPIN_CAP (1u << 22)
__device__ __forceinline__ unsigned xb_ld(unsigned* p)              { return __hip_atomic_load(p, __ATOMIC_RELAXED, __HIP_MEMORY_SCOPE_AGENT); }
__device__ __forceinline__ unsigned xb_add(unsigned* p, unsigned v) { return __hip_atomic_fetch_add(p, v, __ATOMIC_RELAXED, __HIP_MEMORY_SCOPE_AGENT); }
__device__ __forceinline__ unsigned xb_xcc_id() { return (unsigned)__builtin_amdgcn_s_getreg((3 << 11) | 20) & 0xFu; }
#define XB_SPIN(cond, bar) do { unsigned _sp = 0; while (cond) { __builtin_amdgcn_s_sleep(1); \
    if ((++_sp & 255u) == 0u) { if (xb_ld(&(bar)[XB_TMO])) break; if (_sp > XB_SPIN_CAP) { atomicAdd(&(bar)[XB_TMO], 1u); break; } } } } while (0)
struct XcdBarrier { unsigned* bar; unsigned x; volatile LAS unsigned* st; };
__device__ __forceinline__ XcdBarrier xcd_barrier_post(unsigned* bar, volatile LAS unsigned* st, bool t0) {
    XcdBarrier b; b.bar = bar; b.x = xb_xcc_id(); b.st = st;
    if (t0) (void)xb_add(&bar[XB_XCNT(b.x)], 1u);
    return b;
}
__device__ __forceinline__ void xcd_barrier_complete(unsigned* bar, unsigned x, unsigned& nloc, unsigned& nx) {
    const unsigned G = gridDim.x * gridDim.y * gridDim.z;
    unsigned sum, cnt, mine, sp = 0u;
    for (;;) {
        sum = 0u; cnt = 0u; mine = 0u;
#pragma unroll
        for (unsigned j = 0; j < 16; ++j) { const unsigned c = xb_ld(&bar[XB_XCNT(j)]); sum += c; cnt += (c > 0u) ? 1u : 0u; mine = (j == x) ? c : mine; }
        if (sum == G) break;
        __builtin_amdgcn_s_sleep(1);
        if ((++sp & 255u) == 0u) { if (xb_ld(&bar[XB_TMO])) break; if (sp > XB_SPIN_CAP) { atomicAdd(&bar[XB_TMO], 1u); break; } }
    }
    nloc = mine > 0u ? mine : 1u; nx = cnt > 0u ? cnt : 1u;
}
__device__ __forceinline__ void xcd_barrier(const XcdBarrier& b, bool t0) {
    asm volatile("s_waitcnt vmcnt(0)" ::: "memory");
    __syncthreads();
    if (t0) {
        unsigned* bar = b.bar;
        __builtin_amdgcn_s_waitcnt(0);
        unsigned nloc = b.st[0], nx = b.st[1];
        if (nloc == 0u) { xcd_barrier_complete(bar, b.x, nloc, nx); b.st[0] = nloc; b.st[1] = nx; }
        const unsigned old = xb_add(&bar[XB_XSUB(b.x)], 1u);
        const unsigned gen = old / nloc;
        if (old + 1u == (gen + 1u) * nloc) {
            __builtin_amdgcn_fence(__ATOMIC_RELEASE, "agent");
            asm volatile("s_waitcnt vmcnt(0)" ::: "memory");
            const unsigned og = xb_add(&bar[XB_TOP], 1u);
            const unsigned tg = og / nx;
            if (og + 1u == (tg + 1u) * nx) xb_add(&bar[XB_TOPGEN], 1u);
            else XB_SPIN(xb_ld(&bar[XB_TOPGEN]) == tg, bar);
            __builtin_amdgcn_fence(__ATOMIC_ACQUIRE, "agent");
            xb_add(&bar[XB_XGEN(b.x)], 1u);
            asm volatile("s_waitcnt vmcnt(0)" ::: "memory");
        } else {
            XB_SPIN(xb_ld(&bar[XB_XGEN(b.x)]) == gen, bar);
            __builtin_amdgcn_fence(__ATOMIC_ACQUIRE, "agent");
            asm volatile("s_waitcnt vmcnt(0)" ::: "memory");
        }
    }
    __syncthreads();
}

constexpr int BM = 256, BK = 64, HALF = 128, HTB = HALF * BK * 2, NXCD = 8, WGM = 8;
__device__ __forceinline__ int lds_byte(int r, int c) { const int st = (r >> 4) * 2 + (c >> 5), rr = r & 15, cc = c & 31, ob = rr * 64 + cc * 2; return st * 1024 + (ob ^ (((ob >> 9) & 1) << 5)); }
__device__ __forceinline__ void stage_rc(int b, int& R, int& C) { const int st = b / 1024, sb = b % 1024, swz = sb ^ (((sb >> 9) & 1) << 5); R = (st >> 1) * 16 + swz / 64; C = (st & 1) * 32 + (swz % 64) / 2; }
__device__ __forceinline__ int perm32(int rho) { const int n = rho >> 4, i = rho & 15; return 8 * (i >> 2) + 4 * n + (i & 3); }

struct Unit { int pm, pn; };
struct Gemm { const bf16_t* A; const bf16_t* Bt; int lda, ldb, K; size_t a_pm, a_pn, b_pn, b_pb, a_pn2; };
__device__ __forceinline__ Gemm plain_gemm(const bf16_t* A, const bf16_t* Bt, int K) { Gemm g; g.A = A; g.Bt = Bt; g.lda = K; g.ldb = K; g.K = K; g.a_pm = (size_t)BM * K * 2; g.a_pn = 0; g.b_pn = (size_t)BM * K * 2; g.b_pb = 0; g.a_pn2 = 0; return g; }

struct StaticOrder {
    int nM, nN, nwg, G, c;
    __device__ void init(int nM_, int nN_, int G_, int c_) { nM = nM_; nN = nN_; nwg = nM * nN; G = G_; c = c_; }
    __device__ bool next(int i, Unit& u) const {
        const long L = (long)i * G + c; if (L >= nwg) return false;
        int wgid = (int)L; { const int q = nwg / NXCD, r = nwg % NXCD, xcd = wgid % NXCD, off = wgid / NXCD; wgid = (xcd < r ? xcd * (q + 1) : r * (q + 1) + (xcd - r) * q) + off; }
        const int nig = WGM * nN, gid = wgid / nig, fm = gid * WGM, gsz = (nM - fm) < WGM ? (nM - fm) : WGM;
        u.pm = fm + ((wgid % nig) % gsz); u.pn = (wgid % nig) / gsz; return true;
    }
};

typedef f32x4 Acc[2][2][4][2];

template <class Epi>
__device__ __forceinline__ void gemm_phase(LAS unsigned char* lds, const int wid, const Gemm g, const StaticOrder& S, const Epi& E) {
    const int lane = lane_id(), tid = wid * 64 + lane, wr = wid >> 2, wc = wid & 3, fr = lane & 15, fq = lane >> 4;
    const int nt = g.K / BK;
    unsigned voffA[2], voffB[2];
#pragma unroll
    for (int i = 0; i < 2; ++i) { int R, C; stage_rc(tid * 16 + i * 8192, R, C); const int Rb = Epi::PERM ? ((R & ~31) + perm32(R & 31)) : R;
        voffA[i] = (unsigned)(R * g.lda + C) * 2u; voffB[i] = (unsigned)(Rb * g.ldb + C) * 2u; }
    const size_t kstep = (size_t)(BK * 2);
    const size_t hstepA = (size_t)HALF * g.lda * 2, hstepB = (size_t)HALF * g.ldb * 2;
    const unsigned ldsw = (unsigned)wid * 1024u;
    const int aoff = lds_byte(wr * 64 + fr, fq * 8), boff = lds_byte(wc * 32 + fr, fq * 8);
#define PG8_SA(b, h) (((b) * 2 + (h)) * HTB)
#define PG8_SB(b, h) ((4 + (b) * 2 + (h)) * HTB)
#define PG8_STAGE(bufoff, gbase, voff) do { _Pragma("unroll") for (int _i = 0; _i < 2; ++_i) \
        __builtin_amdgcn_global_load_lds((const unsigned*)((const char*)(gbase) + (voff)[_i]), (LAS unsigned*)(lds + (bufoff) + ldsw + _i * 8192), 16, 0, 0); } while (0)
#define PG8_LDA(dst, b, h) do { _Pragma("unroll") for (int m = 0; m < 4; ++m) _Pragma("unroll") for (int k = 0; k < 2; ++k) dst[m][k] = *(const LAS bf16x8*)(lds + PG8_SA(b, h) + aoff + m * 2048 + k * 1024); } while (0)
#define PG8_LDB(dst, b, h) do { _Pragma("unroll") for (int n = 0; n < 2; ++n) _Pragma("unroll") for (int k = 0; k < 2; ++k) dst[n][k] = *(const LAS bf16x8*)(lds + PG8_SB(b, h) + boff + n * 2048 + k * 1024); } while (0)
#define PG8_MMA(ai, bj, At, Bt) do { __builtin_amdgcn_s_setprio(1); _Pragma("unroll") for (int m = 0; m < 4; ++m) _Pragma("unroll") for (int n = 0; n < 2; ++n) _Pragma("unroll") for (int k = 0; k < 2; ++k) \
        acc[ai][bj][m][n] = __builtin_amdgcn_mfma_f32_16x16x32_bf16(Bt[n][k], At[m][k], acc[ai][bj][m][n], 0, 0, 0); __builtin_amdgcn_s_setprio(0); } while (0)
#define PG8_WAIT_V(n) asm volatile("s_waitcnt vmcnt(" #n ")" ::: "memory")
#define PG8_WAIT_L(n) asm volatile("s_waitcnt lgkmcnt(" #n ")" ::: "memory")
#define PG8_BAR __builtin_amdgcn_s_barrier()
#define PG8_SCHED __builtin_amdgcn_sched_barrier(0)
#define PG8_UA(u) ((const char*)g.A + (size_t)(u).pm * g.a_pm + (size_t)(u).pn * g.a_pn + (size_t)((u).pn >> 1) * g.a_pn2)
#define PG8_UB(u) ((const char*)g.Bt + (size_t)(u).pn * g.b_pn + (size_t)((u).pm >> 3) * g.b_pb)
    Unit cur, nxt; int ui = 0;
    if (!S.next(0, cur)) return;
    Acc acc;
#pragma unroll
    for (int a = 0; a < 2; ++a)
#pragma unroll
        for (int b = 0; b < 2; ++b)
#pragma unroll
            for (int m = 0; m < 4; ++m)
#pragma unroll
                for (int n = 0; n < 2; ++n) acc[a][b][m][n] = (f32x4){0.f, 0.f, 0.f, 0.f};
    bf16x8 At[4][2], B0[2][2], B1[2][2];
    const char* cA = PG8_UA(cur); const char* cB = PG8_UB(cur);
    PG8_STAGE(PG8_SB(0, 0), cB, voffB); PG8_STAGE(PG8_SB(0, 1), cB + hstepB, voffB); PG8_STAGE(PG8_SA(0, 0), cA, voffA); PG8_STAGE(PG8_SA(0, 1), cA + hstepA, voffA);
    if (wr == 1) PG8_BAR;
    PG8_WAIT_V(2); PG8_BAR;
    PG8_STAGE(PG8_SB(1, 0), cB + kstep, voffB); PG8_STAGE(PG8_SA(1, 0), cA + kstep, voffA); PG8_STAGE(PG8_SB(1, 1), cB + hstepB + kstep, voffB);
    PG8_WAIT_V(6); PG8_BAR;
    for (;;) {
        const bool has_next = S.next(ui + 1, nxt);
        const char* nA = has_next ? PG8_UA(nxt) : cA; const char* nB = has_next ? PG8_UB(nxt) : cB;
        for (int t = 0; t < nt; t += 2) {
            const bool last = (t == nt - 2);
            const char* a1 = cA + (size_t)(t + 1) * kstep;
            const char* a2 = last ? nA : cA + (size_t)(t + 2) * kstep; const char* b2 = last ? nB : cB + (size_t)(t + 2) * kstep;
            const char* a3 = a2 + kstep; const char* b3 = b2 + kstep;
            PG8_LDB(B0, 0, 0); PG8_LDB(B1, 0, 1); PG8_SCHED; PG8_LDA(At, 0, 0); PG8_STAGE(PG8_SA(1, 1), a1 + hstepA, voffA);
            PG8_WAIT_V(8); PG8_WAIT_L(0); PG8_BAR; PG8_MMA(0, 0, At, B0); PG8_MMA(0, 1, At, B1); PG8_BAR; PG8_SCHED;
            PG8_LDA(At, 0, 1); PG8_STAGE(PG8_SB(0, 0), b2, voffB); PG8_STAGE(PG8_SB(0, 1), b2 + hstepB, voffB); PG8_STAGE(PG8_SA(0, 0), a2, voffA);
            PG8_WAIT_V(8); PG8_WAIT_L(0); PG8_BAR; PG8_MMA(1, 0, At, B0); PG8_MMA(1, 1, At, B1); PG8_BAR; PG8_SCHED;
            PG8_LDB(B0, 1, 0); PG8_LDB(B1, 1, 1); PG8_SCHED; PG8_LDA(At, 1, 0); PG8_STAGE(PG8_SA(0, 1), a2 + hstepA, voffA);
            PG8_WAIT_V(8); PG8_WAIT_L(0); PG8_BAR; PG8_MMA(0, 0, At, B0); PG8_MMA(0, 1, At, B1); PG8_BAR; PG8_SCHED;
            PG8_LDA(At, 1, 1); PG8_STAGE(PG8_SB(1, 0), b3, voffB); PG8_STAGE(PG8_SB(1, 1), b3 + hstepB, voffB); PG8_STAGE(PG8_SA(1, 0), a3, voffA);
            PG8_WAIT_V(8); PG8_WAIT_L(0); PG8_BAR; PG8_MMA(1, 0, At, B0); PG8_MMA(1, 1, At, B1); PG8_BAR; PG8_SCHED;
        }
        if (wr == 0) PG8_BAR;
        E(acc, cur, wr, wc, fr, fq);
        if (!has_next) break;
#pragma unroll
        for (int a = 0; a < 2; ++a)
#pragma unroll
            for (int b = 0; b < 2; ++b)
#pragma unroll
                for (int m = 0; m < 4; ++m)
#pragma unroll
                    for (int n = 0; n < 2; ++n) acc[a][b][m][n] = (f32x4){0.f, 0.f, 0.f, 0.f};
        cur = nxt; cA = nA; cB = nB; ++ui;
        if (wr == 1) PG8_BAR;
    }
    PG8_WAIT_V(0);
    PG8_BAR;
#undef PG8_SA
#undef PG8_SB
#undef PG8_STAGE
#undef PG8_LDA
#undef PG8_LDB
#undef PG8_MMA
#undef PG8_WAIT_V
#undef PG8_WAIT_L
#undef PG8_BAR
#undef PG8_SCHED
#undef PG8_UA
#undef PG8_UB
}

#define EPI_ROWS_BEGIN for (int ai = 0; ai < 2; ++ai) { _Pragma("unroll") for (int m = 0; m < 4; ++m) { const int r = u.pm * BM + ai * HALF + wr * 64 + m * 16 + fr;
#define EPI_ROWS_END } }

__device__ __forceinline__ float rstd_from16(const float* ss, int r) { return rsqrtf(ss[r] * (1.0f / 1024.0f) + NORM_EPS); }

struct EpiProj { static constexpr bool PERM = true;
    const float* rstd; const float* bias; bf16_t* PR; bf16_t* PX; bf16_t* PY;
    __device__ __forceinline__ void operator()(Acc& acc, const Unit& u, int wr, int wc, int fr, int fq) const {
        bf16_t* base; int ld, colt;
        if (u.pn < 7) { base = PR; ld = RW; colt = u.pn * 256; } else if (u.pn < 9) { base = PX; ld = 512; colt = (u.pn - 7) * 256; } else { base = PY; ld = 512; colt = (u.pn - 9) * 256; }
        const int col0 = colt + wc * 32 + 8 * fq, bcol0 = u.pn * 256 + wc * 32 + 8 * fq;
        f32x4 bv[2][2];
#pragma unroll
        for (int bj = 0; bj < 2; ++bj)
#pragma unroll
            for (int n = 0; n < 2; ++n) bv[bj][n] = *(const f32x4*)(bias + bcol0 + bj * HALF + 4 * n);
#pragma unroll
        EPI_ROWS_BEGIN
            const float rs = rstd[r]; bf16_t* rowp = base + (size_t)r * ld + col0;
#pragma unroll
            for (int bj = 0; bj < 2; ++bj) { const f32x4 v0 = acc[ai][bj][m][0] * rs + bv[bj][0], v1 = acc[ai][bj][m][1] * rs + bv[bj][1];
                u32x4 w; w.x = cvt_pk_bf16(v0[0], v0[1]); w.y = cvt_pk_bf16(v0[2], v0[3]); w.z = cvt_pk_bf16(v1[0], v1[1]); w.w = cvt_pk_bf16(v1[2], v1[3]);
                *(u32x4*)(rowp + bj * HALF) = w; }
        EPI_ROWS_END
    }
};
struct EpiGab { static constexpr bool PERM = true;
    const float* rstd; const float* bias; bf16_t* O; int cofs;
    __device__ __forceinline__ void operator()(Acc& acc, const Unit& u, int wr, int wc, int fr, int fq) const {
        const int col0 = cofs + u.pn * 256 + wc * 32 + 8 * fq;
        f32x4 bv[2][2];
#pragma unroll
        for (int bj = 0; bj < 2; ++bj)
#pragma unroll
            for (int n = 0; n < 2; ++n) bv[bj][n] = *(const f32x4*)(bias + col0 + bj * HALF + 4 * n);
#pragma unroll
        EPI_ROWS_BEGIN
            const float rs = rstd[r]; bf16_t* rowp = O + (size_t)r * 2048 + col0;
#pragma unroll
            for (int bj = 0; bj < 2; ++bj) { f32x4 v0 = acc[ai][bj][m][0] * rs + bv[bj][0], v1 = acc[ai][bj][m][1] * rs + bv[bj][1];
#pragma unroll
                for (int j = 0; j < 4; ++j) { v0[j] = sigmoidf_(v0[j]); v1[j] = sigmoidf_(v1[j]); }
                u32x4 w; w.x = cvt_pk_bf16(v0[0], v0[1]); w.y = cvt_pk_bf16(v0[2], v0[3]); w.z = cvt_pk_bf16(v1[0], v1[1]); w.w = cvt_pk_bf16(v1[2], v1[3]);
                *(u32x4*)(rowp + bj * HALF) = w; }
        EPI_ROWS_END
    }
};
struct EpiPlain { static constexpr bool PERM = true;
    bf16_t* O; int ldc;
    __device__ __forceinline__ void operator()(Acc& acc, const Unit& u, int wr, int wc, int fr, int fq) const {
        const int col0 = u.pn * 256 + wc * 32 + 8 * fq;
#pragma unroll
        EPI_ROWS_BEGIN
            bf16_t* rowp = O + (size_t)r * ldc + col0;
#pragma unroll
            for (int bj = 0; bj < 2; ++bj) { const f32x4 v0 = acc[ai][bj][m][0], v1 = acc[ai][bj][m][1];
                u32x4 w; w.x = cvt_pk_bf16(v0[0], v0[1]); w.y = cvt_pk_bf16(v0[2], v0[3]); w.z = cvt_pk_bf16(v1[0], v1[1]); w.w = cvt_pk_bf16(v1[2], v1[3]);
                *(u32x4*)(rowp + bj * HALF) = w; }
        EPI_ROWS_END
    }
};
struct EpiLora { static constexpr bool PERM = true;
    const float* w0; const float* a0; bf16_t* O;
    __device__ __forceinline__ void operator()(Acc& acc, const Unit& u, int wr, int wc, int fr, int fq) const {
        const int kind = u.pn >> 1, ch0 = (u.pn & 1) * 256 + wc * 32 + 8 * fq, col0 = u.pn * 256 + wc * 32 + 8 * fq;
        const float* bsrc = kind == 0 ? w0 : a0;
        f32x4 bv[2][2];
#pragma unroll
        for (int bj = 0; bj < 2; ++bj)
#pragma unroll
            for (int n = 0; n < 2; ++n) bv[bj][n] = kind < 2 ? *(const f32x4*)(bsrc + ch0 + bj * HALF + 4 * n) : (f32x4){0.f, 0.f, 0.f, 0.f};
        const float sc = kind == 0 ? 0.6065306597126334f : 1.0f;
#pragma unroll
        EPI_ROWS_BEGIN
            bf16_t* rowp = O + (size_t)r * 1536 + col0;
#pragma unroll
            for (int bj = 0; bj < 2; ++bj) { f32x4 v0 = acc[ai][bj][m][0] + bv[bj][0], v1 = acc[ai][bj][m][1] + bv[bj][1];
                if (kind < 2) {
#pragma unroll
                    for (int j = 0; j < 4; ++j) { v0[j] = sc * sigmoidf_(v0[j]); v1[j] = sc * sigmoidf_(v1[j]); } }
                u32x4 w; w.x = cvt_pk_bf16(v0[0], v0[1]); w.y = cvt_pk_bf16(v0[2], v0[3]); w.z = cvt_pk_bf16(v1[0], v1[1]); w.w = cvt_pk_bf16(v1[2], v1[3]);
                *(u32x4*)(rowp + bj * HALF) = w; }
        EPI_ROWS_END
    }
};
struct EpiRg { static constexpr bool PERM = true;
    const float* ba; const float* bx; const float* lam; const bf16_t* XBC; bf16_t* LA; bf16_t* U;
    __device__ __forceinline__ void operator()(Acc& acc, const Unit& u, int wr, int wc, int fr, int fq) const {
        const int ch0 = u.pn * 128 + wc * 32 + 8 * fq;
        float vba[8], vbx[8], vls[8];
#pragma unroll
        for (int j = 0; j < 8; ++j) { vba[j] = ba[ch0 + j]; vbx[j] = bx[ch0 + j]; vls[j] = -8.0f * log1pf(__expf(-lam[ch0 + j])); }
#pragma unroll
        EPI_ROWS_BEGIN
            const bool first = (r & (SEQ - 1)) == 0;
            float xb[8]; unpack8(*(const u32x4*)(XBC + (size_t)r * 512 + ch0), xb);
            float la[8], uu[8];
#pragma unroll
            for (int j = 0; j < 8; ++j) { const float ga = sigmoidf_(acc[ai][0][m][j >> 2][j & 3] + vba[j]), gx = sigmoidf_(acc[ai][1][m][j >> 2][j & 3] + vbx[j]);
                la[j] = vls[j] * ga; const float a = __expf(la[j]); const float mult = first ? 1.0f : sqrtf(fmaxf(1.0f - a * a, 0.f)); uu[j] = xb[j] * gx * mult; }
            *(u32x4*)(LA + (size_t)r * 512 + ch0) = pack8(la); *(u32x4*)(U + (size_t)r * 512 + ch0) = pack8(uu);
        EPI_ROWS_END
    }
};
template <bool FIRST> struct EpiBranch { static constexpr bool PERM = true;
    const bf16_t* G; bf16_t* M;
    __device__ __forceinline__ void operator()(Acc& acc, const Unit& u, int wr, int wc, int fr, int fq) const {
        const int col0 = u.pn * 256 + wc * 32 + 8 * fq;
#pragma unroll
        EPI_ROWS_BEGIN
#pragma unroll
            for (int bj = 0; bj < 2; ++bj) { const int c = col0 + bj * HALF;
                float gv[8]; unpack8(*(const u32x4*)(G + (size_t)r * 2048 + (FIRST ? 0 : 1024) + c), gv);
                float o[8];
                if (!FIRST) unpack8(*(const u32x4*)(M + (size_t)r * 1024 + c), o);
#pragma unroll
                for (int j = 0; j < 8; ++j) { const float p = acc[ai][bj][m][j >> 2][j & 3] * gv[j]; o[j] = FIRST ? p : o[j] + p; }
                *(u32x4*)(M + (size_t)r * 1024 + c) = pack8(o); }
        EPI_ROWS_END
    }
};
template <bool BASE_F32> struct EpiRes { static constexpr bool PERM = true;
    const void* base; bf16_t* XB; float* ssp;
    __device__ __forceinline__ void operator()(Acc& acc, const Unit& u, int wr, int wc, int fr, int fq) const {
        const int col0 = u.pn * 256 + wc * 32 + 8 * fq;
#pragma unroll
        EPI_ROWS_BEGIN
            float s = 0.f;
#pragma unroll
            for (int bj = 0; bj < 2; ++bj) { const size_t off = (size_t)r * 1024 + col0 + bj * HALF; float o[8];
                if (BASE_F32) { const f32x4 b0 = *(const f32x4*)((const float*)base + off), b1 = *(const f32x4*)((const float*)base + off + 4);
                    o[0] = b0[0]; o[1] = b0[1]; o[2] = b0[2]; o[3] = b0[3]; o[4] = b1[0]; o[5] = b1[1]; o[6] = b1[2]; o[7] = b1[3]; }
                else unpack8(*(const u32x4*)((const bf16_t*)base + off), o);
#pragma unroll
                for (int j = 0; j < 8; ++j) { o[j] += acc[ai][bj][m][j >> 2][j & 3]; s += o[j] * o[j]; }
                *(u32x4*)(XB + off) = pack8(o); }
            s += __shfl_xor(s, 16); s += __shfl_xor(s, 32);
            if (fq == 0) atomicAdd(ssp + r, s);
        EPI_ROWS_END
    }
};
struct EpiQ { static constexpr bool PERM = true;
    const float* ssp; bf16_t* O;
    __device__ __forceinline__ void operator()(Acc& acc, const Unit& u, int wr, int wc, int fr, int fq) const {
        const int col0 = u.pn * 256 + wc * 32 + 8 * fq;
#pragma unroll
        EPI_ROWS_BEGIN
            const float rs = rstd_from16(ssp, r) * 0.0625f; bf16_t* rowp = O + (size_t)r * 1024 + col0;
#pragma unroll
            for (int bj = 0; bj < 2; ++bj) { const f32x4 v0 = acc[ai][bj][m][0] * rs, v1 = acc[ai][bj][m][1] * rs;
                u32x4 w; w.x = cvt_pk_bf16(v0[0], v0[1]); w.y = cvt_pk_bf16(v0[2], v0[3]); w.z = cvt_pk_bf16(v1[0], v1[1]); w.w = cvt_pk_bf16(v1[2], v1[3]);
                *(u32x4*)(rowp + bj * HALF) = w; }
        EPI_ROWS_END
    }
};
struct EpiSc { static constexpr bool PERM = true;
    bf16_t* O; float* ssp;
    __device__ __forceinline__ void operator()(Acc& acc, const Unit& u, int wr, int wc, int fr, int fq) const {
        const int col0 = u.pn * 256 + wc * 32 + 8 * fq;
#pragma unroll
        EPI_ROWS_BEGIN
            bf16_t* rowp = O + (size_t)r * 1024 + col0; float s = 0.f;
#pragma unroll
            for (int bj = 0; bj < 2; ++bj) { f32x4 v0 = acc[ai][bj][m][0], v1 = acc[ai][bj][m][1];
#pragma unroll
                for (int j = 0; j < 4; ++j) { v0[j] = __expf(v0[j]); v1[j] = __expf(v1[j]); }
                s += ((v0[0] + v0[1]) + (v0[2] + v0[3])) + ((v1[0] + v1[1]) + (v1[2] + v1[3]));
                u32x4 w; w.x = cvt_pk_bf16(v0[0], v0[1]); w.y = cvt_pk_bf16(v0[2], v0[3]); w.z = cvt_pk_bf16(v1[0], v1[1]); w.w = cvt_pk_bf16(v1[2], v1[3]);
                *(u32x4*)(rowp + bj * HALF) = w; }
            s += __shfl_xor(s, 16); s += __shfl_xor(s, 32);
            if (fq == 0) ssp[(size_t)r * 16 + u.pn * 4 + wc] = s;
        EPI_ROWS_END
    }
};
struct EpiPv { static constexpr bool PERM = true;
    const float* ssp; bf16_t* O;
    __device__ __forceinline__ void operator()(Acc& acc, const Unit& u, int wr, int wc, int fr, int fq) const {
        const int col0 = u.pn * 256 + wc * 32 + 8 * fq;
#pragma unroll
        EPI_ROWS_BEGIN
            const f32x4 sp = *(const f32x4*)(ssp + (size_t)r * 16 + u.pn * 4); const float rs = 1.0f / ((sp.x + sp.y) + (sp.z + sp.w));
            bf16_t* rowp = O + (size_t)r * 1024 + col0;
#pragma unroll
            for (int bj = 0; bj < 2; ++bj) { const f32x4 v0 = acc[ai][bj][m][0] * rs, v1 = acc[ai][bj][m][1] * rs;
                u32x4 w; w.x = cvt_pk_bf16(v0[0], v0[1]); w.y = cvt_pk_bf16(v0[2], v0[3]); w.z = cvt_pk_bf16(v1[0], v1[1]); w.w = cvt_pk_bf16(v1[2], v1[3]);
                *(u32x4*)(rowp + bj * HALF) = w; }
        EPI_ROWS_END
    }
};
__device__ __forceinline__ float dpp_ror1(float v) { return __int_as_float(__builtin_amdgcn_update_dpp(0, __float_as_int(v), 0x121, 0xf, 0xf, false)); }
__device__ __forceinline__ float dpp_ror2(float v) { return __int_as_float(__builtin_amdgcn_update_dpp(0, __float_as_int(v), 0x122, 0xf, 0xf, false)); }
struct EpiFfnAct { static constexpr bool PERM = true;
    const float* ssp; const float* cw; const float* cb; bf16_t* ACT; bf16_t* HG;
    __device__ __forceinline__ void operator()(Acc& acc, const Unit& u, int wr, int wc, int fr_, int fq_) const {
        const int l_ = lane_id(), fr = l_ & 15, fq = l_ >> 4;
        const int col0 = u.pn * 128 + wc * 32 + 8 * fq;
#pragma unroll
        for (int ai = 0; ai < 2; ++ai) {
            const int rbase = u.pm * BM + ai * HALF + wr * 64 + fr;
            float rs[4];
#pragma unroll
            for (int m = 0; m < 4; ++m) rs[m] = rstd_from16(ssp, rbase + m * 16);
            const size_t grp = (size_t)(rbase >> 6);
            if (fr < 2) { float t[8];
#pragma unroll
                for (int j = 0; j < 8; ++j) t[j] = acc[ai][0][0][j >> 2][j & 3] * rs[0];
                *(u32x4*)(HG + (grp * 4 + 2 + fr) * DFF + col0) = pack8(t); }
            if (fr >= 14) { float t[8];
#pragma unroll
                for (int j = 0; j < 8; ++j) t[j] = acc[ai][0][3][j >> 2][j & 3] * rs[3];
                *(u32x4*)(HG + (grp * 4 + (fr - 14)) * DFF + col0) = pack8(t); }
#pragma unroll
            for (int j = 0; j < 8; ++j) {
                const float w0 = cw[col0 + j], w1 = cw[DFF + col0 + j], w2 = cw[2 * DFF + col0 + j], b0 = cb[col0 + j];
                float g[4], r1[4], r2[4];
#pragma unroll
                for (int m = 0; m < 4; ++m) { g[m] = acc[ai][0][m][j >> 2][j & 3] * rs[m]; r1[m] = dpp_ror1(g[m]); r2[m] = dpp_ror2(g[m]); }
#pragma unroll
                for (int m = 0; m < 4; ++m) {
                    const float p1 = fr >= 1 ? r1[m] : r1[m > 0 ? m - 1 : 0], p2 = fr >= 2 ? r2[m] : r2[m > 0 ? m - 1 : 0];
                    const float up = acc[ai][1][m][j >> 2][j & 3] * rs[m];
                    const float gate = b0 + w0 * p2 + w1 * p1 + w2 * g[m];
                    acc[ai][1][m][j >> 2][j & 3] = (m == 0 && fr < 2) ? up : gelu_tanh(gate) * up;
                }
            }
#pragma unroll
            for (int m = 0; m < 4; ++m) { const f32x4 v0 = acc[ai][1][m][0], v1 = acc[ai][1][m][1];
                u32x4 w; w.x = cvt_pk_bf16(v0[0], v0[1]); w.y = cvt_pk_bf16(v0[2], v0[3]); w.z = cvt_pk_bf16(v1[0], v1[1]); w.w = cvt_pk_bf16(v1[2], v1[3]);
                *(u32x4*)(ACT + (size_t)(rbase + m * 16) * DFF + col0) = w; }
        }
    }
};

struct Args { const float* in[37]; float* out; unsigned char* ws; int ph_lo, ph_hi; };
enum { I_X = 0, I_MEM, I_NMIXG, I_WIN, I_BIN, I_MU, I_W0, I_WUP, I_A0, I_AUP, I_GUP, I_KK, I_KA, I_RK, I_LNXG, I_LNXB, I_WBA, I_CBW, I_CBB, I_WRGA, I_BRGA, I_WRGX, I_BRGX,
       I_LAM, I_WBB, I_WMIX, I_NXG, I_NMEMG, I_WCQ, I_WCKV, I_WCO, I_NFFNG, I_WFFI, I_FCW, I_FCB, I_WFFO, I_NFING };

__device__ __forceinline__ void transpose_item(const float* W, int ldw, int K, bf16_t* WT, int ldd, const float* gain, int map, int srcofs, LAS float* scr, int item, int lane) {
    const int nkb = K / 64, nb = item / nkb, kb = item % nkb, k0 = 64 * kb, n0 = 32 * nb;
    int ns = n0 + srcofs;
    if (map == 1) { const int tile = n0 >> 8, c = n0 & 255; ns = c < 128 ? tile * 128 + c : DFF + tile * 128 + (c - 128); }
#pragma unroll 8
    for (int i = 0; i < 32; ++i) { const int kk = 2 * i + (lane >> 5); float v = W[(size_t)(k0 + kk) * ldw + ns + (lane & 31)]; if (gain) v *= gain[k0 + kk]; scr[kk * 33 + (lane & 31)] = v; }
    asm volatile("s_waitcnt lgkmcnt(0)" ::: "memory");
    const int c = lane & 7;
#pragma unroll
    for (int j = 0; j < 4; ++j) { const int n = (lane >> 3) + 8 * j; const LAS float* s = scr + (8 * c) * 33 + n;
        u32x4 o; o.x = cvt_pk_bf16(s[0 * 33], s[1 * 33]); o.y = cvt_pk_bf16(s[2 * 33], s[3 * 33]); o.z = cvt_pk_bf16(s[4 * 33], s[5 * 33]); o.w = cvt_pk_bf16(s[6 * 33], s[7 * 33]);
        *(u32x4*)(WT + (size_t)(n0 + n) * ldd + k0 + 8 * c) = o; }
    asm volatile("s_waitcnt lgkmcnt(0)" ::: "memory");
}

__device__ __forceinline__ void phase_prep(const Args& a, LAS unsigned char* lds, int wave, int G) {
    const int lane = lane_id();
    unsigned char* ws = a.ws;
    LAS float* scr = (LAS float*)(lds + wave * 16384);
    const int gw = blockIdx.x * 8 + wave, NGW = G * 8;
#define TJOB(W_, ldw_, K_, Nd_, dst_, gain_, map_, srcofs_) do { const int nitems = ((K_) / 64) * ((Nd_) / 32); \
        for (int it = gw; it < nitems; it += NGW) transpose_item((W_), (ldw_), (K_), (bf16_t*)(ws + (dst_)), (K_), (gain_), (map_), (srcofs_), scr, it, lane); } while (0)
    TJOB(a.in[I_WIN], PIN, 1024, PIN, WS_WIN, a.in[I_NMIXG], 0, 0);
    TJOB(a.in[I_WBA], 1024, 512, 1024, WS_WA, nullptr, 0, 0);
    TJOB(a.in[I_WBB], 1024, 512, 1024, WS_WB, nullptr, 0, 0);
    TJOB(a.in[I_WMIX], 1024, 1024, 1024, WS_WMIX, nullptr, 0, 0);
    TJOB(a.in[I_WCQ], 1024, 1024, 1024, WS_WCQ, a.in[I_NXG], 0, 0);
    TJOB(a.in[I_WCKV], 2048, 1024, 1024, WS_WK, nullptr, 0, 0);
    TJOB(a.in[I_WCKV], 2048, 1024, 1024, WS_WV, nullptr, 0, 1024);
    TJOB(a.in[I_WCO], 1024, 1024, 1024, WS_WCO, nullptr, 0, 0);
    TJOB(a.in[I_WFFI], 2 * DFF, 1024, 2 * DFF, WS_WFFI, a.in[I_NFFNG], 1, 0);
    TJOB(a.in[I_WFFO], 1024, DFF, 1024, WS_WFFO, nullptr, 0, 0);
#undef TJOB
    { float* z1 = (float*)(ws + WS_SSP1); float* z2 = (float*)(ws + WS_SSP2); float* z3 = (float*)(ws + WS_SSP3);
      for (int i = blockIdx.x * 512 + wave * 64 + lane; i < T; i += G * 512) { z1[i] = 0.f; z2[i] = 0.f; z3[i] = 0.f; } }
    const int gid = blockIdx.x * 512 + wave * 64 + lane, NT = G * 512;
    { bf16_t* WL = (bf16_t*)(ws + WS_WLORA);
      for (int i = gid; i < 1536 * 256; i += NT) { const int n = i >> 8, k = i & 255, kind = n >> 9, c = n & 511; float v = 0.f;
          if (kind == 0 && k < 64) v = a.in[I_WUP][k * 512 + c]; else if (kind == 1 && k >= 64 && k < 128) v = a.in[I_AUP][(k - 64) * 512 + c]; else if (kind == 2 && k >= 128) v = a.in[I_GUP][(k - 128) * 512 + c];
          WL[i] = f2bf(v); } }
    { bf16_t* WR = (bf16_t*)(ws + WS_WRG);
      for (int i = gid; i < 1024 * 256; i += NT) { const int n = i >> 8, kk = i & 255, pn = n >> 8, c = n & 255, ch = pn * 128 + (c & 127), hb = ch >> 6, j = ch & 63, k = 256 * (pn >> 1) + kk; float v = 0.f;
          if ((k >> 6) == hb) v = (c < 128 ? a.in[I_WRGA] : a.in[I_WRGX])[(hb * 64 + (k & 63)) * 64 + j];
          WR[i] = f2bf(v); } }
    { const float* x = a.in[I_X]; bf16_t* XB = (bf16_t*)(ws + WS_XB); float* rstd = (float*)(ws + WS_RSTDX);
      for (int r0 = gw; r0 < T; r0 += 4 * NGW) {
          f32x4 v[4][4]; float s[4];
#pragma unroll
          for (int q = 0; q < 4; ++q) { const int r = r0 + q * NGW; s[q] = 0.f; if (r < T) { const f32x4* xr = (const f32x4*)(x + (size_t)r * D) + lane;
#pragma unroll
              for (int j = 0; j < 4; ++j) v[q][j] = xr[64 * j]; } else {
#pragma unroll
              for (int j = 0; j < 4; ++j) v[q][j] = (f32x4){0.f, 0.f, 0.f, 0.f}; } }
#pragma unroll
          for (int q = 0; q < 4; ++q) {
#pragma unroll
              for (int j = 0; j < 4; ++j) s[q] += (v[q][j].x * v[q][j].x + v[q][j].y * v[q][j].y) + (v[q][j].z * v[q][j].z + v[q][j].w * v[q][j].w);
              s[q] = wave_sum(s[q]); }
#pragma unroll
          for (int q = 0; q < 4; ++q) { const int r = r0 + q * NGW; if (r < T) { if (lane == 0) rstd[r] = rsqrtf(s[q] * (1.0f / D) + NORM_EPS);
              u32x2* o = (u32x2*)(XB + (size_t)r * D) + lane;
#pragma unroll
              for (int j = 0; j < 4; ++j) { u32x2 w; w.x = cvt_pk_bf16(v[q][j].x, v[q][j].y); w.y = cvt_pk_bf16(v[q][j].z, v[q][j].w); o[64 * j] = w; } } } } }
    { const float* x = a.in[I_MEM]; bf16_t* XB = (bf16_t*)(ws + WS_MEMN); const float* g = a.in[I_NMEMG];
      for (int r = gw; r < TM; r += NGW) { const f32x4* xr = (const f32x4*)(x + (size_t)r * D) + lane; f32x4 v[4]; float s = 0.f;
#pragma unroll
          for (int j = 0; j < 4; ++j) { v[j] = xr[64 * j]; s += (v[j].x * v[j].x + v[j].y * v[j].y) + (v[j].z * v[j].z + v[j].w * v[j].w); }
          s = wave_sum(s); const float rs = rsqrtf(s * (1.0f / D) + NORM_EPS);
          u32x2* o = (u32x2*)(XB + (size_t)r * D) + lane;
#pragma unroll
          for (int j = 0; j < 4; ++j) { const f32x4 gg = ((const f32x4*)g)[lane + 64 * j]; u32x2 w; w.x = cvt_pk_bf16(v[j].x * rs * gg.x, v[j].y * rs * gg.y); w.y = cvt_pk_bf16(v[j].z * rs * gg.z, v[j].w * rs * gg.w); o[64 * j] = w; } } }
}

__device__ __forceinline__ void phase_elem2(const Args& a, int wave, int G) {
    unsigned char* ws = a.ws;
    const bf16_t* PR = (const bf16_t*)(ws + WS_PR); const bf16_t* PX = (const bf16_t*)(ws + WS_PX);
    bf16_t* LIN = (bf16_t*)(ws + WS_LIN); bf16_t* XBC = (bf16_t*)(ws + WS_XBC);
    const float* mu = a.in[I_MU]; const float* cw = a.in[I_CBW]; const float* cb = a.in[I_CBB];
    const size_t gid = (size_t)blockIdx.x * 512 + wave * 64 + lane_id(), NT = (size_t)G * 512;
    for (size_t i = gid; i < (size_t)T * 96; i += NT) {
        const int t = (int)(i / 96), q = (int)(i % 96), tl = t & (SEQ - 1);
        if (q < 32) { const int c = q * 8; float p[8], pp[8], o[8];
            unpack8(*(const u32x4*)(PR + (size_t)t * RW + 1536 + c), p);
            if (tl > 0) unpack8(*(const u32x4*)(PR + (size_t)(t - 1) * RW + 1536 + c), pp); else {
#pragma unroll
                for (int j = 0; j < 8; ++j) pp[j] = 0.f; }
#pragma unroll
            for (int j = 0; j < 8; ++j) { const float v = p[j] + (pp[j] - p[j]) * mu[1536 + c + j];
                o[j] = c < 64 ? tanhf(v) : (c < 128 ? v : sigmoidf_(v)); }
            *(u32x4*)(LIN + (size_t)t * 256 + c) = pack8(o);
        } else { const int c = (q - 32) * 8; float o[8];
#pragma unroll
            for (int j = 0; j < 8; ++j) o[j] = cb[c + j];
#pragma unroll
            for (int k = 0; k < 4; ++k) { const int dt = 3 - k; if (tl >= dt) { float p[8]; unpack8(*(const u32x4*)(PX + (size_t)(t - dt) * 512 + c), p);
#pragma unroll
                for (int j = 0; j < 8; ++j) o[j] += p[j] * cw[k * 512 + c + j]; } }
            *(u32x4*)(XBC + (size_t)t * 512 + c) = pack8(o);
        }
    }
}

#define DPP_BC(JJ) " row_newbcast:" #JJ " row_mask:0xf bank_mask:0xf"
#define RW_SA(JJ)  asm("v_fmac_f32_dpp %0, %1, %2" DPP_BC(JJ) : "+v"(sacc[JJ & 3]) : "v"(va), "v"(S[JJ]));
#define RW_UPD(JJ) { float t_; \
    asm("v_mul_f32_dpp %0, %1, %2" DPP_BC(JJ) : "=v"(t_) : "v"(vb), "v"(sa)); \
    asm("v_fmac_f32_dpp %0, %1, %2" DPP_BC(JJ) : "+v"(t_) : "v"(vk), "v"(vv)); \
    asm("v_fmac_f32_dpp %0, %1, %2" DPP_BC(JJ) : "+v"(t_) : "v"(vw), "v"(S[JJ])); \
    S[JJ] = t_; \
    asm("v_fmac_f32_dpp %0, %1, %2" DPP_BC(JJ) : "+v"(yacc[JJ & 3]) : "v"(vr), "v"(S[JJ])); }
#define RW_ALL16(M) M(0) M(1) M(2) M(3) M(4) M(5) M(6) M(7) M(8) M(9) M(10) M(11) M(12) M(13) M(14) M(15)

constexpr int RB = 32;
constexpr int PSTEP = 6 * 64;
constexpr int PBUF = RB * PSTEP * 4;

__device__ __forceinline__ float dpp_ror_add(float v, const int ctrl_sel) {
    int t;
    switch (ctrl_sel) {
        case 8: t = __builtin_amdgcn_update_dpp(0, __float_as_int(v), 0x128, 0xf, 0xf, false); break;
        case 4: t = __builtin_amdgcn_update_dpp(0, __float_as_int(v), 0x124, 0xf, 0xf, false); break;
        case 2: t = __builtin_amdgcn_update_dpp(0, __float_as_int(v), 0x122, 0xf, 0xf, false); break;
        default: t = __builtin_amdgcn_update_dpp(0, __float_as_int(v), 0x121, 0xf, 0xf, false); break;
    }
    return v + __int_as_float(t);
}
__device__ __forceinline__ float cross_row_allsum(float v) {
    auto r = __builtin_amdgcn_permlane32_swap(__float_as_uint(v), __float_as_uint(v), false, false);
    v = __uint_as_float(r[0]) + __uint_as_float(r[1]);
    auto r2 = __builtin_amdgcn_permlane16_swap(__float_as_uint(v), __float_as_uint(v), false, false);
    return __uint_as_float(r2[0]) + __uint_as_float(r2[1]);
}
__device__ __forceinline__ float wave_allsum(float v) {
    v = dpp_ror_add(v, 8); v = dpp_ror_add(v, 4); v = dpp_ror_add(v, 2); v = dpp_ror_add(v, 1);
    return cross_row_allsum(v);
}
__device__ __forceinline__ void lds_barrier() { asm volatile("s_waitcnt lgkmcnt(0)" ::: "memory"); __builtin_amdgcn_s_barrier(); asm volatile("" ::: "memory"); }

__device__ __forceinline__ void rwkv_prep_block(const Args& a, LAS float* pb, int tok0, int h, int p, int lane, float mu_r, float mu_k, float mu_v, float ckk, float cka, float crk) {
    const bf16_t* PR = (const bf16_t*)(a.ws + WS_PR); const bf16_t* LOUT = (const bf16_t*)(a.ws + WS_LOUT); float* BON = (float*)(a.ws + WS_BON);
#pragma unroll
    for (int i = 0; i < RB / 4; ++i) {
        const int s = p * (RB / 4) + i; const int tok = tok0 + s; const bool has_prev = (tok & (SEQ - 1)) != 0;
        const bf16_t* prow = PR + (size_t)tok * RW + h * 64 + lane; const bf16_t* qrow = has_prev ? prow - RW : prow;
        const bf16_t* lrow = LOUT + (size_t)tok * 1536 + h * 64 + lane;
        const float rr = bf1(prow[0]), kr = bf1(prow[512]), vr_ = bf1(prow[1024]);
        const float rp = has_prev ? bf1(qrow[0]) : 0.f, kp = has_prev ? bf1(qrow[512]) : 0.f, vp = has_prev ? bf1(qrow[1024]) : 0.f;
        const float e = bf1(lrow[0]), av = bf1(lrow[512]);
        const float r = rr + (rp - rr) * mu_r, k0 = kr + (kp - kr) * mu_k, v = vr_ + (vp - vr_) * mu_v;
        const float w = __expf(-e);
        const float kk = k0 * ckk; const float n2 = wave_allsum(kk * kk); const float kkn = kk / fmaxf(sqrtf(n2), 1e-12f);
        const float k2 = k0 * (1.0f + (av - 1.0f) * cka);
        const float bon = wave_allsum(r * k2 * crk);
        LAS float* pp = pb + s * PSTEP;
        pp[lane] = -kkn; pp[64 + lane] = kkn * av; pp[128 + lane] = k2; pp[192 + lane] = w; pp[256 + lane] = r; pp[320 + lane] = v;
        if (lane == 0) BON[(size_t)tok * 8 + h] = bon;
    }
}

__device__ __forceinline__ void phase_scan(const Args& a, LAS unsigned char* lds, int wave, int G) {
    const int lane = lane_id();
    unsigned char* ws = a.ws;
    constexpr int SB = 16, NBLK = SEQ / RB;
    for (int pair = blockIdx.x; pair < 256; pair += G) {
        const int b = pair >> 3, h = pair & 7, tokb = b * SEQ;
        const int il = lane & 15, irow = 16 * (wave & 3) + il;
        float S[16];
#pragma unroll
        for (int j = 0; j < 16; ++j) S[j] = 0.f;
        const float mu_r = a.in[I_MU][h * 64 + lane], mu_k = a.in[I_MU][512 + h * 64 + lane], mu_v = a.in[I_MU][1024 + h * 64 + lane];
        const float ckk = a.in[I_KK][h * 64 + lane], cka = a.in[I_KA][h * 64 + lane], crk = a.in[I_RK][h * 64 + lane];
        bf16_t* YRAW = (bf16_t*)(ws + WS_YRAW);
        const size_t base = (size_t)tokb * 512 + h * 64 + lane;
        const bf16_t* LA = (const bf16_t*)(ws + WS_RGLA) + base; const bf16_t* U = (const bf16_t*)(ws + WS_RGU) + base; const bf16_t* PY = (const bf16_t*)(ws + WS_PY) + base;
        bf16_t* YB = (bf16_t*)(ws + WS_YB) + base;
        bf16_t cla[SB], cu[SB], cpy[SB]; float hh = 0.f;
        if (wave == 4) {
#pragma unroll
            for (int s = 0; s < SB; ++s) { cla[s] = LA[(size_t)s * 512]; cu[s] = U[(size_t)s * 512]; cpy[s] = PY[(size_t)s * 512]; }
        } else {
#pragma unroll
            for (int s = 0; s < SB; ++s) { cla[s] = 0; cu[s] = 0; cpy[s] = 0; }
        }
        if (wave >= 4) rwkv_prep_block(a, (LAS float*)lds, tokb, h, wave - 4, lane, mu_r, mu_k, mu_v, ckk, cka, crk);
        lds_barrier();
        for (int blk = 0; blk < NBLK; ++blk) {
            if (wave < 4) {
                const LAS float* pb = (const LAS float*)(lds + (blk & 1) * PBUF);
#pragma unroll 2
                for (int s = 0; s < RB; ++s) {
                    const LAS float* pp = pb + s * PSTEP;
                    float va = pp[lane], vb = pp[64 + lane], vk = pp[128 + lane], vw = pp[192 + lane], vr = pp[256 + lane]; const float vv = pp[320 + irow];
                    asm volatile("s_nop 1" : "+v"(va), "+v"(vb), "+v"(vk), "+v"(vw), "+v"(vr));
                    float sacc[4] = {0.f, 0.f, 0.f, 0.f}, yacc[4] = {0.f, 0.f, 0.f, 0.f};
                    RW_ALL16(RW_SA)
                    float sa = (sacc[0] + sacc[1]) + (sacc[2] + sacc[3]);
                    sa = cross_row_allsum(sa);
                    RW_ALL16(RW_UPD)
                    float y = (yacc[0] + yacc[1]) + (yacc[2] + yacc[3]);
                    y = cross_row_allsum(y);
                    const int tok = tokb + blk * RB + s;
                    if (lane < 16) YRAW[(size_t)tok * 512 + h * 64 + irow] = f2bf(y);
                }
            } else {
                if (blk + 1 < NBLK) rwkv_prep_block(a, (LAS float*)(lds + ((blk + 1) & 1) * PBUF), tokb + (blk + 1) * RB, h, wave - 4, lane, mu_r, mu_k, mu_v, ckk, cka, crk);
                if (wave == 4) {
                    for (int sub = 0; sub < RB / SB; ++sub) {
                        const int t0 = blk * RB + sub * SB, tn = (t0 + SB < SEQ) ? t0 + SB : t0;
                        bf16_t nla[SB], nu[SB], npy[SB];
#pragma unroll
                        for (int s = 0; s < SB; ++s) { nla[s] = LA[(size_t)(tn + s) * 512]; nu[s] = U[(size_t)(tn + s) * 512]; npy[s] = PY[(size_t)(tn + s) * 512]; }
#pragma unroll
                        for (int s = 0; s < SB; ++s) { hh = __expf(bf1(cla[s])) * hh + bf1(cu[s]); YB[(size_t)(t0 + s) * 512] = f2bf(hh * gelu_tanh(bf1(cpy[s]))); }
#pragma unroll
                        for (int s = 0; s < SB; ++s) { cla[s] = nla[s]; cu[s] = nu[s]; cpy[s] = npy[s]; }
                    }
                }
            }
            lds_barrier();
        }
    }
    asm volatile("s_waitcnt vmcnt(0)" ::: "memory");
}

__device__ __forceinline__ void phase_post(const Args& a, int wave, int G) {
    unsigned char* ws = a.ws;
    const bf16_t* PR = (const bf16_t*)(ws + WS_PR); const bf16_t* LOUT = (const bf16_t*)(ws + WS_LOUT); const bf16_t* YRAW = (const bf16_t*)(ws + WS_YRAW);
    const float* BON = (const float*)(ws + WS_BON); bf16_t* YA = (bf16_t*)(ws + WS_YA);
    const float* mu = a.in[I_MU]; const float* lg = a.in[I_LNXG]; const float* lb = a.in[I_LNXB];
    const size_t gid = (size_t)blockIdx.x * 512 + wave * 64 + lane_id(), NT = (size_t)G * 512;
    for (size_t i = gid; i < (size_t)T * 64; i += NT) {
        const int t = (int)(i >> 6), c = (int)(i & 63) * 8, h = c >> 6, tl = t & (SEQ - 1);
        float y[8], v[8], vp[8], g[8], o[8];
        unpack8(*(const u32x4*)(YRAW + (size_t)t * 512 + c), y);
        unpack8(*(const u32x4*)(PR + (size_t)t * RW + 1024 + c), v);
        if (tl > 0) unpack8(*(const u32x4*)(PR + (size_t)(t - 1) * RW + 1024 + c), vp); else {
#pragma unroll
            for (int j = 0; j < 8; ++j) vp[j] = 0.f; }
        unpack8(*(const u32x4*)(LOUT + (size_t)t * 1536 + 1024 + c), g);
        float s = 0.f;
#pragma unroll
        for (int j = 0; j < 8; ++j) s += y[j];
        s += __shfl_xor(s, 1); s += __shfl_xor(s, 2); s += __shfl_xor(s, 4);
        const float mean = s * (1.0f / 64.0f); float q = 0.f;
#pragma unroll
        for (int j = 0; j < 8; ++j) { const float d = y[j] - mean; q += d * d; }
        q += __shfl_xor(q, 1); q += __shfl_xor(q, 2); q += __shfl_xor(q, 4);
        const float rs = rsqrtf(q * (1.0f / 64.0f) + LNX_EPS), bon = BON[(size_t)t * 8 + h];
#pragma unroll
        for (int j = 0; j < 8; ++j) { const float vv = v[j] + (vp[j] - v[j]) * mu[1024 + c + j];
            o[j] = ((y[j] - mean) * rs * lg[c + j] + lb[c + j] + bon * vv) * g[j]; }
        *(u32x4*)(YA + (size_t)t * 512 + c) = pack8(o);
    }
}

__device__ __forceinline__ void phase_ffnfix(const Args& a, int wave, int G) {
    unsigned char* ws = a.ws;
    const bf16_t* HG = (const bf16_t*)(ws + WS_HG); bf16_t* ACT = (bf16_t*)(ws + WS_UU);
    const float* cw = a.in[I_FCW]; const float* cb = a.in[I_FCB];
    const size_t gid = (size_t)blockIdx.x * 512 + wave * 64 + lane_id(), NT = (size_t)G * 512;
    constexpr int CPR = DFF / 8;
    for (size_t i = gid; i < (size_t)(T / 64) * 2 * CPR; i += NT) {
        const int c = (int)(i % CPR) * 8, rho = (int)((i / CPR) & 1), grp = (int)(i / (2 * CPR)); const int t = grp * 64 + rho; const bool first = (grp & 31) == 0;
        float p2[8], p1[8], cur[8], up[8], o[8];
#pragma unroll
        for (int j = 0; j < 8; ++j) { p2[j] = 0.f; p1[j] = 0.f; }
        if (rho == 0) { if (!first) { unpack8(*(const u32x4*)(HG + ((size_t)(grp - 1) * 4 + 0) * DFF + c), p2); unpack8(*(const u32x4*)(HG + ((size_t)(grp - 1) * 4 + 1) * DFF + c), p1); } }
        else { if (!first) unpack8(*(const u32x4*)(HG + ((size_t)(grp - 1) * 4 + 1) * DFF + c), p2); unpack8(*(const u32x4*)(HG + ((size_t)grp * 4 + 2) * DFF + c), p1); }
        unpack8(*(const u32x4*)(HG + ((size_t)grp * 4 + 2 + rho) * DFF + c), cur);
        unpack8(*(const u32x4*)(ACT + (size_t)t * DFF + c), up);
#pragma unroll
        for (int j = 0; j < 8; ++j) o[j] = gelu_tanh(cb[c + j] + cw[c + j] * p2[j] + cw[DFF + c + j] * p1[j] + cw[2 * DFF + c + j] * cur[j]) * up[j];
        *(u32x4*)(ACT + (size_t)t * DFF + c) = pack8(o);
    }
}

__device__ __forceinline__ void phase_final(const Args& a, int wave, int G) {
    const int lane = lane_id();
    const float* ssp = (const float*)(a.ws + WS_SSP3); const float* g = a.in[I_NFING]; const bf16_t* X3 = (const bf16_t*)(a.ws + WS_X3B);
    const int gw = blockIdx.x * 8 + wave, NGW = G * 8;
    for (int r0 = gw; r0 < T; r0 += 4 * NGW) {
        u32x4 v[4][2]; float rs[4];
#pragma unroll
        for (int q = 0; q < 4; ++q) { const int r = r0 + q * NGW; if (r < T) { rs[q] = rstd_from16(ssp, r); const u32x4* xr = (const u32x4*)(X3 + (size_t)r * D) + lane; v[q][0] = xr[0]; v[q][1] = xr[64]; } }
#pragma unroll
        for (int q = 0; q < 4; ++q) { const int r = r0 + q * NGW; if (r < T) {
#pragma unroll
            for (int j = 0; j < 2; ++j) { float x[8]; unpack8(v[q][j], x); const int c = 512 * j + 8 * lane; const f32x4 g0 = *(const f32x4*)(g + c), g1 = *(const f32x4*)(g + c + 4);
                f32x4* o = (f32x4*)(a.out + (size_t)r * D + c);
                o[0] = (f32x4){x[0] * rs[q] * g0[0], x[1] * rs[q] * g0[1], x[2] * rs[q] * g0[2], x[3] * rs[q] * g0[3]};
                o[1] = (f32x4){x[4] * rs[q] * g1[0], x[5] * rs[q] * g1[1], x[6] * rs[q] * g1[2], x[7] * rs[q] * g1[3]}; } } }
    }
}

constexpr int NPHASE = 13;
__global__ void __launch_bounds__(512, 2) mega(Args a) {
    extern __shared__ __attribute__((aligned(16))) unsigned char lds_raw[];
    LAS unsigned char* lds = (LAS unsigned char*)lds_raw;
    cg::grid_group grid = cg::this_grid();
    const int wave = __builtin_amdgcn_readfirstlane((int)threadIdx.x >> 6), G = gridDim.x, bid = blockIdx.x;
    unsigned char* ws = a.ws;
    const int lo = a.ph_lo, hi = a.ph_hi;
    const bool t0 = (wave == 0) && (lane_id() == 0);
    volatile LAS unsigned* misc = (volatile LAS unsigned*)(lds + 131072 + 320);
    if (t0) { misc[0] = 0u; misc[1] = 0u; }
    __syncthreads();
    XcdBarrier xb = xcd_barrier_post((unsigned*)(ws + WS_CTL), misc, t0);
#define IN(k) (lo <= (k) && (k) < hi)
#define SEAM(k) do { if (IN(k) && IN((k) + 1)) { if ((k) == 0) grid.sync(); else xcd_barrier(xb, t0); } } while (0)
    bf16_t* const XB = (bf16_t*)(ws + WS_XB);
    const float* rstdx = (const float*)(ws + WS_RSTDX);
    StaticOrder S;

    if (IN(0)) for (int rep_ = 0; rep_ < REPS(0); ++rep_) { phase_prep(a, lds, wave, G); __syncthreads(); } SEAM(0);

    if (IN(1)) for (int rep_ = 0; rep_ < REPS(1); ++rep_) {
        { Gemm g = plain_gemm(XB, (const bf16_t*)(ws + WS_WIN), 1024); S.init(T / BM, 11, G, bid);
          EpiProj E{rstdx, a.in[I_BIN], (bf16_t*)(ws + WS_PR), (bf16_t*)(ws + WS_PX), (bf16_t*)(ws + WS_PY)}; gemm_phase(lds, wave, g, S, E); }
        if ((G & 15) == 0) {
            const int hg = G >> 1, hb_ = (bid >> 4) * 8 + (bid & 7);
            if (((bid >> 3) & 1) == 0) { Gemm g = plain_gemm((const bf16_t*)(ws + WS_MEMN), (const bf16_t*)(ws + WS_WK), 1024); S.init(TM / BM, 4, hg, hb_);
                EpiPlain E{(bf16_t*)(ws + WS_KM), 1024}; gemm_phase(lds, wave, g, S, E); }
            else { Gemm g = plain_gemm((const bf16_t*)(ws + WS_WV), (const bf16_t*)(ws + WS_MEMN), 1024); S.init(4, TM / BM, hg, hb_);
                EpiPlain E{(bf16_t*)(ws + WS_VT), TM}; gemm_phase(lds, wave, g, S, E); }
        } else {
            { Gemm g = plain_gemm((const bf16_t*)(ws + WS_MEMN), (const bf16_t*)(ws + WS_WK), 1024); S.init(TM / BM, 4, G, bid);
              EpiPlain E{(bf16_t*)(ws + WS_KM), 1024}; gemm_phase(lds, wave, g, S, E); }
            { Gemm g = plain_gemm((const bf16_t*)(ws + WS_WV), (const bf16_t*)(ws + WS_MEMN), 1024); S.init(4, TM / BM, G, bid);
              EpiPlain E{(bf16_t*)(ws + WS_VT), TM}; gemm_phase(lds, wave, g, S, E); }
        }
    } SEAM(1);

    if (IN(2)) for (int rep_ = 0; rep_ < REPS(2); ++rep_) phase_elem2(a, wave, G); SEAM(2);
#ifdef PROBE_SYNC
    for (int i_ = 0; i_ < 16; ++i_) grid.sync();
#endif

    if (IN(3)) for (int rep_ = 0; rep_ < REPS(3); ++rep_) {
        { Gemm g = plain_gemm((const bf16_t*)(ws + WS_LIN), (const bf16_t*)(ws + WS_WLORA), 256); S.init(T / BM, 6, G, bid);
          EpiLora E{a.in[I_W0], a.in[I_A0], (bf16_t*)(ws + WS_LOUT)}; gemm_phase(lds, wave, g, S, E); }
        { Gemm g = plain_gemm((const bf16_t*)(ws + WS_XBC), (const bf16_t*)(ws + WS_WRG), 256); g.lda = 512; g.a_pm = (size_t)BM * 512 * 2; g.a_pn2 = 512; S.init(T / BM, 4, G, bid);
          EpiRg E{a.in[I_BRGA], a.in[I_BRGX], a.in[I_LAM], (const bf16_t*)(ws + WS_XBC), (bf16_t*)(ws + WS_RGLA), (bf16_t*)(ws + WS_RGU)}; gemm_phase(lds, wave, g, S, E); }
    } SEAM(3);

    if (IN(4)) for (int rep_ = 0; rep_ < REPS(4); ++rep_) phase_scan(a, lds, wave, G); SEAM(4);
    if (IN(5)) for (int rep_ = 0; rep_ < REPS(5); ++rep_) phase_post(a, wave, G); SEAM(5);

    if (IN(6)) for (int rep_ = 0; rep_ < REPS(6); ++rep_) {
        S.init(T / BM, 4, G, bid);
        { Gemm g = plain_gemm(XB, (const bf16_t*)(ws + WS_WIN) + (size_t)2816 * 1024, 1024); EpiGab E{rstdx, a.in[I_BIN] + 2816, (bf16_t*)(ws + WS_GAB), 0}; gemm_phase(lds, wave, g, S, E); }
        { Gemm g = plain_gemm((const bf16_t*)(ws + WS_YA), (const bf16_t*)(ws + WS_WA), 512); EpiBranch<true> E{(const bf16_t*)(ws + WS_GAB), (bf16_t*)(ws + WS_MERGED)}; gemm_phase(lds, wave, g, S, E); }
        { Gemm g = plain_gemm(XB, (const bf16_t*)(ws + WS_WIN) + (size_t)3840 * 1024, 1024); EpiGab E{rstdx, a.in[I_BIN] + 2816, (bf16_t*)(ws + WS_GAB), 1024}; gemm_phase(lds, wave, g, S, E); }
        { Gemm g = plain_gemm((const bf16_t*)(ws + WS_YB), (const bf16_t*)(ws + WS_WB), 512); EpiBranch<false> E{(const bf16_t*)(ws + WS_GAB), (bf16_t*)(ws + WS_MERGED)}; gemm_phase(lds, wave, g, S, E); }
    } SEAM(6);
    if (IN(7)) for (int rep_ = 0; rep_ < REPS(7); ++rep_) { Gemm g = plain_gemm((const bf16_t*)(ws + WS_MERGED), (const bf16_t*)(ws + WS_WMIX), 1024); S.init(T / BM, 4, G, bid);
        EpiRes<true> E{a.in[I_X], (bf16_t*)(ws + WS_X1B), (float*)(ws + WS_SSP1)}; gemm_phase(lds, wave, g, S, E); } SEAM(7);
    if (IN(8)) for (int rep_ = 0; rep_ < REPS(8); ++rep_) {
        S.init(T / BM, 4, G, bid);
        { Gemm g = plain_gemm((const bf16_t*)(ws + WS_X1B), (const bf16_t*)(ws + WS_WCQ), 1024);
          EpiQ E{(const float*)(ws + WS_SSP1), (bf16_t*)(ws + WS_Q)}; gemm_phase(lds, wave, g, S, E); }
        { Gemm g; g.A = (const bf16_t*)(ws + WS_Q); g.Bt = (const bf16_t*)(ws + WS_KM); g.lda = 1024; g.ldb = 1024; g.K = 256;
          g.a_pm = (size_t)BM * 1024 * 2; g.a_pn = 512; g.b_pn = 512; g.b_pb = (size_t)NMEM * 1024 * 2; g.a_pn2 = 0;
          EpiSc E{(bf16_t*)(ws + WS_PEXP), (float*)(ws + WS_SSPA)}; gemm_phase(lds, wave, g, S, E); }
        { Gemm g; g.A = (const bf16_t*)(ws + WS_PEXP); g.Bt = (const bf16_t*)(ws + WS_VT); g.lda = 1024; g.ldb = TM; g.K = 256;
          g.a_pm = (size_t)BM * 1024 * 2; g.a_pn = 512; g.b_pn = (size_t)256 * TM * 2; g.b_pb = 512; g.a_pn2 = 0;
          EpiPv E{(const float*)(ws + WS_SSPA), (bf16_t*)(ws + WS_O)}; gemm_phase(lds, wave, g, S, E); }
    } SEAM(8);
    if (IN(9)) for (int rep_ = 0; rep_ < REPS(9); ++rep_) { Gemm g = plain_gemm((const bf16_t*)(ws + WS_O), (const bf16_t*)(ws + WS_WCO), 1024); S.init(T / BM, 4, G, bid);
        EpiRes<false> E{(const bf16_t*)(ws + WS_X1B), (bf16_t*)(ws + WS_X2B), (float*)(ws + WS_SSP2)}; gemm_phase(lds, wave, g, S, E); } SEAM(9);
    if (IN(10)) for (int rep_ = 0; rep_ < REPS(10); ++rep_) { Gemm g = plain_gemm((const bf16_t*)(ws + WS_X2B), (const bf16_t*)(ws + WS_WFFI), 1024); S.init(T / BM, 22, G, bid);
        EpiFfnAct E{(const float*)(ws + WS_SSP2), a.in[I_FCW], a.in[I_FCB], (bf16_t*)(ws + WS_UU), (bf16_t*)(ws + WS_HG)}; gemm_phase(lds, wave, g, S, E); } SEAM(10);
    if (IN(11)) for (int rep_ = 0; rep_ < REPS(11); ++rep_) phase_ffnfix(a, wave, G); SEAM(11);
    if (IN(12)) for (int rep_ = 0; rep_ < REPS(12); ++rep_) { Gemm g = plain_gemm((const bf16_t*)(ws + WS_UU), (const bf16_t*)(ws + WS_WFFO), DFF); S.init(T / BM, 4, G, bid);
        EpiRes<false> E{(const bf16_t*)(ws + WS_X2B), (bf16_t*)(ws + WS_X3B), (float*)(ws + WS_SSP3)}; gemm_phase(lds, wave, g, S, E); } SEAM(12);
    if (IN(13)) for (int rep_ = 0; rep_ < REPS(13); ++rep_) phase_final(a, wave, G);
#undef IN
#undef SEAM
}

extern "C" void kernel_launch(void* const* d_in, const int* in_sizes, int n_in, void* d_out, int out_size, void* d_ws, size_t ws_size, hipStream_t stream) {
    static int grid = 0;
    if (grid == 0) {
        if (n_in != 37 || in_sizes[0] != T * D || out_size != T * D || ws_size < WS_END) {
            fprintf(stderr, "kernel_launch: unexpected shapes (n_in %d, in0 %d, out %d, ws %zu < %zu); nothing launched\n", n_in, n_in > 0 ? in_sizes[0] : -1, out_size, ws_size, (size_t)WS_END); grid = -1; return; }
        int dev = 0, cus = 0, per_cu = 0;
        if (hipGetDevice(&dev) != hipSuccess || hipDeviceGetAttribute(&cus, hipDeviceAttributeMultiprocessorCount, dev) != hipSuccess) { grid = -1; return; }
        if (hipFuncSetAttribute((const void*)mega, hipFuncAttributeMaxDynamicSharedMemorySize, LDS_BYTES) != hipSuccess) { fprintf(stderr, "kernel_launch: hipFuncSetAttribute failed\n"); grid = -1; return; }
        if (hipOccupancyMaxActiveBlocksPerMultiprocessor(&per_cu, (const void*)mega, 512, LDS_BYTES) != hipSuccess || per_cu < 1) { fprintf(stderr, "kernel_launch: occupancy query says %d\n", per_cu); per_cu = 1; }
        (void)hipGetLastError();
        grid = cus * 1;
    }
    if (grid < 0) return;
    if (hipMemsetAsync((char*)d_ws + WS_CTL, 0, CTL_BYTES, stream) != hipSuccess) { fprintf(stderr, "kernel_launch: memset failed\n"); return; }
    Args a{};
    for (int i = 0; i < 37; ++i) a.in[i] = (const float*)d_in[i];
    a.out = (float*)d_out; a.ws = (unsigned char*)d_ws;
#if MK_SPLIT
    for (int ph = 0; ph <= NPHASE; ++ph) {
        a.ph_lo = ph; a.ph_hi = ph + 1; void* args[] = {&a};
        hipError_t e = hipLaunchCooperativeKernel((const void*)mega, dim3(grid), dim3(512), args, LDS_BYTES, stream);
        if (e != hipSuccess) { fprintf(stderr, "kernel_launch: launch of phase %d failed: %s\n", ph, hipGetErrorString(e)); break; }
    }
#else
    a.ph_lo = 0; a.ph_hi = NPHASE + 1; void* args[] = {&a};
    hipError_t e = hipLaunchCooperativeKernel((const void*)mega, dim3(grid), dim3(512), args, LDS_BYTES, stream);
    if (e != hipSuccess) fprintf(stderr, "kernel_launch: cooperative launch failed: %s (grid %d)\n", hipGetErrorString(e), grid);
#endif
}
```

```cpp
#include <hip/hip_runtime.h>
#include <hip/hip_cooperative_groups.h>
#include <cstdio>
namespace cg = cooperative_groups;

#ifndef MK_SPLIT
#define MK_SPLIT 0
#endif

#ifndef DUP_PHASE
#define DUP_PHASE -1
#endif
#define REPS(k) ((DUP_PHASE == (k)) ? 2 : 1)
#define LAS __attribute__((address_space(3)))
typedef unsigned short bf16_t;
typedef short bf16x8 __attribute__((ext_vector_type(8)));
typedef float f32x4 __attribute__((ext_vector_type(4)));
typedef float f32x2 __attribute__((ext_vector_type(2)));
typedef unsigned u32x4 __attribute__((ext_vector_type(4)));
typedef unsigned u32x2 __attribute__((ext_vector_type(2)));

constexpr int T = 65536, D = 1024, SEQ = 2048, NB = 32, NMEM = 256, TM = NB * NMEM;
constexpr int AW = 512, RW = 1792, PIN = 4864, DFF = 2816;
constexpr float NORM_EPS = 1e-6f, LNX_EPS = 64e-5f;

constexpr size_t MiB = 1u << 20;
constexpr size_t WS_WIN = 0;
constexpr size_t WS_WFFI = 10 * MiB;
constexpr size_t WS_WFFO = 21 * MiB;
constexpr size_t WS_WMIX = 27 * MiB, WS_WCQ = 29 * MiB, WS_WK = 31 * MiB, WS_WV = 33 * MiB, WS_WCO = 35 * MiB;
constexpr size_t WS_WA = 37 * MiB, WS_WB = 38 * MiB;
constexpr size_t WS_WLORA = 39 * MiB;
constexpr size_t WS_WRG = 40 * MiB;
constexpr size_t WS_CTL = 46 * MiB, CTL_BYTES = 16384;
constexpr size_t WS_RSTDX = 48 * MiB;
constexpr size_t WS_SSP1 = 49 * MiB, WS_SSP2 = 53 * MiB, WS_SSP3 = 57 * MiB, WS_SSPA = 61 * MiB;
constexpr size_t WS_BON = 65 * MiB;
constexpr size_t WS_MEMN = 68 * MiB, WS_KM = 84 * MiB, WS_VT = 100 * MiB;
constexpr size_t WS_XB = 120 * MiB;
constexpr size_t WS_PR = 248 * MiB;
constexpr size_t WS_PX = 472 * MiB, WS_PY = 536 * MiB;
constexpr size_t WS_LIN = 600 * MiB, WS_XBC = 632 * MiB;
constexpr size_t WS_LOUT = 696 * MiB;
constexpr size_t WS_RGLA = 888 * MiB, WS_RGU = 952 * MiB;
constexpr size_t WS_YRAW = WS_PX, WS_YB = WS_LIN, WS_YA = WS_RGLA;
constexpr size_t WS_GAB = 248 * MiB;
constexpr size_t WS_MERGED = 696 * MiB;
constexpr size_t WS_X1B = WS_XB, WS_Q = 248 * MiB, WS_PEXP = 376 * MiB, WS_O = 504 * MiB, WS_X2B = WS_XB;
constexpr size_t WS_X3B = 376 * MiB;
constexpr size_t WS_HG = 248 * MiB, WS_UU = 600 * MiB;
constexpr size_t WS_END = 1016 * MiB;

constexpr int LDS_BYTES = 147456;

__device__ __forceinline__ unsigned cvt_pk_bf16(float lo, float hi) { unsigned r; asm("v_cvt_pk_bf16_f32 %0, %1, %2" : "=v"(r) : "v"(lo), "v"(hi)); return r; }
__device__ __forceinline__ float bf_lo(unsigned w) { return __uint_as_float(w << 16); }
__device__ __forceinline__ float bf_hi(unsigned w) { return __uint_as_float(w & 0xffff0000u); }
__device__ __forceinline__ float bf1(bf16_t b) { return __uint_as_float(((unsigned)b) << 16); }
__device__ __forceinline__ bf16_t f2bf(float f) { return (bf16_t)(cvt_pk_bf16(f, 0.f) & 0xffffu); }
__device__ __forceinline__ float sigmoidf_(float x) { return __builtin_amdgcn_rcpf(1.0f + __expf(-x)); }
__device__ __forceinline__ float gelu_tanh(float x) { const float z = 1.5957691216057308f * (x + 0.044715f * x * x * x); return x * sigmoidf_(z); }
__device__ __forceinline__ int lane_id() { int l; asm volatile("v_mbcnt_lo_u32_b32 %0, -1, 0\n\tv_mbcnt_hi_u32_b32 %0, -1, %0" : "=v"(l)); return l; }
__device__ __forceinline__ float wave_sum(float v) {
#pragma unroll
    for (int o = 1; o < 64; o <<= 1) v += __shfl_xor(v, o);
    return v;
}
__device__ __forceinline__ void unpack8(const u32x4 w, float (&f)[8]) {
    f[0] = bf_lo(w.x); f[1] = bf_hi(w.x); f[2] = bf_lo(w.y); f[3] = bf_hi(w.y); f[4] = bf_lo(w.z); f[5] = bf_hi(w.z); f[6] = bf_lo(w.w); f[7] = bf_hi(w.w);
}
__device__ __forceinline__ u32x4 pack8(const float (&f)[8]) {
    u32x4 w; w.x = cvt_pk_bf16(f[0], f[1]); w.y = cvt_pk_bf16(f[2], f[3]); w.z = cvt_pk_bf16(f[4], f[5]); w.w = cvt_pk_bf16(f[6], f[7]); return w;
}


#define XB_TMO      128
#define XB_XCNT(j)  (256  + 64 * (j))
#define XB_XSUB(j)  (1280 + 64 * (j))
#define XB_XGEN(j)  (2304 + 64 * (j))
#define XB_TOP      3328
#define XB_TOPGEN   3392
#define XCD_BAR_WORDS 3456
#define XB_SPIN_CAP (1u << 22)
__device__ __forceinline__ unsigned xb_ld(unsigned* p)              { return __hip_atomic_load(p, __ATOMIC_RELAXED, __HIP_MEMORY_SCOPE_AGENT); }
__device__ __forceinline__ unsigned xb_add(unsigned* p, unsigned v) { return __hip_atomic_fetch_add(p, v, __ATOMIC_RELAXED, __HIP_MEMORY_SCOPE_AGENT); }
__device__ __forceinline__ unsigned xb_xcc_id() { return (unsigned)__builtin_amdgcn_s_getreg((3 << 11) | 20) & 0xFu; }
#define XB_SPIN(cond, bar) do { unsigned _sp = 0; while (cond) { __builtin_amdgcn_s_sleep(1); \
    if ((++_sp & 255u) == 0u) { if (xb_ld(&(bar)[XB_TMO])) break; if (_sp > XB_SPIN_CAP) { atomicAdd(&(bar)[XB_TMO], 1u); break; } } } } while (0)
struct XcdBarrier { unsigned* bar; unsigned x; volatile LAS unsigned* st; };
__device__ __forceinline__ XcdBarrier xcd_barrier_post(unsigned* bar, volatile LAS unsigned* st, bool t0) {
    XcdBarrier b; b.bar = bar; b.x = xb_xcc_id(); b.st = st;
    if (t0) (void)xb_add(&bar[XB_XCNT(b.x)], 1u);
    return b;
}
__device__ __forceinline__ void xcd_barrier_complete(unsigned* bar, unsigned x, unsigned& nloc, unsigned& nx) {
    const unsigned G = gridDim.x * gridDim.y * gridDim.z;
    unsigned sum, cnt, mine, sp = 0u;
    for (;;) {
        sum = 0u; cnt = 0u; mine = 0u;
#pragma unroll
        for (unsigned j = 0; j < 16; ++j) { const unsigned c = xb_ld(&bar[XB_XCNT(j)]); sum += c; cnt += (c > 0u) ? 1u : 0u; mine = (j == x) ? c : mine; }
        if (sum == G) break;
        __builtin_amdgcn_s_sleep(1);
        if ((++sp & 255u) == 0u) { if (xb_ld(&bar[XB_TMO])) break; if (sp > XB_SPIN_CAP) { atomicAdd(&bar[XB_TMO], 1u); break; } }
    }
    nloc = mine > 0u ? mine : 1u; nx = cnt > 0u ? cnt : 1u;
}
__device__ __forceinline__ void xcd_barrier(const XcdBarrier& b, bool t0) {
    asm volatile("s_waitcnt vmcnt(0)" ::: "memory");
    __syncthreads();
    if (t0) {
        unsigned* bar = b.bar;
        __builtin_amdgcn_s_waitcnt(0);
        unsigned nloc = b.st[0], nx = b.st[1];
        if (nloc == 0u) { xcd_barrier_complete(bar, b.x, nloc, nx); b.st[0] = nloc; b.st[1] = nx; }
        const unsigned old = xb_add(&bar[XB_XSUB(b.x)], 1u);
        const unsigned gen = old / nloc;
        if (old + 1u == (gen + 1u) * nloc) {
            __builtin_amdgcn_fence(__ATOMIC_RELEASE, "agent");
            asm volatile("s_waitcnt vmcnt(0)" ::: "memory");
            const unsigned og = xb_add(&bar[XB_TOP], 1u);
            const unsigned tg = og / nx;
            if (og + 1u == (tg + 1u) * nx) xb_add(&bar[XB_TOPGEN], 1u);
            else XB_SPIN(xb_ld(&bar[XB_TOPGEN]) == tg, bar);
            __builtin_amdgcn_fence(__ATOMIC_ACQUIRE, "agent");
            xb_add(&bar[XB_XGEN(b.x)], 1u);
            asm volatile("s_waitcnt vmcnt(0)" ::: "memory");
        } else {
            XB_SPIN(xb_ld(&bar[XB_XGEN(b.x)]) == gen, bar);
            __builtin_amdgcn_fence(__ATOMIC_ACQUIRE, "agent");
            asm volatile("s_waitcnt vmcnt(0)" ::: "memory");
        }
    }
    __syncthreads();
}

constexpr int BM = 256, BK = 64, HALF = 128, HTB = HALF * BK * 2, NXCD = 8, WGM = 8;
__device__ __forceinline__ int lds_byte(int r, int c) { const int st = (r >> 4) * 2 + (c >> 5), rr = r & 15, cc = c & 31, ob = rr * 64 + cc * 2; return st * 1024 + (ob ^ (((ob >> 9) & 1) << 5)); }
__device__ __forceinline__ void stage_rc(int b, int& R, int& C) { const int st = b / 1024, sb = b % 1024, swz = sb ^ (((sb >> 9) & 1) << 5); R = (st >> 1) * 16 + swz / 64; C = (st & 1) * 32 + (swz % 64) / 2; }
__device__ __forceinline__ int perm32(int rho) { const int n = rho >> 4, i = rho & 15; return 8 * (i >> 2) + 4 * n + (i & 3); }

struct Unit { int pm, pn; };
struct Gemm { const bf16_t* A; const bf16_t* Bt; int lda, ldb, K; size_t a_pm, a_pn, b_pn, b_pb, a_pn2; };
__device__ __forceinline__ Gemm plain_gemm(const bf16_t* A, const bf16_t* Bt, int K) { Gemm g; g.A = A; g.Bt = Bt; g.lda = K; g.ldb = K; g.K = K; g.a_pm = (size_t)BM * K * 2; g.a_pn = 0; g.b_pn = (size_t)BM * K * 2; g.b_pb = 0; g.a_pn2 = 0; return g; }

struct StaticOrder {
    int nM, nN, nwg, G, c;
    __device__ void init(int nM_, int nN_, int G_, int c_) { nM = nM_; nN = nN_; nwg = nM * nN; G = G_; c = c_; }
    __device__ bool next(int i, Unit& u) const {
        const long L = (long)i * G + c; if (L >= nwg) return false;
        int wgid = (int)L; { const int q = nwg / NXCD, r = nwg % NXCD, xcd = wgid % NXCD, off = wgid / NXCD; wgid = (xcd < r ? xcd * (q + 1) : r * (q + 1) + (xcd - r) * q) + off; }
        const int nig = WGM * nN, gid = wgid / nig, fm = gid * WGM, gsz = (nM - fm) < WGM ? (nM - fm) : WGM;
        u.pm = fm + ((wgid % nig) % gsz); u.pn = (wgid % nig) / gsz; return true;
    }
};

typedef f32x4 Acc[2][2][4][2];

template <class Epi>
__device__ __forceinline__ void gemm_phase(LAS unsigned char* lds, const int wid, const Gemm g, const StaticOrder& S, const Epi& E) {
    const int lane = lane_id(), tid = wid * 64 + lane, wr = wid >> 2, wc = wid & 3, fr = lane & 15, fq = lane >> 4;
    const int nt = g.K / BK;
    unsigned voffA[2], voffB[2];
#pragma unroll
    for (int i = 0; i < 2; ++i) { int R, C; stage_rc(tid * 16 + i * 8192, R, C); const int Rb = Epi::PERM ? ((R & ~31) + perm32(R & 31)) : R;
        voffA[i] = (unsigned)(R * g.lda + C) * 2u; voffB[i] = (unsigned)(Rb * g.ldb + C) * 2u; }
    const size_t kstep = (size_t)(BK * 2);
    const size_t hstepA = (size_t)HALF * g.lda * 2, hstepB = (size_t)HALF * g.ldb * 2;
    const unsigned ldsw = (unsigned)wid * 1024u;
    const int aoff = lds_byte(wr * 64 + fr, fq * 8), boff = lds_byte(wc * 32 + fr, fq * 8);
#define PG8_SA(b, h) (((b) * 2 + (h)) * HTB)
#define PG8_SB(b, h) ((4 + (b) * 2 + (h)) * HTB)
#define PG8_STAGE(bufoff, gbase, voff) do { _Pragma("unroll") for (int _i = 0; _i < 2; ++_i) \
        __builtin_amdgcn_global_load_lds((const unsigned*)((const char*)(gbase) + (voff)[_i]), (LAS unsigned*)(lds + (bufoff) + ldsw + _i * 8192), 16, 0, 0); } while (0)
#define PG8_LDA(dst, b, h) do { _Pragma("unroll") for (int m = 0; m < 4; ++m) _Pragma("unroll") for (int k = 0; k < 2; ++k) dst[m][k] = *(const LAS bf16x8*)(lds + PG8_SA(b, h) + aoff + m * 2048 + k * 1024); } while (0)
#define PG8_LDB(dst, b, h) do { _Pragma("unroll") for (int n = 0; n < 2; ++n) _Pragma("unroll") for (int k = 0; k < 2; ++k) dst[n][k] = *(const LAS bf16x8*)(lds + PG8_SB(b, h) + boff + n * 2048 + k * 1024); } while (0)
#define PG8_MMA(ai, bj, At, Bt) do { __builtin_amdgcn_s_setprio(1); _Pragma("unroll") for (int m = 0; m < 4; ++m) _Pragma("unroll") for (int n = 0; n < 2; ++n) _Pragma("unroll") for (int k = 0; k < 2; ++k) \
        acc[ai][bj][m][n] = __builtin_amdgcn_mfma_f32_16x16x32_bf16(Bt[n][k], At[m][k], acc[ai][bj][m][n], 0, 0, 0); __builtin_amdgcn_s_setprio(0); } while (0)
#define PG8_WAIT_V(n) asm volatile("s_waitcnt vmcnt(" #n ")" ::: "memory")
#define PG8_WAIT_L(n) asm volatile("s_waitcnt lgkmcnt(" #n ")" ::: "memory")
#define PG8_BAR __builtin_amdgcn_s_barrier()
#define PG8_SCHED __builtin_amdgcn_sched_barrier(0)
#define PG8_UA(u) ((const char*)g.A + (size_t)(u).pm * g.a_pm + (size_t)(u).pn * g.a_pn + (size_t)((u).pn >> 1) * g.a_pn2)
#define PG8_UB(u) ((const char*)g.Bt + (size_t)(u).pn * g.b_pn + (size_t)((u).pm >> 3) * g.b_pb)
    Unit cur, nxt; int ui = 0;
    if (!S.next(0, cur)) return;
    Acc acc;
#pragma unroll
    for (int a = 0; a < 2; ++a)
#pragma unroll
        for (int b = 0; b < 2; ++b)
#pragma unroll
            for (int m = 0; m < 4; ++m)
#pragma unroll
                for (int n = 0; n < 2; ++n) acc[a][b][m][n] = (f32x4){0.f, 0.f, 0.f, 0.f};
    bf16x8 At[4][2], B0[2][2], B1[2][2];
    const char* cA = PG8_UA(cur); const char* cB = PG8_UB(cur);
    PG8_STAGE(PG8_SB(0, 0), cB, voffB); PG8_STAGE(PG8_SB(0, 1), cB + hstepB, voffB); PG8_STAGE(PG8_SA(0, 0), cA, voffA); PG8_STAGE(PG8_SA(0, 1), cA + hstepA, voffA);
    if (wr == 1) PG8_BAR;
    PG8_WAIT_V(2); PG8_BAR;
    PG8_STAGE(PG8_SB(1, 0), cB + kstep, voffB); PG8_STAGE(PG8_SA(1, 0), cA + kstep, voffA); PG8_STAGE(PG8_SB(1, 1), cB + hstepB + kstep, voffB);
    PG8_WAIT_V(6); PG8_BAR;
    for (;;) {
        const bool has_next = S.next(ui + 1, nxt);
        const char* nA = has_next ? PG8_UA(nxt) : cA; const char* nB = has_next ? PG8_UB(nxt) : cB;
        for (int t = 0; t < nt; t += 2) {
            const bool last = (t == nt - 2);
            const char* a1 = cA + (size_t)(t + 1) * kstep;
            const char* a2 = last ? nA : cA + (size_t)(t + 2) * kstep; const char* b2 = last ? nB : cB + (size_t)(t + 2) * kstep;
            const char* a3 = a2 + kstep; const char* b3 = b2 + kstep;
            PG8_LDB(B0, 0, 0); PG8_LDB(B1, 0, 1); PG8_SCHED; PG8_LDA(At, 0, 0); PG8_STAGE(PG8_SA(1, 1), a1 + hstepA, voffA);
            PG8_WAIT_V(8); PG8_WAIT_L(0); PG8_BAR; PG8_MMA(0, 0, At, B0); PG8_MMA(0, 1, At, B1); PG8_BAR; PG8_SCHED;
            PG8_LDA(At, 0, 1); PG8_STAGE(PG8_SB(0, 0), b2, voffB); PG8_STAGE(PG8_SB(0, 1), b2 + hstepB, voffB); PG8_STAGE(PG8_SA(0, 0), a2, voffA);
            PG8_WAIT_V(8); PG8_WAIT_L(0); PG8_BAR; PG8_MMA(1, 0, At, B0); PG8_MMA(1, 1, At, B1); PG8_BAR; PG8_SCHED;
            PG8_LDB(B0, 1, 0); PG8_LDB(B1, 1, 1); PG8_SCHED; PG8_LDA(At, 1, 0); PG8_STAGE(PG8_SA(0, 1), a2 + hstepA, voffA);
            PG8_WAIT_V(8); PG8_WAIT_L(0); PG8_BAR; PG8_MMA(0, 0, At, B0); PG8_MMA(0, 1, At, B1); PG8_BAR; PG8_SCHED;
            PG8_LDA(At, 1, 1); PG8_STAGE(PG8_SB(1, 0), b3, voffB); PG8_STAGE(PG8_SB(1, 1), b3 + hstepB, voffB); PG8_STAGE(PG8_SA(1, 0), a3, voffA);
            PG8_WAIT_V(8); PG8_WAIT_L(0); PG8_BAR; PG8_MMA(1, 0, At, B0); PG8_MMA(1, 1, At, B1); PG8_BAR; PG8_SCHED;
        }
        if (wr == 0) PG8_BAR;
        E(acc, cur, wr, wc, fr, fq);
        if (!has_next) break;
#pragma unroll
        for (int a = 0; a < 2; ++a)
#pragma unroll
            for (int b = 0; b < 2; ++b)
#pragma unroll
                for (int m = 0; m < 4; ++m)
#pragma unroll
                    for (int n = 0; n < 2; ++n) acc[a][b][m][n] = (f32x4){0.f, 0.f, 0.f, 0.f};
        cur = nxt; cA = nA; cB = nB; ++ui;
        if (wr == 1) PG8_BAR;
    }
    PG8_WAIT_V(0);
    PG8_BAR;
#undef PG8_SA
#undef PG8_SB
#undef PG8_STAGE
#undef PG8_LDA
#undef PG8_LDB
#undef PG8_MMA
#undef PG8_WAIT_V
#undef PG8_WAIT_L
#undef PG8_BAR
#undef PG8_SCHED
#undef PG8_UA
#undef PG8_UB
}

#define EPI_ROWS_BEGIN for (int ai = 0; ai < 2; ++ai) { _Pragma("unroll") for (int m = 0; m < 4; ++m) { const int r = u.pm * BM + ai * HALF + wr * 64 + m * 16 + fr;
#define EPI_ROWS_END } }

__device__ __forceinline__ float rstd_from16(const float* ss, int r) { return rsqrtf(ss[r] * (1.0f / 1024.0f) + NORM_EPS); }

struct EpiProj { static constexpr bool PERM = true;
    const float* rstd; const float* bias; bf16_t* PR; bf16_t* PX; bf16_t* PY;
    __device__ __forceinline__ void operator()(Acc& acc, const Unit& u, int wr, int wc, int fr, int fq) const {
        bf16_t* base; int ld, colt;
        if (u.pn < 7) { base = PR; ld = RW; colt = u.pn * 256; } else if (u.pn < 9) { base = PX; ld = 512; colt = (u.pn - 7) * 256; } else { base = PY; ld = 512; colt = (u.pn - 9) * 256; }
        const int col0 = colt + wc * 32 + 8 * fq, bcol0 = u.pn * 256 + wc * 32 + 8 * fq;
        f32x4 bv[2][2];
#pragma unroll
        for (int bj = 0; bj < 2; ++bj)
#pragma unroll
            for (int n = 0; n < 2; ++n) bv[bj][n] = *(const f32x4*)(bias + bcol0 + bj * HALF + 4 * n);
#pragma unroll
        EPI_ROWS_BEGIN
            const float rs = rstd[r]; bf16_t* rowp = base + (size_t)r * ld + col0;
#pragma unroll
            for (int bj = 0; bj < 2; ++bj) { const f32x4 v0 = acc[ai][bj][m][0] * rs + bv[bj][0], v1 = acc[ai][bj][m][1] * rs + bv[bj][1];
                u32x4 w; w.x = cvt_pk_bf16(v0[0], v0[1]); w.y = cvt_pk_bf16(v0[2], v0[3]); w.z = cvt_pk_bf16(v1[0], v1[1]); w.w = cvt_pk_bf16(v1[2], v1[3]);
                *(u32x4*)(rowp + bj * HALF) = w; }
        EPI_ROWS_END
    }
};
struct EpiGab { static constexpr bool PERM = true;
    const float* rstd; const float* bias; bf16_t* O; int cofs;
    __device__ __forceinline__ void operator()(Acc& acc, const Unit& u, int wr, int wc, int fr, int fq) const {
        const int col0 = cofs + u.pn * 256 + wc * 32 + 8 * fq;
        f32x4 bv[2][2];
#pragma unroll
        for (int bj = 0; bj < 2; ++bj)
#pragma unroll
            for (int n = 0; n < 2; ++n) bv[bj][n] = *(const f32x4*)(bias + col0 + bj * HALF + 4 * n);
#pragma unroll
        EPI_ROWS_BEGIN
            const float rs = rstd[r]; bf16_t* rowp = O + (size_t)r * 2048 + col0;
#pragma unroll
            for (int bj = 0; bj < 2; ++bj) { f32x4 v0 = acc[ai][bj][m][0] * rs + bv[bj][0], v1 = acc[ai][bj][m][1] * rs + bv[bj][1];
#pragma unroll
                for (int j = 0; j < 4; ++j) { v0[j] = sigmoidf_(v0[j]); v1[j] = sigmoidf_(v1[j]); }
                u32x4 w; w.x = cvt_pk_bf16(v0[0], v0[1]); w.y = cvt_pk_bf16(v0[2], v0[3]); w.z = cvt_pk_bf16(v1[0], v1[1]); w.w = cvt_pk_bf16(v1[2], v1[3]);
                *(u32x4*)(rowp + bj * HALF) = w; }
        EPI_ROWS_END
    }
};
struct EpiPlain { static constexpr bool PERM = true;
    bf16_t* O; int ldc;
    __device__ __forceinline__ void operator()(Acc& acc, const Unit& u, int wr, int wc, int fr, int fq) const {
        const int col0 = u.pn * 256 + wc * 32 + 8 * fq;
#pragma unroll
        EPI_ROWS_BEGIN
            bf16_t* rowp = O + (size_t)r * ldc + col0;
#pragma unroll
            for (int bj = 0; bj < 2; ++bj) { const f32x4 v0 = acc[ai][bj][m][0], v1 = acc[ai][bj][m][1];
                u32x4 w; w.x = cvt_pk_bf16(v0[0], v0[1]); w.y = cvt_pk_bf16(v0[2], v0[3]); w.z = cvt_pk_bf16(v1[0], v1[1]); w.w = cvt_pk_bf16(v1[2], v1[3]);
                *(u32x4*)(rowp + bj * HALF) = w; }
        EPI_ROWS_END
    }
};
struct EpiLora { static constexpr bool PERM = true;
    const float* w0; const float* a0; bf16_t* O;
    __device__ __forceinline__ void operator()(Acc& acc, const Unit& u, int wr, int wc, int fr, int fq) const {
        const int kind = u.pn >> 1, ch0 = (u.pn & 1) * 256 + wc * 32 + 8 * fq, col0 = u.pn * 256 + wc * 32 + 8 * fq;
        const float* bsrc = kind == 0 ? w0 : a0;
        f32x4 bv[2][2];
#pragma unroll
        for (int bj = 0; bj < 2; ++bj)
#pragma unroll
            for (int n = 0; n < 2; ++n) bv[bj][n] = kind < 2 ? *(const f32x4*)(bsrc + ch0 + bj * HALF + 4 * n) : (f32x4){0.f, 0.f, 0.f, 0.f};
        const float sc = kind == 0 ? 0.6065306597126334f : 1.0f;
#pragma unroll
        EPI_ROWS_BEGIN
            bf16_t* rowp = O + (size_t)r * 1536 + col0;
#pragma unroll
            for (int bj = 0; bj < 2; ++bj) { f32x4 v0 = acc[ai][bj][m][0] + bv[bj][0], v1 = acc[ai][bj][m][1] + bv[bj][1];
                if (kind < 2) {
#pragma unroll
                    for (int j = 0; j < 4; ++j) { v0[j] = sc * sigmoidf_(v0[j]); v1[j] = sc * sigmoidf_(v1[j]); } }
                u32x4 w; w.x = cvt_pk_bf16(v0[0], v0[1]); w.y = cvt_pk_bf16(v0[2], v0[3]); w.z = cvt_pk_bf16(v1[0], v1[1]); w.w = cvt_pk_bf16(v1[2], v1[3]);
                *(u32x4*)(rowp + bj * HALF) = w; }
        EPI_ROWS_END
    }
};
struct EpiRg { static constexpr bool PERM = true;
    const float* ba; const float* bx; const float* lam; const bf16_t* XBC; bf16_t* LA; bf16_t* U;
    __device__ __forceinline__ void operator()(Acc& acc, const Unit& u, int wr, int wc, int fr, int fq) const {
        const int ch0 = u.pn * 128 + wc * 32 + 8 * fq;
        float vba[8], vbx[8], vls[8];
#pragma unroll
        for (int j = 0; j < 8; ++j) { vba[j] = ba[ch0 + j]; vbx[j] = bx[ch0 + j]; vls[j] = -8.0f * log1pf(__expf(-lam[ch0 + j])); }
#pragma unroll
        EPI_ROWS_BEGIN
            const bool first = (r & (SEQ - 1)) == 0;
            float xb[8]; unpack8(*(const u32x4*)(XBC + (size_t)r * 512 + ch0), xb);
            float la[8], uu[8];
#pragma unroll
            for (int j = 0; j < 8; ++j) { const float ga = sigmoidf_(acc[ai][0][m][j >> 2][j & 3] + vba[j]), gx = sigmoidf_(acc[ai][1][m][j >> 2][j & 3] + vbx[j]);
                la[j] = vls[j] * ga; const float a = __expf(la[j]); const float mult = first ? 1.0f : sqrtf(fmaxf(1.0f - a * a, 0.f)); uu[j] = xb[j] * gx * mult; }
            *(u32x4*)(LA + (size_t)r * 512 + ch0) = pack8(la); *(u32x4*)(U + (size_t)r * 512 + ch0) = pack8(uu);
        EPI_ROWS_END
    }
};
template <bool FIRST> struct EpiBranch { static constexpr bool PERM = true;
    const bf16_t* G; bf16_t* M;
    __device__ __forceinline__ void operator()(Acc& acc, const Unit& u, int wr, int wc, int fr, int fq) const {
        const int col0 = u.pn * 256 + wc * 32 + 8 * fq;
#pragma unroll
        EPI_ROWS_BEGIN
#pragma unroll
            for (int bj = 0; bj < 2; ++bj) { const int c = col0 + bj * HALF;
                float gv[8]; unpack8(*(const u32x4*)(G + (size_t)r * 2048 + (FIRST ? 0 : 1024) + c), gv);
                float o[8];
                if (!FIRST) unpack8(*(const u32x4*)(M + (size_t)r * 1024 + c), o);
#pragma unroll
                for (int j = 0; j < 8; ++j) { const float p = acc[ai][bj][m][j >> 2][j & 3] * gv[j]; o[j] = FIRST ? p : o[j] + p; }
                *(u32x4*)(M + (size_t)r * 1024 + c) = pack8(o); }
        EPI_ROWS_END
    }
};
template <bool BASE_F32> struct EpiRes { static constexpr bool PERM = true;
    const void* base; bf16_t* XB; float* ssp;
    __device__ __forceinline__ void operator()(Acc& acc, const Unit& u, int wr, int wc, int fr, int fq) const {
        const int col0 = u.pn * 256 + wc * 32 + 8 * fq;
#pragma unroll
        EPI_ROWS_BEGIN
            float s = 0.f;
#pragma unroll
            for (int bj = 0; bj < 2; ++bj) { const size_t off = (size_t)r * 1024 + col0 + bj * HALF; float o[8];
                if (BASE_F32) { const f32x4 b0 = *(const f32x4*)((const float*)base + off), b1 = *(const f32x4*)((const float*)base + off + 4);
                    o[0] = b0[0]; o[1] = b0[1]; o[2] = b0[2]; o[3] = b0[3]; o[4] = b1[0]; o[5] = b1[1]; o[6] = b1[2]; o[7] = b1[3]; }
                else unpack8(*(const u32x4*)((const bf16_t*)base + off), o);
#pragma unroll
                for (int j = 0; j < 8; ++j) { o[j] += acc[ai][bj][m][j >> 2][j & 3]; s += o[j] * o[j]; }
                *(u32x4*)(XB + off) = pack8(o); }
            s += __shfl_xor(s, 16); s += __shfl_xor(s, 32);
            if (fq == 0) atomicAdd(ssp + r, s);
        EPI_ROWS_END
    }
};
struct EpiQ { static constexpr bool PERM = true;
    const float* ssp; bf16_t* O;
    __device__ __forceinline__ void operator()(Acc& acc, const Unit& u, int wr, int wc, int fr, int fq) const {
        const int col0 = u.pn * 256 + wc * 32 + 8 * fq;
#pragma unroll
        EPI_ROWS_BEGIN
            const float rs = rstd_from16(ssp, r) * 0.0625f; bf16_t* rowp = O + (size_t)r * 1024 + col0;
#pragma unroll
            for (int bj = 0; bj < 2; ++bj) { const f32x4 v0 = acc[ai][bj][m][0] * rs, v1 = acc[ai][bj][m][1] * rs;
                u32x4 w; w.x = cvt_pk_bf16(v0[0], v0[1]); w.y = cvt_pk_bf16(v0[2], v0[3]); w.z = cvt_pk_bf16(v1[0], v1[1]); w.w = cvt_pk_bf16(v1[2], v1[3]);
                *(u32x4*)(rowp + bj * HALF) = w; }
        EPI_ROWS_END
    }
};
struct EpiSc { static constexpr bool PERM = true;
    bf16_t* O; float* ssp;
    __device__ __forceinline__ void operator()(Acc& acc, const Unit& u, int wr, int wc, int fr, int fq) const {
        const int col0 = u.pn * 256 + wc * 32 + 8 * fq;
#pragma unroll
        EPI_ROWS_BEGIN
            bf16_t* rowp = O + (size_t)r * 1024 + col0; float s = 0.f;
#pragma unroll
            for (int bj = 0; bj < 2; ++bj) { f32x4 v0 = acc[ai][bj][m][0], v1 = acc[ai][bj][m][1];
#pragma unroll
                for (int j = 0; j < 4; ++j) { v0[j] = __expf(v0[j]); v1[j] = __expf(v1[j]); }
                s += ((v0[0] + v0[1]) + (v0[2] + v0[3])) + ((v1[0] + v1[1]) + (v1[2] + v1[3]));
                u32x4 w; w.x = cvt_pk_bf16(v0[0], v0[1]); w.y = cvt_pk_bf16(v0[2], v0[3]); w.z = cvt_pk_bf16(v1[0], v1[1]); w.w = cvt_pk_bf16(v1[2], v1[3]);
                *(u32x4*)(rowp + bj * HALF) = w; }
            s += __shfl_xor(s, 16); s += __shfl_xor(s, 32);
            if (fq == 0) ssp[(size_t)r * 16 + u.pn * 4 + wc] = s;
        EPI_ROWS_END
    }
};
struct EpiPv { static constexpr bool PERM = true;
    const float* ssp; bf16_t* O;
    __device__ __forceinline__ void operator()(Acc& acc, const Unit& u, int wr, int wc, int fr, int fq) const {
        const int col0 = u.pn * 256 + wc * 32 + 8 * fq;
#pragma unroll
        EPI_ROWS_BEGIN
            const f32x4 sp = *(const f32x4*)(ssp + (size_t)r * 16 + u.pn * 4); const float rs = 1.0f / ((sp.x + sp.y) + (sp.z + sp.w));
            bf16_t* rowp = O + (size_t)r * 1024 + col0;
#pragma unroll
            for (int bj = 0; bj < 2; ++bj) { const f32x4 v0 = acc[ai][bj][m][0] * rs, v1 = acc[ai][bj][m][1] * rs;
                u32x4 w; w.x = cvt_pk_bf16(v0[0], v0[1]); w.y = cvt_pk_bf16(v0[2], v0[3]); w.z = cvt_pk_bf16(v1[0], v1[1]); w.w = cvt_pk_bf16(v1[2], v1[3]);
                *(u32x4*)(rowp + bj * HALF) = w; }
        EPI_ROWS_END
    }
};
__device__ __forceinline__ float dpp_ror1(float v) { return __int_as_float(__builtin_amdgcn_update_dpp(0, __float_as_int(v), 0x121, 0xf, 0xf, false)); }
__device__ __forceinline__ float dpp_ror2(float v) { return __int_as_float(__builtin_amdgcn_update_dpp(0, __float_as_int(v), 0x122, 0xf, 0xf, false)); }
struct EpiFfnAct { static constexpr bool PERM = true;
    const float* ssp; const float* cw; const float* cb; bf16_t* ACT; bf16_t* HG;
    __device__ __forceinline__ void operator()(Acc& acc, const Unit& u, int wr, int wc, int fr_, int fq_) const {
        const int l_ = lane_id(), fr = l_ & 15, fq = l_ >> 4;
        const int col0 = u.pn * 128 + wc * 32 + 8 * fq;
#pragma unroll
        for (int ai = 0; ai < 2; ++ai) {
            const int rbase = u.pm * BM + ai * HALF + wr * 64 + fr;
            float rs[4];
#pragma unroll
            for (int m = 0; m < 4; ++m) rs[m] = rstd_from16(ssp, rbase + m * 16);
            const size_t grp = (size_t)(rbase >> 6);
            if (fr < 2) { float t[8];
#pragma unroll
                for (int j = 0; j < 8; ++j) t[j] = acc[ai][0][0][j >> 2][j & 3] * rs[0];
                *(u32x4*)(HG + (grp * 4 + 2 + fr) * DFF + col0) = pack8(t); }
            if (fr >= 14) { float t[8];
#pragma unroll
                for (int j = 0; j < 8; ++j) t[j] = acc[ai][0][3][j >> 2][j & 3] * rs[3];
                *(u32x4*)(HG + (grp * 4 + (fr - 14)) * DFF + col0) = pack8(t); }
#pragma unroll
            for (int j = 0; j < 8; ++j) {
                const float w0 = cw[col0 + j], w1 = cw[DFF + col0 + j], w2 = cw[2 * DFF + col0 + j], b0 = cb[col0 + j];
                float g[4], r1[4], r2[4];
#pragma unroll
                for (int m = 0; m < 4; ++m) { g[m] = acc[ai][0][m][j >> 2][j & 3] * rs[m]; r1[m] = dpp_ror1(g[m]); r2[m] = dpp_ror2(g[m]); }
#pragma unroll
                for (int m = 0; m < 4; ++m) {
                    const float p1 = fr >= 1 ? r1[m] : r1[m > 0 ? m - 1 : 0], p2 = fr >= 2 ? r2[m] : r2[m > 0 ? m - 1 : 0];
                    const float up = acc[ai][1][m][j >> 2][j & 3] * rs[m];
                    const float gate = b0 + w0 * p2 + w1 * p1 + w2 * g[m];
                    acc[ai][1][m][j >> 2][j & 3] = (m == 0 && fr < 2) ? up : gelu_tanh(gate) * up;
                }
            }
#pragma unroll
            for (int m = 0; m < 4; ++m) { const f32x4 v0 = acc[ai][1][m][0], v1 = acc[ai][1][m][1];
                u32x4 w; w.x = cvt_pk_bf16(v0[0], v0[1]); w.y = cvt_pk_bf16(v0[2], v0[3]); w.z = cvt_pk_bf16(v1[0], v1[1]); w.w = cvt_pk_bf16(v1[2], v1[3]);
                *(u32x4*)(ACT + (size_t)(rbase + m * 16) * DFF + col0) = w; }
        }
    }
};

struct Args { const float* in[37]; float* out; unsigned char* ws; int ph_lo, ph_hi; };
enum { I_X = 0, I_MEM, I_NMIXG, I_WIN, I_BIN, I_MU, I_W0, I_WUP, I_A0, I_AUP, I_GUP, I_KK, I_KA, I_RK, I_LNXG, I_LNXB, I_WBA, I_CBW, I_CBB, I_WRGA, I_BRGA, I_WRGX, I_BRGX,
       I_LAM, I_WBB, I_WMIX, I_NXG, I_NMEMG, I_WCQ, I_WCKV, I_WCO, I_NFFNG, I_WFFI, I_FCW, I_FCB, I_WFFO, I_NFING };

__device__ __forceinline__ void transpose_item(const float* W, int ldw, int K, bf16_t* WT, int ldd, const float* gain, int map, int srcofs, LAS float* scr, int item, int lane) {
    const int nkb = K / 64, nb = item / nkb, kb = item % nkb, k0 = 64 * kb, n0 = 32 * nb;
    int ns = n0 + srcofs;
    if (map == 1) { const int tile = n0 >> 8, c = n0 & 255; ns = c < 128 ? tile * 128 + c : DFF + tile * 128 + (c - 128); }
#pragma unroll 8
    for (int i = 0; i < 32; ++i) { const int kk = 2 * i + (lane >> 5); float v = W[(size_t)(k0 + kk) * ldw + ns + (lane & 31)]; if (gain) v *= gain[k0 + kk]; scr[kk * 33 + (lane & 31)] = v; }
    asm volatile("s_waitcnt lgkmcnt(0)" ::: "memory");
    const int c = lane & 7;
#pragma unroll
    for (int j = 0; j < 4; ++j) { const int n = (lane >> 3) + 8 * j; const LAS float* s = scr + (8 * c) * 33 + n;
        u32x4 o; o.x = cvt_pk_bf16(s[0 * 33], s[1 * 33]); o.y = cvt_pk_bf16(s[2 * 33], s[3 * 33]); o.z = cvt_pk_bf16(s[4 * 33], s[5 * 33]); o.w = cvt_pk_bf16(s[6 * 33], s[7 * 33]);
        *(u32x4*)(WT + (size_t)(n0 + n) * ldd + k0 + 8 * c) = o; }
    asm volatile("s_waitcnt lgkmcnt(0)" ::: "memory");
}

__device__ __forceinline__ void phase_prep(const Args& a, LAS unsigned char* lds, int wave, int G) {
    const int lane = lane_id();
    unsigned char* ws = a.ws;
    LAS float* scr = (LAS float*)(lds + wave * 16384);
    const int gw = blockIdx.x * 8 + wave, NGW = G * 8;
#define TJOB(W_, ldw_, K_, Nd_, dst_, gain_, map_, srcofs_) do { const int nitems = ((K_) / 64) * ((Nd_) / 32); \
        for (int it = gw; it < nitems; it += NGW) transpose_item((W_), (ldw_), (K_), (bf16_t*)(ws + (dst_)), (K_), (gain_), (map_), (srcofs_), scr, it, lane); } while (0)
    TJOB(a.in[I_WIN], PIN, 1024, PIN, WS_WIN, a.in[I_NMIXG], 0, 0);
    TJOB(a.in[I_WBA], 1024, 512, 1024, WS_WA, nullptr, 0, 0);
    TJOB(a.in[I_WBB], 1024, 512, 1024, WS_WB, nullptr, 0, 0);
    TJOB(a.in[I_WMIX], 1024, 1024, 1024, WS_WMIX, nullptr, 0, 0);
    TJOB(a.in[I_WCQ], 1024, 1024, 1024, WS_WCQ, a.in[I_NXG], 0, 0);
    TJOB(a.in[I_WCKV], 2048, 1024, 1024, WS_WK, nullptr, 0, 0);
    TJOB(a.in[I_WCKV], 2048, 1024, 1024, WS_WV, nullptr, 0, 1024);
    TJOB(a.in[I_WCO], 1024, 1024, 1024, WS_WCO, nullptr, 0, 0);
    TJOB(a.in[I_WFFI], 2 * DFF, 1024, 2 * DFF, WS_WFFI, a.in[I_NFFNG], 1, 0);
    TJOB(a.in[I_WFFO], 1024, DFF, 1024, WS_WFFO, nullptr, 0, 0);
#undef TJOB
    { float* z1 = (float*)(ws + WS_SSP1); float* z2 = (float*)(ws + WS_SSP2); float* z3 = (float*)(ws + WS_SSP3);
      for (int i = blockIdx.x * 512 + wave * 64 + lane; i < T; i += G * 512) { z1[i] = 0.f; z2[i] = 0.f; z3[i] = 0.f; } }
    const int gid = blockIdx.x * 512 + wave * 64 + lane, NT = G * 512;
    { bf16_t* WL = (bf16_t*)(ws + WS_WLORA);
      for (int i = gid; i < 1536 * 256; i += NT) { const int n = i >> 8, k = i & 255, kind = n >> 9, c = n & 511; float v = 0.f;
          if (kind == 0 && k < 64) v = a.in[I_WUP][k * 512 + c]; else if (kind == 1 && k >= 64 && k < 128) v = a.in[I_AUP][(k - 64) * 512 + c]; else if (kind == 2 && k >= 128) v = a.in[I_GUP][(k - 128) * 512 + c];
          WL[i] = f2bf(v); } }
    { bf16_t* WR = (bf16_t*)(ws + WS_WRG);
      for (int i = gid; i < 1024 * 256; i += NT) { const int n = i >> 8, kk = i & 255, pn = n >> 8, c = n & 255, ch = pn * 128 + (c & 127), hb = ch >> 6, j = ch & 63, k = 256 * (pn >> 1) + kk; float v = 0.f;
          if ((k >> 6) == hb) v = (c < 128 ? a.in[I_WRGA] : a.in[I_WRGX])[(hb * 64 + (k & 63)) * 64 + j];
          WR[i] = f2bf(v); } }
    { const float* x = a.in[I_X]; bf16_t* XB = (bf16_t*)(ws + WS_XB); float* rstd = (float*)(ws + WS_RSTDX);
      for (int r0 = gw; r0 < T; r0 += 4 * NGW) {
          f32x4 v[4][4]; float s[4];
#pragma unroll
          for (int q = 0; q < 4; ++q) { const int r = r0 + q * NGW; s[q] = 0.f; if (r < T) { const f32x4* xr = (const f32x4*)(x + (size_t)r * D) + lane;
#pragma unroll
              for (int j = 0; j < 4; ++j) v[q][j] = xr[64 * j]; } else {
#pragma unroll
              for (int j = 0; j < 4; ++j) v[q][j] = (f32x4){0.f, 0.f, 0.f, 0.f}; } }
#pragma unroll
          for (int q = 0; q < 4; ++q) {
#pragma unroll
              for (int j = 0; j < 4; ++j) s[q] += (v[q][j].x * v[q][j].x + v[q][j].y * v[q][j].y) + (v[q][j].z * v[q][j].z + v[q][j].w * v[q][j].w);
              s[q] = wave_sum(s[q]); }
#pragma unroll
          for (int q = 0; q < 4; ++q) { const int r = r0 + q * NGW; if (r < T) { if (lane == 0) rstd[r] = rsqrtf(s[q] * (1.0f / D) + NORM_EPS);
              u32x2* o = (u32x2*)(XB + (size_t)r * D) + lane;
#pragma unroll
              for (int j = 0; j < 4; ++j) { u32x2 w; w.x = cvt_pk_bf16(v[q][j].x, v[q][j].y); w.y = cvt_pk_bf16(v[q][j].z, v[q][j].w); o[64 * j] = w; } } } } }
    { const float* x = a.in[I_MEM]; bf16_t* XB = (bf16_t*)(ws + WS_MEMN); const float* g = a.in[I_NMEMG];
      for (int r = gw; r < TM; r += NGW) { const f32x4* xr = (const f32x4*)(x + (size_t)r * D) + lane; f32x4 v[4]; float s = 0.f;
#pragma unroll
          for (int j = 0; j < 4; ++j) { v[j] = xr[64 * j]; s += (v[j].x * v[j].x + v[j].y * v[j].y) + (v[j].z * v[j].z + v[j].w * v[j].w); }
          s = wave_sum(s); const float rs = rsqrtf(s * (1.0f / D) + NORM_EPS);
          u32x2* o = (u32x2*)(XB + (size_t)r * D) + lane;
#pragma unroll
          for (int j = 0; j < 4; ++j) { const f32x4 gg = ((const f32x4*)g)[lane + 64 * j]; u32x2 w; w.x = cvt_pk_bf16(v[j].x * rs * gg.x, v[j].y * rs * gg.y); w.y = cvt_pk_bf16(v[j].z * rs * gg.z, v[j].w * rs * gg.w); o[64 * j] = w; } } }
}

__device__ __forceinline__ void phase_elem2(const Args& a, int wave, int G) {
    unsigned char* ws = a.ws;
    const bf16_t* PR = (const bf16_t*)(ws + WS_PR); const bf16_t* PX = (const bf16_t*)(ws + WS_PX);
    bf16_t* LIN = (bf16_t*)(ws + WS_LIN); bf16_t* XBC = (bf16_t*)(ws + WS_XBC);
    const float* mu = a.in[I_MU]; const float* cw = a.in[I_CBW]; const float* cb = a.in[I_CBB];
    const size_t gid = (size_t)blockIdx.x * 512 + wave * 64 + lane_id(), NT = (size_t)G * 512;
    for (size_t i = gid; i < (size_t)T * 96; i += NT) {
        const int t = (int)(i / 96), q = (int)(i % 96), tl = t & (SEQ - 1);
        if (q < 32) { const int c = q * 8; float p[8], pp[8], o[8];
            unpack8(*(const u32x4*)(PR + (size_t)t * RW + 1536 + c), p);
            if (tl > 0) unpack8(*(const u32x4*)(PR + (size_t)(t - 1) * RW + 1536 + c), pp); else {
#pragma unroll
                for (int j = 0; j < 8; ++j) pp[j] = 0.f; }
#pragma unroll
            for (int j = 0; j < 8; ++j) { const float v = p[j] + (pp[j] - p[j]) * mu[1536 + c + j];
                o[j] = c < 64 ? tanhf(v) : (c < 128 ? v : sigmoidf_(v)); }
            *(u32x4*)(LIN + (size_t)t * 256 + c) = pack8(o);
        } else { const int c = (q - 32) * 8; float o[8];
#pragma unroll
            for (int j = 0; j < 8; ++j) o[j] = cb[c + j];
#pragma unroll
            for (int k = 0; k < 4; ++k) { const int dt = 3 - k; if (tl >= dt) { float p[8]; unpack8(*(const u32x4*)(PX + (size_t)(t - dt) * 512 + c), p);
#pragma unroll
                for (int j = 0; j < 8; ++j) o[j] += p[j] * cw[k * 512 + c + j]; } }
            *(u32x4*)(XBC + (size_t)t * 512 + c) = pack8(o);
        }
    }
}

#define DPP_BC(JJ) " row_newbcast:" #JJ " row_mask:0xf bank_mask:0xf"
#define RW_SA(JJ)  asm("v_fmac_f32_dpp %0, %1, %2" DPP_BC(JJ) : "+v"(sacc[JJ & 3]) : "v"(va), "v"(S[JJ]));
#define RW_UPD(JJ) { float t_; \
    asm("v_mul_f32_dpp %0, %1, %2" DPP_BC(JJ) : "=v"(t_) : "v"(vb), "v"(sa)); \
    asm("v_fmac_f32_dpp %0, %1, %2" DPP_BC(JJ) : "+v"(t_) : "v"(vk), "v"(vv)); \
    asm("v_fmac_f32_dpp %0, %1, %2" DPP_BC(JJ) : "+v"(t_) : "v"(vw), "v"(S[JJ])); \
    S[JJ] = t_; \
    asm("v_fmac_f32_dpp %0, %1, %2" DPP_BC(JJ) : "+v"(yacc[JJ & 3]) : "v"(vr), "v"(S[JJ])); }
#define RW_ALL16(M) M(0) M(1) M(2) M(3) M(4) M(5) M(6) M(7) M(8) M(9) M(10) M(11) M(12) M(13) M(14) M(15)

constexpr int RB = 32;
constexpr int PSTEP = 6 * 64;
constexpr int PBUF = RB * PSTEP * 4;

__device__ __forceinline__ float dpp_ror_add(float v, const int ctrl_sel) {
    int t;
    switch (ctrl_sel) {
        case 8: t = __builtin_amdgcn_update_dpp(0, __float_as_int(v), 0x128, 0xf, 0xf, false); break;
        case 4: t = __builtin_amdgcn_update_dpp(0, __float_as_int(v), 0x124, 0xf, 0xf, false); break;
        case 2: t = __builtin_amdgcn_update_dpp(0, __float_as_int(v), 0x122, 0xf, 0xf, false); break;
        default: t = __builtin_amdgcn_update_dpp(0, __float_as_int(v), 0x121, 0xf, 0xf, false); break;
    }
    return v + __int_as_float(t);
}
__device__ __forceinline__ float cross_row_allsum(float v) {
    auto r = __builtin_amdgcn_permlane32_swap(__float_as_uint(v), __float_as_uint(v), false, false);
    v = __uint_as_float(r[0]) + __uint_as_float(r[1]);
    auto r2 = __builtin_amdgcn_permlane16_swap(__float_as_uint(v), __float_as_uint(v), false, false);
    return __uint_as_float(r2[0]) + __uint_as_float(r2[1]);
}
__device__ __forceinline__ float wave_allsum(float v) {
    v = dpp_ror_add(v, 8); v = dpp_ror_add(v, 4); v = dpp_ror_add(v, 2); v = dpp_ror_add(v, 1);
    return cross_row_allsum(v);
}
__device__ __forceinline__ void lds_barrier() { asm volatile("s_waitcnt lgkmcnt(0)" ::: "memory"); __builtin_amdgcn_s_barrier(); asm volatile("" ::: "memory"); }

__device__ __forceinline__ void rwkv_prep_block(const Args& a, LAS float* pb, int tok0, int h, int p, int lane, float mu_r, float mu_k, float mu_v, float ckk, float cka, float crk) {
    const bf16_t* PR = (const bf16_t*)(a.ws + WS_PR); const bf16_t* LOUT = (const bf16_t*)(a.ws + WS_LOUT); float* BON = (float*)(a.ws + WS_BON);
#pragma unroll
    for (int i = 0; i < RB / 4; ++i) {
        const int s = p * (RB / 4) + i; const int tok = tok0 + s; const bool has_prev = (tok & (SEQ - 1)) != 0;
        const bf16_t* prow = PR + (size_t)tok * RW + h * 64 + lane; const bf16_t* qrow = has_prev ? prow - RW : prow;
        const bf16_t* lrow = LOUT + (size_t)tok * 1536 + h * 64 + lane;
        const float rr = bf1(prow[0]), kr = bf1(prow[512]), vr_ = bf1(prow[1024]);
        const float rp = has_prev ? bf1(qrow[0]) : 0.f, kp = has_prev ? bf1(qrow[512]) : 0.f, vp = has_prev ? bf1(qrow[1024]) : 0.f;
        const float e = bf1(lrow[0]), av = bf1(lrow[512]);
        const float r = rr + (rp - rr) * mu_r, k0 = kr + (kp - kr) * mu_k, v = vr_ + (vp - vr_) * mu_v;
        const float w = __expf(-e);
        const float kk = k0 * ckk; const float n2 = wave_allsum(kk * kk); const float kkn = kk / fmaxf(sqrtf(n2), 1e-12f);
        const float k2 = k0 * (1.0f + (av - 1.0f) * cka);
        const float bon = wave_allsum(r * k2 * crk);
        LAS float* pp = pb + s * PSTEP;
        pp[lane] = -kkn; pp[64 + lane] = kkn * av; pp[128 + lane] = k2; pp[192 + lane] = w; pp[256 + lane] = r; pp[320 + lane] = v;
        if (lane == 0) BON[(size_t)tok * 8 + h] = bon;
    }
}

__device__ __forceinline__ void phase_scan(const Args& a, LAS unsigned char* lds, int wave, int G) {
    const int lane = lane_id();
    unsigned char* ws = a.ws;
    constexpr int SB = 16, NBLK = SEQ / RB;
    for (int pair = blockIdx.x; pair < 256; pair += G) {
        const int b = pair >> 3, h = pair & 7, tokb = b * SEQ;
        const int il = lane & 15, irow = 16 * (wave & 3) + il;
        float S[16];
#pragma unroll
        for (int j = 0; j < 16; ++j) S[j] = 0.f;
        const float mu_r = a.in[I_MU][h * 64 + lane], mu_k = a.in[I_MU][512 + h * 64 + lane], mu_v = a.in[I_MU][1024 + h * 64 + lane];
        const float ckk = a.in[I_KK][h * 64 + lane], cka = a.in[I_KA][h * 64 + lane], crk = a.in[I_RK][h * 64 + lane];
        bf16_t* YRAW = (bf16_t*)(ws + WS_YRAW);
        const size_t base = (size_t)tokb * 512 + h * 64 + lane;
        const bf16_t* LA = (const bf16_t*)(ws + WS_RGLA) + base; const bf16_t* U = (const bf16_t*)(ws + WS_RGU) + base; const bf16_t* PY = (const bf16_t*)(ws + WS_PY) + base;
        bf16_t* YB = (bf16_t*)(ws + WS_YB) + base;
        bf16_t cla[SB], cu[SB], cpy[SB]; float hh = 0.f;
        if (wave == 4) {
#pragma unroll
            for (int s = 0; s < SB; ++s) { cla[s] = LA[(size_t)s * 512]; cu[s] = U[(size_t)s * 512]; cpy[s] = PY[(size_t)s * 512]; }
        } else {
#pragma unroll
            for (int s = 0; s < SB; ++s) { cla[s] = 0; cu[s] = 0; cpy[s] = 0; }
        }
        if (wave >= 4) rwkv_prep_block(a, (LAS float*)lds, tokb, h, wave - 4, lane, mu_r, mu_k, mu_v, ckk, cka, crk);
        lds_barrier();
        for (int blk = 0; blk < NBLK; ++blk) {
            if (wave < 4) {
                const LAS float* pb = (const LAS float*)(lds + (blk & 1) * PBUF);
#pragma unroll 2
                for (int s = 0; s < RB; ++s) {
                    const LAS float* pp = pb + s * PSTEP;
                    float va = pp[lane], vb = pp[64 + lane], vk = pp[128 + lane], vw = pp[192 + lane], vr = pp[256 + lane]; const float vv = pp[320 + irow];
                    asm volatile("s_nop 1" : "+v"(va), "+v"(vb), "+v"(vk), "+v"(vw), "+v"(vr));
                    float sacc[4] = {0.f, 0.f, 0.f, 0.f}, yacc[4] = {0.f, 0.f, 0.f, 0.f};
                    RW_ALL16(RW_SA)
                    float sa = (sacc[0] + sacc[1]) + (sacc[2] + sacc[3]);
                    sa = cross_row_allsum(sa);
                    RW_ALL16(RW_UPD)
                    float y = (yacc[0] + yacc[1]) + (yacc[2] + yacc[3]);
                    y = cross_row_allsum(y);
                    const int tok = tokb + blk * RB + s;
                    if (lane < 16) YRAW[(size_t)tok * 512 + h * 64 + irow] = f2bf(y);
                }
            } else {
                if (blk + 1 < NBLK) rwkv_prep_block(a, (LAS float*)(lds + ((blk + 1) & 1) * PBUF), tokb + (blk + 1) * RB, h, wave - 4, lane, mu_r, mu_k, mu_v, ckk, cka, crk);
                if (wave == 4) {
                    for (int sub = 0; sub < RB / SB; ++sub) {
                        const int t0 = blk * RB + sub * SB, tn = (t0 + SB < SEQ) ? t0 + SB : t0;
                        bf16_t nla[SB], nu[SB], npy[SB];
#pragma unroll
                        for (int s = 0; s < SB; ++s) { nla[s] = LA[(size_t)(tn + s) * 512]; nu[s] = U[(size_t)(tn + s) * 512]; npy[s] = PY[(size_t)(tn + s) * 512]; }
#pragma unroll
                        for (int s = 0; s < SB; ++s) { hh = __expf(bf1(cla[s])) * hh + bf1(cu[s]); YB[(size_t)(t0 + s) * 512] = f2bf(hh * gelu_tanh(bf1(cpy[s]))); }
#pragma unroll
                        for (int s = 0; s < SB; ++s) { cla[s] = nla[s]; cu[s] = nu[s]; cpy[s] = npy[s]; }
                    }
                }
            }
            lds_barrier();
        }
    }
    asm volatile("s_waitcnt vmcnt(0)" ::: "memory");
}

__device__ __forceinline__ void phase_post(const Args& a, int wave, int G) {
    unsigned char* ws = a.ws;
    const bf16_t* PR = (const bf16_t*)(ws + WS_PR); const bf16_t* LOUT = (const bf16_t*)(ws + WS_LOUT); const bf16_t* YRAW = (const bf16_t*)(ws + WS_YRAW);
    const float* BON = (const float*)(ws + WS_BON); bf16_t* YA = (bf16_t*)(ws + WS_YA);
    const float* mu = a.in[I_MU]; const float* lg = a.in[I_LNXG]; const float* lb = a.in[I_LNXB];
    const size_t gid = (size_t)blockIdx.x * 512 + wave * 64 + lane_id(), NT = (size_t)G * 512;
    for (size_t i = gid; i < (size_t)T * 64; i += NT) {
        const int t = (int)(i >> 6), c = (int)(i & 63) * 8, h = c >> 6, tl = t & (SEQ - 1);
        float y[8], v[8], vp[8], g[8], o[8];
        unpack8(*(const u32x4*)(YRAW + (size_t)t * 512 + c), y);
        unpack8(*(const u32x4*)(PR + (size_t)t * RW + 1024 + c), v);
        if (tl > 0) unpack8(*(const u32x4*)(PR + (size_t)(t - 1) * RW + 1024 + c), vp); else {
#pragma unroll
            for (int j = 0; j < 8; ++j) vp[j] = 0.f; }
        unpack8(*(const u32x4*)(LOUT + (size_t)t * 1536 + 1024 + c), g);
        float s = 0.f;
#pragma unroll
        for (int j = 0; j < 8; ++j) s += y[j];
        s += __shfl_xor(s, 1); s += __shfl_xor(s, 2); s += __shfl_xor(s, 4);
        const float mean = s * (1.0f / 64.0f); float q = 0.f;
#pragma unroll
        for (int j = 0; j < 8; ++j) { const float d = y[j] - mean; q += d * d; }
        q += __shfl_xor(q, 1); q += __shfl_xor(q, 2); q += __shfl_xor(q, 4);
        const float rs = rsqrtf(q * (1.0f / 64.0f) + LNX_EPS), bon = BON[(size_t)t * 8 + h];
#pragma unroll
        for (int j = 0; j < 8; ++j) { const float vv = v[j] + (vp[j] - v[j]) * mu[1024 + c + j];
            o[j] = ((y[j] - mean) * rs * lg[c + j] + lb[c + j] + bon * vv) * g[j]; }
        *(u32x4*)(YA + (size_t)t * 512 + c) = pack8(o);
    }
}

__device__ __forceinline__ void phase_ffnfix(const Args& a, int wave, int G) {
    unsigned char* ws = a.ws;
    const bf16_t* HG = (const bf16_t*)(ws + WS_HG); bf16_t* ACT = (bf16_t*)(ws + WS_UU);
    const float* cw = a.in[I_FCW]; const float* cb = a.in[I_FCB];
    const size_t gid = (size_t)blockIdx.x * 512 + wave * 64 + lane_id(), NT = (size_t)G * 512;
    constexpr int CPR = DFF / 8;
    for (size_t i = gid; i < (size_t)(T / 64) * 2 * CPR; i += NT) {
        const int c = (int)(i % CPR) * 8, rho = (int)((i / CPR) & 1), grp = (int)(i / (2 * CPR)); const int t = grp * 64 + rho; const bool first = (grp & 31) == 0;
        float p2[8], p1[8], cur[8], up[8], o[8];
#pragma unroll
        for (int j = 0; j < 8; ++j) { p2[j] = 0.f; p1[j] = 0.f; }
        if (rho == 0) { if (!first) { unpack8(*(const u32x4*)(HG + ((size_t)(grp - 1) * 4 + 0) * DFF + c), p2); unpack8(*(const u32x4*)(HG + ((size_t)(grp - 1) * 4 + 1) * DFF + c), p1); } }
        else { if (!first) unpack8(*(const u32x4*)(HG + ((size_t)(grp - 1) * 4 + 1) * DFF + c), p2); unpack8(*(const u32x4*)(HG + ((size_t)grp * 4 + 2) * DFF + c), p1); }
        unpack8(*(const u32x4*)(HG + ((size_t)grp * 4 + 2 + rho) * DFF + c), cur);
        unpack8(*(const u32x4*)(ACT + (size_t)t * DFF + c), up);
#pragma unroll
        for (int j = 0; j < 8; ++j) o[j] = gelu_tanh(cb[c + j] + cw[c + j] * p2[j] + cw[DFF + c + j] * p1[j] + cw[2 * DFF + c + j] * cur[j]) * up[j];
        *(u32x4*)(ACT + (size_t)t * DFF + c) = pack8(o);
    }
}

__device__ __forceinline__ void phase_final(const Args& a, int wave, int G) {
    const int lane = lane_id();
    const float* ssp = (const float*)(a.ws + WS_SSP3); const float* g = a.in[I_NFING]; const bf16_t* X3 = (const bf16_t*)(a.ws + WS_X3B);
    const int gw = blockIdx.x * 8 + wave, NGW = G * 8;
    for (int r0 = gw; r0 < T; r0 += 4 * NGW) {
        u32x4 v[4][2]; float rs[4];
#pragma unroll
        for (int q = 0; q < 4; ++q) { const int r = r0 + q * NGW; if (r < T) { rs[q] = rstd_from16(ssp, r); const u32x4* xr = (const u32x4*)(X3 + (size_t)r * D) + lane; v[q][0] = xr[0]; v[q][1] = xr[64]; } }
#pragma unroll
        for (int q = 0; q < 4; ++q) { const int r = r0 + q * NGW; if (r < T) {
#pragma unroll
            for (int j = 0; j < 2; ++j) { float x[8]; unpack8(v[q][j], x); const int c = 512 * j + 8 * lane; const f32x4 g0 = *(const f32x4*)(g + c), g1 = *(const f32x4*)(g + c + 4);
                f32x4* o = (f32x4*)(a.out + (size_t)r * D + c);
                o[0] = (f32x4){x[0] * rs[q] * g0[0], x[1] * rs[q] * g0[1], x[2] * rs[q] * g0[2], x[3] * rs[q] * g0[3]};
                o[1] = (f32x4){x[4] * rs[q] * g1[0], x[5] * rs[q] * g1[1], x[6] * rs[q] * g1[2], x[7] * rs[q] * g1[3]}; } } }
    }
}

constexpr int NPHASE = 13;
__global__ void __launch_bounds__(512, 2) mega(Args a) {
    extern __shared__ __attribute__((aligned(16))) unsigned char lds_raw[];
    LAS unsigned char* lds = (LAS unsigned char*)lds_raw;
    cg::grid_group grid = cg::this_grid();
    const int wave = __builtin_amdgcn_readfirstlane((int)threadIdx.x >> 6), G = gridDim.x, bid = blockIdx.x;
    unsigned char* ws = a.ws;
    const int lo = a.ph_lo, hi = a.ph_hi;
    const bool t0 = (wave == 0) && (lane_id() == 0);
    volatile LAS unsigned* misc = (volatile LAS unsigned*)(lds + 131072 + 320);
    if (t0) { misc[0] = 0u; misc[1] = 0u; }
    __syncthreads();
    XcdBarrier xb = xcd_barrier_post((unsigned*)(ws + WS_CTL), misc, t0);
    if (a.ph_hi < 0) grid.sync();
#define IN(k) (lo <= (k) && (k) < hi)
#define SEAM(k) do { if (IN(k) && IN((k) + 1)) xcd_barrier(xb, t0); } while (0)
    bf16_t* const XB = (bf16_t*)(ws + WS_XB);
    const float* rstdx = (const float*)(ws + WS_RSTDX);
    StaticOrder S;

    if (IN(0)) for (int rep_ = 0; rep_ < REPS(0); ++rep_) { phase_prep(a, lds, wave, G); __syncthreads(); } SEAM(0);

    if (IN(1)) for (int rep_ = 0; rep_ < REPS(1); ++rep_) {
        { Gemm g = plain_gemm(XB, (const bf16_t*)(ws + WS_WIN), 1024); S.init(T / BM, 11, G, bid);
          EpiProj E{rstdx, a.in[I_BIN], (bf16_t*)(ws + WS_PR), (bf16_t*)(ws + WS_PX), (bf16_t*)(ws + WS_PY)}; gemm_phase(lds, wave, g, S, E); }
        if ((G & 15) == 0) {
            const int hg = G >> 1, hb_ = (bid >> 4) * 8 + (bid & 7);
            if (((bid >> 3) & 1) == 0) { Gemm g = plain_gemm((const bf16_t*)(ws + WS_MEMN), (const bf16_t*)(ws + WS_WK), 1024); S.init(TM / BM, 4, hg, hb_);
                EpiPlain E{(bf16_t*)(ws + WS_KM), 1024}; gemm_phase(lds, wave, g, S, E); }
            else { Gemm g = plain_gemm((const bf16_t*)(ws + WS_WV), (const bf16_t*)(ws + WS_MEMN), 1024); S.init(4, TM / BM, hg, hb_);
                EpiPlain E{(bf16_t*)(ws + WS_VT), TM}; gemm_phase(lds, wave, g, S, E); }
        } else {
            { Gemm g = plain_gemm((const bf16_t*)(ws + WS_MEMN), (const bf16_t*)(ws + WS_WK), 1024); S.init(TM / BM, 4, G, bid);
              EpiPlain E{(bf16_t*)(ws + WS_KM), 1024}; gemm_phase(lds, wave, g, S, E); }
            { Gemm g = plain_gemm((const bf16_t*)(ws + WS_WV), (const bf16_t*)(ws + WS_MEMN), 1024); S.init(4, TM / BM, G, bid);
              EpiPlain E{(bf16_t*)(ws + WS_VT), TM}; gemm_phase(lds, wave, g, S, E); }
        }
    } SEAM(1);

    if (IN(2)) for (int rep_ = 0; rep_ < REPS(2); ++rep_) phase_elem2(a, wave, G); SEAM(2);
#ifdef PROBE_SYNC
    for (int i_ = 0; i_ < 16; ++i_) grid.sync();
#endif

    if (IN(3)) for (int rep_ = 0; rep_ < REPS(3); ++rep_) {
        { Gemm g = plain_gemm((const bf16_t*)(ws + WS_LIN), (const bf16_t*)(ws + WS_WLORA), 256); S.init(T / BM, 6, G, bid);
          EpiLora E{a.in[I_W0], a.in[I_A0], (bf16_t*)(ws + WS_LOUT)}; gemm_phase(lds, wave, g, S, E); }
        { Gemm g = plain_gemm((const bf16_t*)(ws + WS_XBC), (const bf16_t*)(ws + WS_WRG), 256); g.lda = 512; g.a_pm = (size_t)BM * 512 * 2; g.a_pn2 = 512; S.init(T / BM, 4, G, bid);
          EpiRg E{a.in[I_BRGA], a.in[I_BRGX], a.in[I_LAM], (const bf16_t*)(ws + WS_XBC), (bf16_t*)(ws + WS_RGLA), (bf16_t*)(ws + WS_RGU)}; gemm_phase(lds, wave, g, S, E); }
    } SEAM(3);

    if (IN(4)) for (int rep_ = 0; rep_ < REPS(4); ++rep_) phase_scan(a, lds, wave, G); SEAM(4);
    if (IN(5)) for (int rep_ = 0; rep_ < REPS(5); ++rep_) phase_post(a, wave, G); SEAM(5);

    if (IN(6)) for (int rep_ = 0; rep_ < REPS(6); ++rep_) {
        S.init(T / BM, 4, G, bid);
        { Gemm g = plain_gemm(XB, (const bf16_t*)(ws + WS_WIN) + (size_t)2816 * 1024, 1024); EpiGab E{rstdx, a.in[I_BIN] + 2816, (bf16_t*)(ws + WS_GAB), 0}; gemm_phase(lds, wave, g, S, E); }
        { Gemm g = plain_gemm((const bf16_t*)(ws + WS_YA), (const bf16_t*)(ws + WS_WA), 512); EpiBranch<true> E{(const bf16_t*)(ws + WS_GAB), (bf16_t*)(ws + WS_MERGED)}; gemm_phase(lds, wave, g, S, E); }
        { Gemm g = plain_gemm(XB, (const bf16_t*)(ws + WS_WIN) + (size_t)3840 * 1024, 1024); EpiGab E{rstdx, a.in[I_BIN] + 2816, (bf16_t*)(ws + WS_GAB), 1024}; gemm_phase(lds, wave, g, S, E); }
        { Gemm g = plain_gemm((const bf16_t*)(ws + WS_YB), (const bf16_t*)(ws + WS_WB), 512); EpiBranch<false> E{(const bf16_t*)(ws + WS_GAB), (bf16_t*)(ws + WS_MERGED)}; gemm_phase(lds, wave, g, S, E); }
    } SEAM(6);
    if (IN(7)) for (int rep_ = 0; rep_ < REPS(7); ++rep_) { Gemm g = plain_gemm((const bf16_t*)(ws + WS_MERGED), (const bf16_t*)(ws + WS_WMIX), 1024); S.init(T / BM, 4, G, bid);
        EpiRes<true> E{a.in[I_X], (bf16_t*)(ws + WS_X1B), (float*)(ws + WS_SSP1)}; gemm_phase(lds, wave, g, S, E); } SEAM(7);
    if (IN(8)) for (int rep_ = 0; rep_ < REPS(8); ++rep_) {
        S.init(T / BM, 4, G, bid);
        { Gemm g = plain_gemm((const bf16_t*)(ws + WS_X1B), (const bf16_t*)(ws + WS_WCQ), 1024);
          EpiQ E{(const float*)(ws + WS_SSP1), (bf16_t*)(ws + WS_Q)}; gemm_phase(lds, wave, g, S, E); }
        { Gemm g; g.A = (const bf16_t*)(ws + WS_Q); g.Bt = (const bf16_t*)(ws + WS_KM); g.lda = 1024; g.ldb = 1024; g.K = 256;
          g.a_pm = (size_t)BM * 1024 * 2; g.a_pn = 512; g.b_pn = 512; g.b_pb = (size_t)NMEM * 1024 * 2; g.a_pn2 = 0;
          EpiSc E{(bf16_t*)(ws + WS_PEXP), (float*)(ws + WS_SSPA)}; gemm_phase(lds, wave, g, S, E); }
        { Gemm g; g.A = (const bf16_t*)(ws + WS_PEXP); g.Bt = (const bf16_t*)(ws + WS_VT); g.lda = 1024; g.ldb = TM; g.K = 256;
          g.a_pm = (size_t)BM * 1024 * 2; g.a_pn = 512; g.b_pn = (size_t)256 * TM * 2; g.b_pb = 512; g.a_pn2 = 0;
          EpiPv E{(const float*)(ws + WS_SSPA), (bf16_t*)(ws + WS_O)}; gemm_phase(lds, wave, g, S, E); }
    } SEAM(8);
    if (IN(9)) for (int rep_ = 0; rep_ < REPS(9); ++rep_) { Gemm g = plain_gemm((const bf16_t*)(ws + WS_O), (const bf16_t*)(ws + WS_WCO), 1024); S.init(T / BM, 4, G, bid);
        EpiRes<false> E{(const bf16_t*)(ws + WS_X1B), (bf16_t*)(ws + WS_X2B), (float*)(ws + WS_SSP2)}; gemm_phase(lds, wave, g, S, E); } SEAM(9);
    if (IN(10)) for (int rep_ = 0; rep_ < REPS(10); ++rep_) { Gemm g = plain_gemm((const bf16_t*)(ws + WS_X2B), (const bf16_t*)(ws + WS_WFFI), 1024); S.init(T / BM, 22, G, bid);
        EpiFfnAct E{(const float*)(ws + WS_SSP2), a.in[I_FCW], a.in[I_FCB], (bf16_t*)(ws + WS_UU), (bf16_t*)(ws + WS_HG)}; gemm_phase(lds, wave, g, S, E); } SEAM(10);
    if (IN(11)) for (int rep_ = 0; rep_ < REPS(11); ++rep_) phase_ffnfix(a, wave, G); SEAM(11);
    if (IN(12)) for (int rep_ = 0; rep_ < REPS(12); ++rep_) { Gemm g = plain_gemm((const bf16_t*)(ws + WS_UU), (const bf16_t*)(ws + WS_WFFO), DFF); S.init(T / BM, 4, G, bid);
        EpiRes<false> E{(const bf16_t*)(ws + WS_X2B), (bf16_t*)(ws + WS_X3B), (float*)(ws + WS_SSP3)}; gemm_phase(lds, wave, g, S, E); } SEAM(12);
    if (IN(13)) for (int rep_ = 0; rep_ < REPS(13); ++rep_) phase_final(a, wave, G);
#undef IN
#undef SEAM
}

extern "C" void kernel_launch(void* const* d_in, const int* in_sizes, int n_in, void* d_out, int out_size, void* d_ws, size_t ws_size, hipStream_t stream) {
    static int grid = 0;
    if (grid == 0) {
        if (n_in != 37 || in_sizes[0] != T * D || out_size != T * D || ws_size < WS_END) {
            fprintf(stderr, "kernel_launch: unexpected shapes (n_in %d, in0 %d, out %d, ws %zu < %zu); nothing launched\n", n_in, n_in > 0 ? in_sizes[0] : -1, out_size, ws_size, (size_t)WS_END); grid = -1; return; }
        int dev = 0, cus = 0, per_cu = 0;
        if (hipGetDevice(&dev) != hipSuccess || hipDeviceGetAttribute(&cus, hipDeviceAttributeMultiprocessorCount, dev) != hipSuccess) { grid = -1; return; }
        if (hipFuncSetAttribute((const void*)mega, hipFuncAttributeMaxDynamicSharedMemorySize, LDS_BYTES) != hipSuccess) { fprintf(stderr, "kernel_launch: hipFuncSetAttribute failed\n"); grid = -1; return; }
        if (hipOccupancyMaxActiveBlocksPerMultiprocessor(&per_cu, (const void*)mega, 512, LDS_BYTES) != hipSuccess || per_cu < 1) { fprintf(stderr, "kernel_launch: occupancy query says %d\n", per_cu); per_cu = 1; }
        (void)hipGetLastError();
        grid = cus * 1;
    }
    if (grid < 0) return;
    if (hipMemsetAsync((char*)d_ws + WS_CTL, 0, CTL_BYTES, stream) != hipSuccess) { fprintf(stderr, "kernel_launch: memset failed\n"); return; }
    Args a{};
    for (int i = 0; i < 37; ++i) a.in[i] = (const float*)d_in[i];
    a.out = (float*)d_out; a.ws = (unsigned char*)d_ws;
#if MK_SPLIT
    for (int ph = 0; ph <= NPHASE; ++ph) {
        a.ph_lo = ph; a.ph_hi = ph + 1; void* args[] = {&a};
        hipError_t e = hipLaunchCooperativeKernel((const void*)mega, dim3(grid), dim3(512), args, LDS_BYTES, stream);
        if (e != hipSuccess) { fprintf(stderr, "kernel_launch: launch of phase %d failed: %s\n", ph, hipGetErrorString(e)); break; }
    }
#else
    a.ph_lo = 0; a.ph_hi = NPHASE + 1; void* args[] = {&a};
    hipError_t e = hipLaunchCooperativeKernel((const void*)mega, dim3(grid), dim3(512), args, LDS_BYTES, stream);
    if (e != hipSuccess) fprintf(stderr, "kernel_launch: cooperative launch failed: %s (grid %d)\n", hipGetErrorString(e), grid);
#endif
}
```

```cpp
#include <hip/hip_runtime.h>
#include <hip/hip_cooperative_groups.h>
#include <cstdio>
namespace cg = cooperative_groups;

#ifndef MK_SPLIT
#define MK_SPLIT 0
#endif

#ifndef DUP_PHASE
#define DUP_PHASE -1
#endif
#define REPS(k) ((DUP_PHASE == (k)) ? 2 : 1)
#define LAS __attribute__((address_space(3)))
typedef unsigned short bf16_t;
typedef short bf16x8 __attribute__((ext_vector_type(8)));
typedef float f32x4 __attribute__((ext_vector_type(4)));
typedef float f32x2 __attribute__((ext_vector_type(2)));
typedef unsigned u32x4 __attribute__((ext_vector_type(4)));
typedef unsigned u32x2 __attribute__((ext_vector_type(2)));

constexpr int T = 65536, D = 1024, SEQ = 2048, NB = 32, NMEM = 256, TM = NB * NMEM;
constexpr int AW = 512, RW = 1792, PIN = 4864, DFF = 2816;
constexpr float NORM_EPS = 1e-6f, LNX_EPS = 64e-5f;

constexpr size_t MiB = 1u << 20;
constexpr size_t WS_WIN = 0;
constexpr size_t WS_WFFI = 10 * MiB;
constexpr size_t WS_WFFO = 21 * MiB;
constexpr size_t WS_WMIX = 27 * MiB, WS_WCQ = 29 * MiB, WS_WK = 31 * MiB, WS_WV = 33 * MiB, WS_WCO = 35 * MiB;
constexpr size_t WS_WA = 37 * MiB, WS_WB = 38 * MiB;
constexpr size_t WS_WLORA = 39 * MiB;
constexpr size_t WS_WRG = 40 * MiB;
constexpr size_t WS_CTL = 46 * MiB, CTL_BYTES = 16384;
constexpr size_t WS_RSTDX = 48 * MiB;
constexpr size_t WS_SSP1 = 49 * MiB, WS_SSP2 = 53 * MiB, WS_SSP3 = 57 * MiB, WS_SSPA = 61 * MiB;
constexpr size_t WS_BON = 65 * MiB;
constexpr size_t WS_MEMN = 68 * MiB, WS_KM = 84 * MiB, WS_VT = 100 * MiB;
constexpr size_t WS_XB = 120 * MiB;
constexpr size_t WS_PR = 248 * MiB;
constexpr size_t WS_PX = 472 * MiB, WS_PY = 536 * MiB;
constexpr size_t WS_LIN = 600 * MiB, WS_XBC = 632 * MiB;
constexpr size_t WS_LOUT = 696 * MiB;
constexpr size_t WS_RGLA = 888 * MiB, WS_RGU = 952 * MiB;
constexpr size_t WS_YRAW = WS_PX, WS_YB = WS_LIN, WS_YA = WS_RGLA;
constexpr size_t WS_GAB = 248 * MiB;
constexpr size_t WS_MERGED = 696 * MiB;
constexpr size_t WS_X1B = WS_XB, WS_Q = 248 * MiB, WS_PEXP = 376 * MiB, WS_O = 504 * MiB, WS_X2B = WS_XB;
constexpr size_t WS_X3B = 376 * MiB;
constexpr size_t WS_HG = 248 * MiB, WS_UU = 600 * MiB;
constexpr size_t WS_END = 1016 * MiB;

constexpr int LDS_BYTES = 147456;

__device__ __forceinline__ unsigned cvt_pk_bf16(float lo, float hi) { unsigned r; asm("v_cvt_pk_bf16_f32 %0, %1, %2" : "=v"(r) : "v"(lo), "v"(hi)); return r; }
__device__ __forceinline__ float bf_lo(unsigned w) { return __uint_as_float(w << 16); }
__device__ __forceinline__ float bf_hi(unsigned w) { return __uint_as_float(w & 0xffff0000u); }
__device__ __forceinline__ float bf1(bf16_t b) { return __uint_as_float(((unsigned)b) << 16); }
__device__ __forceinline__ bf16_t f2bf(float f) { return (bf16_t)(cvt_pk_bf16(f, 0.f) & 0xffffu); }
__device__ __forceinline__ float sigmoidf_(float x) { return __builtin_amdgcn_rcpf(1.0f + __expf(-x)); }
__device__ __forceinline__ float gelu_tanh(float x) { const float z = 1.5957691216057308f * (x + 0.044715f * x * x * x); return x * sigmoidf_(z); }
__device__ __forceinline__ int lane_id() { int l; asm volatile("v_mbcnt_lo_u32_b32 %0, -1, 0\n\tv_mbcnt_hi_u32_b32 %0, -1, %0" : "=v"(l)); return l; }
__device__ __forceinline__ float wave_sum(float v) {
#pragma unroll
    for (int o = 1; o < 64; o <<= 1) v += __shfl_xor(v, o);
    return v;
}
__device__ __forceinline__ void unpack8(const u32x4 w, float (&f)[8]) {
    f[0] = bf_lo(w.x); f[1] = bf_hi(w.x); f[2] = bf_lo(w.y); f[3] = bf_hi(w.y); f[4] = bf_lo(w.z); f[5] = bf_hi(w.z); f[6] = bf_lo(w.w); f[7] = bf_hi(w.w);
}
__device__ __forceinline__ u32x4 pack8(const float (&f)[8]) {
    u32x4 w; w.x = cvt_pk_bf16(f[0], f[1]); w.y = cvt_pk_bf16(f[2], f[3]); w.z = cvt_pk_bf16(f[4], f[5]); w.w = cvt_pk_bf16(f[6], f[7]); return w;
}


#define XB_TMO      128
#define XB_XCNT(j)  (256  + 64 * (j))
#define XB_XSUB(j)  (1280 + 64 * (j))
#define XB_XGEN(j)  (2304 + 64 * (j))
#define XB_TOP      3328
#define XB_TOPGEN   3392
#define XCD_BAR_WORDS 3456
#define XB_SPIN_CAP (1u << 22)
__device__ __forceinline__ unsigned xb_ld(unsigned* p)              { return __hip_atomic_load(p, __ATOMIC_RELAXED, __HIP_MEMORY_SCOPE_AGENT); }
__device__ __forceinline__ unsigned xb_add(unsigned* p, unsigned v) { return __hip_atomic_fetch_add(p, v, __ATOMIC_RELAXED, __HIP_MEMORY_SCOPE_AGENT); }
__device__ __forceinline__ unsigned xb_xcc_id() { return (unsigned)__builtin_amdgcn_s_getreg((3 << 11) | 20) & 0xFu; }
#define XB_SPIN(cond, bar) do { unsigned _sp = 0; while (cond) { __builtin_amdgcn_s_sleep(1); \
    if ((++_sp & 255u) == 0u) { if (xb_ld(&(bar)[XB_TMO])) break; if (_sp > XB_SPIN_CAP) { atomicAdd(&(bar)[XB_TMO], 1u); break; } } } } while (0)
struct XcdBarrier { unsigned* bar; unsigned x; volatile LAS unsigned* st; };
__device__ __forceinline__ XcdBarrier xcd_barrier_post(unsigned* bar, volatile LAS unsigned* st, bool t0) {
    XcdBarrier b; b.bar = bar; b.x = xb_xcc_id(); b.st = st;
    if (t0) (void)xb_add(&bar[XB_XCNT(b.x)], 1u);
    return b;
}
__device__ __forceinline__ void xcd_barrier_complete(unsigned* bar, unsigned x, unsigned& nloc, unsigned& nx) {
    const unsigned G = gridDim.x * gridDim.y * gridDim.z;
    unsigned sum, cnt, mine, sp = 0u;
    for (;;) {
        sum = 0u; cnt = 0u; mine = 0u;
#pragma unroll
        for (unsigned j = 0; j < 16; ++j) { const unsigned c = xb_ld(&bar[XB_XCNT(j)]); sum += c; cnt += (c > 0u) ? 1u : 0u; mine = (j == x) ? c : mine; }
        if (sum == G) break;
        __builtin_amdgcn_s_sleep(1);
        if ((++sp & 255u) == 0u) { if (xb_ld(&bar[XB_TMO])) break; if (sp > XB_SPIN_CAP) { atomicAdd(&bar[XB_TMO], 1u); break; } }
    }
    nloc = mine > 0u ? mine : 1u; nx = cnt > 0u ? cnt : 1u;
}
__device__ __forceinline__ void xcd_barrier(const XcdBarrier& b, bool t0) {
    asm volatile("s_waitcnt vmcnt(0)" ::: "memory");
    __syncthreads();
    if (t0) {
        unsigned* bar = b.bar;
        __builtin_amdgcn_s_waitcnt(0);
        unsigned nloc = b.st[0], nx = b.st[1];
        if (nloc == 0u) { xcd_barrier_complete(bar, b.x, nloc, nx); b.st[0] = nloc; b.st[1] = nx; }
        const unsigned old = xb_add(&bar[XB_XSUB(b.x)], 1u);
        const unsigned gen = old / nloc;
        if (old + 1u == (gen + 1u) * nloc) {
            __builtin_amdgcn_fence(__ATOMIC_RELEASE, "agent");
            asm volatile("s_waitcnt vmcnt(0)" ::: "memory");
            const unsigned og = xb_add(&bar[XB_TOP], 1u);
            const unsigned tg = og / nx;
            if (og + 1u == (tg + 1u) * nx) xb_add(&bar[XB_TOPGEN], 1u);
            else XB_SPIN(xb_ld(&bar[XB_TOPGEN]) == tg, bar);
            __builtin_amdgcn_fence(__ATOMIC_ACQUIRE, "agent");
            xb_add(&bar[XB_XGEN(b.x)], 1u);
            asm volatile("s_waitcnt vmcnt(0)" ::: "memory");
        } else {
            XB_SPIN(xb_ld(&bar[XB_XGEN(b.x)]) == gen, bar);
            __builtin_amdgcn_fence(__ATOMIC_ACQUIRE, "agent");
            asm volatile("s_waitcnt vmcnt(0)" ::: "memory");
        }
    }
    __syncthreads();
}

constexpr int BM = 256, BK = 64, HALF = 128, HTB = HALF * BK * 2, NXCD = 8, WGM = 8;
__device__ __forceinline__ int lds_byte(int r, int c) { const int st = (r >> 4) * 2 + (c >> 5), rr = r & 15, cc = c & 31, ob = rr * 64 + cc * 2; return st * 1024 + (ob ^ (((ob >> 9) & 1) << 5)); }
__device__ __forceinline__ void stage_rc(int b, int& R, int& C) { const int st = b / 1024, sb = b % 1024, swz = sb ^ (((sb >> 9) & 1) << 5); R = (st >> 1) * 16 + swz / 64; C = (st & 1) * 32 + (swz % 64) / 2; }
__device__ __forceinline__ int perm32(int rho) { const int n = rho >> 4, i = rho & 15; return 8 * (i >> 2) + 4 * n + (i & 3); }

struct Unit { int pm, pn; };
struct Gemm { const bf16_t* A; const bf16_t* Bt; int lda, ldb, K; size_t a_pm, a_pn, b_pn, b_pb, a_pn2; };
__device__ __forceinline__ Gemm plain_gemm(const bf16_t* A, const bf16_t* Bt, int K) { Gemm g; g.A = A; g.Bt = Bt; g.lda = K; g.ldb = K; g.K = K; g.a_pm = (size_t)BM * K * 2; g.a_pn = 0; g.b_pn = (size_t)BM * K * 2; g.b_pb = 0; g.a_pn2 = 0; return g; }

struct StaticOrder {
    int nM, nN, nwg, G, c;
    __device__ void init(int nM_, int nN_, int G_, int c_) { nM = nM_; nN = nN_; nwg = nM * nN; G = G_; c = c_; }
    __device__ bool next(int i, Unit& u) const {
        const long L = (long)i * G + c; if (L >= nwg) return false;
        int wgid = (int)L; { const int q = nwg / NXCD, r = nwg % NXCD, xcd = wgid % NXCD, off = wgid / NXCD; wgid = (xcd < r ? xcd * (q + 1) : r * (q + 1) + (xcd - r) * q) + off; }
        const int nig = WGM * nN, gid = wgid / nig, fm = gid * WGM, gsz = (nM - fm) < WGM ? (nM - fm) : WGM;
        u.pm = fm + ((wgid % nig) % gsz); u.pn = (wgid % nig) / gsz; return true;
    }
};

typedef f32x4 Acc[2][2][4][2];

template <class Epi>
__device__ __forceinline__ void gemm_phase(LAS unsigned char* lds, const int wid, const Gemm g, const StaticOrder& S, const Epi& E) {
    const int lane = lane_id(), tid = wid * 64 + lane, wr = wid >> 2, wc = wid & 3, fr = lane & 15, fq = lane >> 4;
    const int nt = g.K / BK;
    unsigned voffA[2], voffB[2];
#pragma unroll
    for (int i = 0; i < 2; ++i) { int R, C; stage_rc(tid * 16 + i * 8192, R, C); const int Rb = Epi::PERM ? ((R & ~31) + perm32(R & 31)) : R;
        voffA[i] = (unsigned)(R * g.lda + C) * 2u; voffB[i] = (unsigned)(Rb * g.ldb + C) * 2u; }
    const size_t kstep = (size_t)(BK * 2);
    const size_t hstepA = (size_t)HALF * g.lda * 2, hstepB = (size_t)HALF * g.ldb * 2;
    const unsigned ldsw = (unsigned)wid * 1024u;
    const int aoff = lds_byte(wr * 64 + fr, fq * 8), boff = lds_byte(wc * 32 + fr, fq * 8);
#define PG8_SA(b, h) (((b) * 2 + (h)) * HTB)
#define PG8_SB(b, h) ((4 + (b) * 2 + (h)) * HTB)
#define PG8_STAGE(bufoff, gbase, voff) do { _Pragma("unroll") for (int _i = 0; _i < 2; ++_i) \
        __builtin_amdgcn_global_load_lds((const unsigned*)((const char*)(gbase) + (voff)[_i]), (LAS unsigned*)(lds + (bufoff) + ldsw + _i * 8192), 16, 0, 0); } while (0)
#define PG8_LDA(dst, b, h) do { _Pragma("unroll") for (int m = 0; m < 4; ++m) _Pragma("unroll") for (int k = 0; k < 2; ++k) dst[m][k] = *(const LAS bf16x8*)(lds + PG8_SA(b, h) + aoff + m * 2048 + k * 1024); } while (0)
#define PG8_LDB(dst, b, h) do { _Pragma("unroll") for (int n = 0; n < 2; ++n) _Pragma("unroll") for (int k = 0; k < 2; ++k) dst[n][k] = *(const LAS bf16x8*)(lds + PG8_SB(b, h) + boff + n * 2048 + k * 1024); } while (0)
#define PG8_MMA(ai, bj, At, Bt) do { __builtin_amdgcn_s_setprio(1); _Pragma("unroll") for (int m = 0; m < 4; ++m) _Pragma("unroll") for (int n = 0; n < 2; ++n) _Pragma("unroll") for (int k = 0; k < 2; ++k) \
        acc[ai][bj][m][n] = __builtin_amdgcn_mfma_f32_16x16x32_bf16(Bt[n][k], At[m][k], acc[ai][bj][m][n], 0, 0, 0); __builtin_amdgcn_s_setprio(0); } while (0)
#define PG8_WAIT_V(n) asm volatile("s_waitcnt vmcnt(" #n ")" ::: "memory")
#define PG8_WAIT_L(n) asm volatile("s_waitcnt lgkmcnt(" #n ")" ::: "memory")
#define PG8_BAR __builtin_amdgcn_s_barrier()
#define PG8_SCHED __builtin_amdgcn_sched_barrier(0)
#define PG8_UA(u) ((const char*)g.A + (size_t)(u).pm * g.a_pm + (size_t)(u).pn * g.a_pn + (size_t)((u).pn >> 1) * g.a_pn2)
#define PG8_UB(u) ((const char*)g.Bt + (size_t)(u).pn * g.b_pn + (size_t)((u).pm >> 3) * g.b_pb)
    Unit cur, nxt; int ui = 0;
    if (!S.next(0, cur)) return;
    Acc acc;
#pragma unroll
    for (int a = 0; a < 2; ++a)
#pragma unroll
        for (int b = 0; b < 2; ++b)
#pragma unroll
            for (int m = 0; m < 4; ++m)
#pragma unroll
                for (int n = 0; n < 2; ++n) acc[a][b][m][n] = (f32x4){0.f, 0.f, 0.f, 0.f};
    bf16x8 At[4][2], B0[2][2], B1[2][2];
    const char* cA = PG8_UA(cur); const char* cB = PG8_UB(cur);
    PG8_STAGE(PG8_SB(0, 0), cB, voffB); PG8_STAGE(PG8_SB(0, 1), cB + hstepB, voffB); PG8_STAGE(PG8_SA(0, 0), cA, voffA); PG8_STAGE(PG8_SA(0, 1), cA + hstepA, voffA);
    if (wr == 1) PG8_BAR;
    PG8_WAIT_V(2); PG8_BAR;
    PG8_STAGE(PG8_SB(1, 0), cB + kstep, voffB); PG8_STAGE(PG8_SA(1, 0), cA + kstep, voffA); PG8_STAGE(PG8_SB(1, 1), cB + hstepB + kstep, voffB);
    PG8_WAIT_V(6); PG8_BAR;
    for (;;) {
        const bool has_next = S.next(ui + 1, nxt);
        const char* nA = has_next ? PG8_UA(nxt) : cA; const char* nB = has_next ? PG8_UB(nxt) : cB;
        for (int t = 0; t < nt; t += 2) {
            const bool last = (t == nt - 2);
            const char* a1 = cA + (size_t)(t + 1) * kstep;
            const char* a2 = last ? nA : cA + (size_t)(t + 2) * kstep; const char* b2 = last ? nB : cB + (size_t)(t + 2) * kstep;
            const char* a3 = a2 + kstep; const char* b3 = b2 + kstep;
            PG8_LDB(B0, 0, 0); PG8_LDB(B1, 0, 1); PG8_SCHED; PG8_LDA(At, 0, 0); PG8_STAGE(PG8_SA(1, 1), a1 + hstepA, voffA);
            PG8_WAIT_V(8); PG8_WAIT_L(0); PG8_BAR; PG8_MMA(0, 0, At, B0); PG8_MMA(0, 1, At, B1); PG8_BAR; PG8_SCHED;
            PG8_LDA(At, 0, 1); PG8_STAGE(PG8_SB(0, 0), b2, voffB); PG8_STAGE(PG8_SB(0, 1), b2 + hstepB, voffB); PG8_STAGE(PG8_SA(0, 0), a2, voffA);
            PG8_WAIT_V(8); PG8_WAIT_L(0); PG8_BAR; PG8_MMA(1, 0, At, B0); PG8_MMA(1, 1, At, B1); PG8_BAR; PG8_SCHED;
            PG8_LDB(B0, 1, 0); PG8_LDB(B1, 1, 1); PG8_SCHED; PG8_LDA(At, 1, 0); PG8_STAGE(PG8_SA(0, 1), a2 + hstepA, voffA);
            PG8_WAIT_V(8); PG8_WAIT_L(0); PG8_BAR; PG8_MMA(0, 0, At, B0); PG8_MMA(0, 1, At, B1); PG8_BAR; PG8_SCHED;
            PG8_LDA(At, 1, 1); PG8_STAGE(PG8_SB(1, 0), b3, voffB); PG8_STAGE(PG8_SB(1, 1), b3 + hstepB, voffB); PG8_STAGE(PG8_SA(1, 0), a3, voffA);
            PG8_WAIT_V(8); PG8_WAIT_L(0); PG8_BAR; PG8_MMA(1, 0, At, B0); PG8_MMA(1, 1, At, B1); PG8_BAR; PG8_SCHED;
        }
        if (wr == 0) PG8_BAR;
        E(acc, cur, wr, wc, fr, fq);
        if (!has_next) break;
#pragma unroll
        for (int a = 0; a < 2; ++a)
#pragma unroll
            for (int b = 0; b < 2; ++b)
#pragma unroll
                for (int m = 0; m < 4; ++m)
#pragma unroll
                    for (int n = 0; n < 2; ++n) acc[a][b][m][n] = (f32x4){0.f, 0.f, 0.f, 0.f};
        cur = nxt; cA = nA; cB = nB; ++ui;
        if (wr == 1) PG8_BAR;
    }
    PG8_WAIT_V(0);
    PG8_BAR;
#undef PG8_SA
#undef PG8_SB
#undef PG8_STAGE
#undef PG8_LDA
#undef PG8_LDB
#undef PG8_MMA
#undef PG8_WAIT_V
#undef PG8_WAIT_L
#undef PG8_BAR
#undef PG8_SCHED
#undef PG8_UA
#undef PG8_UB
}

#define EPI_ROWS_BEGIN for (int ai = 0; ai < 2; ++ai) { _Pragma("unroll") for (int m = 0; m < 4; ++m) { const int r = u.pm * BM + ai * HALF + wr * 64 + m * 16 + fr;
#define EPI_ROWS_END } }

__device__ __forceinline__ float rstd_from16(const float* ss, int r) { return rsqrtf(ss[r] * (1.0f / 1024.0f) + NORM_EPS); }

struct EpiProj { static constexpr bool PERM = true;
    const float* rstd; const float* bias; bf16_t* PR; bf16_t* PX; bf16_t* PY;
    __device__ __forceinline__ void operator()(Acc& acc, const Unit& u, int wr, int wc, int fr, int fq) const {
        bf16_t* base; int ld, colt;
        if (u.pn < 7) { base = PR; ld = RW; colt = u.pn * 256; } else if (u.pn < 9) { base = PX; ld = 512; colt = (u.pn - 7) * 256; } else { base = PY; ld = 512; colt = (u.pn - 9) * 256; }
        const int col0 = colt + wc * 32 + 8 * fq, bcol0 = u.pn * 256 + wc * 32 + 8 * fq;
        f32x4 bv[2][2];
#pragma unroll
        for (int bj = 0; bj < 2; ++bj)
#pragma unroll
            for (int n = 0; n < 2; ++n) bv[bj][n] = *(const f32x4*)(bias + bcol0 + bj * HALF + 4 * n);
#pragma unroll
        EPI_ROWS_BEGIN
            const float rs = rstd[r]; bf16_t* rowp = base + (size_t)r * ld + col0;
#pragma unroll
            for (int bj = 0; bj < 2; ++bj) { const f32x4 v0 = acc[ai][bj][m][0] * rs + bv[bj][0], v1 = acc[ai][bj][m][1] * rs + bv[bj][1];
                u32x4 w; w.x = cvt_pk_bf16(v0[0], v0[1]); w.y = cvt_pk_bf16(v0[2], v0[3]); w.z = cvt_pk_bf16(v1[0], v1[1]); w.w = cvt_pk_bf16(v1[2], v1[3]);
                *(u32x4*)(rowp + bj * HALF) = w; }
        EPI_ROWS_END
    }
};
struct EpiGab { static constexpr bool PERM = true;
    const float* rstd; const float* bias; bf16_t* O; int cofs;
    __device__ __forceinline__ void operator()(Acc& acc, const Unit& u, int wr, int wc, int fr, int fq) const {
        const int col0 = cofs + u.pn * 256 + wc * 32 + 8 * fq;
        f32x4 bv[2][2];
#pragma unroll
        for (int bj = 0; bj < 2; ++bj)
#pragma unroll
            for (int n = 0; n < 2; ++n) bv[bj][n] = *(const f32x4*)(bias + col0 + bj * HALF + 4 * n);
#pragma unroll
        EPI_ROWS_BEGIN
            const float rs = rstd[r]; bf16_t* rowp = O + (size_t)r * 2048 + col0;
#pragma unroll
            for (int bj = 0; bj < 2; ++bj) { f32x4 v0 = acc[ai][bj][m][0] * rs + bv[bj][0], v1 = acc[ai][bj][m][1] * rs + bv[bj][1];
#pragma unroll
                for (int j = 0; j < 4; ++j) { v0[j] = sigmoidf_(v0[j]); v1[j] = sigmoidf_(v1[j]); }
                u32x4 w; w.x = cvt_pk_bf16(v0[0], v0[1]); w.y = cvt_pk_bf16(v0[2], v0[3]); w.z = cvt_pk_bf16(v1[0], v1[1]); w.w = cvt_pk_bf16(v1[2], v1[3]);
                *(u32x4*)(rowp + bj * HALF) = w; }
        EPI_ROWS_END
    }
};
struct EpiPlain { static constexpr bool PERM = true;
    bf16_t* O; int ldc;
    __device__ __forceinline__ void operator()(Acc& acc, const Unit& u, int wr, int wc, int fr, int fq) const {
        const int col0 = u.pn * 256 + wc * 32 + 8 * fq;
#pragma unroll
        EPI_ROWS_BEGIN
            bf16_t* rowp = O + (size_t)r * ldc + col0;
#pragma unroll
            for (int bj = 0; bj < 2; ++bj) { const f32x4 v0 = acc[ai][bj][m][0], v1 = acc[ai][bj][m][1];
                u32x4 w; w.x = cvt_pk_bf16(v0[0], v0[1]); w.y = cvt_pk_bf16(v0[2], v0[3]); w.z = cvt_pk_bf16(v1[0], v1[1]); w.w = cvt_pk_bf16(v1[2], v1[3]);
                *(u32x4*)(rowp + bj * HALF) = w; }
        EPI_ROWS_END
    }
};
struct EpiLora { static constexpr bool PERM = true;
    const float* w0; const float* a0; bf16_t* O;
    __device__ __forceinline__ void operator()(Acc& acc, const Unit& u, int wr, int wc, int fr, int fq) const {
        const int kind = u.pn >> 1, ch0 = (u.pn & 1) * 256 + wc * 32 + 8 * fq, col0 = u.pn * 256 + wc * 32 + 8 * fq;
        const float* bsrc = kind == 0 ? w0 : a0;
        f32x4 bv[2][2];
#pragma unroll
        for (int bj = 0; bj < 2; ++bj)
#pragma unroll
            for (int n = 0; n < 2; ++n) bv[bj][n] = kind < 2 ? *(const f32x4*)(bsrc + ch0 + bj * HALF + 4 * n) : (f32x4){0.f, 0.f, 0.f, 0.f};
        const float sc = kind == 0 ? 0.6065306597126334f : 1.0f;
#pragma unroll
        EPI_ROWS_BEGIN
            bf16_t* rowp = O + (size_t)r * 1536 + col0;
#pragma unroll
            for (int bj = 0; bj < 2; ++bj) { f32x4 v0 = acc[ai][bj][m][0] + bv[bj][0], v1 = acc[ai][bj][m][1] + bv[bj][1];
                if (kind < 2) {
#pragma unroll
                    for (int j = 0; j < 4; ++j) { v0[j] = sc * sigmoidf_(v0[j]); v1[j] = sc * sigmoidf_(v1[j]); } }
                u32x4 w; w.x = cvt_pk_bf16(v0[0], v0[1]); w.y = cvt_pk_bf16(v0[2], v0[3]); w.z = cvt_pk_bf16(v1[0], v1[1]); w.w = cvt_pk_bf16(v1[2], v1[3]);
                *(u32x4*)(rowp + bj * HALF) = w; }
        EPI_ROWS_END
    }
};
struct EpiRg { static constexpr bool PERM = true;
    const float* ba; const float* bx; const float* lam; const bf16_t* XBC; bf16_t* LA; bf16_t* U;
    __device__ __forceinline__ void operator()(Acc& acc, const Unit& u, int wr, int wc, int fr, int fq) const {
        const int ch0 = u.pn * 128 + wc * 32 + 8 * fq;
        float vba[8], vbx[8], vls[8];
#pragma unroll
        for (int j = 0; j < 8; ++j) { vba[j] = ba[ch0 + j]; vbx[j] = bx[ch0 + j]; vls[j] = -8.0f * log1pf(__expf(-lam[ch0 + j])); }
#pragma unroll
        EPI_ROWS_BEGIN
            const bool first = (r & (SEQ - 1)) == 0;
            float xb[8]; unpack8(*(const u32x4*)(XBC + (size_t)r * 512 + ch0), xb);
            float la[8], uu[8];
#pragma unroll
            for (int j = 0; j < 8; ++j) { const float ga = sigmoidf_(acc[ai][0][m][j >> 2][j & 3] + vba[j]), gx = sigmoidf_(acc[ai][1][m][j >> 2][j & 3] + vbx[j]);
                la[j] = vls[j] * ga; const float a = __expf(la[j]); const float mult = first ? 1.0f : sqrtf(fmaxf(1.0f - a * a, 0.f)); uu[j] = xb[j] * gx * mult; }
            *(u32x4*)(LA + (size_t)r * 512 + ch0) = pack8(la); *(u32x4*)(U + (size_t)r * 512 + ch0) = pack8(uu);
        EPI_ROWS_END
    }
};
template <bool FIRST> struct EpiBranch { static constexpr bool PERM = true;
    const bf16_t* G; bf16_t* M;
    __device__ __forceinline__ void operator()(Acc& acc, const Unit& u, int wr, int wc, int fr, int fq) const {
        const int col0 = u.pn * 256 + wc * 32 + 8 * fq;
#pragma unroll
        EPI_ROWS_BEGIN
#pragma unroll
            for (int bj = 0; bj < 2; ++bj) { const int c = col0 + bj * HALF;
                float gv[8]; unpack8(*(const u32x4*)(G + (size_t)r * 2048 + (FIRST ? 0 : 1024) + c), gv);
                float o[8];
                if (!FIRST) unpack8(*(const u32x4*)(M + (size_t)r * 1024 + c), o);
#pragma unroll
                for (int j = 0; j < 8; ++j) { const float p = acc[ai][bj][m][j >> 2][j & 3] * gv[j]; o[j] = FIRST ? p : o[j] + p; }
                *(u32x4*)(M + (size_t)r * 1024 + c) = pack8(o); }
        EPI_ROWS_END
    }
};
template <bool BASE_F32> struct EpiRes { static constexpr bool PERM = true;
    const void* base; bf16_t* XB; float* ssp;
    __device__ __forceinline__ void operator()(Acc& acc, const Unit& u, int wr, int wc, int fr, int fq) const {
        const int col0 = u.pn * 256 + wc * 32 + 8 * fq;
#pragma unroll
        EPI_ROWS_BEGIN
            float s = 0.f;
#pragma unroll
            for (int bj = 0; bj < 2; ++bj) { const size_t off = (size_t)r * 1024 + col0 + bj * HALF; float o[8];
                if (BASE_F32) { const f32x4 b0 = *(const f32x4*)((const float*)base + off), b1 = *(const f32x4*)((const float*)base + off + 4);
                    o[0] = b0[0]; o[1] = b0[1]; o[2] = b0[2]; o[3] = b0[3]; o[4] = b1[0]; o[5] = b1[1]; o[6] = b1[2]; o[7] = b1[3]; }
                else unpack8(*(const u32x4*)((const bf16_t*)base + off), o);
#pragma unroll
                for (int j = 0; j < 8; ++j) { o[j] += acc[ai][bj][m][j >> 2][j & 3]; s += o[j] * o[j]; }
                *(u32x4*)(XB + off) = pack8(o); }
            s += __shfl_xor(s, 16); s += __shfl_xor(s, 32);
            if (fq == 0) atomicAdd(ssp + r, s);
        EPI_ROWS_END
    }
};
struct EpiQ { static constexpr bool PERM = true;
    const float* ssp; bf16_t* O;
    __device__ __forceinline__ void operator()(Acc& acc, const Unit& u, int wr, int wc, int fr, int fq) const {
        const int col0 = u.pn * 256 + wc * 32 + 8 * fq;
#pragma unroll
        EPI_ROWS_BEGIN
            const float rs = rstd_from16(ssp, r) * 0.0625f; bf16_t* rowp = O + (size_t)r * 1024 + col0;
#pragma unroll
            for (int bj = 0; bj < 2; ++bj) { const f32x4 v0 = acc[ai][bj][m][0] * rs, v1 = acc[ai][bj][m][1] * rs;
                u32x4 w; w.x = cvt_pk_bf16(v0[0], v0[1]); w.y = cvt_pk_bf16(v0[2], v0[3]); w.z = cvt_pk_bf16(v1[0], v1[1]); w.w = cvt_pk_bf16(v1[2], v1[3]);
                *(u32x4*)(rowp + bj * HALF) = w; }
        EPI_ROWS_END
    }
};
struct EpiSc { static constexpr bool PERM = true;
    bf16_t* O; float* ssp;
    __device__ __forceinline__ void operator()(Acc& acc, const Unit& u, int wr, int wc, int fr, int fq) const {
        const int col0 = u.pn * 256 + wc * 32 + 8 * fq;
#pragma unroll
        EPI_ROWS_BEGIN
            bf16_t* rowp = O + (size_t)r * 1024 + col0; float s = 0.f;
#pragma unroll
            for (int bj = 0; bj < 2; ++bj) { f32x4 v0 = acc[ai][bj][m][0], v1 = acc[ai][bj][m][1];
#pragma unroll
                for (int j = 0; j < 4; ++j) { v0[j] = __expf(v0[j]); v1[j] = __expf(v1[j]); }
                s += ((v0[0] + v0[1]) + (v0[2] + v0[3])) + ((v1[0] + v1[1]) + (v1[2] + v1[3]));
                u32x4 w; w.x = cvt_pk_bf16(v0[0], v0[1]); w.y = cvt_pk_bf16(v0[2], v0[3]); w.z = cvt_pk_bf16(v1[0], v1[1]); w.w = cvt_pk_bf16(v1[2], v1[3]);
                *(u32x4*)(rowp + bj * HALF) = w; }
            s += __shfl_xor(s, 16); s += __shfl_xor(s, 32);
            if (fq == 0) ssp[(size_t)r * 16 + u.pn * 4 + wc] = s;
        EPI_ROWS_END
    }
};
struct EpiPv { static constexpr bool PERM = true;
    const float* ssp; bf16_t* O;
    __device__ __forceinline__ void operator()(Acc& acc, const Unit& u, int wr, int wc, int fr, int fq) const {
        const int col0 = u.pn * 256 + wc * 32 + 8 * fq;
#pragma unroll
        EPI_ROWS_BEGIN
            const f32x4 sp = *(const f32x4*)(ssp + (size_t)r * 16 + u.pn * 4); const float rs = 1.0f / ((sp.x + sp.y) + (sp.z + sp.w));
            bf16_t* rowp = O + (size_t)r * 1024 + col0;
#pragma unroll
            for (int bj = 0; bj < 2; ++bj) { const f32x4 v0 = acc[ai][bj][m][0] * rs, v1 = acc[ai][bj][m][1] * rs;
                u32x4 w; w.x = cvt_pk_bf16(v0[0], v0[1]); w.y = cvt_pk_bf16(v0[2], v0[3]); w.z = cvt_pk_bf16(v1[0], v1[1]); w.w = cvt_pk_bf16(v1[2], v1[3]);
                *(u32x4*)(rowp + bj * HALF) = w; }
        EPI_ROWS_END
    }
};
__device__ __forceinline__ float dpp_ror1(float v) { return __int_as_float(__builtin_amdgcn_update_dpp(0, __float_as_int(v), 0x121, 0xf, 0xf, false)); }
__device__ __forceinline__ float dpp_ror2(float v) { return __int_as_float(__builtin_amdgcn_update_dpp(0, __float_as_int(v), 0x122, 0xf, 0xf, false)); }
struct EpiFfnAct { static constexpr bool PERM = true;
    const float* ssp; const float* cw; const float* cb; bf16_t* ACT; bf16_t* HG;
    __device__ __forceinline__ void operator()(Acc& acc, const Unit& u, int wr, int wc, int fr_, int fq_) const {
        const int l_ = lane_id(), fr = l_ & 15, fq = l_ >> 4;
        const int col0 = u.pn * 128 + wc * 32 + 8 * fq;
#pragma unroll
        for (int ai = 0; ai < 2; ++ai) {
            const int rbase = u.pm * BM + ai * HALF + wr * 64 + fr;
            float rs[4];
#pragma unroll
            for (int m = 0; m < 4; ++m) rs[m] = rstd_from16(ssp, rbase + m * 16);
            const size_t grp = (size_t)(rbase >> 6);
            if (fr < 2) { float t[8];
#pragma unroll
                for (int j = 0; j < 8; ++j) t[j] = acc[ai][0][0][j >> 2][j & 3] * rs[0];
                *(u32x4*)(HG + (grp * 4 + 2 + fr) * DFF + col0) = pack8(t); }
            if (fr >= 14) { float t[8];
#pragma unroll
                for (int j = 0; j < 8; ++j) t[j] = acc[ai][0][3][j >> 2][j & 3] * rs[3];
                *(u32x4*)(HG + (grp * 4 + (fr - 14)) * DFF + col0) = pack8(t); }
#pragma unroll
            for (int j = 0; j < 8; ++j) {
                const float w0 = cw[col0 + j], w1 = cw[DFF + col0 + j], w2 = cw[2 * DFF + col0 + j], b0 = cb[col0 + j];
                float g[4], r1[4], r2[4];
#pragma unroll
                for (int m = 0; m < 4; ++m) { g[m] = acc[ai][0][m][j >> 2][j & 3] * rs[m]; r1[m] = dpp_ror1(g[m]); r2[m] = dpp_ror2(g[m]); }
#pragma unroll
                for (int m = 0; m < 4; ++m) {
                    const float p1 = fr >= 1 ? r1[m] : r1[m > 0 ? m - 1 : 0], p2 = fr >= 2 ? r2[m] : r2[m > 0 ? m - 1 : 0];
                    const float up = acc[ai][1][m][j >> 2][j & 3] * rs[m];
                    const float gate = b0 + w0 * p2 + w1 * p1 + w2 * g[m];
                    acc[ai][1][m][j >> 2][j & 3] = (m == 0 && fr < 2) ? up : gelu_tanh(gate) * up;
                }
            }
#pragma unroll
            for (int m = 0; m < 4; ++m) { const f32x4 v0 = acc[ai][1][m][0], v1 = acc[ai][1][m][1];
                u32x4 w; w.x = cvt_pk_bf16(v0[0], v0[1]); w.y = cvt_pk_bf16(v0[2], v0[3]); w.z = cvt_pk_bf16(v1[0], v1[1]); w.w = cvt_pk_bf16(v1[2], v1[3]);
                *(u32x4*)(ACT + (size_t)(rbase + m * 16) * DFF + col0) = w; }
        }
    }
};

struct Args { const float* in[37]; float* out; unsigned char* ws; int ph_lo, ph_hi; };
enum { I_X = 0, I_MEM, I_NMIXG, I_WIN, I_BIN, I_MU, I_W0, I_WUP, I_A0, I_AUP, I_GUP, I_KK, I_KA, I_RK, I_LNXG, I_LNXB, I_WBA, I_CBW, I_CBB, I_WRGA, I_BRGA, I_WRGX, I_BRGX,
       I_LAM, I_WBB, I_WMIX, I_NXG, I_NMEMG, I_WCQ, I_WCKV, I_WCO, I_NFFNG, I_WFFI, I_FCW, I_FCB, I_WFFO, I_NFING };

__device__ __forceinline__ void transpose_item(const float* W, int ldw, int K, bf16_t* WT, int ldd, const float* gain, int map, int srcofs, LAS float* scr, int item, int lane) {
    const int nkb = K / 64, nb = item / nkb, kb = item % nkb, k0 = 64 * kb, n0 = 32 * nb;
    int ns = n0 + srcofs;
    if (map == 1) { const int tile = n0 >> 8, c = n0 & 255; ns = c < 128 ? tile * 128 + c : DFF + tile * 128 + (c - 128); }
#pragma unroll 8
    for (int i = 0; i < 32; ++i) { const int kk = 2 * i + (lane >> 5); float v = W[(size_t)(k0 + kk) * ldw + ns + (lane & 31)]; if (gain) v *= gain[k0 + kk]; scr[kk * 33 + (lane & 31)] = v; }
    asm volatile("s_waitcnt lgkmcnt(0)" ::: "memory");
    const int c = lane & 7;
#pragma unroll
    for (int j = 0; j < 4; ++j) { const int n = (lane >> 3) + 8 * j; const LAS float* s = scr + (8 * c) * 33 + n;
        u32x4 o; o.x = cvt_pk_bf16(s[0 * 33], s[1 * 33]); o.y = cvt_pk_bf16(s[2 * 33], s[3 * 33]); o.z = cvt_pk_bf16(s[4 * 33], s[5 * 33]); o.w = cvt_pk_bf16(s[6 * 33], s[7 * 33]);
        *(u32x4*)(WT + (size_t)(n0 + n) * ldd + k0 + 8 * c) = o; }
    asm volatile("s_waitcnt lgkmcnt(0)" ::: "memory");
}

__device__ __forceinline__ void phase_prep(const Args& a, LAS unsigned char* lds, int wave, int G) {
    const int lane = lane_id();
    unsigned char* ws = a.ws;
    LAS float* scr = (LAS float*)(lds + wave * 16384);
    const int gw = blockIdx.x * 8 + wave, NGW = G * 8;
#define TJOB(W_, ldw_, K_, Nd_, dst_, gain_, map_, srcofs_) do { const int nitems = ((K_) / 64) * ((Nd_) / 32); \
        for (int it = gw; it < nitems; it += NGW) transpose_item((W_), (ldw_), (K_), (bf16_t*)(ws + (dst_)), (K_), (gain_), (map_), (srcofs_), scr, it, lane); } while (0)
    TJOB(a.in[I_WIN], PIN, 1024, PIN, WS_WIN, a.in[I_NMIXG], 0, 0);
    TJOB(a.in[I_WBA], 1024, 512, 1024, WS_WA, nullptr, 0, 0);
    TJOB(a.in[I_WBB], 1024, 512, 1024, WS_WB, nullptr, 0, 0);
    TJOB(a.in[I_WMIX], 1024, 1024, 1024, WS_WMIX, nullptr, 0, 0);
    TJOB(a.in[I_WCQ], 1024, 1024, 1024, WS_WCQ, a.in[I_NXG], 0, 0);
    TJOB(a.in[I_WCKV], 2048, 1024, 1024, WS_WK, nullptr, 0, 0);
    TJOB(a.in[I_WCKV], 2048, 1024, 1024, WS_WV, nullptr, 0, 1024);
    TJOB(a.in[I_WCO], 1024, 1024, 1024, WS_WCO, nullptr, 0, 0);
    TJOB(a.in[I_WFFI], 2 * DFF, 1024, 2 * DFF, WS_WFFI, a.in[I_NFFNG], 1, 0);
    TJOB(a.in[I_WFFO], 1024, DFF, 1024, WS_WFFO, nullptr, 0, 0);
#undef TJOB
    { float* z1 = (float*)(ws + WS_SSP1); float* z2 = (float*)(ws + WS_SSP2); float* z3 = (float*)(ws + WS_SSP3);
      for (int i = blockIdx.x * 512 + wave * 64 + lane; i < T; i += G * 512) { z1[i] = 0.f; z2[i] = 0.f; z3[i] = 0.f; } }
    const int gid = blockIdx.x * 512 + wave * 64 + lane, NT = G * 512;
    { bf16_t* WL = (bf16_t*)(ws + WS_WLORA);
      for (int i = gid; i < 1536 * 256; i += NT) { const int n = i >> 8, k = i & 255, kind = n >> 9, c = n & 511; float v = 0.f;
          if (kind == 0 && k < 64) v = a.in[I_WUP][k * 512 + c]; else if (kind == 1 && k >= 64 && k < 128) v = a.in[I_AUP][(k - 64) * 512 + c]; else if (kind == 2 && k >= 128) v = a.in[I_GUP][(k - 128) * 512 + c];
          WL[i] = f2bf(v); } }
    { bf16_t* WR = (bf16_t*)(ws + WS_WRG);
      for (int i = gid; i < 1024 * 256; i += NT) { const int n = i >> 8, kk = i & 255, pn = n >> 8, c = n & 255, ch = pn * 128 + (c & 127), hb = ch >> 6, j = ch & 63, k = 256 * (pn >> 1) + kk; float v = 0.f;
          if ((k >> 6) == hb) v = (c < 128 ? a.in[I_WRGA] : a.in[I_WRGX])[(hb * 64 + (k & 63)) * 64 + j];
          WR[i] = f2bf(v); } }
    { const float* x = a.in[I_X]; bf16_t* XB = (bf16_t*)(ws + WS_XB); float* rstd = (float*)(ws + WS_RSTDX);
      for (int r0 = gw; r0 < T; r0 += 4 * NGW) {
          f32x4 v[4][4]; float s[4];
#pragma unroll
          for (int q = 0; q < 4; ++q) { const int r = r0 + q * NGW; s[q] = 0.f; if (r < T) { const f32x4* xr = (const f32x4*)(x + (size_t)r * D) + lane;
#pragma unroll
              for (int j = 0; j < 4; ++j) v[q][j] = xr[64 * j]; } else {
#pragma unroll
              for (int j = 0; j < 4; ++j) v[q][j] = (f32x4){0.f, 0.f, 0.f, 0.f}; } }
#pragma unroll
          for (int q = 0; q < 4; ++q) {
#pragma unroll
              for (int j = 0; j < 4; ++j) s[q] += (v[q][j].x * v[q][j].x + v[q][j].y * v[q][j].y) + (v[q][j].z * v[q][j].z + v[q][j].w * v[q][j].w);
              s[q] = wave_sum(s[q]); }
#pragma unroll
          for (int q = 0; q < 4; ++q) { const int r = r0 + q * NGW; if (r < T) { if (lane == 0) rstd[r] = rsqrtf(s[q] * (1.0f / D) + NORM_EPS);
              u32x2* o = (u32x2*)(XB + (size_t)r * D) + lane;
#pragma unroll
              for (int j = 0; j < 4; ++j) { u32x2 w; w.x = cvt_pk_bf16(v[q][j].x, v[q][j].y); w.y = cvt_pk_bf16(v[q][j].z, v[q][j].w); o[64 * j] = w; } } } } }
    { const float* x = a.in[I_MEM]; bf16_t* XB = (bf16_t*)(ws + WS_MEMN); const float* g = a.in[I_NMEMG];
      for (int r = gw; r < TM; r += NGW) { const f32x4* xr = (const f32x4*)(x + (size_t)r * D) + lane; f32x4 v[4]; float s = 0.f;
#pragma unroll
          for (int j = 0; j < 4; ++j) { v[j] = xr[64 * j]; s += (v[j].x * v[j].x + v[j].y * v[j].y) + (v[j].z * v[j].z + v[j].w * v[j].w); }
          s = wave_sum(s); const float rs = rsqrtf(s * (1.0f / D) + NORM_EPS);
          u32x2* o = (u32x2*)(XB + (size_t)r * D) + lane;
#pragma unroll
          for (int j = 0; j < 4; ++j) { const f32x4 gg = ((const f32x4*)g)[lane + 64 * j]; u32x2 w; w.x = cvt_pk_bf16(v[j].x * rs * gg.x, v[j].y * rs * gg.y); w.y = cvt_pk_bf16(v[j].z * rs * gg.z, v[j].w * rs * gg.w); o[64 * j] = w; } } }
}

__device__ __forceinline__ void phase_elem2(const Args& a, int wave, int G) {
    unsigned char* ws = a.ws;
    const bf16_t* PR = (const bf16_t*)(ws + WS_PR); const bf16_t* PX = (const bf16_t*)(ws + WS_PX);
    bf16_t* LIN = (bf16_t*)(ws + WS_LIN); bf16_t* XBC = (bf16_t*)(ws + WS_XBC);
    const float* mu = a.in[I_MU]; const float* cw = a.in[I_CBW]; const float* cb = a.in[I_CBB];
    const size_t gid = (size_t)blockIdx.x * 512 + wave * 64 + lane_id(), NT = (size_t)G * 512;
    for (size_t i = gid; i < (size_t)T * 96; i += NT) {
        const int t = (int)(i / 96), q = (int)(i % 96), tl = t & (SEQ - 1);
        if (q < 32) { const int c = q * 8; float p[8], pp[8], o[8];
            unpack8(*(const u32x4*)(PR + (size_t)t * RW + 1536 + c), p);
            if (tl > 0) unpack8(*(const u32x4*)(PR + (size_t)(t - 1) * RW + 1536 + c), pp); else {
#pragma unroll
                for (int j = 0; j < 8; ++j) pp[j] = 0.f; }
#pragma unroll
            for (int j = 0; j < 8; ++j) { const float v = p[j] + (pp[j] - p[j]) * mu[1536 + c + j];
                o[j] = c < 64 ? tanhf(v) : (c < 128 ? v : sigmoidf_(v)); }
            *(u32x4*)(LIN + (size_t)t * 256 + c) = pack8(o);
        } else { const int c = (q - 32) * 8; float o[8];
#pragma unroll
            for (int j = 0; j < 8; ++j) o[j] = cb[c + j];
#pragma unroll
            for (int k = 0; k < 4; ++k) { const int dt = 3 - k; if (tl >= dt) { float p[8]; unpack8(*(const u32x4*)(PX + (size_t)(t - dt) * 512 + c), p);
#pragma unroll
                for (int j = 0; j < 8; ++j) o[j] += p[j] * cw[k * 512 + c + j]; } }
            *(u32x4*)(XBC + (size_t)t * 512 + c) = pack8(o);
        }
    }
}

#define DPP_BC(JJ) " row_newbcast:" #JJ " row_mask:0xf bank_mask:0xf"
#define RW_SA(JJ)  asm("v_fmac_f32_dpp %0, %1, %2" DPP_BC(JJ) : "+v"(sacc[JJ & 3]) : "v"(va), "v"(S[JJ]));
#define RW_UPD(JJ) { float t_; \
    asm("v_mul_f32_dpp %0, %1, %2" DPP_BC(JJ) : "=v"(t_) : "v"(vb), "v"(sa)); \
    asm("v_fmac_f32_dpp %0, %1, %2" DPP_BC(JJ) : "+v"(t_) : "v"(vk), "v"(vv)); \
    asm("v_fmac_f32_dpp %0, %1, %2" DPP_BC(JJ) : "+v"(t_) : "v"(vw), "v"(S[JJ])); \
    S[JJ] = t_; \
    asm("v_fmac_f32_dpp %0, %1, %2" DPP_BC(JJ) : "+v"(yacc[JJ & 3]) : "v"(vr), "v"(S[JJ])); }
#define RW_ALL16(M) M(0) M(1) M(2) M(3) M(4) M(5) M(6) M(7) M(8) M(9) M(10) M(11) M(12) M(13) M(14) M(15)

constexpr int RB = 32;
constexpr int PSTEP = 6 * 64;
constexpr int PBUF = RB * PSTEP * 4;

__device__ __forceinline__ float dpp_ror_add(float v, const int ctrl_sel) {
    int t;
    switch (ctrl_sel) {
        case 8: t = __builtin_amdgcn_update_dpp(0, __float_as_int(v), 0x128, 0xf, 0xf, false); break;
        case 4: t = __builtin_amdgcn_update_dpp(0, __float_as_int(v), 0x124, 0xf, 0xf, false); break;
        case 2: t = __builtin_amdgcn_update_dpp(0, __float_as_int(v), 0x122, 0xf, 0xf, false); break;
        default: t = __builtin_amdgcn_update_dpp(0, __float_as_int(v), 0x121, 0xf, 0xf, false); break;
    }
    return v + __int_as_float(t);
}
__device__ __forceinline__ float cross_row_allsum(float v) {
    auto r = __builtin_amdgcn_permlane32_swap(__float_as_uint(v), __float_as_uint(v), false, false);
    v = __uint_as_float(r[0]) + __uint_as_float(r[1]);
    auto r2 = __builtin_amdgcn_permlane16_swap(__float_as_uint(v), __float_as_uint(v), false, false);
    return __uint_as_float(r2[0]) + __uint_as_float(r2[1]);
}
__device__ __forceinline__ float wave_allsum(float v) {
    v = dpp_ror_add(v, 8); v = dpp_ror_add(v, 4); v = dpp_ror_add(v, 2); v = dpp_ror_add(v, 1);
    return cross_row_allsum(v);
}
__device__ __forceinline__ void lds_barrier() { asm volatile("s_waitcnt lgkmcnt(0)" ::: "memory"); __builtin_amdgcn_s_barrier(); asm volatile("" ::: "memory"); }

constexpr int NPS = RB / 4;
__device__ __forceinline__ void prod_load(const Args& a, bf16_t (&raw)[NPS][8], int tok0, int h, int p, int lane) {
    const bf16_t* PR = (const bf16_t*)(a.ws + WS_PR); const bf16_t* LOUT = (const bf16_t*)(a.ws + WS_LOUT);
#pragma unroll
    for (int i = 0; i < NPS; ++i) { const int tok = tok0 + p + 4 * i; const bool has_prev = (tok & (SEQ - 1)) != 0;
        const bf16_t* prow = PR + (size_t)tok * RW + h * 64 + lane; const bf16_t* qrow = has_prev ? prow - RW : prow; const bf16_t* lrow = LOUT + (size_t)tok * 1536 + h * 64 + lane;
        raw[i][0] = prow[0]; raw[i][1] = prow[512]; raw[i][2] = prow[1024]; raw[i][3] = qrow[0]; raw[i][4] = qrow[512]; raw[i][5] = qrow[1024]; raw[i][6] = lrow[0]; raw[i][7] = lrow[512]; }
}
__device__ __forceinline__ void prod_compute(const Args& a, const bf16_t (&raw)[NPS][8], LAS float* pb, int tok0, int h, int p, int lane, float mu_r, float mu_k, float mu_v, float ckk, float cka, float crk) {
    float* BON = (float*)(a.ws + WS_BON);
#pragma unroll
    for (int i = 0; i < NPS; ++i) { const int s = p + 4 * i, tok = tok0 + s; const bool has_prev = (tok & (SEQ - 1)) != 0;
        const float rr = bf1(raw[i][0]), kr = bf1(raw[i][1]), vr_ = bf1(raw[i][2]);
        const float rp = has_prev ? bf1(raw[i][3]) : 0.f, kp = has_prev ? bf1(raw[i][4]) : 0.f, vp = has_prev ? bf1(raw[i][5]) : 0.f;
        const float e = bf1(raw[i][6]), av = bf1(raw[i][7]);
        const float r = rr + (rp - rr) * mu_r, k0 = kr + (kp - kr) * mu_k, v = vr_ + (vp - vr_) * mu_v;
        const float w = __expf(-e);
        const float kk = k0 * ckk; const float n2 = wave_allsum(kk * kk); const float kkn = kk * rsqrtf(fmaxf(n2, 1e-24f));
        const float k2 = k0 * (1.0f + (av - 1.0f) * cka);
        const float bon = wave_allsum(r * k2 * crk);
        LAS float* pp = pb + s * PSTEP;
        pp[lane] = -kkn; pp[64 + lane] = kkn * av; pp[128 + lane] = k2; pp[192 + lane] = w; pp[256 + lane] = r; pp[320 + lane] = v;
        if (lane == 0) BON[(size_t)tok * 8 + h] = bon; }
}

__device__ __forceinline__ void phase_scan(const Args& a, LAS unsigned char* lds, int wave, int G) {
    const int lane = lane_id();
    unsigned char* ws = a.ws;
    constexpr int SB = 16, NBLK = SEQ / RB;
    for (int pair = blockIdx.x; pair < 256; pair += G) {
        const int b = pair >> 3, h = pair & 7, tokb = b * SEQ;
        if (wave < 4) {
            const int il = lane & 15, irow = 16 * wave + il;
            float S[16];
#pragma unroll
            for (int j = 0; j < 16; ++j) S[j] = 0.f;
            bf16_t* YRAW = (bf16_t*)(ws + WS_YRAW);
            lds_barrier();
            for (int blk = 0; blk < NBLK; ++blk) {
                const LAS float* pb = (const LAS float*)(lds + (blk & 1) * PBUF);
#pragma unroll 2
                for (int s = 0; s < RB; ++s) {
                    const LAS float* pp = pb + s * PSTEP;
                    float va = pp[lane], vb = pp[64 + lane], vk = pp[128 + lane], vw = pp[192 + lane], vr = pp[256 + lane]; const float vv = pp[320 + irow];
                    asm volatile("s_nop 1" : "+v"(va), "+v"(vb), "+v"(vk), "+v"(vw), "+v"(vr));
                    float sacc[4] = {0.f, 0.f, 0.f, 0.f}, yacc[4] = {0.f, 0.f, 0.f, 0.f};
                    RW_ALL16(RW_SA)
                    float sa = (sacc[0] + sacc[1]) + (sacc[2] + sacc[3]);
                    sa = cross_row_allsum(sa);
                    RW_ALL16(RW_UPD)
                    float y = (yacc[0] + yacc[1]) + (yacc[2] + yacc[3]);
                    y = cross_row_allsum(y);
                    const int tok = tokb + blk * RB + s;
                    if (lane < 16) YRAW[(size_t)tok * 512 + h * 64 + irow] = f2bf(y);
                }
                lds_barrier();
            }
        } else {
            const float mu_r = a.in[I_MU][h * 64 + lane], mu_k = a.in[I_MU][512 + h * 64 + lane], mu_v = a.in[I_MU][1024 + h * 64 + lane];
            const float ckk = a.in[I_KK][h * 64 + lane], cka = a.in[I_KA][h * 64 + lane], crk = a.in[I_RK][h * 64 + lane];
            const size_t base = (size_t)tokb * 512 + h * 64 + lane;
            const bf16_t* LA = (const bf16_t*)(ws + WS_RGLA) + base; const bf16_t* U = (const bf16_t*)(ws + WS_RGU) + base; const bf16_t* PY = (const bf16_t*)(ws + WS_PY) + base;
            bf16_t* YB = (bf16_t*)(ws + WS_YB) + base;
            bf16_t cla[SB], cu[SB], cpy[SB]; float hh = 0.f;
#pragma unroll
            for (int s = 0; s < SB; ++s) { cla[s] = 0; cu[s] = 0; cpy[s] = 0; }
            if (wave == 4) {
#pragma unroll
                for (int s = 0; s < SB; ++s) { cla[s] = LA[(size_t)s * 512]; cu[s] = U[(size_t)s * 512]; cpy[s] = PY[(size_t)s * 512]; }
            }
            bf16_t raw[NPS][8];
            prod_load(a, raw, tokb, h, wave - 4, lane); prod_compute(a, raw, (LAS float*)lds, tokb, h, wave - 4, lane, mu_r, mu_k, mu_v, ckk, cka, crk); prod_load(a, raw, tokb + RB, h, wave - 4, lane);
            lds_barrier();
            for (int blk = 0; blk < NBLK; ++blk) {
                if (blk + 1 < NBLK) { prod_compute(a, raw, (LAS float*)(lds + ((blk + 1) & 1) * PBUF), tokb + (blk + 1) * RB, h, wave - 4, lane, mu_r, mu_k, mu_v, ckk, cka, crk);
                    if (blk + 2 < NBLK) prod_load(a, raw, tokb + (blk + 2) * RB, h, wave - 4, lane); }
                if (wave == 4) {
                    for (int sub = 0; sub < RB / SB; ++sub) {
                        const int t0 = blk * RB + sub * SB, tn = (t0 + SB < SEQ) ? t0 + SB : t0;
                        bf16_t nla[SB], nu[SB], npy[SB];
#pragma unroll
                        for (int s = 0; s < SB; ++s) { nla[s] = LA[(size_t)(tn + s) * 512]; nu[s] = U[(size_t)(tn + s) * 512]; npy[s] = PY[(size_t)(tn + s) * 512]; }
#pragma unroll
                        for (int s = 0; s < SB; ++s) { hh = __expf(bf1(cla[s])) * hh + bf1(cu[s]); YB[(size_t)(t0 + s) * 512] = f2bf(hh * gelu_tanh(bf1(cpy[s]))); }
#pragma unroll
                        for (int s = 0; s < SB; ++s) { cla[s] = nla[s]; cu[s] = nu[s]; cpy[s] = npy[s]; }
                    }
                }
                lds_barrier();
            }
        }
    }
    asm volatile("s_waitcnt vmcnt(0)" ::: "memory");
}

__device__ __forceinline__ void phase_post(const Args& a, int wave, int G) {
    unsigned char* ws = a.ws;
    const bf16_t* PR = (const bf16_t*)(ws + WS_PR); const bf16_t* LOUT = (const bf16_t*)(ws + WS_LOUT); const bf16_t* YRAW = (const bf16_t*)(ws + WS_YRAW);
    const float* BON = (const float*)(ws + WS_BON); bf16_t* YA = (bf16_t*)(ws + WS_YA);
    const float* mu = a.in[I_MU]; const float* lg = a.in[I_LNXG]; const float* lb = a.in[I_LNXB];
    const size_t gid = (size_t)blockIdx.x * 512 + wave * 64 + lane_id(), NT = (size_t)G * 512;
    for (size_t i = gid; i < (size_t)T * 64; i += NT) {
        const int t = (int)(i >> 6), c = (int)(i & 63) * 8, h = c >> 6, tl = t & (SEQ - 1);
        float y[8], v[8], vp[8], g[8], o[8];
        unpack8(*(const u32x4*)(YRAW + (size_t)t * 512 + c), y);
        unpack8(*(const u32x4*)(PR + (size_t)t * RW + 1024 + c), v);
        if (tl > 0) unpack8(*(const u32x4*)(PR + (size_t)(t - 1) * RW + 1024 + c), vp); else {
#pragma unroll
            for (int j = 0; j < 8; ++j) vp[j] = 0.f; }
        unpack8(*(const u32x4*)(LOUT + (size_t)t * 1536 + 1024 + c), g);
        float s = 0.f;
#pragma unroll
        for (int j = 0; j < 8; ++j) s += y[j];
        s += __shfl_xor(s, 1); s += __shfl_xor(s, 2); s += __shfl_xor(s, 4);
        const float mean = s * (1.0f / 64.0f); float q = 0.f;
#pragma unroll
        for (int j = 0; j < 8; ++j) { const float d = y[j] - mean; q += d * d; }
        q += __shfl_xor(q, 1); q += __shfl_xor(q, 2); q += __shfl_xor(q, 4);
        const float rs = rsqrtf(q * (1.0f / 64.0f) + LNX_EPS), bon = BON[(size_t)t * 8 + h];
#pragma unroll
        for (int j = 0; j < 8; ++j) { const float vv = v[j] + (vp[j] - v[j]) * mu[1024 + c + j];
            o[j] = ((y[j] - mean) * rs * lg[c + j] + lb[c + j] + bon * vv) * g[j]; }
        *(u32x4*)(YA + (size_t)t * 512 + c) = pack8(o);
    }
}

__device__ __forceinline__ void phase_ffnfix(const Args& a, int wave, int G) {
    unsigned char* ws = a.ws;
    const bf16_t* HG = (const bf16_t*)(ws + WS_HG); bf16_t* ACT = (bf16_t*)(ws + WS_UU);
    const float* cw = a.in[I_FCW]; const float* cb = a.in[I_FCB];
    const size_t gid = (size_t)blockIdx.x * 512 + wave * 64 + lane_id(), NT = (size_t)G * 512;
    constexpr int CPR = DFF / 8;
    for (size_t i = gid; i < (size_t)(T / 64) * 2 * CPR; i += NT) {
        const int c = (int)(i % CPR) * 8, rho = (int)((i / CPR) & 1), grp = (int)(i / (2 * CPR)); const int t = grp * 64 + rho; const bool first = (grp & 31) == 0;
        float p2[8], p1[8], cur[8], up[8], o[8];
#pragma unroll
        for (int j = 0; j < 8; ++j) { p2[j] = 0.f; p1[j] = 0.f; }
        if (rho == 0) { if (!first) { unpack8(*(const u32x4*)(HG + ((size_t)(grp - 1) * 4 + 0) * DFF + c), p2); unpack8(*(const u32x4*)(HG + ((size_t)(grp - 1) * 4 + 1) * DFF + c), p1); } }
        else { if (!first) unpack8(*(const u32x4*)(HG + ((size_t)(grp - 1) * 4 + 1) * DFF + c), p2); unpack8(*(const u32x4*)(HG + ((size_t)grp * 4 + 2) * DFF + c), p1); }
        unpack8(*(const u32x4*)(HG + ((size_t)grp * 4 + 2 + rho) * DFF + c), cur);
        unpack8(*(const u32x4*)(ACT + (size_t)t * DFF + c), up);
#pragma unroll
        for (int j = 0; j < 8; ++j) o[j] = gelu_tanh(cb[c + j] + cw[c + j] * p2[j] + cw[DFF + c + j] * p1[j] + cw[2 * DFF + c + j] * cur[j]) * up[j];
        *(u32x4*)(ACT + (size_t)t * DFF + c) = pack8(o);
    }
}

__device__ __forceinline__ void phase_final(const Args& a, int wave, int G) {
    const int lane = lane_id();
    const float* ssp = (const float*)(a.ws + WS_SSP3); const float* g = a.in[I_NFING]; const bf16_t* X3 = (const bf16_t*)(a.ws + WS_X3B);
    const int gw = blockIdx.x * 8 + wave, NGW = G * 8;
    for (int r0 = gw; r0 < T; r0 += 4 * NGW) {
        u32x4 v[4][2]; float rs[4];
#pragma unroll
        for (int q = 0; q < 4; ++q) { const int r = r0 + q * NGW; if (r < T) { rs[q] = rstd_from16(ssp, r); const u32x4* xr = (const u32x4*)(X3 + (size_t)r * D) + lane; v[q][0] = xr[0]; v[q][1] = xr[64]; } }
#pragma unroll
        for (int q = 0; q < 4; ++q) { const int r = r0 + q * NGW; if (r < T) {
#pragma unroll
            for (int j = 0; j < 2; ++j) { float x[8]; unpack8(v[q][j], x); const int c = 512 * j + 8 * lane; const f32x4 g0 = *(const f32x4*)(g + c), g1 = *(const f32x4*)(g + c + 4);
                f32x4* o = (f32x4*)(a.out + (size_t)r * D + c);
                o[0] = (f32x4){x[0] * rs[q] * g0[0], x[1] * rs[q] * g0[1], x[2] * rs[q] * g0[2], x[3] * rs[q] * g0[3]};
                o[1] = (f32x4){x[4] * rs[q] * g1[0], x[5] * rs[q] * g1[1], x[6] * rs[q] * g1[2], x[7] * rs[q] * g1[3]}; } } }
    }
}

constexpr int NPHASE = 13;
__global__ void __launch_bounds__(512, 2) mega(Args a) {
    extern __shared__ __attribute__((aligned(16))) unsigned char lds_raw[];
    LAS unsigned char* lds = (LAS unsigned char*)lds_raw;
    cg::grid_group grid = cg::this_grid();
    const int wave = __builtin_amdgcn_readfirstlane((int)threadIdx.x >> 6), G = gridDim.x, bid = blockIdx.x;
    unsigned char* ws = a.ws;
    const int lo = a.ph_lo, hi = a.ph_hi;
    const bool t0 = (wave == 0) && (lane_id() == 0);
    volatile LAS unsigned* misc = (volatile LAS unsigned*)(lds + 131072 + 320);
    if (t0) { misc[0] = 0u; misc[1] = 0u; }
    __syncthreads();
    XcdBarrier xb = xcd_barrier_post((unsigned*)(ws + WS_CTL), misc, t0);
    if (a.ph_hi < 0) grid.sync();
#define IN(k) (lo <= (k) && (k) < hi)
#define SEAM(k) do { if (IN(k) && IN((k) + 1)) xcd_barrier(xb, t0); } while (0)
    bf16_t* const XB = (bf16_t*)(ws + WS_XB);
    const float* rstdx = (const float*)(ws + WS_RSTDX);
    StaticOrder S;

    if (IN(0)) for (int rep_ = 0; rep_ < REPS(0); ++rep_) { phase_prep(a, lds, wave, G); __syncthreads(); } SEAM(0);

    if (IN(1)) for (int rep_ = 0; rep_ < REPS(1); ++rep_) {
        { Gemm g = plain_gemm(XB, (const bf16_t*)(ws + WS_WIN), 1024); S.init(T / BM, 11, G, bid);
          EpiProj E{rstdx, a.in[I_BIN], (bf16_t*)(ws + WS_PR), (bf16_t*)(ws + WS_PX), (bf16_t*)(ws + WS_PY)}; gemm_phase(lds, wave, g, S, E); }
        if ((G & 15) == 0) {
            const int hg = G >> 1, hb_ = (bid >> 4) * 8 + (bid & 7);
            if (((bid >> 3) & 1) == 0) { Gemm g = plain_gemm((const bf16_t*)(ws + WS_MEMN), (const bf16_t*)(ws + WS_WK), 1024); S.init(TM / BM, 4, hg, hb_);
                EpiPlain E{(bf16_t*)(ws + WS_KM), 1024}; gemm_phase(lds, wave, g, S, E); }
            else { Gemm g = plain_gemm((const bf16_t*)(ws + WS_WV), (const bf16_t*)(ws + WS_MEMN), 1024); S.init(4, TM / BM, hg, hb_);
                EpiPlain E{(bf16_t*)(ws + WS_VT), TM}; gemm_phase(lds, wave, g, S, E); }
        } else {
            { Gemm g = plain_gemm((const bf16_t*)(ws + WS_MEMN), (const bf16_t*)(ws + WS_WK), 1024); S.init(TM / BM, 4, G, bid);
              EpiPlain E{(bf16_t*)(ws + WS_KM), 1024}; gemm_phase(lds, wave, g, S, E); }
            { Gemm g = plain_gemm((const bf16_t*)(ws + WS_WV), (const bf16_t*)(ws + WS_MEMN), 1024); S.init(4, TM / BM, G, bid);
              EpiPlain E{(bf16_t*)(ws + WS_VT), TM}; gemm_phase(lds, wave, g, S, E); }
        }
    } SEAM(1);

    if (IN(2)) for (int rep_ = 0; rep_ < REPS(2); ++rep_) phase_elem2(a, wave, G); SEAM(2);
#ifdef PROBE_SYNC
    for (int i_ = 0; i_ < 16; ++i_) grid.sync();
#endif

    if (IN(3)) for (int rep_ = 0; rep_ < REPS(3); ++rep_) {
        { Gemm g = plain_gemm((const bf16_t*)(ws + WS_LIN), (const bf16_t*)(ws + WS_WLORA), 256); S.init(T / BM, 6, G, bid);
          EpiLora E{a.in[I_W0], a.in[I_A0], (bf16_t*)(ws + WS_LOUT)}; gemm_phase(lds, wave, g, S, E); }
        { Gemm g = plain_gemm((const bf16_t*)(ws + WS_XBC), (const bf16_t*)(ws + WS_WRG), 256); g.lda = 512; g.a_pm = (size_t)BM * 512 * 2; g.a_pn2 = 512; S.init(T / BM, 4, G, bid);
          EpiRg E{a.in[I_BRGA], a.in[I_BRGX], a.in[I_LAM], (const bf16_t*)(ws + WS_XBC), (bf16_t*)(ws + WS_RGLA), (bf16_t*)(ws + WS_RGU)}; gemm_phase(lds, wave, g, S, E); }
    } SEAM(3);

    if (IN(4)) for (int rep_ = 0; rep_ < REPS(4); ++rep_) phase_scan(a, lds, wave, G); SEAM(4);
    if (IN(5)) for (int rep_ = 0; rep_ < REPS(5); ++rep_) phase_post(a, wave, G); SEAM(5);

    if (IN(6)) for (int rep_ = 0; rep_ < REPS(6); ++rep_) {
        S.init(T / BM, 4, G, bid);
        { Gemm g = plain_gemm(XB, (const bf16_t*)(ws + WS_WIN) + (size_t)2816 * 1024, 1024); EpiGab E{rstdx, a.in[I_BIN] + 2816, (bf16_t*)(ws + WS_GAB), 0}; gemm_phase(lds, wave, g, S, E); }
        { Gemm g = plain_gemm((const bf16_t*)(ws + WS_YA), (const bf16_t*)(ws + WS_WA), 512); EpiBranch<true> E{(const bf16_t*)(ws + WS_GAB), (bf16_t*)(ws + WS_MERGED)}; gemm_phase(lds, wave, g, S, E); }
        { Gemm g = plain_gemm(XB, (const bf16_t*)(ws + WS_WIN) + (size_t)3840 * 1024, 1024); EpiGab E{rstdx, a.in[I_BIN] + 2816, (bf16_t*)(ws + WS_GAB), 1024}; gemm_phase(lds, wave, g, S, E); }
        { Gemm g = plain_gemm((const bf16_t*)(ws + WS_YB), (const bf16_t*)(ws + WS_WB), 512); EpiBranch<false> E{(const bf16_t*)(ws + WS_GAB), (bf16_t*)(ws + WS_MERGED)}; gemm_phase(lds, wave, g, S, E); }
    } SEAM(6);
    if (IN(7)) for (int rep_ = 0; rep_ < REPS(7); ++rep_) { Gemm g = plain_gemm((const bf16_t*)(ws + WS_MERGED), (const bf16_t*)(ws + WS_WMIX), 1024); S.init(T / BM, 4, G, bid);
        EpiRes<true> E{a.in[I_X], (bf16_t*)(ws + WS_X1B), (float*)(ws + WS_SSP1)}; gemm_phase(lds, wave, g, S, E); } SEAM(7);
    if (IN(8)) for (int rep_ = 0; rep_ < REPS(8); ++rep_) {
        S.init(T / BM, 4, G, bid);
        { Gemm g = plain_gemm((const bf16_t*)(ws + WS_X1B), (const bf16_t*)(ws + WS_WCQ), 1024);
          EpiQ E{(const float*)(ws + WS_SSP1), (bf16_t*)(ws + WS_Q)}; gemm_phase(lds, wave, g, S, E); }
        { Gemm g; g.A = (const bf16_t*)(ws + WS_Q); g.Bt = (const bf16_t*)(ws + WS_KM); g.lda = 1024; g.ldb = 1024; g.K = 256;
          g.a_pm = (size_t)BM * 1024 * 2; g.a_pn = 512; g.b_pn = 512; g.b_pb = (size_t)NMEM * 1024 * 2; g.a_pn2 = 0;
          EpiSc E{(bf16_t*)(ws + WS_PEXP), (float*)(ws + WS_SSPA)}; gemm_phase(lds, wave, g, S, E); }
        { Gemm g; g.A = (const bf16_t*)(ws + WS_PEXP); g.Bt = (const bf16_t*)(ws + WS_VT); g.lda = 1024; g.ldb = TM; g.K = 256;
          g.a_pm = (size_t)BM * 1024 * 2; g.a_pn = 512; g.b_pn = (size_t)256 * TM * 2; g.b_pb = 512; g.a_pn2 = 0;
          EpiPv E{(const float*)(ws + WS_SSPA), (bf16_t*)(ws + WS_O)}; gemm_phase(lds, wave, g, S, E); }
    } SEAM(8);
    if (IN(9)) for (int rep_ = 0; rep_ < REPS(9); ++rep_) { Gemm g = plain_gemm((const bf16_t*)(ws + WS_O), (const bf16_t*)(ws + WS_WCO), 1024); S.init(T / BM, 4, G, bid);
        EpiRes<false> E{(const bf16_t*)(ws + WS_X1B), (bf16_t*)(ws + WS_X2B), (float*)(ws + WS_SSP2)}; gemm_phase(lds, wave, g, S, E); } SEAM(9);
    if (IN(10)) for (int rep_ = 0; rep_ < REPS(10); ++rep_) { Gemm g = plain_gemm((const bf16_t*)(ws + WS_X2B), (const bf16_t*)(ws + WS_WFFI), 1024); S.init(T / BM, 22, G, bid);
        EpiFfnAct E{(const float*)(ws + WS_SSP2), a.in[I_FCW], a.in[I_FCB], (bf16_t*)(ws + WS_UU), (bf16_t*)(ws + WS_HG)}; gemm_phase(lds, wave, g, S, E); } SEAM(10);
    if (IN(11)) for (int rep_ = 0; rep_ < REPS(11); ++rep_) phase_ffnfix(a, wave, G); SEAM(11);
    if (IN(12)) for (int rep_ = 0; rep_ < REPS(12); ++rep_) { Gemm g = plain_gemm((const bf16_t*)(ws + WS_UU), (const bf16_t*)(ws + WS_WFFO), DFF); S.init(T / BM, 4, G, bid);
        EpiRes<false> E{(const bf16_t*)(ws + WS_X2B), (bf16_t*)(ws + WS_X3B), (float*)(ws + WS_SSP3)}; gemm_phase(lds, wave, g, S, E); } SEAM(12);
    if (IN(13)) for (int rep_ = 0; rep_ < REPS(13); ++rep_) phase_final(a, wave, G);
#undef IN
#undef SEAM
}

extern "C" void kernel_launch(void* const* d_in, const int* in_sizes, int n_in, void* d_out, int out_size, void* d_ws, size_t ws_size, hipStream_t stream) {
    static int grid = 0;
    if (grid == 0) {
        if (n_in != 37 || in_sizes[0] != T * D || out_size != T * D || ws_size < WS_END) {
            fprintf(stderr, "kernel_launch: unexpected shapes (n_in %d, in0 %d, out %d, ws %zu < %zu); nothing launched\n", n_in, n_in > 0 ? in_sizes[0] : -1, out_size, ws_size, (size_t)WS_END); grid = -1; return; }
        int dev = 0, cus = 0, per_cu = 0;
        if (hipGetDevice(&dev) != hipSuccess || hipDeviceGetAttribute(&cus, hipDeviceAttributeMultiprocessorCount, dev) != hipSuccess) { grid = -1; return; }
        if (hipFuncSetAttribute((const void*)mega, hipFuncAttributeMaxDynamicSharedMemorySize, LDS_BYTES) != hipSuccess) { fprintf(stderr, "kernel_launch: hipFuncSetAttribute failed\n"); grid = -1; return; }
        if (hipOccupancyMaxActiveBlocksPerMultiprocessor(&per_cu, (const void*)mega, 512, LDS_BYTES) != hipSuccess || per_cu < 1) { fprintf(stderr, "kernel_launch: occupancy query says %d\n", per_cu); per_cu = 1; }
        (void)hipGetLastError();
        grid = cus * 1;
    }
    if (grid < 0) return;
    if (hipMemsetAsync((char*)d_ws + WS_CTL, 0, CTL_BYTES, stream) != hipSuccess) { fprintf(stderr, "kernel_launch: memset failed\n"); return; }
    Args a{};
    for (int i = 0; i < 37; ++i) a.in[i] = (const float*)d_in[i];
    a.out = (float*)d_out; a.ws = (unsigned char*)d_ws;
#if MK_SPLIT
    for (int ph = 0; ph <= NPHASE; ++ph) {
        a.ph_lo = ph; a.ph_hi = ph + 1; void* args[] = {&a};
        hipError_t e = hipLaunchCooperativeKernel((const void*)mega, dim3(grid), dim3(512), args, LDS_BYTES, stream);
        if (e != hipSuccess) { fprintf(stderr, "kernel_launch: launch of phase %d failed: %s\n", ph, hipGetErrorString(e)); break; }
    }
#else
    a.ph_lo = 0; a.ph_hi = NPHASE + 1; void* args[] = {&a};
    hipError_t e = hipLaunchCooperativeKernel((const void*)mega, dim3(grid), dim3(512), args, LDS_BYTES, stream);
    if (e != hipSuccess) fprintf(stderr, "kernel_launch: cooperative launch failed: %s (grid %d)\n", hipGetErrorString(e), grid);
#endif
}
```

```cpp
#include <hip/hip_runtime.h>
#include <hip/hip_cooperative_groups.h>
#include <cstdio>
namespace cg = cooperative_groups;

#ifndef MK_SPLIT
#define MK_SPLIT 0
#endif

#ifndef DUP_PHASE
#define DUP_PHASE -1
#endif
#define REPS(k) ((DUP_PHASE == (k)) ? 2 : 1)
#define LAS __attribute__((address_space(3)))
typedef unsigned short bf16_t;
typedef short bf16x8 __attribute__((ext_vector_type(8)));
typedef float f32x4 __attribute__((ext_vector_type(4)));
typedef float f32x2 __attribute__((ext_vector_type(2)));
typedef unsigned u32x4 __attribute__((ext_vector_type(4)));
typedef unsigned u32x2 __attribute__((ext_vector_type(2)));

constexpr int T = 65536, D = 1024, SEQ = 2048, NB = 32, NMEM = 256, TM = NB * NMEM;
constexpr int AW = 512, RW = 1792, PIN = 4864, DFF = 2816;
constexpr float NORM_EPS = 1e-6f, LNX_EPS = 64e-5f;

constexpr size_t MiB = 1u << 20;
constexpr size_t WS_WIN = 0;
constexpr size_t WS_WFFI = 10 * MiB;
constexpr size_t WS_WFFO = 21 * MiB;
constexpr size_t WS_WMIX = 27 * MiB, WS_WCQ = 29 * MiB, WS_WK = 31 * MiB, WS_WV = 33 * MiB, WS_WCO = 35 * MiB;
constexpr size_t WS_WA = 37 * MiB, WS_WB = 38 * MiB;
constexpr size_t WS_WLORA = 39 * MiB;
constexpr size_t WS_WRG = 40 * MiB;
constexpr size_t WS_CTL = 46 * MiB, CTL_BYTES = 16384;
constexpr size_t WS_RSTDX = 48 * MiB;
constexpr size_t WS_SSP1 = 49 * MiB, WS_SSP2 = 53 * MiB, WS_SSP3 = 57 * MiB, WS_SSPA = 61 * MiB;
constexpr size_t WS_BON = 65 * MiB;
constexpr size_t WS_MEMN = 68 * MiB, WS_KM = 84 * MiB, WS_VT = 100 * MiB;
constexpr size_t WS_XB = 120 * MiB;
constexpr size_t WS_PR = 248 * MiB;
constexpr size_t WS_PX = 472 * MiB, WS_PY = 536 * MiB;
constexpr size_t WS_LIN = 600 * MiB, WS_XBC = 632 * MiB;
constexpr size_t WS_LOUT = 696 * MiB;
constexpr size_t WS_RGLA = 888 * MiB, WS_RGU = 952 * MiB;
constexpr size_t WS_YRAW = WS_PX, WS_YB = WS_LIN, WS_YA = WS_RGLA;
constexpr size_t WS_GAB = 248 * MiB;
constexpr size_t WS_MERGED = 696 * MiB;
constexpr size_t WS_X1B = WS_XB, WS_Q = 248 * MiB, WS_PEXP = 376 * MiB, WS_O = 504 * MiB, WS_X2B = WS_XB;
constexpr size_t WS_X3B = 376 * MiB;
constexpr size_t WS_HG = 248 * MiB, WS_UU = 600 * MiB;
constexpr size_t WS_END = 1016 * MiB;

constexpr int LDS_BYTES = 147456;

__device__ __forceinline__ unsigned cvt_pk_bf16(float lo, float hi) { unsigned r; asm("v_cvt_pk_bf16_f32 %0, %1, %2" : "=v"(r) : "v"(lo), "v"(hi)); return r; }
__device__ __forceinline__ float bf_lo(unsigned w) { return __uint_as_float(w << 16); }
__device__ __forceinline__ float bf_hi(unsigned w) { return __uint_as_float(w & 0xffff0000u); }
__device__ __forceinline__ float bf1(bf16_t b) { return __uint_as_float(((unsigned)b) << 16); }
__device__ __forceinline__ bf16_t f2bf(float f) { return (bf16_t)(cvt_pk_bf16(f, 0.f) & 0xffffu); }
__device__ __forceinline__ float sigmoidf_(float x) { return __builtin_amdgcn_rcpf(1.0f + __expf(-x)); }
__device__ __forceinline__ float gelu_tanh(float x) { const float z = 1.5957691216057308f * (x + 0.044715f * x * x * x); return x * sigmoidf_(z); }
__device__ __forceinline__ int lane_id() { int l; asm volatile("v_mbcnt_lo_u32_b32 %0, -1, 0\n\tv_mbcnt_hi_u32_b32 %0, -1, %0" : "=v"(l)); return l; }
__device__ __forceinline__ float wave_sum(float v) {
#pragma unroll
    for (int o = 1; o < 64; o <<= 1) v += __shfl_xor(v, o);
    return v;
}
__device__ __forceinline__ void unpack8(const u32x4 w, float (&f)[8]) {
    f[0] = bf_lo(w.x); f[1] = bf_hi(w.x); f[2] = bf_lo(w.y); f[3] = bf_hi(w.y); f[4] = bf_lo(w.z); f[5] = bf_hi(w.z); f[6] = bf_lo(w.w); f[7] = bf_hi(w.w);
}
__device__ __forceinline__ u32x4 pack8(const float (&f)[8]) {
    u32x4 w; w.x = cvt_pk_bf16(f[0], f[1]); w.y = cvt_pk_bf16(f[2], f[3]); w.z = cvt_pk_bf16(f[4], f[5]); w.w = cvt_pk_bf16(f[6], f[7]); return w;
}


#define XB_TMO      128
#define XB_XCNT(j)  (256  + 64 * (j))
#define XB_XSUB(j)  (1280 + 64 * (j))
#define XB_XGEN(j)  (2304 + 64 * (j))
#define XB_TOP      3328
#define XB_TOPGEN   3392
#define XCD_BAR_WORDS 3456
#define XB_SPIN_CAP (1u << 22)
__device__ __forceinline__ unsigned xb_ld(unsigned* p)              { return __hip_atomic_load(p, __ATOMIC_RELAXED, __HIP_MEMORY_SCOPE_AGENT); }
__device__ __forceinline__ unsigned xb_add(unsigned* p, unsigned v) { return __hip_atomic_fetch_add(p, v, __ATOMIC_RELAXED, __HIP_MEMORY_SCOPE_AGENT); }
__device__ __forceinline__ unsigned xb_xcc_id() { return (unsigned)__builtin_amdgcn_s_getreg((3 << 11) | 20) & 0xFu; }
#define XB_SPIN(cond, bar) do { unsigned _sp = 0; while (cond) { __builtin_amdgcn_s_sleep(1); \
    if ((++_sp & 255u) == 0u) { if (xb_ld(&(bar)[XB_TMO])) break; if (_sp > XB_SPIN_CAP) { atomicAdd(&(bar)[XB_TMO], 1u); break; } } } } while (0)
struct XcdBarrier { unsigned* bar; unsigned x; volatile LAS unsigned* st; };
__device__ __forceinline__ XcdBarrier xcd_barrier_post(unsigned* bar, volatile LAS unsigned* st, bool t0) {
    XcdBarrier b; b.bar = bar; b.x = xb_xcc_id(); b.st = st;
    if (t0) (void)xb_add(&bar[XB_XCNT(b.x)], 1u);
    return b;
}
__device__ __forceinline__ void xcd_barrier_complete(unsigned* bar, unsigned x, unsigned& nloc, unsigned& nx) {
    const unsigned G = gridDim.x * gridDim.y * gridDim.z;
    unsigned sum, cnt, mine, sp = 0u;
    for (;;) {
        sum = 0u; cnt = 0u; mine = 0u;
#pragma unroll
        for (unsigned j = 0; j < 16; ++j) { const unsigned c = xb_ld(&bar[XB_XCNT(j)]); sum += c; cnt += (c > 0u) ? 1u : 0u; mine = (j == x) ? c : mine; }
        if (sum == G) break;
        __builtin_amdgcn_s_sleep(1);
        if ((++sp & 255u) == 0u) { if (xb_ld(&bar[XB_TMO])) break; if (sp > XB_SPIN_CAP) { atomicAdd(&bar[XB_TMO], 1u); break; } }
    }
    nloc = mine > 0u ? mine : 1u; nx = cnt > 0u ? cnt : 1u;
}
__device__ __forceinline__ void xcd_barrier(const XcdBarrier& b, bool t0) {
    asm volatile("s_waitcnt vmcnt(0)" ::: "memory");
    __syncthreads();
    if (t0) {
        unsigned* bar = b.bar;
        __builtin_amdgcn_s_waitcnt(0);
        unsigned nloc = b.st[0], nx = b.st[1];
        if (nloc == 0u) { xcd_barrier_complete(bar, b.x, nloc, nx); b.st[0] = nloc; b.st[1] = nx; }
        const unsigned old = xb_add(&bar[XB_XSUB(b.x)], 1u);
        const unsigned gen = old / nloc;
        if (old + 1u == (gen + 1u) * nloc) {
            __builtin_amdgcn_fence(__ATOMIC_RELEASE, "agent");
            asm volatile("s_waitcnt vmcnt(0)" ::: "memory");
            const unsigned og = xb_add(&bar[XB_TOP], 1u);
            const unsigned tg = og / nx;
            if (og + 1u == (tg + 1u) * nx) xb_add(&bar[XB_TOPGEN], 1u);
            else XB_SPIN(xb_ld(&bar[XB_TOPGEN]) == tg, bar);
            __builtin_amdgcn_fence(__ATOMIC_ACQUIRE, "agent");
            xb_add(&bar[XB_XGEN(b.x)], 1u);
            asm volatile("s_waitcnt vmcnt(0)" ::: "memory");
        } else {
            XB_SPIN(xb_ld(&bar[XB_XGEN(b.x)]) == gen, bar);
            __builtin_amdgcn_fence(__ATOMIC_ACQUIRE, "agent");
            asm volatile("s_waitcnt vmcnt(0)" ::: "memory");
        }
    }
    __syncthreads();
}

constexpr int BM = 256, BK = 64, HALF = 128, HTB = HALF * BK * 2, NXCD = 8, WGM = 8;
__device__ __forceinline__ int lds_byte(int r, int c) { const int st = (r >> 4) * 2 + (c >> 5), rr = r & 15, cc = c & 31, ob = rr * 64 + cc * 2; return st * 1024 + (ob ^ (((ob >> 9) & 1) << 5)); }
__device__ __forceinline__ void stage_rc(int b, int& R, int& C) { const int st = b / 1024, sb = b % 1024, swz = sb ^ (((sb >> 9) & 1) << 5); R = (st >> 1) * 16 + swz / 64; C = (st & 1) * 32 + (swz % 64) / 2; }
__device__ __forceinline__ int perm32(int rho) { const int n = rho >> 4, i = rho & 15; return 8 * (i >> 2) + 4 * n + (i & 3); }

struct Unit { int pm, pn; };
struct Gemm { const bf16_t* A; const bf16_t* Bt; int lda, ldb, K; size_t a_pm, a_pn, b_pn, b_pb, a_pn2; };
__device__ __forceinline__ Gemm plain_gemm(const bf16_t* A, const bf16_t* Bt, int K) { Gemm g; g.A = A; g.Bt = Bt; g.lda = K; g.ldb = K; g.K = K; g.a_pm = (size_t)BM * K * 2; g.a_pn = 0; g.b_pn = (size_t)BM * K * 2; g.b_pb = 0; g.a_pn2 = 0; return g; }

struct StaticOrder {
    int nM, nN, nwg, G, c;
    __device__ void init(int nM_, int nN_, int G_, int c_) { nM = nM_; nN = nN_; nwg = nM * nN; G = G_; c = c_; }
    __device__ bool next(int i, Unit& u) const {
        const long L = (long)i * G + c; if (L >= nwg) return false;
        int wgid = (int)L; { const int q = nwg / NXCD, r = nwg % NXCD, xcd = wgid % NXCD, off = wgid / NXCD; wgid = (xcd < r ? xcd * (q + 1) : r * (q + 1) + (xcd - r) * q) + off; }
        const int nig = WGM * nN, gid = wgid / nig, fm = gid * WGM, gsz = (nM - fm) < WGM ? (nM - fm) : WGM;
        u.pm = fm + ((wgid % nig) % gsz); u.pn = (wgid % nig) / gsz; return true;
    }
};

typedef f32x4 Acc[2][2][4][2];

template <class Epi>
__device__ __forceinline__ void gemm_phase(LAS unsigned char* lds, const int wid, const Gemm g, const StaticOrder& S, const Epi& E) {
    const int lane = lane_id(), tid = wid * 64 + lane, wr = wid >> 2, wc = wid & 3, fr = lane & 15, fq = lane >> 4;
    const int nt = g.K / BK;
    unsigned voffA[2], voffB[2];
#pragma unroll
    for (int i = 0; i < 2; ++i) { int R, C; stage_rc(tid * 16 + i * 8192, R, C); const int Rb = Epi::PERM ? ((R & ~31) + perm32(R & 31)) : R;
        voffA[i] = (unsigned)(R * g.lda + C) * 2u; voffB[i] = (unsigned)(Rb * g.ldb + C) * 2u; }
    const size_t kstep = (size_t)(BK * 2);
    const size_t hstepA = (size_t)HALF * g.lda * 2, hstepB = (size_t)HALF * g.ldb * 2;
    const unsigned ldsw = (unsigned)wid * 1024u;
    const int aoff = lds_byte(wr * 64 + fr, fq * 8), boff = lds_byte(wc * 32 + fr, fq * 8);
#define PG8_SA(b, h) (((b) * 2 + (h)) * HTB)
#define PG8_SB(b, h) ((4 + (b) * 2 + (h)) * HTB)
#define PG8_STAGE(bufoff, gbase, voff) do { _Pragma("unroll") for (int _i = 0; _i < 2; ++_i) \
        __builtin_amdgcn_global_load_lds((const unsigned*)((const char*)(gbase) + (voff)[_i]), (LAS unsigned*)(lds + (bufoff) + ldsw + _i * 8192), 16, 0, 0); } while (0)
#define PG8_LDA(dst, b, h) do { _Pragma("unroll") for (int m = 0; m < 4; ++m) _Pragma("unroll") for (int k = 0; k < 2; ++k) dst[m][k] = *(const LAS bf16x8*)(lds + PG8_SA(b, h) + aoff + m * 2048 + k * 1024); } while (0)
#define PG8_LDB(dst, b, h) do { _Pragma("unroll") for (int n = 0; n < 2; ++n) _Pragma("unroll") for (int k = 0; k < 2; ++k) dst[n][k] = *(const LAS bf16x8*)(lds + PG8_SB(b, h) + boff + n * 2048 + k * 1024); } while (0)
#define PG8_MMA(ai, bj, At, Bt) do { __builtin_amdgcn_s_setprio(1); _Pragma("unroll") for (int m = 0; m < 4; ++m) _Pragma("unroll") for (int n = 0; n < 2; ++n) _Pragma("unroll") for (int k = 0; k < 2; ++k) \
        acc[ai][bj][m][n] = __builtin_amdgcn_mfma_f32_16x16x32_bf16(Bt[n][k], At[m][k], acc[ai][bj][m][n], 0, 0, 0); __builtin_amdgcn_s_setprio(0); } while (0)
#define PG8_WAIT_V(n) asm volatile("s_waitcnt vmcnt(" #n ")" ::: "memory")
#define PG8_WAIT_L(n) asm volatile("s_waitcnt lgkmcnt(" #n ")" ::: "memory")
#define PG8_BAR __builtin_amdgcn_s_barrier()
#define PG8_SCHED __builtin_amdgcn_sched_barrier(0)
#define PG8_UA(u) ((const char*)g.A + (size_t)(u).pm * g.a_pm + (size_t)(u).pn * g.a_pn + (size_t)((u).pn >> 1) * g.a_pn2)
#define PG8_UB(u) ((const char*)g.Bt + (size_t)(u).pn * g.b_pn + (size_t)((u).pm >> 3) * g.b_pb)
    Unit cur, nxt; int ui = 0;
    if (!S.next(0, cur)) return;
    Acc acc;
#pragma unroll
    for (int a = 0; a < 2; ++a)
#pragma unroll
        for (int b = 0; b < 2; ++b)
#pragma unroll
            for (int m = 0; m < 4; ++m)
#pragma unroll
                for (int n = 0; n < 2; ++n) acc[a][b][m][n] = (f32x4){0.f, 0.f, 0.f, 0.f};
    bf16x8 At[4][2], B0[2][2], B1[2][2];
    const char* cA = PG8_UA(cur); const char* cB = PG8_UB(cur);
    PG8_STAGE(PG8_SB(0, 0), cB, voffB); PG8_STAGE(PG8_SB(0, 1), cB + hstepB, voffB); PG8_STAGE(PG8_SA(0, 0), cA, voffA); PG8_STAGE(PG8_SA(0, 1), cA + hstepA, voffA);
    if (wr == 1) PG8_BAR;
    PG8_WAIT_V(2); PG8_BAR;
    PG8_STAGE(PG8_SB(1, 0), cB + kstep, voffB); PG8_STAGE(PG8_SA(1, 0), cA + kstep, voffA); PG8_STAGE(PG8_SB(1, 1), cB + hstepB + kstep, voffB);
    PG8_WAIT_V(6); PG8_BAR;
    for (;;) {
        const bool has_next = S.next(ui + 1, nxt);
        const char* nA = has_next ? PG8_UA(nxt) : cA; const char* nB = has_next ? PG8_UB(nxt) : cB;
        for (int t = 0; t < nt; t += 2) {
            const bool last = (t == nt - 2);
            const char* a1 = cA + (size_t)(t + 1) * kstep;
            const char* a2 = last ? nA : cA + (size_t)(t + 2) * kstep; const char* b2 = last ? nB : cB + (size_t)(t + 2) * kstep;
            const char* a3 = a2 + kstep; const char* b3 = b2 + kstep;
            PG8_LDB(B0, 0, 0); PG8_LDB(B1, 0, 1); PG8_SCHED; PG8_LDA(At, 0, 0); PG8_STAGE(PG8_SA(1, 1), a1 + hstepA, voffA);
            PG8_WAIT_V(8); PG8_WAIT_L(0); PG8_BAR; PG8_MMA(0, 0, At, B0); PG8_MMA(0, 1, At, B1); PG8_BAR; PG8_SCHED;
            PG8_LDA(At, 0, 1); PG8_STAGE(PG8_SB(0, 0), b2, voffB); PG8_STAGE(PG8_SB(0, 1), b2 + hstepB, voffB); PG8_STAGE(PG8_SA(0, 0), a2, voffA);
            PG8_WAIT_V(8); PG8_WAIT_L(0); PG8_BAR; PG8_MMA(1, 0, At, B0); PG8_MMA(1, 1, At, B1); PG8_BAR; PG8_SCHED;
            PG8_LDB(B0, 1, 0); PG8_LDB(B1, 1, 1); PG8_SCHED; PG8_LDA(At, 1, 0); PG8_STAGE(PG8_SA(0, 1), a2 + hstepA, voffA);
            PG8_WAIT_V(8); PG8_WAIT_L(0); PG8_BAR; PG8_MMA(0, 0, At, B0); PG8_MMA(0, 1, At, B1); PG8_BAR; PG8_SCHED;
            PG8_LDA(At, 1, 1); PG8_STAGE(PG8_SB(1, 0), b3, voffB); PG8_STAGE(PG8_SB(1, 1), b3 + hstepB, voffB); PG8_STAGE(PG8_SA(1, 0), a3, voffA);
            PG8_WAIT_V(8); PG8_WAIT_L(0); PG8_BAR; PG8_MMA(1, 0, At, B0); PG8_MMA(1, 1, At, B1); PG8_BAR; PG8_SCHED;
        }
        if (wr == 0) PG8_BAR;
        E(acc, cur, wr, wc, fr, fq);
        if (!has_next) break;
#pragma unroll
        for (int a = 0; a < 2; ++a)
#pragma unroll
            for (int b = 0; b < 2; ++b)
#pragma unroll
                for (int m = 0; m < 4; ++m)
#pragma unroll
                    for (int n = 0; n < 2; ++n) acc[a][b][m][n] = (f32x4){0.f, 0.f, 0.f, 0.f};
        cur = nxt; cA = nA; cB = nB; ++ui;
        if (wr == 1) PG8_BAR;
    }
    PG8_WAIT_V(0);
    PG8_BAR;
#undef PG8_SA
#undef PG8_SB
#undef PG8_STAGE
#undef PG8_LDA
#undef PG8_LDB
#undef PG8_MMA
#undef PG8_WAIT_V
#undef PG8_WAIT_L
#undef PG8_BAR
#undef PG8_SCHED
#undef PG8_UA
#undef PG8_UB
}

#define EPI_ROWS_BEGIN for (int ai = 0; ai < 2; ++ai) { _Pragma("unroll") for (int m = 0; m < 4; ++m) { const int r = u.pm * BM + ai * HALF + wr * 64 + m * 16 + fr;
#define EPI_ROWS_END } }

__device__ __forceinline__ float rstd_from16(const float* ss, int r) { return rsqrtf(ss[r] * (1.0f / 1024.0f) + NORM_EPS); }

struct EpiProj { static constexpr bool PERM = true;
    const float* rstd; const float* bias; bf16_t* PR; bf16_t* PX; bf16_t* PY;
    __device__ __forceinline__ void operator()(Acc& acc, const Unit& u, int wr, int wc, int fr, int fq) const {
        bf16_t* base; int ld, colt;
        if (u.pn < 7) { base = PR; ld = RW; colt = u.pn * 256; } else if (u.pn < 9) { base = PX; ld = 512; colt = (u.pn - 7) * 256; } else { base = PY; ld = 512; colt = (u.pn - 9) * 256; }
        const int col0 = colt + wc * 32 + 8 * fq, bcol0 = u.pn * 256 + wc * 32 + 8 * fq;
        f32x4 bv[2][2];
#pragma unroll
        for (int bj = 0; bj < 2; ++bj)
#pragma unroll
            for (int n = 0; n < 2; ++n) bv[bj][n] = *(const f32x4*)(bias + bcol0 + bj * HALF + 4 * n);
#pragma unroll
        EPI_ROWS_BEGIN
            const float rs = rstd[r]; bf16_t* rowp = base + (size_t)r * ld + col0;
#pragma unroll
            for (int bj = 0; bj < 2; ++bj) { const f32x4 v0 = acc[ai][bj][m][0] * rs + bv[bj][0], v1 = acc[ai][bj][m][1] * rs + bv[bj][1];
                u32x4 w; w.x = cvt_pk_bf16(v0[0], v0[1]); w.y = cvt_pk_bf16(v0[2], v0[3]); w.z = cvt_pk_bf16(v1[0], v1[1]); w.w = cvt_pk_bf16(v1[2], v1[3]);
                *(u32x4*)(rowp + bj * HALF) = w; }
        EPI_ROWS_END
    }
};
struct EpiGab { static constexpr bool PERM = true;
    const float* rstd; const float* bias; bf16_t* O; int cofs;
    __device__ __forceinline__ void operator()(Acc& acc, const Unit& u, int wr, int wc, int fr, int fq) const {
        const int col0 = cofs + u.pn * 256 + wc * 32 + 8 * fq;
        f32x4 bv[2][2];
#pragma unroll
        for (int bj = 0; bj < 2; ++bj)
#pragma unroll
            for (int n = 0; n < 2; ++n) bv[bj][n] = *(const f32x4*)(bias + col0 + bj * HALF + 4 * n);
#pragma unroll
        EPI_ROWS_BEGIN
            const float rs = rstd[r]; bf16_t* rowp = O + (size_t)r * 2048 + col0;
#pragma unroll
            for (int bj = 0; bj < 2; ++bj) { f32x4 v0 = acc[ai][bj][m][0] * rs + bv[bj][0], v1 = acc[ai][bj][m][1] * rs + bv[bj][1];
#pragma unroll
                for (int j = 0; j < 4; ++j) { v0[j] = sigmoidf_(v0[j]); v1[j] = sigmoidf_(v1[j]); }
                u32x4 w; w.x = cvt_pk_bf16(v0[0], v0[1]); w.y = cvt_pk_bf16(v0[2], v0[3]); w.z = cvt_pk_bf16(v1[0], v1[1]); w.w = cvt_pk_bf16(v1[2], v1[3]);
                *(u32x4*)(rowp + bj * HALF) = w; }
        EPI_ROWS_END
    }
};
struct EpiPlain { static constexpr bool PERM = true;
    bf16_t* O; int ldc;
    __device__ __forceinline__ void operator()(Acc& acc, const Unit& u, int wr, int wc, int fr, int fq) const {
        const int col0 = u.pn * 256 + wc * 32 + 8 * fq;
#pragma unroll
        EPI_ROWS_BEGIN
            bf16_t* rowp = O + (size_t)r * ldc + col0;
#pragma unroll
            for (int bj = 0; bj < 2; ++bj) { const f32x4 v0 = acc[ai][bj][m][0], v1 = acc[ai][bj][m][1];
                u32x4 w; w.x = cvt_pk_bf16(v0[0], v0[1]); w.y = cvt_pk_bf16(v0[2], v0[3]); w.z = cvt_pk_bf16(v1[0], v1[1]); w.w = cvt_pk_bf16(v1[2], v1[3]);
                *(u32x4*)(rowp + bj * HALF) = w; }
        EPI_ROWS_END
    }
};
struct EpiLora { static constexpr bool PERM = true;
    const float* w0; const float* a0; bf16_t* O;
    __device__ __forceinline__ void operator()(Acc& acc, const Unit& u, int wr, int wc, int fr, int fq) const {
        const int kind = u.pn >> 1, ch0 = (u.pn & 1) * 256 + wc * 32 + 8 * fq, col0 = u.pn * 256 + wc * 32 + 8 * fq;
        const float* bsrc = kind == 0 ? w0 : a0;
        f32x4 bv[2][2];
#pragma unroll
        for (int bj = 0; bj < 2; ++bj)
#pragma unroll
            for (int n = 0; n < 2; ++n) bv[bj][n] = kind < 2 ? *(const f32x4*)(bsrc + ch0 + bj * HALF + 4 * n) : (f32x4){0.f, 0.f, 0.f, 0.f};
        const float sc = kind == 0 ? 0.6065306597126334f : 1.0f;
#pragma unroll
        EPI_ROWS_BEGIN
            bf16_t* rowp = O + (size_t)r * 1536 + col0;
#pragma unroll
            for (int bj = 0; bj < 2; ++bj) { f32x4 v0 = acc[ai][bj][m][0] + bv[bj][0], v1 = acc[ai][bj][m][1] + bv[bj][1];
                if (kind < 2) {
#pragma unroll
                    for (int j = 0; j < 4; ++j) { v0[j] = sc * sigmoidf_(v0[j]); v1[j] = sc * sigmoidf_(v1[j]); } }
                u32x4 w; w.x = cvt_pk_bf16(v0[0], v0[1]); w.y = cvt_pk_bf16(v0[2], v0[3]); w.z = cvt_pk_bf16(v1[0], v1[1]); w.w = cvt_pk_bf16(v1[2], v1[3]);
                *(u32x4*)(rowp + bj * HALF) = w; }
        EPI_ROWS_END
    }
};
struct EpiRg { static constexpr bool PERM = true;
    const float* ba; const float* bx; const float* lam; const bf16_t* XBC; bf16_t* LA; bf16_t* U;
    __device__ __forceinline__ void operator()(Acc& acc, const Unit& u, int wr, int wc, int fr, int fq) const {
        const int ch0 = u.pn * 128 + wc * 32 + 8 * fq;
        float vba[8], vbx[8], vls[8];
#pragma unroll
        for (int j = 0; j < 8; ++j) { vba[j] = ba[ch0 + j]; vbx[j] = bx[ch0 + j]; vls[j] = -8.0f * log1pf(__expf(-lam[ch0 + j])); }
#pragma unroll
        EPI_ROWS_BEGIN
            const bool first = (r & (SEQ - 1)) == 0;
            float xb[8]; unpack8(*(const u32x4*)(XBC + (size_t)r * 512 + ch0), xb);
            float la[8], uu[8];
#pragma unroll
            for (int j = 0; j < 8; ++j) { const float ga = sigmoidf_(acc[ai][0][m][j >> 2][j & 3] + vba[j]), gx = sigmoidf_(acc[ai][1][m][j >> 2][j & 3] + vbx[j]);
                la[j] = vls[j] * ga; const float a = __expf(la[j]); const float mult = first ? 1.0f : sqrtf(fmaxf(1.0f - a * a, 0.f)); uu[j] = xb[j] * gx * mult; }
            *(u32x4*)(LA + (size_t)r * 512 + ch0) = pack8(la); *(u32x4*)(U + (size_t)r * 512 + ch0) = pack8(uu);
        EPI_ROWS_END
    }
};
template <bool FIRST> struct EpiBranch { static constexpr bool PERM = true;
    const bf16_t* G; bf16_t* M;
    __device__ __forceinline__ void operator()(Acc& acc, const Unit& u, int wr, int wc, int fr, int fq) const {
        const int col0 = u.pn * 256 + wc * 32 + 8 * fq;
#pragma unroll
        EPI_ROWS_BEGIN
#pragma unroll
            for (int bj = 0; bj < 2; ++bj) { const int c = col0 + bj * HALF;
                float gv[8]; unpack8(*(const u32x4*)(G + (size_t)r * 2048 + (FIRST ? 0 : 1024) + c), gv);
                float o[8];
                if (!FIRST) unpack8(*(const u32x4*)(M + (size_t)r * 1024 + c), o);
#pragma unroll
                for (int j = 0; j < 8; ++j) { const float p = acc[ai][bj][m][j >> 2][j & 3] * gv[j]; o[j] = FIRST ? p : o[j] + p; }
                *(u32x4*)(M + (size_t)r * 1024 + c) = pack8(o); }
        EPI_ROWS_END
    }
};
template <bool BASE_F32> struct EpiRes { static constexpr bool PERM = true;
    const void* base; bf16_t* XB; float* ssp;
    __device__ __forceinline__ void operator()(Acc& acc, const Unit& u, int wr, int wc, int fr, int fq) const {
        const int col0 = u.pn * 256 + wc * 32 + 8 * fq;
#pragma unroll
        EPI_ROWS_BEGIN
            float s = 0.f;
#pragma unroll
            for (int bj = 0; bj < 2; ++bj) { const size_t off = (size_t)r * 1024 + col0 + bj * HALF; float o[8];
                if (BASE_F32) { const f32x4 b0 = *(const f32x4*)((const float*)base + off), b1 = *(const f32x4*)((const float*)base + off + 4);
                    o[0] = b0[0]; o[1] = b0[1]; o[2] = b0[2]; o[3] = b0[3]; o[4] = b1[0]; o[5] = b1[1]; o[6] = b1[2]; o[7] = b1[3]; }
                else unpack8(*(const u32x4*)((const bf16_t*)base + off), o);
#pragma unroll
                for (int j = 0; j < 8; ++j) { o[j] += acc[ai][bj][m][j >> 2][j & 3]; s += o[j] * o[j]; }
                *(u32x4*)(XB + off) = pack8(o); }
            s += __shfl_xor(s, 16); s += __shfl_xor(s, 32);
            if (fq == 0) atomicAdd(ssp + r, s);
        EPI_ROWS_END
    }
};
struct EpiQ { static constexpr bool PERM = true;
    const float* ssp; bf16_t* O;
    __device__ __forceinline__ void operator()(Acc& acc, const Unit& u, int wr, int wc, int fr, int fq) const {
        const int col0 = u.pn * 256 + wc * 32 + 8 * fq;
#pragma unroll
        EPI_ROWS_BEGIN
            const float rs = rstd_from16(ssp, r) * 0.0625f; bf16_t* rowp = O + (size_t)r * 1024 + col0;
#pragma unroll
            for (int bj = 0; bj < 2; ++bj) { const f32x4 v0 = acc[ai][bj][m][0] * rs, v1 = acc[ai][bj][m][1] * rs;
                u32x4 w; w.x = cvt_pk_bf16(v0[0], v0[1]); w.y = cvt_pk_bf16(v0[2], v0[3]); w.z = cvt_pk_bf16(v1[0], v1[1]); w.w = cvt_pk_bf16(v1[2], v1[3]);
                *(u32x4*)(rowp + bj * HALF) = w; }
        EPI_ROWS_END
    }
};
struct EpiSc { static constexpr bool PERM = true;
    bf16_t* O; float* ssp;
    __device__ __forceinline__ void operator()(Acc& acc, const Unit& u, int wr, int wc, int fr, int fq) const {
        const int col0 = u.pn * 256 + wc * 32 + 8 * fq;
#pragma unroll
        EPI_ROWS_BEGIN
            bf16_t* rowp = O + (size_t)r * 1024 + col0; float s = 0.f;
#pragma unroll
            for (int bj = 0; bj < 2; ++bj) { f32x4 v0 = acc[ai][bj][m][0], v1 = acc[ai][bj][m][1];
#pragma unroll
                for (int j = 0; j < 4; ++j) { v0[j] = __expf(v0[j]); v1[j] = __expf(v1[j]); }
                s += ((v0[0] + v0[1]) + (v0[2] + v0[3])) + ((v1[0] + v1[1]) + (v1[2] + v1[3]));
                u32x4 w; w.x = cvt_pk_bf16(v0[0], v0[1]); w.y = cvt_pk_bf16(v0[2], v0[3]); w.z = cvt_pk_bf16(v1[0], v1[1]); w.w = cvt_pk_bf16(v1[2], v1[3]);
                *(u32x4*)(rowp + bj * HALF) = w; }
            s += __shfl_xor(s, 16); s += __shfl_xor(s, 32);
            if (fq == 0) ssp[(size_t)r * 16 + u.pn * 4 + wc] = s;
        EPI_ROWS_END
    }
};
struct EpiPv { static constexpr bool PERM = true;
    const float* ssp; bf16_t* O;
    __device__ __forceinline__ void operator()(Acc& acc, const Unit& u, int wr, int wc, int fr, int fq) const {
        const int col0 = u.pn * 256 + wc * 32 + 8 * fq;
#pragma unroll
        EPI_ROWS_BEGIN
            const f32x4 sp = *(const f32x4*)(ssp + (size_t)r * 16 + u.pn * 4); const float rs = 1.0f / ((sp.x + sp.y) + (sp.z + sp.w));
            bf16_t* rowp = O + (size_t)r * 1024 + col0;
#pragma unroll
            for (int bj = 0; bj < 2; ++bj) { const f32x4 v0 = acc[ai][bj][m][0] * rs, v1 = acc[ai][bj][m][1] * rs;
                u32x4 w; w.x = cvt_pk_bf16(v0[0], v0[1]); w.y = cvt_pk_bf16(v0[2], v0[3]); w.z = cvt_pk_bf16(v1[0], v1[1]); w.w = cvt_pk_bf16(v1[2], v1[3]);
                *(u32x4*)(rowp + bj * HALF) = w; }
        EPI_ROWS_END
    }
};
__device__ __forceinline__ float dpp_ror1(float v) { return __int_as_float(__builtin_amdgcn_update_dpp(0, __float_as_int(v), 0x121, 0xf, 0xf, false)); }
__device__ __forceinline__ float dpp_ror2(float v) { return __int_as_float(__builtin_amdgcn_update_dpp(0, __float_as_int(v), 0x122, 0xf, 0xf, false)); }
struct EpiFfnAct { static constexpr bool PERM = true;
    const float* ssp; const float* cw; const float* cb; bf16_t* ACT; bf16_t* HG;
    __device__ __forceinline__ void operator()(Acc& acc, const Unit& u, int wr, int wc, int fr_, int fq_) const {
        const int l_ = lane_id(), fr = l_ & 15, fq = l_ >> 4;
        const int col0 = u.pn * 128 + wc * 32 + 8 * fq;
#pragma unroll
        for (int ai = 0; ai < 2; ++ai) {
            const int rbase = u.pm * BM + ai * HALF + wr * 64 + fr;
            float rs[4];
#pragma unroll
            for (int m = 0; m < 4; ++m) rs[m] = rstd_from16(ssp, rbase + m * 16);
            const size_t grp = (size_t)(rbase >> 6);
            if (fr < 2) { float t[8];
#pragma unroll
                for (int j = 0; j < 8; ++j) t[j] = acc[ai][0][0][j >> 2][j & 3] * rs[0];
                *(u32x4*)(HG + (grp * 4 + 2 + fr) * DFF + col0) = pack8(t); }
            if (fr >= 14) { float t[8];
#pragma unroll
                for (int j = 0; j < 8; ++j) t[j] = acc[ai][0][3][j >> 2][j & 3] * rs[3];
                *(u32x4*)(HG + (grp * 4 + (fr - 14)) * DFF + col0) = pack8(t); }
#pragma unroll
            for (int j = 0; j < 8; ++j) {
                const float w0 = cw[col0 + j], w1 = cw[DFF + col0 + j], w2 = cw[2 * DFF + col0 + j], b0 = cb[col0 + j];
                float g[4], r1[4], r2[4];
#pragma unroll
                for (int m = 0; m < 4; ++m) { g[m] = acc[ai][0][m][j >> 2][j & 3] * rs[m]; r1[m] = dpp_ror1(g[m]); r2[m] = dpp_ror2(g[m]); }
#pragma unroll
                for (int m = 0; m < 4; ++m) {
                    const float p1 = fr >= 1 ? r1[m] : r1[m > 0 ? m - 1 : 0], p2 = fr >= 2 ? r2[m] : r2[m > 0 ? m - 1 : 0];
                    const float up = acc[ai][1][m][j >> 2][j & 3] * rs[m];
                    const float gate = b0 + w0 * p2 + w1 * p1 + w2 * g[m];
                    acc[ai][1][m][j >> 2][j & 3] = (m == 0 && fr < 2) ? up : gelu_tanh(gate) * up;
                }
            }
#pragma unroll
            for (int m = 0; m < 4; ++m) { const f32x4 v0 = acc[ai][1][m][0], v1 = acc[ai][1][m][1];
                u32x4 w; w.x = cvt_pk_bf16(v0[0], v0[1]); w.y = cvt_pk_bf16(v0[2], v0[3]); w.z = cvt_pk_bf16(v1[0], v1[1]); w.w = cvt_pk_bf16(v1[2], v1[3]);
                *(u32x4*)(ACT + (size_t)(rbase + m * 16) * DFF + col0) = w; }
        }
    }
};

struct Args { const float* in[37]; float* out; unsigned char* ws; int ph_lo, ph_hi; };
enum { I_X = 0, I_MEM, I_NMIXG, I_WIN, I_BIN, I_MU, I_W0, I_WUP, I_A0, I_AUP, I_GUP, I_KK, I_KA, I_RK, I_LNXG, I_LNXB, I_WBA, I_CBW, I_CBB, I_WRGA, I_BRGA, I_WRGX, I_BRGX,
       I_LAM, I_WBB, I_WMIX, I_NXG, I_NMEMG, I_WCQ, I_WCKV, I_WCO, I_NFFNG, I_WFFI, I_FCW, I_FCB, I_WFFO, I_NFING };

__device__ __forceinline__ void transpose_item(const float* W, int ldw, int K, bf16_t* WT, int ldd, const float* gain, int map, int srcofs, LAS float* scr, int item, int lane) {
    const int nkb = K / 64, nb = item / nkb, kb = item % nkb, k0 = 64 * kb, n0 = 32 * nb;
    int ns = n0 + srcofs;
    if (map == 1) { const int tile = n0 >> 8, c = n0 & 255; ns = c < 128 ? tile * 128 + c : DFF + tile * 128 + (c - 128); }
#pragma unroll 8
    for (int i = 0; i < 32; ++i) { const int kk = 2 * i + (lane >> 5); float v = W[(size_t)(k0 + kk) * ldw + ns + (lane & 31)]; if (gain) v *= gain[k0 + kk]; scr[kk * 33 + (lane & 31)] = v; }
    asm volatile("s_waitcnt lgkmcnt(0)" ::: "memory");
    const int c = lane & 7;
#pragma unroll
    for (int j = 0; j < 4; ++j) { const int n = (lane >> 3) + 8 * j; const LAS float* s = scr + (8 * c) * 33 + n;
        u32x4 o; o.x = cvt_pk_bf16(s[0 * 33], s[1 * 33]); o.y = cvt_pk_bf16(s[2 * 33], s[3 * 33]); o.z = cvt_pk_bf16(s[4 * 33], s[5 * 33]); o.w = cvt_pk_bf16(s[6 * 33], s[7 * 33]);
        *(u32x4*)(WT + (size_t)(n0 + n) * ldd + k0 + 8 * c) = o; }
    asm volatile("s_waitcnt lgkmcnt(0)" ::: "memory");
}

__device__ __forceinline__ void phase_prep(const Args& a, LAS unsigned char* lds, int wave, int G) {
    const int lane = lane_id();
    unsigned char* ws = a.ws;
    LAS float* scr = (LAS float*)(lds + wave * 16384);
    const int gw = blockIdx.x * 8 + wave, NGW = G * 8;
#define TJOB(W_, ldw_, K_, Nd_, dst_, gain_, map_, srcofs_) do { const int nitems = ((K_) / 64) * ((Nd_) / 32); \
        for (int it = gw; it < nitems; it += NGW) transpose_item((W_), (ldw_), (K_), (bf16_t*)(ws + (dst_)), (K_), (gain_), (map_), (srcofs_), scr, it, lane); } while (0)
    TJOB(a.in[I_WIN], PIN, 1024, PIN, WS_WIN, a.in[I_NMIXG], 0, 0);
    TJOB(a.in[I_WBA], 1024, 512, 1024, WS_WA, nullptr, 0, 0);
    TJOB(a.in[I_WBB], 1024, 512, 1024, WS_WB, nullptr, 0, 0);
    TJOB(a.in[I_WMIX], 1024, 1024, 1024, WS_WMIX, nullptr, 0, 0);
    TJOB(a.in[I_WCQ], 1024, 1024, 1024, WS_WCQ, a.in[I_NXG], 0, 0);
    TJOB(a.in[I_WCKV], 2048, 1024, 1024, WS_WK, nullptr, 0, 0);
    TJOB(a.in[I_WCKV], 2048, 1024, 1024, WS_WV, nullptr, 0, 1024);
    TJOB(a.in[I_WCO], 1024, 1024, 1024, WS_WCO, nullptr, 0, 0);
    TJOB(a.in[I_WFFI], 2 * DFF, 1024, 2 * DFF, WS_WFFI, a.in[I_NFFNG], 1, 0);
    TJOB(a.in[I_WFFO], 1024, DFF, 1024, WS_WFFO, nullptr, 0, 0);
#undef TJOB
    { float* z1 = (float*)(ws + WS_SSP1); float* z2 = (float*)(ws + WS_SSP2); float* z3 = (float*)(ws + WS_SSP3);
      for (int i = blockIdx.x * 512 + wave * 64 + lane; i < T; i += G * 512) { z1[i] = 0.f; z2[i] = 0.f; z3[i] = 0.f; } }
    const int gid = blockIdx.x * 512 + wave * 64 + lane, NT = G * 512;
    { bf16_t* WL = (bf16_t*)(ws + WS_WLORA);
      for (int i = gid; i < 1536 * 256; i += NT) { const int n = i >> 8, k = i & 255, kind = n >> 9, c = n & 511; float v = 0.f;
          if (kind == 0 && k < 64) v = a.in[I_WUP][k * 512 + c]; else if (kind == 1 && k >= 64 && k < 128) v = a.in[I_AUP][(k - 64) * 512 + c]; else if (kind == 2 && k >= 128) v = a.in[I_GUP][(k - 128) * 512 + c];
          WL[i] = f2bf(v); } }
    { bf16_t* WR = (bf16_t*)(ws + WS_WRG);
      for (int i = gid; i < 1024 * 256; i += NT) { const int n = i >> 8, kk = i & 255, pn = n >> 8, c = n & 255, ch = pn * 128 + (c & 127), hb = ch >> 6, j = ch & 63, k = 256 * (pn >> 1) + kk; float v = 0.f;
          if ((k >> 6) == hb) v = (c < 128 ? a.in[I_WRGA] : a.in[I_WRGX])[(hb * 64 + (k & 63)) * 64 + j];
          WR[i] = f2bf(v); } }
    { const float* x = a.in[I_X]; bf16_t* XB = (bf16_t*)(ws + WS_XB); float* rstd = (float*)(ws + WS_RSTDX);
      for (int r0 = gw; r0 < T; r0 += 4 * NGW) {
          f32x4 v[4][4]; float s[4];
#pragma unroll
          for (int q = 0; q < 4; ++q) { const int r = r0 + q * NGW; s[q] = 0.f; if (r < T) { const f32x4* xr = (const f32x4*)(x + (size_t)r * D) + lane;
#pragma unroll
              for (int j = 0; j < 4; ++j) v[q][j] = xr[64 * j]; } else {
#pragma unroll
              for (int j = 0; j < 4; ++j) v[q][j] = (f32x4){0.f, 0.f, 0.f, 0.f}; } }
#pragma unroll
          for (int q = 0; q < 4; ++q) {
#pragma unroll
              for (int j = 0; j < 4; ++j) s[q] += (v[q][j].x * v[q][j].x + v[q][j].y * v[q][j].y) + (v[q][j].z * v[q][j].z + v[q][j].w * v[q][j].w);
              s[q] = wave_sum(s[q]); }
#pragma unroll
          for (int q = 0; q < 4; ++q) { const int r = r0 + q * NGW; if (r < T) { if (lane == 0) rstd[r] = rsqrtf(s[q] * (1.0f / D) + NORM_EPS);
              u32x2* o = (u32x2*)(XB + (size_t)r * D) + lane;
#pragma unroll
              for (int j = 0; j < 4; ++j) { u32x2 w; w.x = cvt_pk_bf16(v[q][j].x, v[q][j].y); w.y = cvt_pk_bf16(v[q][j].z, v[q][j].w); o[64 * j] = w; } } } } }
    { const float* x = a.in[I_MEM]; bf16_t* XB = (bf16_t*)(ws + WS_MEMN); const float* g = a.in[I_NMEMG];
      for (int r = gw; r < TM; r += NGW) { const f32x4* xr = (const f32x4*)(x + (size_t)r * D) + lane; f32x4 v[4]; float s = 0.f;
#pragma unroll
          for (int j = 0; j < 4; ++j) { v[j] = xr[64 * j]; s += (v[j].x * v[j].x + v[j].y * v[j].y) + (v[j].z * v[j].z + v[j].w * v[j].w); }
          s = wave_sum(s); const float rs = rsqrtf(s * (1.0f / D) + NORM_EPS);
          u32x2* o = (u32x2*)(XB + (size_t)r * D) + lane;
#pragma unroll
          for (int j = 0; j < 4; ++j) { const f32x4 gg = ((const f32x4*)g)[lane + 64 * j]; u32x2 w; w.x = cvt_pk_bf16(v[j].x * rs * gg.x, v[j].y * rs * gg.y); w.y = cvt_pk_bf16(v[j].z * rs * gg.z, v[j].w * rs * gg.w); o[64 * j] = w; } } }
}

__device__ __forceinline__ float tanh_fast(float v) { return 1.0f - 2.0f * __builtin_amdgcn_rcpf(__expf(2.0f * v) + 1.0f); }
__device__ __forceinline__ void phase_elem2(const Args& a, int wave, int G) {
    unsigned char* ws = a.ws;
    const bf16_t* PR = (const bf16_t*)(ws + WS_PR); const bf16_t* PX = (const bf16_t*)(ws + WS_PX);
    bf16_t* LIN = (bf16_t*)(ws + WS_LIN); bf16_t* XBC = (bf16_t*)(ws + WS_XBC);
    const size_t gid = (size_t)blockIdx.x * 512 + wave * 64 + lane_id(), NT = (size_t)G * 512;
    {
        const int c = (int)(gid & 31) * 8; float mu[8];
#pragma unroll
        for (int j = 0; j < 8; ++j) mu[j] = a.in[I_MU][1536 + c + j];
        const size_t N = (size_t)T * 32;
        for (size_t i0 = gid; i0 < N; i0 += 4 * NT) {
            u32x4 P[4], Q[4]; bool hp[4], ok[4];
#pragma unroll
            for (int u = 0; u < 4; ++u) { const size_t i = i0 + u * NT; ok[u] = i < N; const int t = (int)((ok[u] ? i : i0) >> 5); hp[u] = (t & (SEQ - 1)) != 0;
                P[u] = *(const u32x4*)(PR + (size_t)t * RW + 1536 + c); Q[u] = *(const u32x4*)(PR + (size_t)(hp[u] ? t - 1 : t) * RW + 1536 + c); }
#pragma unroll
            for (int u = 0; u < 4; ++u) { const size_t i = i0 + u * NT; if (!ok[u]) continue; const int t = (int)(i >> 5);
                float p[8], pp[8], o[8]; unpack8(P[u], p); unpack8(Q[u], pp);
#pragma unroll
                for (int j = 0; j < 8; ++j) { const float q = hp[u] ? pp[j] : 0.f; const float v = p[j] + (q - p[j]) * mu[j]; o[j] = c < 64 ? tanh_fast(v) : (c < 128 ? v : sigmoidf_(v)); }
                *(u32x4*)(LIN + (size_t)t * 256 + c) = pack8(o); }
        }
    }
    {
        const int c = (int)(gid & 63) * 8; float w[4][8], b0[8];
#pragma unroll
        for (int j = 0; j < 8; ++j) { b0[j] = a.in[I_CBB][c + j];
#pragma unroll
            for (int k = 0; k < 4; ++k) w[k][j] = a.in[I_CBW][k * 512 + c + j]; }
        const size_t N = (size_t)T * 64;
        for (size_t i0 = gid; i0 < N; i0 += 2 * NT) {
            u32x4 X[2][4]; bool ok[2]; int tl[2];
#pragma unroll
            for (int u = 0; u < 2; ++u) { const size_t i = i0 + u * NT; ok[u] = i < N; const int t = (int)((ok[u] ? i : i0) >> 6); tl[u] = t & (SEQ - 1);
#pragma unroll
                for (int k = 0; k < 4; ++k) { const int dt = 3 - k; X[u][k] = *(const u32x4*)(PX + (size_t)(tl[u] >= dt ? t - dt : t) * 512 + c); } }
#pragma unroll
            for (int u = 0; u < 2; ++u) { const size_t i = i0 + u * NT; if (!ok[u]) continue; const int t = (int)(i >> 6);
                float o[8];
#pragma unroll
                for (int j = 0; j < 8; ++j) o[j] = b0[j];
#pragma unroll
                for (int k = 0; k < 4; ++k) { float p[8]; unpack8(X[u][k], p); const bool in = tl[u] >= 3 - k;
#pragma unroll
                    for (int j = 0; j < 8; ++j) o[j] += in ? p[j] * w[k][j] : 0.f; }
                *(u32x4*)(XBC + (size_t)t * 512 + c) = pack8(o); }
        }
    }
}

#define DPP_BC(JJ) " row_newbcast:" #JJ " row_mask:0xf bank_mask:0xf"
#define RW_SA(JJ)  asm("v_fmac_f32_dpp %0, %1, %2" DPP_BC(JJ) : "+v"(sacc[JJ & 3]) : "v"(va), "v"(S[JJ]));
#define RW_UPD(JJ) { float t_; \
    asm("v_mul_f32_dpp %0, %1, %2" DPP_BC(JJ) : "=v"(t_) : "v"(vb), "v"(sa)); \
    asm("v_fmac_f32_dpp %0, %1, %2" DPP_BC(JJ) : "+v"(t_) : "v"(vk), "v"(vv)); \
    asm("v_fmac_f32_dpp %0, %1, %2" DPP_BC(JJ) : "+v"(t_) : "v"(vw), "v"(S[JJ])); \
    S[JJ] = t_; \
    asm("v_fmac_f32_dpp %0, %1, %2" DPP_BC(JJ) : "+v"(yacc[JJ & 3]) : "v"(vr), "v"(S[JJ])); }
#define RW_ALL16(M) M(0) M(1) M(2) M(3) M(4) M(5) M(6) M(7) M(8) M(9) M(10) M(11) M(12) M(13) M(14) M(15)

constexpr int RB = 32;
constexpr int PSTEP = 6 * 64;
constexpr int PBUF = RB * PSTEP * 4;

__device__ __forceinline__ float dpp_ror_add(float v, const int ctrl_sel) {
    int t;
    switch (ctrl_sel) {
        case 8: t = __builtin_amdgcn_update_dpp(0, __float_as_int(v), 0x128, 0xf, 0xf, false); break;
        case 4: t = __builtin_amdgcn_update_dpp(0, __float_as_int(v), 0x124, 0xf, 0xf, false); break;
        case 2: t = __builtin_amdgcn_update_dpp(0, __float_as_int(v), 0x122, 0xf, 0xf, false); break;
        default: t = __builtin_amdgcn_update_dpp(0, __float_as_int(v), 0x121, 0xf, 0xf, false); break;
    }
    return v + __int_as_float(t);
}
__device__ __forceinline__ float cross_row_allsum(float v) {
    auto r = __builtin_amdgcn_permlane32_swap(__float_as_uint(v), __float_as_uint(v), false, false);
    v = __uint_as_float(r[0]) + __uint_as_float(r[1]);
    auto r2 = __builtin_amdgcn_permlane16_swap(__float_as_uint(v), __float_as_uint(v), false, false);
    return __uint_as_float(r2[0]) + __uint_as_float(r2[1]);
}
__device__ __forceinline__ float wave_allsum(float v) {
    v = dpp_ror_add(v, 8); v = dpp_ror_add(v, 4); v = dpp_ror_add(v, 2); v = dpp_ror_add(v, 1);
    return cross_row_allsum(v);
}
__device__ __forceinline__ void lds_barrier() { asm volatile("s_waitcnt lgkmcnt(0)" ::: "memory"); __builtin_amdgcn_s_barrier(); asm volatile("" ::: "memory"); }

constexpr int NPS = RB / 4;
__device__ __forceinline__ void prod_load(const Args& a, bf16_t (&raw)[NPS][8], int tok0, int h, int p, int lane) {
    const bf16_t* PR = (const bf16_t*)(a.ws + WS_PR); const bf16_t* LOUT = (const bf16_t*)(a.ws + WS_LOUT);
#pragma unroll
    for (int i = 0; i < NPS; ++i) { const int tok = tok0 + p + 4 * i; const bool has_prev = (tok & (SEQ - 1)) != 0;
        const bf16_t* prow = PR + (size_t)tok * RW + h * 64 + lane; const bf16_t* qrow = has_prev ? prow - RW : prow; const bf16_t* lrow = LOUT + (size_t)tok * 1536 + h * 64 + lane;
        raw[i][0] = prow[0]; raw[i][1] = prow[512]; raw[i][2] = prow[1024]; raw[i][3] = qrow[0]; raw[i][4] = qrow[512]; raw[i][5] = qrow[1024]; raw[i][6] = lrow[0]; raw[i][7] = lrow[512]; }
}
__device__ __forceinline__ void prod_compute(const Args& a, const bf16_t (&raw)[NPS][8], LAS float* pb, int tok0, int h, int p, int lane, float mu_r, float mu_k, float mu_v, float ckk, float cka, float crk) {
    float* BON = (float*)(a.ws + WS_BON);
#pragma unroll
    for (int i = 0; i < NPS; ++i) { const int s = p + 4 * i, tok = tok0 + s; const bool has_prev = (tok & (SEQ - 1)) != 0;
        const float rr = bf1(raw[i][0]), kr = bf1(raw[i][1]), vr_ = bf1(raw[i][2]);
        const float rp = has_prev ? bf1(raw[i][3]) : 0.f, kp = has_prev ? bf1(raw[i][4]) : 0.f, vp = has_prev ? bf1(raw[i][5]) : 0.f;
        const float e = bf1(raw[i][6]), av = bf1(raw[i][7]);
        const float r = rr + (rp - rr) * mu_r, k0 = kr + (kp - kr) * mu_k, v = vr_ + (vp - vr_) * mu_v;
        const float w = __expf(-e);
        const float kk = k0 * ckk; const float n2 = wave_allsum(kk * kk); const float kkn = kk * rsqrtf(fmaxf(n2, 1e-24f));
        const float k2 = k0 * (1.0f + (av - 1.0f) * cka);
        const float bon = wave_allsum(r * k2 * crk);
        LAS float* pp = pb + s * PSTEP;
        pp[lane] = -kkn; pp[64 + lane] = kkn * av; pp[128 + lane] = k2; pp[192 + lane] = w; pp[256 + lane] = r; pp[320 + lane] = v;
        if (lane == 0) BON[(size_t)tok * 8 + h] = bon; }
}

__device__ __forceinline__ void phase_scan(const Args& a, LAS unsigned char* lds, int wave, int G) {
    const int lane = lane_id();
    unsigned char* ws = a.ws;
    constexpr int SB = 16, NBLK = SEQ / RB;
    for (int pair = blockIdx.x; pair < 256; pair += G) {
        const int b = pair >> 3, h = pair & 7, tokb = b * SEQ;
        if (wave < 4) {
            const int il = lane & 15, irow = 16 * wave + il;
            float S[16];
#pragma unroll
            for (int j = 0; j < 16; ++j) S[j] = 0.f;
            bf16_t* YRAW = (bf16_t*)(ws + WS_YRAW);
            lds_barrier();
            for (int blk = 0; blk < NBLK; ++blk) {
                const LAS float* pb = (const LAS float*)(lds + (blk & 1) * PBUF);
#pragma unroll 2
                for (int s = 0; s < RB; ++s) {
                    const LAS float* pp = pb + s * PSTEP;
                    float va = pp[lane], vb = pp[64 + lane], vk = pp[128 + lane], vw = pp[192 + lane], vr = pp[256 + lane]; const float vv = pp[320 + irow];
                    asm volatile("s_nop 1" : "+v"(va), "+v"(vb), "+v"(vk), "+v"(vw), "+v"(vr));
                    float sacc[4] = {0.f, 0.f, 0.f, 0.f}, yacc[4] = {0.f, 0.f, 0.f, 0.f};
                    RW_ALL16(RW_SA)
                    float sa = (sacc[0] + sacc[1]) + (sacc[2] + sacc[3]);
                    sa = cross_row_allsum(sa);
                    RW_ALL16(RW_UPD)
                    float y = (yacc[0] + yacc[1]) + (yacc[2] + yacc[3]);
                    y = cross_row_allsum(y);
                    const int tok = tokb + blk * RB + s;
                    if (lane < 16) YRAW[(size_t)tok * 512 + h * 64 + irow] = f2bf(y);
                }
                lds_barrier();
            }
        } else {
            const float mu_r = a.in[I_MU][h * 64 + lane], mu_k = a.in[I_MU][512 + h * 64 + lane], mu_v = a.in[I_MU][1024 + h * 64 + lane];
            const float ckk = a.in[I_KK][h * 64 + lane], cka = a.in[I_KA][h * 64 + lane], crk = a.in[I_RK][h * 64 + lane];
            const size_t base = (size_t)tokb * 512 + h * 64 + lane;
            const bf16_t* LA = (const bf16_t*)(ws + WS_RGLA) + base; const bf16_t* U = (const bf16_t*)(ws + WS_RGU) + base; const bf16_t* PY = (const bf16_t*)(ws + WS_PY) + base;
            bf16_t* YB = (bf16_t*)(ws + WS_YB) + base;
            bf16_t cla[SB], cu[SB], cpy[SB]; float hh = 0.f;
#pragma unroll
            for (int s = 0; s < SB; ++s) { cla[s] = 0; cu[s] = 0; cpy[s] = 0; }
            if (wave == 4) {
#pragma unroll
                for (int s = 0; s < SB; ++s) { cla[s] = LA[(size_t)s * 512]; cu[s] = U[(size_t)s * 512]; cpy[s] = PY[(size_t)s * 512]; }
            }
            bf16_t raw[NPS][8];
            prod_load(a, raw, tokb, h, wave - 4, lane); prod_compute(a, raw, (LAS float*)lds, tokb, h, wave - 4, lane, mu_r, mu_k, mu_v, ckk, cka, crk); prod_load(a, raw, tokb + RB, h, wave - 4, lane);
            lds_barrier();
            for (int blk = 0; blk < NBLK; ++blk) {
                if (blk + 1 < NBLK) { prod_compute(a, raw, (LAS float*)(lds + ((blk + 1) & 1) * PBUF), tokb + (blk + 1) * RB, h, wave - 4, lane, mu_r, mu_k, mu_v, ckk, cka, crk);
                    if (blk + 2 < NBLK) prod_load(a, raw, tokb + (blk + 2) * RB, h, wave - 4, lane); }
                if (wave == 4) {
                    for (int sub = 0; sub < RB / SB; ++sub) {
                        const int t0 = blk * RB + sub * SB, tn = (t0 + SB < SEQ) ? t0 + SB : t0;
                        bf16_t nla[SB], nu[SB], npy[SB];
#pragma unroll
                        for (int s = 0; s < SB; ++s) { nla[s] = LA[(size_t)(tn + s) * 512]; nu[s] = U[(size_t)(tn + s) * 512]; npy[s] = PY[(size_t)(tn + s) * 512]; }
#pragma unroll
                        for (int s = 0; s < SB; ++s) { hh = __expf(bf1(cla[s])) * hh + bf1(cu[s]); YB[(size_t)(t0 + s) * 512] = f2bf(hh * gelu_tanh(bf1(cpy[s]))); }
#pragma unroll
                        for (int s = 0; s < SB; ++s) { cla[s] = nla[s]; cu[s] = nu[s]; cpy[s] = npy[s]; }
                    }
                }
                lds_barrier();
            }
        }
    }
    asm volatile("s_waitcnt vmcnt(0)" ::: "memory");
}

__device__ __forceinline__ void phase_post(const Args& a, int wave, int G) {
    unsigned char* ws = a.ws;
    const bf16_t* PR = (const bf16_t*)(ws + WS_PR); const bf16_t* LOUT = (const bf16_t*)(ws + WS_LOUT); const bf16_t* YRAW = (const bf16_t*)(ws + WS_YRAW);
    const float* BON = (const float*)(ws + WS_BON); bf16_t* YA = (bf16_t*)(ws + WS_YA);
    const size_t gid = (size_t)blockIdx.x * 512 + wave * 64 + lane_id(), NT = (size_t)G * 512;
    const int c = (int)(gid & 63) * 8, h = c >> 6; float mu[8], lg[8], lb[8];
#pragma unroll
    for (int j = 0; j < 8; ++j) { mu[j] = a.in[I_MU][1024 + c + j]; lg[j] = a.in[I_LNXG][c + j]; lb[j] = a.in[I_LNXB][c + j]; }
    const size_t N = (size_t)T * 64;
    for (size_t i0 = gid; i0 < N; i0 += 4 * NT) {
        u32x4 Y[4], V[4], VP[4], GG[4]; float bn[4]; bool ok[4], hp[4];
#pragma unroll
        for (int u = 0; u < 4; ++u) { const size_t i = i0 + u * NT; ok[u] = i < N; const int t = (int)((ok[u] ? i : i0) >> 6); hp[u] = (t & (SEQ - 1)) != 0;
            Y[u] = *(const u32x4*)(YRAW + (size_t)t * 512 + c); V[u] = *(const u32x4*)(PR + (size_t)t * RW + 1024 + c); VP[u] = *(const u32x4*)(PR + (size_t)(hp[u] ? t - 1 : t) * RW + 1024 + c);
            GG[u] = *(const u32x4*)(LOUT + (size_t)t * 1536 + 1024 + c); bn[u] = BON[(size_t)t * 8 + h]; }
#pragma unroll
        for (int u = 0; u < 4; ++u) { const size_t i = i0 + u * NT; const int t = (int)((ok[u] ? i : i0) >> 6);
            float y[8], v[8], vp[8], g[8], o[8]; unpack8(Y[u], y); unpack8(V[u], v); unpack8(VP[u], vp); unpack8(GG[u], g);
            float s = 0.f;
#pragma unroll
            for (int j = 0; j < 8; ++j) s += y[j];
            s += __shfl_xor(s, 1); s += __shfl_xor(s, 2); s += __shfl_xor(s, 4);
            const float mean = s * (1.0f / 64.0f); float q = 0.f;
#pragma unroll
            for (int j = 0; j < 8; ++j) { const float d = y[j] - mean; q += d * d; }
            q += __shfl_xor(q, 1); q += __shfl_xor(q, 2); q += __shfl_xor(q, 4);
            const float rs = rsqrtf(q * (1.0f / 64.0f) + LNX_EPS);
#pragma unroll
            for (int j = 0; j < 8; ++j) { const float pv = hp[u] ? vp[j] : 0.f; const float vv = v[j] + (pv - v[j]) * mu[j];
                o[j] = ((y[j] - mean) * rs * lg[j] + lb[j] + bn[u] * vv) * g[j]; }
            if (ok[u]) *(u32x4*)(YA + (size_t)t * 512 + c) = pack8(o); }
    }
}

__device__ __forceinline__ void phase_ffnfix(const Args& a, int wave, int G) {
    unsigned char* ws = a.ws;
    const bf16_t* HG = (const bf16_t*)(ws + WS_HG); bf16_t* ACT = (bf16_t*)(ws + WS_UU);
    const float* cw = a.in[I_FCW]; const float* cb = a.in[I_FCB];
    const size_t gid = (size_t)blockIdx.x * 512 + wave * 64 + lane_id(), NT = (size_t)G * 512;
    constexpr int CPR = DFF / 8;
    for (size_t i = gid; i < (size_t)(T / 64) * 2 * CPR; i += NT) {
        const int c = (int)(i % CPR) * 8, rho = (int)((i / CPR) & 1), grp = (int)(i / (2 * CPR)); const int t = grp * 64 + rho; const bool first = (grp & 31) == 0;
        float p2[8], p1[8], cur[8], up[8], o[8];
#pragma unroll
        for (int j = 0; j < 8; ++j) { p2[j] = 0.f; p1[j] = 0.f; }
        if (rho == 0) { if (!first) { unpack8(*(const u32x4*)(HG + ((size_t)(grp - 1) * 4 + 0) * DFF + c), p2); unpack8(*(const u32x4*)(HG + ((size_t)(grp - 1) * 4 + 1) * DFF + c), p1); } }
        else { if (!first) unpack8(*(const u32x4*)(HG + ((size_t)(grp - 1) * 4 + 1) * DFF + c), p2); unpack8(*(const u32x4*)(HG + ((size_t)grp * 4 + 2) * DFF + c), p1); }
        unpack8(*(const u32x4*)(HG + ((size_t)grp * 4 + 2 + rho) * DFF + c), cur);
        unpack8(*(const u32x4*)(ACT + (size_t)t * DFF + c), up);
#pragma unroll
        for (int j = 0; j < 8; ++j) o[j] = gelu_tanh(cb[c + j] + cw[c + j] * p2[j] + cw[DFF + c + j] * p1[j] + cw[2 * DFF + c + j] * cur[j]) * up[j];
        *(u32x4*)(ACT + (size_t)t * DFF + c) = pack8(o);
    }
}

__device__ __forceinline__ void phase_final(const Args& a, int wave, int G) {
    const int lane = lane_id();
    const float* ssp = (const float*)(a.ws + WS_SSP3); const float* g = a.in[I_NFING]; const bf16_t* X3 = (const bf16_t*)(a.ws + WS_X3B);
    const int gw = blockIdx.x * 8 + wave, NGW = G * 8;
    for (int r0 = gw; r0 < T; r0 += 4 * NGW) {
        u32x4 v[4][2]; float rs[4];
#pragma unroll
        for (int q = 0; q < 4; ++q) { const int r = r0 + q * NGW; if (r < T) { rs[q] = rstd_from16(ssp, r); const u32x4* xr = (const u32x4*)(X3 + (size_t)r * D) + lane; v[q][0] = xr[0]; v[q][1] = xr[64]; } }
#pragma unroll
        for (int q = 0; q < 4; ++q) { const int r = r0 + q * NGW; if (r < T) {
#pragma unroll
            for (int j = 0; j < 2; ++j) { float x[8]; unpack8(v[q][j], x); const int c = 512 * j + 8 * lane; const f32x4 g0 = *(const f32x4*)(g + c), g1 = *(const f32x4*)(g + c + 4);
                f32x4* o = (f32x4*)(a.out + (size_t)r * D + c);
                o[0] = (f32x4){x[0] * rs[q] * g0[0], x[1] * rs[q] * g0[1], x[2] * rs[q] * g0[2], x[3] * rs[q] * g0[3]};
                o[1] = (f32x4){x[4] * rs[q] * g1[0], x[5] * rs[q] * g1[1], x[6] * rs[q] * g1[2], x[7] * rs[q] * g1[3]}; } } }
    }
}

constexpr int NPHASE = 13;
__global__ void __launch_bounds__(512, 2) mega(Args a) {
    extern __shared__ __attribute__((aligned(16))) unsigned char lds_raw[];
    LAS unsigned char* lds = (LAS unsigned char*)lds_raw;
    cg::grid_group grid = cg::this_grid();
    const int wave = __builtin_amdgcn_readfirstlane((int)threadIdx.x >> 6), G = gridDim.x, bid = blockIdx.x;
    unsigned char* ws = a.ws;
    const int lo = a.ph_lo, hi = a.ph_hi;
    const bool t0 = (wave == 0) && (lane_id() == 0);
    volatile LAS unsigned* misc = (volatile LAS unsigned*)(lds + 131072 + 320);
    if (t0) { misc[0] = 0u; misc[1] = 0u; }
    __syncthreads();
    XcdBarrier xb = xcd_barrier_post((unsigned*)(ws + WS_CTL), misc, t0);
    if (a.ph_hi < 0) grid.sync();
#define IN(k) (lo <= (k) && (k) < hi)
#define SEAM(k) do { if (IN(k) && IN((k) + 1)) xcd_barrier(xb, t0); } while (0)
    bf16_t* const XB = (bf16_t*)(ws + WS_XB);
    const float* rstdx = (const float*)(ws + WS_RSTDX);
    StaticOrder S;

    if (IN(0)) for (int rep_ = 0; rep_ < REPS(0); ++rep_) { phase_prep(a, lds, wave, G); __syncthreads(); } SEAM(0);

    if (IN(1)) for (int rep_ = 0; rep_ < REPS(1); ++rep_) {
        { Gemm g = plain_gemm(XB, (const bf16_t*)(ws + WS_WIN), 1024); S.init(T / BM, 11, G, bid);
          EpiProj E{rstdx, a.in[I_BIN], (bf16_t*)(ws + WS_PR), (bf16_t*)(ws + WS_PX), (bf16_t*)(ws + WS_PY)}; gemm_phase(lds, wave, g, S, E); }
        if ((G & 15) == 0) {
            const int hg = G >> 1, hb_ = (bid >> 4) * 8 + (bid & 7);
            if (((bid >> 3) & 1) == 0) { Gemm g = plain_gemm((const bf16_t*)(ws + WS_MEMN), (const bf16_t*)(ws + WS_WK), 1024); S.init(TM / BM, 4, hg, hb_);
                EpiPlain E{(bf16_t*)(ws + WS_KM), 1024}; gemm_phase(lds, wave, g, S, E); }
            else { Gemm g = plain_gemm((const bf16_t*)(ws + WS_WV), (const bf16_t*)(ws + WS_MEMN), 1024); S.init(4, TM / BM, hg, hb_);
                EpiPlain E{(bf16_t*)(ws + WS_VT), TM}; gemm_phase(lds, wave, g, S, E); }
        } else {
            { Gemm g = plain_gemm((const bf16_t*)(ws + WS_MEMN), (const bf16_t*)(ws + WS_WK), 1024); S.init(TM / BM, 4, G, bid);
              EpiPlain E{(bf16_t*)(ws + WS_KM), 1024}; gemm_phase(lds, wave, g, S, E); }
            { Gemm g = plain_gemm((const bf16_t*)(ws + WS_WV), (const bf16_t*)(ws + WS_MEMN), 1024); S.init(4, TM / BM, G, bid);
              EpiPlain E{(bf16_t*)(ws + WS_VT), TM}; gemm_phase(lds, wave, g, S, E); }
        }
    } SEAM(1);

    if (IN(2)) for (int rep_ = 0; rep_ < REPS(2); ++rep_) phase_elem2(a, wave, G); SEAM(2);
#ifdef PROBE_SYNC
    for (int i_ = 0; i_ < 16; ++i_) grid.sync();
#endif

    if (IN(3)) for (int rep_ = 0; rep_ < REPS(3); ++rep_) {
        { Gemm g = plain_gemm((const bf16_t*)(ws + WS_LIN), (const bf16_t*)(ws + WS_WLORA), 256); S.init(T / BM, 6, G, bid);
          EpiLora E{a.in[I_W0], a.in[I_A0], (bf16_t*)(ws + WS_LOUT)}; gemm_phase(lds, wave, g, S, E); }
        { Gemm g = plain_gemm((const bf16_t*)(ws + WS_XBC), (const bf16_t*)(ws + WS_WRG), 256); g.lda = 512; g.a_pm = (size_t)BM * 512 * 2; g.a_pn2 = 512; S.init(T / BM, 4, G, bid);
          EpiRg E{a.in[I_BRGA], a.in[I_BRGX], a.in[I_LAM], (const bf16_t*)(ws + WS_XBC), (bf16_t*)(ws + WS_RGLA), (bf16_t*)(ws + WS_RGU)}; gemm_phase(lds, wave, g, S, E); }
    } SEAM(3);

    if (IN(4)) for (int rep_ = 0; rep_ < REPS(4); ++rep_) phase_scan(a, lds, wave, G); SEAM(4);
    if (IN(5)) for (int rep_ = 0; rep_ < REPS(5); ++rep_) phase_post(a, wave, G); SEAM(5);

    if (IN(6)) for (int rep_ = 0; rep_ < REPS(6); ++rep_) {
        S.init(T / BM, 4, G, bid);
        { Gemm g = plain_gemm(XB, (const bf16_t*)(ws + WS_WIN) + (size_t)2816 * 1024, 1024); EpiGab E{rstdx, a.in[I_BIN] + 2816, (bf16_t*)(ws + WS_GAB), 0}; gemm_phase(lds, wave, g, S, E); }
        { Gemm g = plain_gemm((const bf16_t*)(ws + WS_YA), (const bf16_t*)(ws + WS_WA), 512); EpiBranch<true> E{(const bf16_t*)(ws + WS_GAB), (bf16_t*)(ws + WS_MERGED)}; gemm_phase(lds, wave, g, S, E); }
        { Gemm g = plain_gemm(XB, (const bf16_t*)(ws + WS_WIN) + (size_t)3840 * 1024, 1024); EpiGab E{rstdx, a.in[I_BIN] + 2816, (bf16_t*)(ws + WS_GAB), 1024}; gemm_phase(lds, wave, g, S, E); }
        { Gemm g = plain_gemm((const bf16_t*)(ws + WS_YB), (const bf16_t*)(ws + WS_WB), 512); EpiBranch<false> E{(const bf16_t*)(ws + WS_GAB), (bf16_t*)(ws + WS_MERGED)}; gemm_phase(lds, wave, g, S, E); }
    } SEAM(6);
    if (IN(7)) for (int rep_ = 0; rep_ < REPS(7); ++rep_) { Gemm g = plain_gemm((const bf16_t*)(ws + WS_MERGED), (const bf16_t*)(ws + WS_WMIX), 1024); S.init(T / BM, 4, G, bid);
        EpiRes<true> E{a.in[I_X], (bf16_t*)(ws + WS_X1B), (float*)(ws + WS_SSP1)}; gemm_phase(lds, wave, g, S, E); } SEAM(7);
    if (IN(8)) for (int rep_ = 0; rep_ < REPS(8); ++rep_) {
        S.init(T / BM, 4, G, bid);
        { Gemm g = plain_gemm((const bf16_t*)(ws + WS_X1B), (const bf16_t*)(ws + WS_WCQ), 1024);
          EpiQ E{(const float*)(ws + WS_SSP1), (bf16_t*)(ws + WS_Q)}; gemm_phase(lds, wave, g, S, E); }
        { Gemm g; g.A = (const bf16_t*)(ws + WS_Q); g.Bt = (const bf16_t*)(ws + WS_KM); g.lda = 1024; g.ldb = 1024; g.K = 256;
          g.a_pm = (size_t)BM * 1024 * 2; g.a_pn = 512; g.b_pn = 512; g.b_pb = (size_t)NMEM * 1024 * 2; g.a_pn2 = 0;
          EpiSc E{(bf16_t*)(ws + WS_PEXP), (float*)(ws + WS_SSPA)}; gemm_phase(lds, wave, g, S, E); }
        { Gemm g; g.A = (const bf16_t*)(ws + WS_PEXP); g.Bt = (const bf16_t*)(ws + WS_VT); g.lda = 1024; g.ldb = TM; g.K = 256;
          g.a_pm = (size_t)BM * 1024 * 2; g.a_pn = 512; g.b_pn = (size_t)256 * TM * 2; g.b_pb = 512; g.a_pn2 = 0;
          EpiPv E{(const float*)(ws + WS_SSPA), (bf16_t*)(ws + WS_O)}; gemm_phase(lds, wave, g, S, E); }
    } SEAM(8);
    if (IN(9)) for (int rep_ = 0; rep_ < REPS(9); ++rep_) { Gemm g = plain_gemm((const bf16_t*)(ws + WS_O), (const bf16_t*)(ws + WS_WCO), 1024); S.init(T / BM, 4, G, bid);
        EpiRes<false> E{(const bf16_t*)(ws + WS_X1B), (bf16_t*)(ws + WS_X2B), (float*)(ws + WS_SSP2)}; gemm_phase(lds, wave, g, S, E); } SEAM(9);
    if (IN(10)) for (int rep_ = 0; rep_ < REPS(10); ++rep_) { Gemm g = plain_gemm((const bf16_t*)(ws + WS_X2B), (const bf16_t*)(ws + WS_WFFI), 1024); S.init(T / BM, 22, G, bid);
        EpiFfnAct E{(const float*)(ws + WS_SSP2), a.in[I_FCW], a.in[I_FCB], (bf16_t*)(ws + WS_UU), (bf16_t*)(ws + WS_HG)}; gemm_phase(lds, wave, g, S, E); } SEAM(10);
    if (IN(11)) for (int rep_ = 0; rep_ < REPS(11); ++rep_) phase_ffnfix(a, wave, G); SEAM(11);
    if (IN(12)) for (int rep_ = 0; rep_ < REPS(12); ++rep_) { Gemm g = plain_gemm((const bf16_t*)(ws + WS_UU), (const bf16_t*)(ws + WS_WFFO), DFF); S.init(T / BM, 4, G, bid);
        EpiRes<false> E{(const bf16_t*)(ws + WS_X2B), (bf16_t*)(ws + WS_X3B), (float*)(ws + WS_SSP3)}; gemm_phase(lds, wave, g, S, E); } SEAM(12);
    if (IN(13)) for (int rep_ = 0; rep_ < REPS(13); ++rep_) phase_final(a, wave, G);
#undef IN
#undef SEAM
}

extern "C" void kernel_launch(void* const* d_in, const int* in_sizes, int n_in, void* d_out, int out_size, void* d_ws, size_t ws_size, hipStream_t stream) {
    static int grid = 0;
    if (grid == 0) {
        if (n_in != 37 || in_sizes[0] != T * D || out_size != T * D || ws_size < WS_END) {
            fprintf(stderr, "kernel_launch: unexpected shapes (n_in %d, in0 %d, out %d, ws %zu < %zu); nothing launched\n", n_in, n_in > 0 ? in_sizes[0] : -1, out_size, ws_size, (size_t)WS_END); grid = -1; return; }
        int dev = 0, cus = 0, per_cu = 0;
        if (hipGetDevice(&dev) != hipSuccess || hipDeviceGetAttribute(&cus, hipDeviceAttributeMultiprocessorCount, dev) != hipSuccess) { grid = -1; return; }
        if (hipFuncSetAttribute((const void*)mega, hipFuncAttributeMaxDynamicSharedMemorySize, LDS_BYTES) != hipSuccess) { fprintf(stderr, "kernel_launch: hipFuncSetAttribute failed\n"); grid = -1; return; }
        if (hipOccupancyMaxActiveBlocksPerMultiprocessor(&per_cu, (const void*)mega, 512, LDS_BYTES) != hipSuccess || per_cu < 1) { fprintf(stderr, "kernel_launch: occupancy query says %d\n", per_cu); per_cu = 1; }
        (void)hipGetLastError();
        grid = cus * 1;
    }
    if (grid < 0) return;
    if (hipMemsetAsync((char*)d_ws + WS_CTL, 0, CTL_BYTES, stream) != hipSuccess) { fprintf(stderr, "kernel_launch: memset failed\n"); return; }
    Args a{};
    for (int i = 0; i < 37; ++i) a.in[i] = (const float*)d_in[i];
    a.out = (float*)d_out; a.ws = (unsigned char*)d_ws;
#if MK_SPLIT
    for (int ph = 0; ph <= NPHASE; ++ph) {
        a.ph_lo = ph; a.ph_hi = ph + 1; void* args[] = {&a};
        hipError_t e = hipLaunchCooperativeKernel((const void*)mega, dim3(grid), dim3(512), args, LDS_BYTES, stream);
        if (e != hipSuccess) { fprintf(stderr, "kernel_launch: launch of phase %d failed: %s\n", ph, hipGetErrorString(e)); break; }
    }
#else
    a.ph_lo = 0; a.ph_hi = NPHASE + 1; void* args[] = {&a};
    hipError_t e = hipLaunchCooperativeKernel((const void*)mega, dim3(grid), dim3(512), args, LDS_BYTES, stream);
    if (e != hipSuccess) fprintf(stderr, "kernel_launch: cooperative launch failed: %s (grid %d)\n", hipGetErrorString(e), grid);
#endif
}
```

```cpp
#include <hip/hip_runtime.h>
#include <hip/hip_cooperative_groups.h>
#include <cstdio>
namespace cg = cooperative_groups;

#ifndef MK_SPLIT
#define MK_SPLIT 0
#endif

#ifndef DUP_PHASE
#define DUP_PHASE -1
#endif
#define REPS(k) ((DUP_PHASE == (k)) ? 2 : 1)
#define LAS __attribute__((address_space(3)))
typedef unsigned short bf16_t;
typedef short bf16x8 __attribute__((ext_vector_type(8)));
typedef float f32x4 __attribute__((ext_vector_type(4)));
typedef float f32x2 __attribute__((ext_vector_type(2)));
typedef unsigned u32x4 __attribute__((ext_vector_type(4)));
typedef unsigned u32x2 __attribute__((ext_vector_type(2)));

constexpr int T = 65536, D = 1024, SEQ = 2048, NB = 32, NMEM = 256, TM = NB * NMEM;
constexpr int AW = 512, RW = 1792, PIN = 4864, DFF = 2816;
constexpr float NORM_EPS = 1e-6f, LNX_EPS = 64e-5f;

constexpr size_t MiB = 1u << 20;
constexpr size_t WS_WIN = 0;
constexpr size_t WS_WFFI = 10 * MiB;
constexpr size_t WS_WFFO = 21 * MiB;
constexpr size_t WS_WMIX = 27 * MiB, WS_WCQ = 29 * MiB, WS_WK = 31 * MiB, WS_WV = 33 * MiB, WS_WCO = 35 * MiB;
constexpr size_t WS_WA = 37 * MiB, WS_WB = 38 * MiB;
constexpr size_t WS_WLORA = 39 * MiB;
constexpr size_t WS_WRG = 40 * MiB;
constexpr size_t WS_CTL = 46 * MiB, CTL_BYTES = 16384;
constexpr size_t WS_RSTDX = 48 * MiB;
constexpr size_t WS_SSP1 = 49 * MiB, WS_SSP2 = 53 * MiB, WS_SSP3 = 57 * MiB, WS_SSPA = 61 * MiB;
constexpr size_t WS_BON = 65 * MiB;
constexpr size_t WS_MEMN = 68 * MiB, WS_KM = 84 * MiB, WS_VT = 100 * MiB;
constexpr size_t WS_XB = 120 * MiB;
constexpr size_t WS_PR = 248 * MiB;
constexpr size_t WS_PX = 472 * MiB, WS_PY = 536 * MiB;
constexpr size_t WS_LIN = 600 * MiB, WS_XBC = 632 * MiB;
constexpr size_t WS_LOUT = 696 * MiB;
constexpr size_t WS_RGLA = 888 * MiB, WS_RGU = 952 * MiB;
constexpr size_t WS_YRAW = WS_PX, WS_YB = WS_LIN, WS_YA = WS_RGLA;
constexpr size_t WS_GAB = 248 * MiB;
constexpr size_t WS_MERGED = 696 * MiB;
constexpr size_t WS_X1B = WS_XB, WS_Q = 248 * MiB, WS_PEXP = 376 * MiB, WS_O = 504 * MiB, WS_X2B = WS_XB;
constexpr size_t WS_X3B = 376 * MiB;
constexpr size_t WS_HG = 248 * MiB, WS_UU = 600 * MiB;
constexpr size_t WS_END = 1016 * MiB;

constexpr int LDS_BYTES = 147456;

__device__ __forceinline__ unsigned cvt_pk_bf16(float lo, float hi) { unsigned r; asm("v_cvt_pk_bf16_f32 %0, %1, %2" : "=v"(r) : "v"(lo), "v"(hi)); return r; }
__device__ __forceinline__ float bf_lo(unsigned w) { return __uint_as_float(w << 16); }
__device__ __forceinline__ float bf_hi(unsigned w) { return __uint_as_float(w & 0xffff0000u); }
__device__ __forceinline__ float bf1(bf16_t b) { return __uint_as_float(((unsigned)b) << 16); }
__device__ __forceinline__ bf16_t f2bf(float f) { return (bf16_t)(cvt_pk_bf16(f, 0.f) & 0xffffu); }
__device__ __forceinline__ float sigmoidf_(float x) { return __builtin_amdgcn_rcpf(1.0f + __expf(-x)); }
__device__ __forceinline__ float gelu_tanh(float x) { const float z = 1.5957691216057308f * (x + 0.044715f * x * x * x); return x * sigmoidf_(z); }
__device__ __forceinline__ int lane_id() { int l; asm volatile("v_mbcnt_lo_u32_b32 %0, -1, 0\n\tv_mbcnt_hi_u32_b32 %0, -1, %0" : "=v"(l)); return l; }
__device__ __forceinline__ float wave_sum(float v) {
#pragma unroll
    for (int o = 1; o < 64; o <<= 1) v += __shfl_xor(v, o);
    return v;
}
__device__ __forceinline__ void unpack8(const u32x4 w, float (&f)[8]) {
    f[0] = bf_lo(w.x); f[1] = bf_hi(w.x); f[2] = bf_lo(w.y); f[3] = bf_hi(w.y); f[4] = bf_lo(w.z); f[5] = bf_hi(w.z); f[6] = bf_lo(w.w); f[7] = bf_hi(w.w);
}
__device__ __forceinline__ u32x4 pack8(const float (&f)[8]) {
    u32x4 w; w.x = cvt_pk_bf16(f[0], f[1]); w.y = cvt_pk_bf16(f[2], f[3]); w.z = cvt_pk_bf16(f[4], f[5]); w.w = cvt_pk_bf16(f[6], f[7]); return w;
}


#define XB_TMO      128
#define XB_XCNT(j)  (256  + 64 * (j))
#define XB_XSUB(j)  (1280 + 64 * (j))
#define XB_XGEN(j)  (2304 + 64 * (j))
#define XB_TOP      3328
#define XB_TOPGEN   3392
#define XCD_BAR_WORDS 3456
#define XB_SPIN_CAP (1u << 22)
__device__ __forceinline__ unsigned xb_ld(unsigned* p)              { return __hip_atomic_load(p, __ATOMIC_RELAXED, __HIP_MEMORY_SCOPE_AGENT); }
__device__ __forceinline__ unsigned xb_add(unsigned* p, unsigned v) { return __hip_atomic_fetch_add(p, v, __ATOMIC_RELAXED, __HIP_MEMORY_SCOPE_AGENT); }
__device__ __forceinline__ unsigned xb_xcc_id() { return (unsigned)__builtin_amdgcn_s_getreg((3 << 11) | 20) & 0xFu; }
#define XB_SPIN(cond, bar) do { unsigned _sp = 0; while (cond) { __builtin_amdgcn_s_sleep(1); \
    if ((++_sp & 255u) == 0u) { if (xb_ld(&(bar)[XB_TMO])) break; if (_sp > XB_SPIN_CAP) { atomicAdd(&(bar)[XB_TMO], 1u); break; } } } } while (0)
struct XcdBarrier { unsigned* bar; unsigned x; volatile LAS unsigned* st; };
__device__ __forceinline__ XcdBarrier xcd_barrier_post(unsigned* bar, volatile LAS unsigned* st, bool t0) {
    XcdBarrier b; b.bar = bar; b.x = xb_xcc_id(); b.st = st;
    if (t0) (void)xb_add(&bar[XB_XCNT(b.x)], 1u);
    return b;
}
__device__ __forceinline__ void xcd_barrier_complete(unsigned* bar, unsigned x, unsigned& nloc, unsigned& nx) {
    const unsigned G = gridDim.x * gridDim.y * gridDim.z;
    unsigned sum, cnt, mine, sp = 0u;
    for (;;) {
        sum = 0u; cnt = 0u; mine = 0u;
#pragma unroll
        for (unsigned j = 0; j < 16; ++j) { const unsigned c = xb_ld(&bar[XB_XCNT(j)]); sum += c; cnt += (c > 0u) ? 1u : 0u; mine = (j == x) ? c : mine; }
        if (sum == G) break;
        __builtin_amdgcn_s_sleep(1);
        if ((++sp & 255u) == 0u) { if (xb_ld(&bar[XB_TMO])) break; if (sp > XB_SPIN_CAP) { atomicAdd(&bar[XB_TMO], 1u); break; } }
    }
    nloc = mine > 0u ? mine : 1u; nx = cnt > 0u ? cnt : 1u;
}
__device__ __forceinline__ void xcd_barrier(const XcdBarrier& b, bool t0) {
    asm volatile("s_waitcnt vmcnt(0)" ::: "memory");
    __syncthreads();
    if (t0) {
        unsigned* bar = b.bar;
        __builtin_amdgcn_s_waitcnt(0);
        unsigned nloc = b.st[0], nx = b.st[1];
        if (nloc == 0u) { xcd_barrier_complete(bar, b.x, nloc, nx); b.st[0] = nloc; b.st[1] = nx; }
        const unsigned old = xb_add(&bar[XB_XSUB(b.x)], 1u);
        const unsigned gen = old / nloc;
        if (old + 1u == (gen + 1u) * nloc) {
            __builtin_amdgcn_fence(__ATOMIC_RELEASE, "agent");
            asm volatile("s_waitcnt vmcnt(0)" ::: "memory");
            const unsigned og = xb_add(&bar[XB_TOP], 1u);
            const unsigned tg = og / nx;
            if (og + 1u == (tg + 1u) * nx) xb_add(&bar[XB_TOPGEN], 1u);
            else XB_SPIN(xb_ld(&bar[XB_TOPGEN]) == tg, bar);
            __builtin_amdgcn_fence(__ATOMIC_ACQUIRE, "agent");
            xb_add(&bar[XB_XGEN(b.x)], 1u);
            asm volatile("s_waitcnt vmcnt(0)" ::: "memory");
        } else {
            XB_SPIN(xb_ld(&bar[XB_XGEN(b.x)]) == gen, bar);
            __builtin_amdgcn_fence(__ATOMIC_ACQUIRE, "agent");
            asm volatile("s_waitcnt vmcnt(0)" ::: "memory");
        }
    }
    __syncthreads();
}

constexpr int BM = 256, BK = 64, HALF = 128, HTB = HALF * BK * 2, NXCD = 8, WGM = 8;
__device__ __forceinline__ int lds_byte(int r, int c) { const int st = (r >> 4) * 2 + (c >> 5), rr = r & 15, cc = c & 31, ob = rr * 64 + cc * 2; return st * 1024 + (ob ^ (((ob >> 9) & 1) << 5)); }
__device__ __forceinline__ void stage_rc(int b, int& R, int& C) { const int st = b / 1024, sb = b % 1024, swz = sb ^ (((sb >> 9) & 1) << 5); R = (st >> 1) * 16 + swz / 64; C = (st & 1) * 32 + (swz % 64) / 2; }
__device__ __forceinline__ int perm32(int rho) { const int n = rho >> 4, i = rho & 15; return 8 * (i >> 2) + 4 * n + (i & 3); }

struct Unit { int pm, pn; };
struct Gemm { const bf16_t* A; const bf16_t* Bt; int lda, ldb, K; size_t a_pm, a_pn, b_pn, b_pb, a_pn2; };
__device__ __forceinline__ Gemm plain_gemm(const bf16_t* A, const bf16_t* Bt, int K) { Gemm g; g.A = A; g.Bt = Bt; g.lda = K; g.ldb = K; g.K = K; g.a_pm = (size_t)BM * K * 2; g.a_pn = 0; g.b_pn = (size_t)BM * K * 2; g.b_pb = 0; g.a_pn2 = 0; return g; }

struct StaticOrder {
    int nM, nN, nwg, G, c;
    __device__ void init(int nM_, int nN_, int G_, int c_) { nM = nM_; nN = nN_; nwg = nM * nN; G = G_; c = c_; }
    __device__ bool next(int i, Unit& u) const {
        const long L = (long)i * G + c; if (L >= nwg) return false;
        int wgid = (int)L; { const int q = nwg / NXCD, r = nwg % NXCD, xcd = wgid % NXCD, off = wgid / NXCD; wgid = (xcd < r ? xcd * (q + 1) : r * (q + 1) + (xcd - r) * q) + off; }
        const int nig = WGM * nN, gid = wgid / nig, fm = gid * WGM, gsz = (nM - fm) < WGM ? (nM - fm) : WGM;
        u.pm = fm + ((wgid % nig) % gsz); u.pn = (wgid % nig) / gsz; return true;
    }
};

typedef f32x4 Acc[2][2][4][2];

template <class Epi>
__device__ __forceinline__ void gemm_phase(LAS unsigned char* lds, const int wid, const Gemm g, const StaticOrder& S, const Epi& E) {
    const int lane = lane_id(), tid = wid * 64 + lane, wr = wid >> 2, wc = wid & 3, fr = lane & 15, fq = lane >> 4;
    const int nt = g.K / BK;
    unsigned voffA[2], voffB[2];
#pragma unroll
    for (int i = 0; i < 2; ++i) { int R, C; stage_rc(tid * 16 + i * 8192, R, C); const int Rb = Epi::PERM ? ((R & ~31) + perm32(R & 31)) : R;
        voffA[i] = (unsigned)(R * g.lda + C) * 2u; voffB[i] = (unsigned)(Rb * g.ldb + C) * 2u; }
    const size_t kstep = (size_t)(BK * 2);
    const size_t hstepA = (size_t)HALF * g.lda * 2, hstepB = (size_t)HALF * g.ldb * 2;
    const unsigned ldsw = (unsigned)wid * 1024u;
    const int aoff = lds_byte(wr * 64 + fr, fq * 8), boff = lds_byte(wc * 32 + fr, fq * 8);
#define PG8_SA(b, h) (((b) * 2 + (h)) * HTB)
#define PG8_SB(b, h) ((4 + (b) * 2 + (h)) * HTB)
#define PG8_STAGE(bufoff, gbase, voff) do { _Pragma("unroll") for (int _i = 0; _i < 2; ++_i) \
        __builtin_amdgcn_global_load_lds((const unsigned*)((const char*)(gbase) + (voff)[_i]), (LAS unsigned*)(lds + (bufoff) + ldsw + _i * 8192), 16, 0, 0); } while (0)
#define PG8_LDA(dst, b, h) do { _Pragma("unroll") for (int m = 0; m < 4; ++m) _Pragma("unroll") for (int k = 0; k < 2; ++k) dst[m][k] = *(const LAS bf16x8*)(lds + PG8_SA(b, h) + aoff + m * 2048 + k * 1024); } while (0)
#define PG8_LDB(dst, b, h) do { _Pragma("unroll") for (int n = 0; n < 2; ++n) _Pragma("unroll") for (int k = 0; k < 2; ++k) dst[n][k] = *(const LAS bf16x8*)(lds + PG8_SB(b, h) + boff + n * 2048 + k * 1024); } while (0)
#define PG8_MMA(ai, bj, At, Bt) do { __builtin_amdgcn_s_setprio(1); _Pragma("unroll") for (int m = 0; m < 4; ++m) _Pragma("unroll") for (int n = 0; n < 2; ++n) _Pragma("unroll") for (int k = 0; k < 2; ++k) \
        acc[ai][bj][m][n] = __builtin_amdgcn_mfma_f32_16x16x32_bf16(Bt[n][k], At[m][k], acc[ai][bj][m][n], 0, 0, 0); __builtin_amdgcn_s_setprio(0); } while (0)
#define PG8_WAIT_V(n) asm volatile("s_waitcnt vmcnt(" #n ")" ::: "memory")
#define PG8_WAIT_L(n) asm volatile("s_waitcnt lgkmcnt(" #n ")" ::: "memory")
#define PG8_BAR __builtin_amdgcn_s_barrier()
#define PG8_SCHED __builtin_amdgcn_sched_barrier(0)
#define PG8_UA(u) ((const char*)g.A + (size_t)(u).pm * g.a_pm + (size_t)(u).pn * g.a_pn + (size_t)((u).pn >> 1) * g.a_pn2)
#define PG8_UB(u) ((const char*)g.Bt + (size_t)(u).pn * g.b_pn + (size_t)((u).pm >> 3) * g.b_pb)
    Unit cur, nxt; int ui = 0;
    if (!S.next(0, cur)) return;
    Acc acc;
#pragma unroll
    for (int a = 0; a < 2; ++a)
#pragma unroll
        for (int b = 0; b < 2; ++b)
#pragma unroll
            for (int m = 0; m < 4; ++m)
#pragma unroll
                for (int n = 0; n < 2; ++n) acc[a][b][m][n] = (f32x4){0.f, 0.f, 0.f, 0.f};
    bf16x8 At[4][2], B0[2][2], B1[2][2];
    const char* cA = PG8_UA(cur); const char* cB = PG8_UB(cur);
    PG8_STAGE(PG8_SB(0, 0), cB, voffB); PG8_STAGE(PG8_SB(0, 1), cB + hstepB, voffB); PG8_STAGE(PG8_SA(0, 0), cA, voffA); PG8_STAGE(PG8_SA(0, 1), cA + hstepA, voffA);
    if (wr == 1) PG8_BAR;
    PG8_WAIT_V(2); PG8_BAR;
    PG8_STAGE(PG8_SB(1, 0), cB + kstep, voffB); PG8_STAGE(PG8_SA(1, 0), cA + kstep, voffA); PG8_STAGE(PG8_SB(1, 1), cB + hstepB + kstep, voffB);
    PG8_WAIT_V(6); PG8_BAR;
    for (;;) {
        const bool has_next = S.next(ui + 1, nxt);
        const char* nA = has_next ? PG8_UA(nxt) : cA; const char* nB = has_next ? PG8_UB(nxt) : cB;
        for (int t = 0; t < nt; t += 2) {
            const bool last = (t == nt - 2);
            const char* a1 = cA + (size_t)(t + 1) * kstep;
            const char* a2 = last ? nA : cA + (size_t)(t + 2) * kstep; const char* b2 = last ? nB : cB + (size_t)(t + 2) * kstep;
            const char* a3 = a2 + kstep; const char* b3 = b2 + kstep;
            PG8_LDB(B0, 0, 0); PG8_LDB(B1, 0, 1); PG8_SCHED; PG8_LDA(At, 0, 0); PG8_STAGE(PG8_SA(1, 1), a1 + hstepA, voffA);
            PG8_WAIT_V(8); PG8_WAIT_L(0); PG8_BAR; PG8_MMA(0, 0, At, B0); PG8_MMA(0, 1, At, B1); PG8_BAR; PG8_SCHED;
            PG8_LDA(At, 0, 1); PG8_STAGE(PG8_SB(0, 0), b2, voffB); PG8_STAGE(PG8_SB(0, 1), b2 + hstepB, voffB); PG8_STAGE(PG8_SA(0, 0), a2, voffA);
            PG8_WAIT_V(8); PG8_WAIT_L(0); PG8_BAR; PG8_MMA(1, 0, At, B0); PG8_MMA(1, 1, At, B1); PG8_BAR; PG8_SCHED;
            PG8_LDB(B0, 1, 0); PG8_LDB(B1, 1, 1); PG8_SCHED; PG8_LDA(At, 1, 0); PG8_STAGE(PG8_SA(0, 1), a2 + hstepA, voffA);
            PG8_WAIT_V(8); PG8_WAIT_L(0); PG8_BAR; PG8_MMA(0, 0, At, B0); PG8_MMA(0, 1, At, B1); PG8_BAR; PG8_SCHED;
            PG8_LDA(At, 1, 1); PG8_STAGE(PG8_SB(1, 0), b3, voffB); PG8_STAGE(PG8_SB(1, 1), b3 + hstepB, voffB); PG8_STAGE(PG8_SA(1, 0), a3, voffA);
            PG8_WAIT_V(8); PG8_WAIT_L(0); PG8_BAR; PG8_MMA(1, 0, At, B0); PG8_MMA(1, 1, At, B1); PG8_BAR; PG8_SCHED;
        }
        if (wr == 0) PG8_BAR;
        E(acc, cur, wr, wc, fr, fq);
        if (!has_next) break;
#pragma unroll
        for (int a = 0; a < 2; ++a)
#pragma unroll
            for (int b = 0; b < 2; ++b)
#pragma unroll
                for (int m = 0; m < 4; ++m)
#pragma unroll
                    for (int n = 0; n < 2; ++n) acc[a][b][m][n] = (f32x4){0.f, 0.f, 0.f, 0.f};
        cur = nxt; cA = nA; cB = nB; ++ui;
        if (wr == 1) PG8_BAR;
    }
    PG8_WAIT_V(0);
    PG8_BAR;
#undef PG8_SA
#undef PG8_SB
#undef PG8_STAGE
#undef PG8_LDA
#undef PG8_LDB
#undef PG8_MMA
#undef PG8_WAIT_V
#undef PG8_WAIT_L
#undef PG8_BAR
#undef PG8_SCHED
#undef PG8_UA
#undef PG8_UB
}

#define EPI_ROWS_BEGIN for (int ai = 0; ai < 2; ++ai) { _Pragma("unroll") for (int m = 0; m < 4; ++m) { const int r = u.pm * BM + ai * HALF + wr * 64 + m * 16 + fr;
#define EPI_ROWS_END } }

__device__ __forceinline__ float rstd_from16(const float* ss, int r) { return rsqrtf(ss[r] * (1.0f / 1024.0f) + NORM_EPS); }

struct EpiProj { static constexpr bool PERM = true;
    const float* rstd; const float* bias; bf16_t* PR; bf16_t* PX; bf16_t* PY;
    __device__ __forceinline__ void operator()(Acc& acc, const Unit& u, int wr, int wc, int fr, int fq) const {
        bf16_t* base; int ld, colt;
        if (u.pn < 7) { base = PR; ld = RW; colt = u.pn * 256; } else if (u.pn < 9) { base = PX; ld = 512; colt = (u.pn - 7) * 256; } else { base = PY; ld = 512; colt = (u.pn - 9) * 256; }
        const int col0 = colt + wc * 32 + 8 * fq, bcol0 = u.pn * 256 + wc * 32 + 8 * fq;
        f32x4 bv[2][2];
#pragma unroll
        for (int bj = 0; bj < 2; ++bj)
#pragma unroll
            for (int n = 0; n < 2; ++n) bv[bj][n] = *(const f32x4*)(bias + bcol0 + bj * HALF + 4 * n);
#pragma unroll
        EPI_ROWS_BEGIN
            const float rs = rstd[r]; bf16_t* rowp = base + (size_t)r * ld + col0;
#pragma unroll
            for (int bj = 0; bj < 2; ++bj) { const f32x4 v0 = acc[ai][bj][m][0] * rs + bv[bj][0], v1 = acc[ai][bj][m][1] * rs + bv[bj][1];
                u32x4 w; w.x = cvt_pk_bf16(v0[0], v0[1]); w.y = cvt_pk_bf16(v0[2], v0[3]); w.z = cvt_pk_bf16(v1[0], v1[1]); w.w = cvt_pk_bf16(v1[2], v1[3]);
                *(u32x4*)(rowp + bj * HALF) = w; }
        EPI_ROWS_END
    }
};
struct EpiGab { static constexpr bool PERM = true;
    const float* rstd; const float* bias; bf16_t* O; int cofs;
    __device__ __forceinline__ void operator()(Acc& acc, const Unit& u, int wr, int wc, int fr, int fq) const {
        const int col0 = cofs + u.pn * 256 + wc * 32 + 8 * fq;
        f32x4 bv[2][2];
#pragma unroll
        for (int bj = 0; bj < 2; ++bj)
#pragma unroll
            for (int n = 0; n < 2; ++n) bv[bj][n] = *(const f32x4*)(bias + col0 + bj * HALF + 4 * n);
#pragma unroll
        EPI_ROWS_BEGIN
            const float rs = rstd[r]; bf16_t* rowp = O + (size_t)r * 2048 + col0;
#pragma unroll
            for (int bj = 0; bj < 2; ++bj) { f32x4 v0 = acc[ai][bj][m][0] * rs + bv[bj][0], v1 = acc[ai][bj][m][1] * rs + bv[bj][1];
#pragma unroll
                for (int j = 0; j < 4; ++j) { v0[j] = sigmoidf_(v0[j]); v1[j] = sigmoidf_(v1[j]); }
                u32x4 w; w.x = cvt_pk_bf16(v0[0], v0[1]); w.y = cvt_pk_bf16(v0[2], v0[3]); w.z = cvt_pk_bf16(v1[0], v1[1]); w.w = cvt_pk_bf16(v1[2], v1[3]);
                *(u32x4*)(rowp + bj * HALF) = w; }
        EPI_ROWS_END
    }
};
struct EpiPlain { static constexpr bool PERM = true;
    bf16_t* O; int ldc;
    __device__ __forceinline__ void operator()(Acc& acc, const Unit& u, int wr, int wc, int fr, int fq) const {
        const int col0 = u.pn * 256 + wc * 32 + 8 * fq;
#pragma unroll
        EPI_ROWS_BEGIN
            bf16_t* rowp = O + (size_t)r * ldc + col0;
#pragma unroll
            for (int bj = 0; bj < 2; ++bj) { const f32x4 v0 = acc[ai][bj][m][0], v1 = acc[ai][bj][m][1];
                u32x4 w; w.x = cvt_pk_bf16(v0[0], v0[1]); w.y = cvt_pk_bf16(v0[2], v0[3]); w.z = cvt_pk_bf16(v1[0], v1[1]); w.w = cvt_pk_bf16(v1[2], v1[3]);
                *(u32x4*)(rowp + bj * HALF) = w; }
        EPI_ROWS_END
    }
};
struct EpiLora { static constexpr bool PERM = true;
    const float* w0; const float* a0; bf16_t* O;
    __device__ __forceinline__ void operator()(Acc& acc, const Unit& u, int wr, int wc, int fr, int fq) const {
        const int kind = u.pn >> 1, ch0 = (u.pn & 1) * 256 + wc * 32 + 8 * fq, col0 = u.pn * 256 + wc * 32 + 8 * fq;
        const float* bsrc = kind == 0 ? w0 : a0;
        f32x4 bv[2][2];
#pragma unroll
        for (int bj = 0; bj < 2; ++bj)
#pragma unroll
            for (int n = 0; n < 2; ++n) bv[bj][n] = kind < 2 ? *(const f32x4*)(bsrc + ch0 + bj * HALF + 4 * n) : (f32x4){0.f, 0.f, 0.f, 0.f};
        const float sc = kind == 0 ? 0.6065306597126334f : 1.0f;
#pragma unroll
        EPI_ROWS_BEGIN
            bf16_t* rowp = O + (size_t)r * 1536 + col0;
#pragma unroll
            for (int bj = 0; bj < 2; ++bj) { f32x4 v0 = acc[ai][bj][m][0] + bv[bj][0], v1 = acc[ai][bj][m][1] + bv[bj][1];
                if (kind < 2) {
#pragma unroll
                    for (int j = 0; j < 4; ++j) { v0[j] = sc * sigmoidf_(v0[j]); v1[j] = sc * sigmoidf_(v1[j]); } }
                u32x4 w; w.x = cvt_pk_bf16(v0[0], v0[1]); w.y = cvt_pk_bf16(v0[2], v0[3]); w.z = cvt_pk_bf16(v1[0], v1[1]); w.w = cvt_pk_bf16(v1[2], v1[3]);
                *(u32x4*)(rowp + bj * HALF) = w; }
        EPI_ROWS_END
    }
};
struct EpiRg { static constexpr bool PERM = true;
    const float* ba; const float* bx; const float* lam; const bf16_t* XBC; bf16_t* LA; bf16_t* U;
    __device__ __forceinline__ void operator()(Acc& acc, const Unit& u, int wr, int wc, int fr, int fq) const {
        const int ch0 = u.pn * 128 + wc * 32 + 8 * fq;
        float vba[8], vbx[8], vls[8];
#pragma unroll
        for (int j = 0; j < 8; ++j) { vba[j] = ba[ch0 + j]; vbx[j] = bx[ch0 + j]; vls[j] = -8.0f * log1pf(__expf(-lam[ch0 + j])); }
#pragma unroll
        EPI_ROWS_BEGIN
            const bool first = (r & (SEQ - 1)) == 0;
            float xb[8]; unpack8(*(const u32x4*)(XBC + (size_t)r * 512 + ch0), xb);
            float la[8], uu[8];
#pragma unroll
            for (int j = 0; j < 8; ++j) { const float ga = sigmoidf_(acc[ai][0][m][j >> 2][j & 3] + vba[j]), gx = sigmoidf_(acc[ai][1][m][j >> 2][j & 3] + vbx[j]);
                la[j] = vls[j] * ga; const float a = __expf(la[j]); const float mult = first ? 1.0f : sqrtf(fmaxf(1.0f - a * a, 0.f)); uu[j] = xb[j] * gx * mult; }
            *(u32x4*)(LA + (size_t)r * 512 + ch0) = pack8(la); *(u32x4*)(U + (size_t)r * 512 + ch0) = pack8(uu);
        EPI_ROWS_END
    }
};
template <bool FIRST> struct EpiBranch { static constexpr bool PERM = true;
    const bf16_t* G; bf16_t* M;
    __device__ __forceinline__ void operator()(Acc& acc, const Unit& u, int wr, int wc, int fr, int fq) const {
        const int col0 = u.pn * 256 + wc * 32 + 8 * fq;
#pragma unroll
        EPI_ROWS_BEGIN
#pragma unroll
            for (int bj = 0; bj < 2; ++bj) { const int c = col0 + bj * HALF;
                float gv[8]; unpack8(*(const u32x4*)(G + (size_t)r * 2048 + (FIRST ? 0 : 1024) + c), gv);
                float o[8];
                if (!FIRST) unpack8(*(const u32x4*)(M + (size_t)r * 1024 + c), o);
#pragma unroll
                for (int j = 0; j < 8; ++j) { const float p = acc[ai][bj][m][j >> 2][j & 3] * gv[j]; o[j] = FIRST ? p : o[j] + p; }
                *(u32x4*)(M + (size_t)r * 1024 + c) = pack8(o); }
        EPI_ROWS_END
    }
};
template <bool BASE_F32> struct EpiRes { static constexpr bool PERM = true;
    const void* base; bf16_t* XB; float* ssp;
    __device__ __forceinline__ void operator()(Acc& acc, const Unit& u, int wr, int wc, int fr, int fq) const {
        const int col0 = u.pn * 256 + wc * 32 + 8 * fq;
#pragma unroll
        EPI_ROWS_BEGIN
            float s = 0.f;
#pragma unroll
            for (int bj = 0; bj < 2; ++bj) { const size_t off = (size_t)r * 1024 + col0 + bj * HALF; float o[8];
                if (BASE_F32) { const f32x4 b0 = *(const f32x4*)((const float*)base + off), b1 = *(const f32x4*)((const float*)base + off + 4);
                    o[0] = b0[0]; o[1] = b0[1]; o[2] = b0[2]; o[3] = b0[3]; o[4] = b1[0]; o[5] = b1[1]; o[6] = b1[2]; o[7] = b1[3]; }
                else unpack8(*(const u32x4*)((const bf16_t*)base + off), o);
#pragma unroll
                for (int j = 0; j < 8; ++j) { o[j] += acc[ai][bj][m][j >> 2][j & 3]; s += o[j] * o[j]; }
                *(u32x4*)(XB + off) = pack8(o); }
            s += __shfl_xor(s, 16); s += __shfl_xor(s, 32);
            if (fq == 0) atomicAdd(ssp + r, s);
        EPI_ROWS_END
    }
};
struct EpiQ { static constexpr bool PERM = true;
    const float* ssp; bf16_t* O;
    __device__ __forceinline__ void operator()(Acc& acc, const Unit& u, int wr, int wc, int fr, int fq) const {
        const int col0 = u.pn * 256 + wc * 32 + 8 * fq;
#pragma unroll
        EPI_ROWS_BEGIN
            const float rs = rstd_from16(ssp, r) * 0.0625f; bf16_t* rowp = O + (size_t)r * 1024 + col0;
#pragma unroll
            for (int bj = 0; bj < 2; ++bj) { const f32x4 v0 = acc[ai][bj][m][0] * rs, v1 = acc[ai][bj][m][1] * rs;
                u32x4 w; w.x = cvt_pk_bf16(v0[0], v0[1]); w.y = cvt_pk_bf16(v0[2], v0[3]); w.z = cvt_pk_bf16(v1[0], v1[1]); w.w = cvt_pk_bf16(v1[2], v1[3]);
                *(u32x4*)(rowp + bj * HALF) = w; }
        EPI_ROWS_END
    }
};
struct EpiSc { static constexpr bool PERM = true;
    bf16_t* O; float* ssp;
    __device__ __forceinline__ void operator()(Acc& acc, const Unit& u, int wr, int wc, int fr, int fq) const {
        const int col0 = u.pn * 256 + wc * 32 + 8 * fq;
#pragma unroll
        EPI_ROWS_BEGIN
            bf16_t* rowp = O + (size_t)r * 1024 + col0; float s = 0.f;
#pragma unroll
            for (int bj = 0; bj < 2; ++bj) { f32x4 v0 = acc[ai][bj][m][0], v1 = acc[ai][bj][m][1];
#pragma unroll
                for (int j = 0; j < 4; ++j) { v0[j] = __expf(v0[j]); v1[j] = __expf(v1[j]); }
                s += ((v0[0] + v0[1]) + (v0[2] + v0[3])) + ((v1[0] + v1[1]) + (v1[2] + v1[3]));
                u32x4 w; w.x = cvt_pk_bf16(v0[0], v0[1]); w.y = cvt_pk_bf16(v0[2], v0[3]); w.z = cvt_pk_bf16(v1[0], v1[1]); w.w = cvt_pk_bf16(v1[2], v1[3]);
                *(u32x4*)(rowp + bj * HALF) = w; }
            s += __shfl_xor(s, 16); s += __shfl_xor(s, 32);
            if (fq == 0) ssp[(size_t)r * 16 + u.pn * 4 + wc] = s;
        EPI_ROWS_END
    }
};
struct EpiPv { static constexpr bool PERM = true;
    const float* ssp; bf16_t* O;
    __device__ __forceinline__ void operator()(Acc& acc, const Unit& u, int wr, int wc, int fr, int fq) const {
        const int col0 = u.pn * 256 + wc * 32 + 8 * fq;
#pragma unroll
        EPI_ROWS_BEGIN
            const f32x4 sp = *(const f32x4*)(ssp + (size_t)r * 16 + u.pn * 4); const float rs = 1.0f / ((sp.x + sp.y) + (sp.z + sp.w));
            bf16_t* rowp = O + (size_t)r * 1024 + col0;
#pragma unroll
            for (int bj = 0; bj < 2; ++bj) { const f32x4 v0 = acc[ai][bj][m][0] * rs, v1 = acc[ai][bj][m][1] * rs;
                u32x4 w; w.x = cvt_pk_bf16(v0[0], v0[1]); w.y = cvt_pk_bf16(v0[2], v0[3]); w.z = cvt_pk_bf16(v1[0], v1[1]); w.w = cvt_pk_bf16(v1[2], v1[3]);
                *(u32x4*)(rowp + bj * HALF) = w; }
        EPI_ROWS_END
    }
};
__device__ __forceinline__ float dpp_ror1(float v) { return __int_as_float(__builtin_amdgcn_update_dpp(0, __float_as_int(v), 0x121, 0xf, 0xf, false)); }
__device__ __forceinline__ float dpp_ror2(float v) { return __int_as_float(__builtin_amdgcn_update_dpp(0, __float_as_int(v), 0x122, 0xf, 0xf, false)); }
struct EpiFfnAct { static constexpr bool PERM = true;
    const float* ssp; const float* cw; const float* cb; bf16_t* ACT; bf16_t* HG;
    __device__ __forceinline__ void operator()(Acc& acc, const Unit& u, int wr, int wc, int fr_, int fq_) const {
        const int l_ = lane_id(), fr = l_ & 15, fq = l_ >> 4;
        const int col0 = u.pn * 128 + wc * 32 + 8 * fq;
#pragma unroll
        for (int ai = 0; ai < 2; ++ai) {
            const int rbase = u.pm * BM + ai * HALF + wr * 64 + fr;
            float rs[4];
#pragma unroll
            for (int m = 0; m < 4; ++m) rs[m] = rstd_from16(ssp, rbase + m * 16);
            const size_t grp = (size_t)(rbase >> 6);
            if (fr < 2) { float t[8];
#pragma unroll
                for (int j = 0; j < 8; ++j) t[j] = acc[ai][0][0][j >> 2][j & 3] * rs[0];
                *(u32x4*)(HG + (grp * 4 + 2 + fr) * DFF + col0) = pack8(t); }
            if (fr >= 14) { float t[8];
#pragma unroll
                for (int j = 0; j < 8; ++j) t[j] = acc[ai][0][3][j >> 2][j & 3] * rs[3];
                *(u32x4*)(HG + (grp * 4 + (fr - 14)) * DFF + col0) = pack8(t); }
#pragma unroll
            for (int j = 0; j < 8; ++j) {
                const float w0 = cw[col0 + j], w1 = cw[DFF + col0 + j], w2 = cw[2 * DFF + col0 + j], b0 = cb[col0 + j];
                float g[4], r1[4], r2[4];
#pragma unroll
                for (int m = 0; m < 4; ++m) { g[m] = acc[ai][0][m][j >> 2][j & 3] * rs[m]; r1[m] = dpp_ror1(g[m]); r2[m] = dpp_ror2(g[m]); }
#pragma unroll
                for (int m = 0; m < 4; ++m) {
                    const float p1 = fr >= 1 ? r1[m] : r1[m > 0 ? m - 1 : 0], p2 = fr >= 2 ? r2[m] : r2[m > 0 ? m - 1 : 0];
                    const float up = acc[ai][1][m][j >> 2][j & 3] * rs[m];
                    const float gate = b0 + w0 * p2 + w1 * p1 + w2 * g[m];
                    acc[ai][1][m][j >> 2][j & 3] = (m == 0 && fr < 2) ? up : gelu_tanh(gate) * up;
                }
            }
#pragma unroll
            for (int m = 0; m < 4; ++m) { const f32x4 v0 = acc[ai][1][m][0], v1 = acc[ai][1][m][1];
                u32x4 w; w.x = cvt_pk_bf16(v0[0], v0[1]); w.y = cvt_pk_bf16(v0[2], v0[3]); w.z = cvt_pk_bf16(v1[0], v1[1]); w.w = cvt_pk_bf16(v1[2], v1[3]);
                *(u32x4*)(ACT + (size_t)(rbase + m * 16) * DFF + col0) = w; }
        }
    }
};

struct Args { const float* in[37]; float* out; unsigned char* ws; int ph_lo, ph_hi; };
enum { I_X = 0, I_MEM, I_NMIXG, I_WIN, I_BIN, I_MU, I_W0, I_WUP, I_A0, I_AUP, I_GUP, I_KK, I_KA, I_RK, I_LNXG, I_LNXB, I_WBA, I_CBW, I_CBB, I_WRGA, I_BRGA, I_WRGX, I_BRGX,
       I_LAM, I_WBB, I_WMIX, I_NXG, I_NMEMG, I_WCQ, I_WCKV, I_WCO, I_NFFNG, I_WFFI, I_FCW, I_FCB, I_WFFO, I_NFING };

__device__ __forceinline__ void transpose_item(const float* W, int ldw, int K, bf16_t* WT, int ldd, const float* gain, int map, int srcofs, LAS float* scr, int item, int lane) {
    const int nkb = K / 64, nb = item / nkb, kb = item % nkb, k0 = 64 * kb, n0 = 32 * nb;
    int ns = n0 + srcofs;
    if (map == 1) { const int tile = n0 >> 8, c = n0 & 255; ns = c < 128 ? tile * 128 + c : DFF + tile * 128 + (c - 128); }
#pragma unroll
    for (int i = 0; i < 32; ++i) { const int kk = 2 * i + (lane >> 5); float v = W[(size_t)(k0 + kk) * ldw + ns + (lane & 31)]; if (gain) v *= gain[k0 + kk]; scr[kk * 33 + (lane & 31)] = v; }
    asm volatile("s_waitcnt lgkmcnt(0)" ::: "memory");
    const int c = lane & 7;
#pragma unroll
    for (int j = 0; j < 4; ++j) { const int n = (lane >> 3) + 8 * j; const LAS float* s = scr + (8 * c) * 33 + n;
        u32x4 o; o.x = cvt_pk_bf16(s[0 * 33], s[1 * 33]); o.y = cvt_pk_bf16(s[2 * 33], s[3 * 33]); o.z = cvt_pk_bf16(s[4 * 33], s[5 * 33]); o.w = cvt_pk_bf16(s[6 * 33], s[7 * 33]);
        *(u32x4*)(WT + (size_t)(n0 + n) * ldd + k0 + 8 * c) = o; }
    asm volatile("s_waitcnt lgkmcnt(0)" ::: "memory");
}

__device__ __forceinline__ void phase_prep(const Args& a, LAS unsigned char* lds, int wave, int G) {
    const int lane = lane_id();
    unsigned char* ws = a.ws;
    LAS float* scr = (LAS float*)(lds + wave * 16384);
    const int gw = blockIdx.x * 8 + wave, NGW = G * 8;
#define TITEMS(K_, Nd_) (((K_) / 64) * ((Nd_) / 32))
#define TJOB(W_, ldw_, K_, Nd_, dst_, gain_, map_, srcofs_) if (r < TITEMS(K_, Nd_)) { transpose_item((W_), (ldw_), (K_), (bf16_t*)(ws + (dst_)), (K_), (gain_), (map_), (srcofs_), scr, r, lane); continue; } r -= TITEMS(K_, Nd_);
    constexpr int NITEMS_ALL = TITEMS(1024, PIN) + 2 * TITEMS(512, 1024) + 5 * TITEMS(1024, 1024) + TITEMS(1024, 2 * DFF) + TITEMS(DFF, 1024);
    for (int it = gw; it < NITEMS_ALL; it += NGW) {
        int r = it;
        TJOB(a.in[I_WFFI], 2 * DFF, 1024, 2 * DFF, WS_WFFI, a.in[I_NFFNG], 1, 0)
        TJOB(a.in[I_WIN], PIN, 1024, PIN, WS_WIN, a.in[I_NMIXG], 0, 0)
        TJOB(a.in[I_WFFO], 1024, DFF, 1024, WS_WFFO, nullptr, 0, 0)
        TJOB(a.in[I_WMIX], 1024, 1024, 1024, WS_WMIX, nullptr, 0, 0)
        TJOB(a.in[I_WCQ], 1024, 1024, 1024, WS_WCQ, a.in[I_NXG], 0, 0)
        TJOB(a.in[I_WCKV], 2048, 1024, 1024, WS_WK, nullptr, 0, 0)
        TJOB(a.in[I_WCKV], 2048, 1024, 1024, WS_WV, nullptr, 0, 1024)
        TJOB(a.in[I_WCO], 1024, 1024, 1024, WS_WCO, nullptr, 0, 0)
        TJOB(a.in[I_WBA], 1024, 512, 1024, WS_WA, nullptr, 0, 0)
        TJOB(a.in[I_WBB], 1024, 512, 1024, WS_WB, nullptr, 0, 0)
    }
#undef TJOB
#undef TITEMS
    { float* z1 = (float*)(ws + WS_SSP1); float* z2 = (float*)(ws + WS_SSP2); float* z3 = (float*)(ws + WS_SSP3);
      for (int i = blockIdx.x * 512 + wave * 64 + lane; i < T; i += G * 512) { z1[i] = 0.f; z2[i] = 0.f; z3[i] = 0.f; } }
    const int gid = blockIdx.x * 512 + wave * 64 + lane, NT = G * 512;
    { bf16_t* WL = (bf16_t*)(ws + WS_WLORA);
      for (int i = gid; i < 1536 * 256; i += NT) { const int n = i >> 8, k = i & 255, kind = n >> 9, c = n & 511; float v = 0.f;
          if (kind == 0 && k < 64) v = a.in[I_WUP][k * 512 + c]; else if (kind == 1 && k >= 64 && k < 128) v = a.in[I_AUP][(k - 64) * 512 + c]; else if (kind == 2 && k >= 128) v = a.in[I_GUP][(k - 128) * 512 + c];
          WL[i] = f2bf(v); } }
    { bf16_t* WR = (bf16_t*)(ws + WS_WRG);
      for (int i = gid; i < 1024 * 256; i += NT) { const int n = i >> 8, kk = i & 255, pn = n >> 8, c = n & 255, ch = pn * 128 + (c & 127), hb = ch >> 6, j = ch & 63, k = 256 * (pn >> 1) + kk; float v = 0.f;
          if ((k >> 6) == hb) v = (c < 128 ? a.in[I_WRGA] : a.in[I_WRGX])[(hb * 64 + (k & 63)) * 64 + j];
          WR[i] = f2bf(v); } }
    { const float* x = a.in[I_X]; bf16_t* XB = (bf16_t*)(ws + WS_XB); float* rstd = (float*)(ws + WS_RSTDX);
      for (int r0 = gw; r0 < T; r0 += 4 * NGW) {
          f32x4 v[4][4]; float s[4];
#pragma unroll
          for (int q = 0; q < 4; ++q) { const int r = r0 + q * NGW; s[q] = 0.f; if (r < T) { const f32x4* xr = (const f32x4*)(x + (size_t)r * D) + lane;
#pragma unroll
              for (int j = 0; j < 4; ++j) v[q][j] = xr[64 * j]; } else {
#pragma unroll
              for (int j = 0; j < 4; ++j) v[q][j] = (f32x4){0.f, 0.f, 0.f, 0.f}; } }
#pragma unroll
          for (int q = 0; q < 4; ++q) {
#pragma unroll
              for (int j = 0; j < 4; ++j) s[q] += (v[q][j].x * v[q][j].x + v[q][j].y * v[q][j].y) + (v[q][j].z * v[q][j].z + v[q][j].w * v[q][j].w);
              s[q] = wave_sum(s[q]); }
#pragma unroll
          for (int q = 0; q < 4; ++q) { const int r = r0 + q * NGW; if (r < T) { if (lane == 0) rstd[r] = rsqrtf(s[q] * (1.0f / D) + NORM_EPS);
              u32x2* o = (u32x2*)(XB + (size_t)r * D) + lane;
#pragma unroll
              for (int j = 0; j < 4; ++j) { u32x2 w; w.x = cvt_pk_bf16(v[q][j].x, v[q][j].y); w.y = cvt_pk_bf16(v[q][j].z, v[q][j].w); o[64 * j] = w; } } } } }
    { const float* x = a.in[I_MEM]; bf16_t* XB = (bf16_t*)(ws + WS_MEMN); const float* g = a.in[I_NMEMG];
      for (int r = gw; r < TM; r += NGW) { const f32x4* xr = (const f32x4*)(x + (size_t)r * D) + lane; f32x4 v[4]; float s = 0.f;
#pragma unroll
          for (int j = 0; j < 4; ++j) { v[j] = xr[64 * j]; s += (v[j].x * v[j].x + v[j].y * v[j].y) + (v[j].z * v[j].z + v[j].w * v[j].w); }
          s = wave_sum(s); const float rs = rsqrtf(s * (1.0f / D) + NORM_EPS);
          u32x2* o = (u32x2*)(XB + (size_t)r * D) + lane;
#pragma unroll
          for (int j = 0; j < 4; ++j) { const f32x4 gg = ((const f32x4*)g)[lane + 64 * j]; u32x2 w; w.x = cvt_pk_bf16(v[j].x * rs * gg.x, v[j].y * rs * gg.y); w.y = cvt_pk_bf16(v[j].z * rs * gg.z, v[j].w * rs * gg.w); o[64 * j] = w; } } }
}

__device__ __forceinline__ float tanh_fast(float v) { return 1.0f - 2.0f * __builtin_amdgcn_rcpf(__expf(2.0f * v) + 1.0f); }
__device__ __forceinline__ void phase_elem2(const Args& a, int wave, int G) {
    unsigned char* ws = a.ws;
    const bf16_t* PR = (const bf16_t*)(ws + WS_PR); const bf16_t* PX = (const bf16_t*)(ws + WS_PX);
    bf16_t* LIN = (bf16_t*)(ws + WS_LIN); bf16_t* XBC = (bf16_t*)(ws + WS_XBC);
    const size_t gid = (size_t)blockIdx.x * 512 + wave * 64 + lane_id(), NT = (size_t)G * 512;
    {
        const int c = (int)(gid & 31) * 8; float mu[8];
#pragma unroll
        for (int j = 0; j < 8; ++j) mu[j] = a.in[I_MU][1536 + c + j];
        const size_t N = (size_t)T * 32;
        for (size_t i0 = gid; i0 < N; i0 += 4 * NT) {
            u32x4 P[4], Q[4]; bool hp[4], ok[4];
#pragma unroll
            for (int u = 0; u < 4; ++u) { const size_t i = i0 + u * NT; ok[u] = i < N; const int t = (int)((ok[u] ? i : i0) >> 5); hp[u] = (t & (SEQ - 1)) != 0;
                P[u] = *(const u32x4*)(PR + (size_t)t * RW + 1536 + c); Q[u] = *(const u32x4*)(PR + (size_t)(hp[u] ? t - 1 : t) * RW + 1536 + c); }
#pragma unroll
            for (int u = 0; u < 4; ++u) { const size_t i = i0 + u * NT; if (!ok[u]) continue; const int t = (int)(i >> 5);
                float p[8], pp[8], o[8]; unpack8(P[u], p); unpack8(Q[u], pp);
#pragma unroll
                for (int j = 0; j < 8; ++j) { const float q = hp[u] ? pp[j] : 0.f; const float v = p[j] + (q - p[j]) * mu[j]; o[j] = c < 64 ? tanh_fast(v) : (c < 128 ? v : sigmoidf_(v)); }
                *(u32x4*)(LIN + (size_t)t * 256 + c) = pack8(o); }
        }
    }
    {
        const int c = (int)(gid & 63) * 8; float w[4][8], b0[8];
#pragma unroll
        for (int j = 0; j < 8; ++j) { b0[j] = a.in[I_CBB][c + j];
#pragma unroll
            for (int k = 0; k < 4; ++k) w[k][j] = a.in[I_CBW][k * 512 + c + j]; }
        const size_t N = (size_t)T * 64;
        for (size_t i0 = gid; i0 < N; i0 += 4 * NT) {
            u32x4 X[4][4]; bool ok[4]; int tl[4];
#pragma unroll
            for (int u = 0; u < 4; ++u) { const size_t i = i0 + u * NT; ok[u] = i < N; const int t = (int)((ok[u] ? i : i0) >> 6); tl[u] = t & (SEQ - 1);
#pragma unroll
                for (int k = 0; k < 4; ++k) { const int dt = 3 - k; X[u][k] = *(const u32x4*)(PX + (size_t)(tl[u] >= dt ? t - dt : t) * 512 + c); } }
#pragma unroll
            for (int u = 0; u < 4; ++u) { const size_t i = i0 + u * NT; if (!ok[u]) continue; const int t = (int)(i >> 6);
                float o[8];
#pragma unroll
                for (int j = 0; j < 8; ++j) o[j] = b0[j];
#pragma unroll
                for (int k = 0; k < 4; ++k) { float p[8]; unpack8(X[u][k], p); const bool in = tl[u] >= 3 - k;
#pragma unroll
                    for (int j = 0; j < 8; ++j) o[j] += in ? p[j] * w[k][j] : 0.f; }
                *(u32x4*)(XBC + (size_t)t * 512 + c) = pack8(o); }
        }
    }
}

#define DPP_BC(JJ) " row_newbcast:" #JJ " row_mask:0xf bank_mask:0xf"
#define RW_SA(JJ)  asm("v_fmac_f32_dpp %0, %1, %2" DPP_BC(JJ) : "+v"(sacc[JJ & 3]) : "v"(va), "v"(S[JJ]));
#define RW_UPD(JJ) { float t_; \
    asm("v_mul_f32_dpp %0, %1, %2" DPP_BC(JJ) : "=v"(t_) : "v"(vb), "v"(sa)); \
    asm("v_fmac_f32_dpp %0, %1, %2" DPP_BC(JJ) : "+v"(t_) : "v"(vk), "v"(vv)); \
    asm("v_fmac_f32_dpp %0, %1, %2" DPP_BC(JJ) : "+v"(t_) : "v"(vw), "v"(S[JJ])); \
    S[JJ] = t_; \
    asm("v_fmac_f32_dpp %0, %1, %2" DPP_BC(JJ) : "+v"(yacc[JJ & 3]) : "v"(vr), "v"(S[JJ])); }
#define RW_ALL16(M) M(0) M(1) M(2) M(3) M(4) M(5) M(6) M(7) M(8) M(9) M(10) M(11) M(12) M(13) M(14) M(15)

constexpr int RB = 32;
constexpr int PSTEP = 6 * 64;
constexpr int PBUF = RB * PSTEP * 4;

__device__ __forceinline__ float dpp_ror_add(float v, const int ctrl_sel) {
    int t;
    switch (ctrl_sel) {
        case 8: t = __builtin_amdgcn_update_dpp(0, __float_as_int(v), 0x128, 0xf, 0xf, false); break;
        case 4: t = __builtin_amdgcn_update_dpp(0, __float_as_int(v), 0x124, 0xf, 0xf, false); break;
        case 2: t = __builtin_amdgcn_update_dpp(0, __float_as_int(v), 0x122, 0xf, 0xf, false); break;
        default: t = __builtin_amdgcn_update_dpp(0, __float_as_int(v), 0x121, 0xf, 0xf, false); break;
    }
    return v + __int_as_float(t);
}
__device__ __forceinline__ float cross_row_allsum(float v) {
    auto r = __builtin_amdgcn_permlane32_swap(__float_as_uint(v), __float_as_uint(v), false, false);
    v = __uint_as_float(r[0]) + __uint_as_float(r[1]);
    auto r2 = __builtin_amdgcn_permlane16_swap(__float_as_uint(v), __float_as_uint(v), false, false);
    return __uint_as_float(r2[0]) + __uint_as_float(r2[1]);
}
__device__ __forceinline__ float wave_allsum(float v) {
    v = dpp_ror_add(v, 8); v = dpp_ror_add(v, 4); v = dpp_ror_add(v, 2); v = dpp_ror_add(v, 1);
    return cross_row_allsum(v);
}
__device__ __forceinline__ void lds_barrier() { asm volatile("s_waitcnt lgkmcnt(0)" ::: "memory"); __builtin_amdgcn_s_barrier(); asm volatile("" ::: "memory"); }

constexpr int NPS = RB / 4;
__device__ __forceinline__ void prod_load(const Args& a, bf16_t (&raw)[NPS][8], int tok0, int h, int p, int lane) {
    const bf16_t* PR = (const bf16_t*)(a.ws + WS_PR); const bf16_t* LOUT = (const bf16_t*)(a.ws + WS_LOUT);
#pragma unroll
    for (int i = 0; i < NPS; ++i) { const int tok = tok0 + p + 4 * i; const bool has_prev = (tok & (SEQ - 1)) != 0;
        const bf16_t* prow = PR + (size_t)tok * RW + h * 64 + lane; const bf16_t* qrow = has_prev ? prow - RW : prow; const bf16_t* lrow = LOUT + (size_t)tok * 1536 + h * 64 + lane;
        raw[i][0] = prow[0]; raw[i][1] = prow[512]; raw[i][2] = prow[1024]; raw[i][3] = qrow[0]; raw[i][4] = qrow[512]; raw[i][5] = qrow[1024]; raw[i][6] = lrow[0]; raw[i][7] = lrow[512]; }
}
__device__ __forceinline__ void prod_compute(const Args& a, const bf16_t (&raw)[NPS][8], LAS float* pb, int tok0, int h, int p, int lane, float mu_r, float mu_k, float mu_v, float ckk, float cka, float crk) {
    float* BON = (float*)(a.ws + WS_BON);
#pragma unroll
    for (int i = 0; i < NPS; ++i) { const int s = p + 4 * i, tok = tok0 + s; const bool has_prev = (tok & (SEQ - 1)) != 0;
        const float rr = bf1(raw[i][0]), kr = bf1(raw[i][1]), vr_ = bf1(raw[i][2]);
        const float rp = has_prev ? bf1(raw[i][3]) : 0.f, kp = has_prev ? bf1(raw[i][4]) : 0.f, vp = has_prev ? bf1(raw[i][5]) : 0.f;
        const float e = bf1(raw[i][6]), av = bf1(raw[i][7]);
        const float r = rr + (rp - rr) * mu_r, k0 = kr + (kp - kr) * mu_k, v = vr_ + (vp - vr_) * mu_v;
        const float w = __expf(-e);
        const float kk = k0 * ckk; const float n2 = wave_allsum(kk * kk); const float kkn = kk * rsqrtf(fmaxf(n2, 1e-24f));
        const float k2 = k0 * (1.0f + (av - 1.0f) * cka);
        const float bon = wave_allsum(r * k2 * crk);
        LAS float* pp = pb + s * PSTEP;
        pp[lane] = -kkn; pp[64 + lane] = kkn * av; pp[128 + lane] = k2; pp[192 + lane] = w; pp[256 + lane] = r; pp[320 + lane] = v;
        if (lane == 0) BON[(size_t)tok * 8 + h] = bon; }
}

__device__ __forceinline__ void phase_scan(const Args& a, LAS unsigned char* lds, int wave, int G) {
    const int lane = lane_id();
    unsigned char* ws = a.ws;
    constexpr int SB = 16, NBLK = SEQ / RB;
    for (int pair = blockIdx.x; pair < 256; pair += G) {
        const int b = pair >> 3, h = pair & 7, tokb = b * SEQ;
        if (wave < 4) {
            const int il = lane & 15, irow = 16 * wave + il;
            float S[16];
#pragma unroll
            for (int j = 0; j < 16; ++j) S[j] = 0.f;
            bf16_t* YRAW = (bf16_t*)(ws + WS_YRAW);
            lds_barrier();
            for (int blk = 0; blk < NBLK; ++blk) {
                const LAS float* pb = (const LAS float*)(lds + (blk & 1) * PBUF);
#pragma unroll 2
                for (int s = 0; s < RB; ++s) {
                    const LAS float* pp = pb + s * PSTEP;
                    float va = pp[lane], vb = pp[64 + lane], vk = pp[128 + lane], vw = pp[192 + lane], vr = pp[256 + lane]; const float vv = pp[320 + irow];
                    asm volatile("s_nop 1" : "+v"(va), "+v"(vb), "+v"(vk), "+v"(vw), "+v"(vr));
                    float sacc[4] = {0.f, 0.f, 0.f, 0.f}, yacc[4] = {0.f, 0.f, 0.f, 0.f};
                    RW_ALL16(RW_SA)
                    float sa = (sacc[0] + sacc[1]) + (sacc[2] + sacc[3]);
                    sa = cross_row_allsum(sa);
                    RW_ALL16(RW_UPD)
                    float y = (yacc[0] + yacc[1]) + (yacc[2] + yacc[3]);
                    y = cross_row_allsum(y);
                    const int tok = tokb + blk * RB + s;
                    if (lane < 16) YRAW[(size_t)tok * 512 + h * 64 + irow] = f2bf(y);
                }
                lds_barrier();
            }
        } else {
            const float mu_r = a.in[I_MU][h * 64 + lane], mu_k = a.in[I_MU][512 + h * 64 + lane], mu_v = a.in[I_MU][1024 + h * 64 + lane];
            const float ckk = a.in[I_KK][h * 64 + lane], cka = a.in[I_KA][h * 64 + lane], crk = a.in[I_RK][h * 64 + lane];
            const size_t base = (size_t)tokb * 512 + h * 64 + lane;
            const bf16_t* LA = (const bf16_t*)(ws + WS_RGLA) + base; const bf16_t* U = (const bf16_t*)(ws + WS_RGU) + base; const bf16_t* PY = (const bf16_t*)(ws + WS_PY) + base;
            bf16_t* YB = (bf16_t*)(ws + WS_YB) + base;
            bf16_t cla[SB], cu[SB], cpy[SB]; float hh = 0.f;
#pragma unroll
            for (int s = 0; s < SB; ++s) { cla[s] = 0; cu[s] = 0; cpy[s] = 0; }
            if (wave == 4) {
#pragma unroll
                for (int s = 0; s < SB; ++s) { cla[s] = LA[(size_t)s * 512]; cu[s] = U[(size_t)s * 512]; cpy[s] = PY[(size_t)s * 512]; }
            }
            bf16_t raw[NPS][8];
            prod_load(a, raw, tokb, h, wave - 4, lane); prod_compute(a, raw, (LAS float*)lds, tokb, h, wave - 4, lane, mu_r, mu_k, mu_v, ckk, cka, crk); prod_load(a, raw, tokb + RB, h, wave - 4, lane);
            lds_barrier();
            for (int blk = 0; blk < NBLK; ++blk) {
                if (blk + 1 < NBLK) { prod_compute(a, raw, (LAS float*)(lds + ((blk + 1) & 1) * PBUF), tokb + (blk + 1) * RB, h, wave - 4, lane, mu_r, mu_k, mu_v, ckk, cka, crk);
                    if (blk + 2 < NBLK) prod_load(a, raw, tokb + (blk + 2) * RB, h, wave - 4, lane); }
                if (wave == 4) {
                    for (int sub = 0; sub < RB / SB; ++sub) {
                        const int t0 = blk * RB + sub * SB, tn = (t0 + SB < SEQ) ? t0 + SB : t0;
                        bf16_t nla[SB], nu[SB], npy[SB];
#pragma unroll
                        for (int s = 0; s < SB; ++s) { nla[s] = LA[(size_t)(tn + s) * 512]; nu[s] = U[(size_t)(tn + s) * 512]; npy[s] = PY[(size_t)(tn + s) * 512]; }
#pragma unroll
                        for (int s = 0; s < SB; ++s) { hh = __expf(bf1(cla[s])) * hh + bf1(cu[s]); YB[(size_t)(t0 + s) * 512] = f2bf(hh * gelu_tanh(bf1(cpy[s]))); }
#pragma unroll
                        for (int s = 0; s < SB; ++s) { cla[s] = nla[s]; cu[s] = nu[s]; cpy[s] = npy[s]; }
                    }
                }
                lds_barrier();
            }
        }
    }
    asm volatile("s_waitcnt vmcnt(0)" ::: "memory");
}

__device__ __forceinline__ void phase_post(const Args& a, int wave, int G) {
    unsigned char* ws = a.ws;
    const bf16_t* PR = (const bf16_t*)(ws + WS_PR); const bf16_t* LOUT = (const bf16_t*)(ws + WS_LOUT); const bf16_t* YRAW = (const bf16_t*)(ws + WS_YRAW);
    const float* BON = (const float*)(ws + WS_BON); bf16_t* YA = (bf16_t*)(ws + WS_YA);
    const size_t gid = (size_t)blockIdx.x * 512 + wave * 64 + lane_id(), NT = (size_t)G * 512;
    const int c = (int)(gid & 63) * 8, h = c >> 6; float mu[8], lg[8], lb[8];
#pragma unroll
    for (int j = 0; j < 8; ++j) { mu[j] = a.in[I_MU][1024 + c + j]; lg[j] = a.in[I_LNXG][c + j]; lb[j] = a.in[I_LNXB][c + j]; }
    const size_t N = (size_t)T * 64;
    for (size_t i0 = gid; i0 < N; i0 += 4 * NT) {
        u32x4 Y[4], V[4], VP[4], GG[4]; float bn[4]; bool ok[4], hp[4];
#pragma unroll
        for (int u = 0; u < 4; ++u) { const size_t i = i0 + u * NT; ok[u] = i < N; const int t = (int)((ok[u] ? i : i0) >> 6); hp[u] = (t & (SEQ - 1)) != 0;
            Y[u] = *(const u32x4*)(YRAW + (size_t)t * 512 + c); V[u] = *(const u32x4*)(PR + (size_t)t * RW + 1024 + c); VP[u] = *(const u32x4*)(PR + (size_t)(hp[u] ? t - 1 : t) * RW + 1024 + c);
            GG[u] = *(const u32x4*)(LOUT + (size_t)t * 1536 + 1024 + c); bn[u] = BON[(size_t)t * 8 + h]; }
#pragma unroll
        for (int u = 0; u < 4; ++u) { const size_t i = i0 + u * NT; const int t = (int)((ok[u] ? i : i0) >> 6);
            float y[8], v[8], vp[8], g[8], o[8]; unpack8(Y[u], y); unpack8(V[u], v); unpack8(VP[u], vp); unpack8(GG[u], g);
            float s = 0.f;
#pragma unroll
            for (int j = 0; j < 8; ++j) s += y[j];
            s += __shfl_xor(s, 1); s += __shfl_xor(s, 2); s += __shfl_xor(s, 4);
            const float mean = s * (1.0f / 64.0f); float q = 0.f;
#pragma unroll
            for (int j = 0; j < 8; ++j) { const float d = y[j] - mean; q += d * d; }
            q += __shfl_xor(q, 1); q += __shfl_xor(q, 2); q += __shfl_xor(q, 4);
            const float rs = rsqrtf(q * (1.0f / 64.0f) + LNX_EPS);
#pragma unroll
            for (int j = 0; j < 8; ++j) { const float pv = hp[u] ? vp[j] : 0.f; const float vv = v[j] + (pv - v[j]) * mu[j];
                o[j] = ((y[j] - mean) * rs * lg[j] + lb[j] + bn[u] * vv) * g[j]; }
            if (ok[u]) *(u32x4*)(YA + (size_t)t * 512 + c) = pack8(o); }
    }
}

__device__ __forceinline__ void phase_ffnfix(const Args& a, int wave, int G) {
    unsigned char* ws = a.ws;
    const bf16_t* HG = (const bf16_t*)(ws + WS_HG); bf16_t* ACT = (bf16_t*)(ws + WS_UU);
    const float* cw = a.in[I_FCW]; const float* cb = a.in[I_FCB];
    const size_t gid = (size_t)blockIdx.x * 512 + wave * 64 + lane_id(), NT = (size_t)G * 512;
    constexpr int CPR = DFF / 8;
    for (size_t i = gid; i < (size_t)(T / 64) * 2 * CPR; i += NT) {
        const int c = (int)(i % CPR) * 8, rho = (int)((i / CPR) & 1), grp = (int)(i / (2 * CPR)); const int t = grp * 64 + rho; const bool first = (grp & 31) == 0;
        float p2[8], p1[8], cur[8], up[8], o[8];
#pragma unroll
        for (int j = 0; j < 8; ++j) { p2[j] = 0.f; p1[j] = 0.f; }
        if (rho == 0) { if (!first) { unpack8(*(const u32x4*)(HG + ((size_t)(grp - 1) * 4 + 0) * DFF + c), p2); unpack8(*(const u32x4*)(HG + ((size_t)(grp - 1) * 4 + 1) * DFF + c), p1); } }
        else { if (!first) unpack8(*(const u32x4*)(HG + ((size_t)(grp - 1) * 4 + 1) * DFF + c), p2); unpack8(*(const u32x4*)(HG + ((size_t)grp * 4 + 2) * DFF + c), p1); }
        unpack8(*(const u32x4*)(HG + ((size_t)grp * 4 + 2 + rho) * DFF + c), cur);
        unpack8(*(const u32x4*)(ACT + (size_t)t * DFF + c), up);
#pragma unroll
        for (int j = 0; j < 8; ++j) o[j] = gelu_tanh(cb[c + j] + cw[c + j] * p2[j] + cw[DFF + c + j] * p1[j] + cw[2 * DFF + c + j] * cur[j]) * up[j];
        *(u32x4*)(ACT + (size_t)t * DFF + c) = pack8(o);
    }
}

__device__ __forceinline__ void phase_final(const Args& a, int wave, int G) {
    const int lane = lane_id();
    const float* ssp = (const float*)(a.ws + WS_SSP3); const float* g = a.in[I_NFING]; const bf16_t* X3 = (const bf16_t*)(a.ws + WS_X3B);
    const int gw = blockIdx.x * 8 + wave, NGW = G * 8;
    for (int r0 = gw; r0 < T; r0 += 4 * NGW) {
        u32x4 v[4][2]; float rs[4];
#pragma unroll
        for (int q = 0; q < 4; ++q) { const int r = r0 + q * NGW; if (r < T) { rs[q] = rstd_from16(ssp, r); const u32x4* xr = (const u32x4*)(X3 + (size_t)r * D) + lane; v[q][0] = xr[0]; v[q][1] = xr[64]; } }
#pragma unroll
        for (int q = 0; q < 4; ++q) { const int r = r0 + q * NGW; if (r < T) {
#pragma unroll
            for (int j = 0; j < 2; ++j) { float x[8]; unpack8(v[q][j], x); const int c = 512 * j + 8 * lane; const f32x4 g0 = *(const f32x4*)(g + c), g1 = *(const f32x4*)(g + c + 4);
                f32x4* o = (f32x4*)(a.out + (size_t)r * D + c);
                o[0] = (f32x4){x[0] * rs[q] * g0[0], x[1] * rs[q] * g0[1], x[2] * rs[q] * g0[2], x[3] * rs[q] * g0[3]};
                o[1] = (f32x4){x[4] * rs[q] * g1[0], x[5] * rs[q] * g1[1], x[6] * rs[q] * g1[2], x[7] * rs[q] * g1[3]}; } } }
    }
}

constexpr int NPHASE = 13;
__global__ void __launch_bounds__(512, 2) mega(Args a) {
    extern __shared__ __attribute__((aligned(16))) unsigned char lds_raw[];
    LAS unsigned char* lds = (LAS unsigned char*)lds_raw;
    cg::grid_group grid = cg::this_grid();
    const int wave = __builtin_amdgcn_readfirstlane((int)threadIdx.x >> 6), G = gridDim.x, bid = blockIdx.x;
    unsigned char* ws = a.ws;
    const int lo = a.ph_lo, hi = a.ph_hi;
    const bool t0 = (wave == 0) && (lane_id() == 0);
    volatile LAS unsigned* misc = (volatile LAS unsigned*)(lds + 131072 + 320);
    if (t0) { misc[0] = 0u; misc[1] = 0u; }
    __syncthreads();
    XcdBarrier xb = xcd_barrier_post((unsigned*)(ws + WS_CTL), misc, t0);
    if (a.ph_hi < 0) grid.sync();
#define IN(k) (lo <= (k) && (k) < hi)
#define SEAM(k) do { if (IN(k) && IN((k) + 1)) xcd_barrier(xb, t0); } while (0)
    bf16_t* const XB = (bf16_t*)(ws + WS_XB);
    const float* rstdx = (const float*)(ws + WS_RSTDX);
    StaticOrder S;

    if (IN(0)) for (int rep_ = 0; rep_ < REPS(0); ++rep_) { phase_prep(a, lds, wave, G); __syncthreads(); } SEAM(0);

    if (IN(1)) for (int rep_ = 0; rep_ < REPS(1); ++rep_) {
        { Gemm g = plain_gemm(XB, (const bf16_t*)(ws + WS_WIN), 1024); S.init(T / BM, 11, G, bid);
          EpiProj E{rstdx, a.in[I_BIN], (bf16_t*)(ws + WS_PR), (bf16_t*)(ws + WS_PX), (bf16_t*)(ws + WS_PY)}; gemm_phase(lds, wave, g, S, E); }
        if ((G & 15) == 0) {
            const int hg = G >> 1, hb_ = (bid >> 4) * 8 + (bid & 7);
            if (((bid >> 3) & 1) == 0) { Gemm g = plain_gemm((const bf16_t*)(ws + WS_MEMN), (const bf16_t*)(ws + WS_WK), 1024); S.init(TM / BM, 4, hg, hb_);
                EpiPlain E{(bf16_t*)(ws + WS_KM), 1024}; gemm_phase(lds, wave, g, S, E); }
            else { Gemm g = plain_gemm((const bf16_t*)(ws + WS_WV), (const bf16_t*)(ws + WS_MEMN), 1024); S.init(4, TM / BM, hg, hb_);
                EpiPlain E{(bf16_t*)(ws + WS_VT), TM}; gemm_phase(lds, wave, g, S, E); }
        } else {
            { Gemm g = plain_gemm((const bf16_t*)(ws + WS_MEMN), (const bf16_t*)(ws + WS_WK), 1024); S.init(TM / BM, 4, G, bid);
              EpiPlain E{(bf16_t*)(ws + WS_KM), 1024}; gemm_phase(lds, wave, g, S, E); }
            { Gemm g = plain_gemm((const bf16_t*)(ws + WS_WV), (const bf16_t*)(ws + WS_MEMN), 1024); S.init(4, TM / BM, G, bid);
              EpiPlain E{(bf16_t*)(ws + WS_VT), TM}; gemm_phase(lds, wave, g, S, E); }
        }
    } SEAM(1);

    if (IN(2)) for (int rep_ = 0; rep_ < REPS(2); ++rep_) phase_elem2(a, wave, G); SEAM(2);
#ifdef PROBE_SYNC
    for (int i_ = 0; i_ < 16; ++i_) grid.sync();
#endif

    if (IN(3)) for (int rep_ = 0; rep_ < REPS(3); ++rep_) {
        { Gemm g = plain_gemm((const bf16_t*)(ws + WS_LIN), (const bf16_t*)(ws + WS_WLORA), 256); S.init(T / BM, 6, G, bid);
          EpiLora E{a.in[I_W0], a.in[I_A0], (bf16_t*)(ws + WS_LOUT)}; gemm_phase(lds, wave, g, S, E); }
        { Gemm g = plain_gemm((const bf16_t*)(ws + WS_XBC), (const bf16_t*)(ws + WS_WRG), 256); g.lda = 512; g.a_pm = (size_t)BM * 512 * 2; g.a_pn2 = 512; S.init(T / BM, 4, G, bid);
          EpiRg E{a.in[I_BRGA], a.in[I_BRGX], a.in[I_LAM], (const bf16_t*)(ws + WS_XBC), (bf16_t*)(ws + WS_RGLA), (bf16_t*)(ws + WS_RGU)}; gemm_phase(lds, wave, g, S, E); }
    } SEAM(3);

    if (IN(4)) for (int rep_ = 0; rep_ < REPS(4); ++rep_) phase_scan(a, lds, wave, G); SEAM(4);
    if (IN(5)) for (int rep_ = 0; rep_ < REPS(5); ++rep_) phase_post(a, wave, G); SEAM(5);

    if (IN(6)) for (int rep_ = 0; rep_ < REPS(6); ++rep_) {
        S.init(T / BM, 4, G, bid);
        { Gemm g = plain_gemm(XB, (const bf16_t*)(ws + WS_WIN) + (size_t)2816 * 1024, 1024); EpiGab E{rstdx, a.in[I_BIN] + 2816, (bf16_t*)(ws + WS_GAB), 0}; gemm_phase(lds, wave, g, S, E); }
        { Gemm g = plain_gemm((const bf16_t*)(ws + WS_YA), (const bf16_t*)(ws + WS_WA), 512); EpiBranch<true> E{(const bf16_t*)(ws + WS_GAB), (bf16_t*)(ws + WS_MERGED)}; gemm_phase(lds, wave, g, S, E); }
        { Gemm g = plain_gemm(XB, (const bf16_t*)(ws + WS_WIN) + (size_t)3840 * 1024, 1024); EpiGab E{rstdx, a.in[I_BIN] + 2816, (bf16_t*)(ws + WS_GAB), 1024}; gemm_phase(lds, wave, g, S, E); }
        { Gemm g = plain_gemm((const bf16_t*)(ws + WS_YB), (const bf16_t*)(ws + WS_WB), 512); EpiBranch<false> E{(const bf16_t*)(ws + WS_GAB), (bf16_t*)(ws + WS_MERGED)}; gemm_phase(lds, wave, g, S, E); }
    } SEAM(6);
    if (IN(7)) for (int rep_ = 0; rep_ < REPS(7); ++rep_) { Gemm g = plain_gemm((const bf16_t*)(ws + WS_MERGED), (const bf16_t*)(ws + WS_WMIX), 1024); S.init(T / BM, 4, G, bid);
        EpiRes<true> E{a.in[I_X], (bf16_t*)(ws + WS_X1B), (float*)(ws + WS_SSP1)}; gemm_phase(lds, wave, g, S, E); } SEAM(7);
    if (IN(8)) for (int rep_ = 0; rep_ < REPS(8); ++rep_) {
        S.init(T / BM, 4, G, bid);
        { Gemm g = plain_gemm((const bf16_t*)(ws + WS_X1B), (const bf16_t*)(ws + WS_WCQ), 1024);
          EpiQ E{(const float*)(ws + WS_SSP1), (bf16_t*)(ws + WS_Q)}; gemm_phase(lds, wave, g, S, E); }
        { Gemm g; g.A = (const bf16_t*)(ws + WS_Q); g.Bt = (const bf16_t*)(ws + WS_KM); g.lda = 1024; g.ldb = 1024; g.K = 256;
          g.a_pm = (size_t)BM * 1024 * 2; g.a_pn = 512; g.b_pn = 512; g.b_pb = (size_t)NMEM * 1024 * 2; g.a_pn2 = 0;
          EpiSc E{(bf16_t*)(ws + WS_PEXP), (float*)(ws + WS_SSPA)}; gemm_phase(lds, wave, g, S, E); }
        { Gemm g; g.A = (const bf16_t*)(ws + WS_PEXP); g.Bt = (const bf16_t*)(ws + WS_VT); g.lda = 1024; g.ldb = TM; g.K = 256;
          g.a_pm = (size_t)BM * 1024 * 2; g.a_pn = 512; g.b_pn = (size_t)256 * TM * 2; g.b_pb = 512; g.a_pn2 = 0;
          EpiPv E{(const float*)(ws + WS_SSPA), (bf16_t*)(ws + WS_O)}; gemm_phase(lds, wave, g, S, E); }
    } SEAM(8);
    if (IN(9)) for (int rep_ = 0; rep_ < REPS(9); ++rep_) { Gemm g = plain_gemm((const bf16_t*)(ws + WS_O), (const bf16_t*)(ws + WS_WCO), 1024); S.init(T / BM, 4, G, bid);
        EpiRes<false> E{(const bf16_t*)(ws + WS_X1B), (bf16_t*)(ws + WS_X2B), (float*)(ws + WS_SSP2)}; gemm_phase(lds, wave, g, S, E); } SEAM(9);
    if (IN(10)) for (int rep_ = 0; rep_ < REPS(10); ++rep_) { Gemm g = plain_gemm((const bf16_t*)(ws + WS_X2B), (const bf16_t*)(ws + WS_WFFI), 1024); S.init(T / BM, 22, G, bid);
        EpiFfnAct E{(const float*)(ws + WS_SSP2), a.in[I_FCW], a.in[I_FCB], (bf16_t*)(ws + WS_UU), (bf16_t*)(ws + WS_HG)}; gemm_phase(lds, wave, g, S, E); } SEAM(10);
    if (IN(11)) for (int rep_ = 0; rep_ < REPS(11); ++rep_) phase_ffnfix(a, wave, G); SEAM(11);
    if (IN(12)) for (int rep_ = 0; rep_ < REPS(12); ++rep_) { Gemm g = plain_gemm((const bf16_t*)(ws + WS_UU), (const bf16_t*)(ws + WS_WFFO), DFF); S.init(T / BM, 4, G, bid);
        EpiRes<false> E{(const bf16_t*)(ws + WS_X2B), (bf16_t*)(ws + WS_X3B), (float*)(ws + WS_SSP3)}; gemm_phase(lds, wave, g, S, E); } SEAM(12);
    if (IN(13)) for (int rep_ = 0; rep_ < REPS(13); ++rep_) phase_final(a, wave, G);
#undef IN
#undef SEAM
}

extern "C" void kernel_launch(void* const* d_in, const int* in_sizes, int n_in, void* d_out, int out_size, void* d_ws, size_t ws_size, hipStream_t stream) {
    static int grid = 0;
    if (grid == 0) {
        if (n_in != 37 || in_sizes[0] != T * D || out_size != T * D || ws_size < WS_END) {
            fprintf(stderr, "kernel_launch: unexpected shapes (n_in %d, in0 %d, out %d, ws %zu < %zu); nothing launched\n", n_in, n_in > 0 ? in_sizes[0] : -1, out_size, ws_size, (size_t)WS_END); grid = -1; return; }
        int dev = 0, cus = 0, per_cu = 0;
        if (hipGetDevice(&dev) != hipSuccess || hipDeviceGetAttribute(&cus, hipDeviceAttributeMultiprocessorCount, dev) != hipSuccess) { grid = -1; return; }
        if (hipFuncSetAttribute((const void*)mega, hipFuncAttributeMaxDynamicSharedMemorySize, LDS_BYTES) != hipSuccess) { fprintf(stderr, "kernel_launch: hipFuncSetAttribute failed\n"); grid = -1; return; }
        if (hipOccupancyMaxActiveBlocksPerMultiprocessor(&per_cu, (const void*)mega, 512, LDS_BYTES) != hipSuccess || per_cu < 1) { fprintf(stderr, "kernel_launch: occupancy query says %d\n", per_cu); per_cu = 1; }
        (void)hipGetLastError();
        grid = cus * 1;
    }
    if (grid < 0) return;
    if (hipMemsetAsync((char*)d_ws + WS_CTL, 0, CTL_BYTES, stream) != hipSuccess) { fprintf(stderr, "kernel_launch: memset failed\n"); return; }
    Args a{};
    for (int i = 0; i < 37; ++i) a.in[i] = (const float*)d_in[i];
    a.out = (float*)d_out; a.ws = (unsigned char*)d_ws;
#if MK_SPLIT
    for (int ph = 0; ph <= NPHASE; ++ph) {
        a.ph_lo = ph; a.ph_hi = ph + 1; void* args[] = {&a};
        hipError_t e = hipLaunchCooperativeKernel((const void*)mega, dim3(grid), dim3(512), args, LDS_BYTES, stream);
        if (e != hipSuccess) { fprintf(stderr, "kernel_launch: launch of phase %d failed: %s\n", ph, hipGetErrorString(e)); break; }
    }
#else
    a.ph_lo = 0; a.ph_hi = NPHASE + 1; void* args[] = {&a};
    hipError_t e = hipLaunchCooperativeKernel((const void*)mega, dim3(grid), dim3(512), args, LDS_BYTES, stream);
    if (e != hipSuccess) fprintf(stderr, "kernel_launch: cooperative launch failed: %s (grid %d)\n", hipGetErrorString(e), grid);
#endif
}
```

```cpp
#include <hip/hip_runtime.h>
#include <hip/hip_cooperative_groups.h>
#include <cstdio>
namespace cg = cooperative_groups;

#ifndef MK_SPLIT
#define MK_SPLIT 0
#endif

#ifndef DUP_PHASE
#define DUP_PHASE -1
#endif
#define REPS(k) ((DUP_PHASE == (k)) ? 2 : 1)
#define LAS __attribute__((address_space(3)))
typedef unsigned short bf16_t;
typedef short bf16x8 __attribute__((ext_vector_type(8)));
typedef float f32x4 __attribute__((ext_vector_type(4)));
typedef float f32x2 __attribute__((ext_vector_type(2)));
typedef unsigned u32x4 __attribute__((ext_vector_type(4)));
typedef unsigned u32x2 __attribute__((ext_vector_type(2)));

constexpr int T = 65536, D = 1024, SEQ = 2048, NB = 32, NMEM = 256, TM = NB * NMEM;
constexpr int AW = 512, RW = 1792, PIN = 4864, DFF = 2816;
constexpr float NORM_EPS = 1e-6f, LNX_EPS = 64e-5f;

constexpr size_t MiB = 1u << 20;
constexpr size_t WS_WIN = 0;
constexpr size_t WS_WFFI = 10 * MiB;
constexpr size_t WS_WFFO = 21 * MiB;
constexpr size_t WS_WMIX = 27 * MiB, WS_WCQ = 29 * MiB, WS_WK = 31 * MiB, WS_WV = 33 * MiB, WS_WCO = 35 * MiB;
constexpr size_t WS_WA = 37 * MiB, WS_WB = 38 * MiB;
constexpr size_t WS_WLORA = 39 * MiB;
constexpr size_t WS_WRG = 40 * MiB;
constexpr size_t WS_CTL = 46 * MiB, CTL_BYTES = 16384;
constexpr size_t WS_RSTDX = 48 * MiB;
constexpr size_t WS_SSP1 = 49 * MiB, WS_SSP2 = 53 * MiB, WS_SSP3 = 57 * MiB, WS_SSPA = 61 * MiB;
constexpr size_t WS_BON = 65 * MiB;
constexpr size_t WS_MEMN = 68 * MiB, WS_KM = 84 * MiB, WS_VT = 100 * MiB;
constexpr size_t WS_XB = 120 * MiB;
constexpr size_t WS_PR = 248 * MiB;
constexpr size_t WS_PX = 472 * MiB, WS_PY = 536 * MiB;
constexpr size_t WS_LIN = 600 * MiB, WS_XBC = 632 * MiB;
constexpr size_t WS_LOUT = 696 * MiB;
constexpr size_t WS_RGLA = 888 * MiB, WS_RGU = 952 * MiB;
constexpr size_t WS_YRAW = WS_PX, WS_YB = WS_LIN, WS_YA = WS_RGLA;
constexpr size_t WS_GAB = 248 * MiB;
constexpr size_t WS_MERGED = 696 * MiB;
constexpr size_t WS_X1B = WS_XB, WS_Q = 248 * MiB, WS_PEXP = 376 * MiB, WS_O = 504 * MiB, WS_X2B = WS_XB;
constexpr size_t WS_X3B = 376 * MiB;
constexpr size_t WS_HG = 248 * MiB, WS_UU = 600 * MiB;
constexpr size_t WS_END = 1016 * MiB;

constexpr int LDS_BYTES = 147456;

__device__ __forceinline__ unsigned cvt_pk_bf16(float lo, float hi) { unsigned r; asm("v_cvt_pk_bf16_f32 %0, %1, %2" : "=v"(r) : "v"(lo), "v"(hi)); return r; }
__device__ __forceinline__ float bf_lo(unsigned w) { return __uint_as_float(w << 16); }
__device__ __forceinline__ float bf_hi(unsigned w) { return __uint_as_float(w & 0xffff0000u); }
__device__ __forceinline__ float bf1(bf16_t b) { return __uint_as_float(((unsigned)b) << 16); }
__device__ __forceinline__ bf16_t f2bf(float f) { return (bf16_t)(cvt_pk_bf16(f, 0.f) & 0xffffu); }
__device__ __forceinline__ float sigmoidf_(float x) { return __builtin_amdgcn_rcpf(1.0f + __expf(-x)); }
__device__ __forceinline__ float gelu_tanh(float x) { const float z = 1.5957691216057308f * (x + 0.044715f * x * x * x); return x * sigmoidf_(z); }
__device__ __forceinline__ int lane_id() { int l; asm volatile("v_mbcnt_lo_u32_b32 %0, -1, 0\n\tv_mbcnt_hi_u32_b32 %0, -1, %0" : "=v"(l)); return l; }
__device__ __forceinline__ float wave_sum(float v) {
#pragma unroll
    for (int o = 1; o < 64; o <<= 1) v += __shfl_xor(v, o);
    return v;
}
__device__ __forceinline__ void unpack8(const u32x4 w, float (&f)[8]) {
    f[0] = bf_lo(w.x); f[1] = bf_hi(w.x); f[2] = bf_lo(w.y); f[3] = bf_hi(w.y); f[4] = bf_lo(w.z); f[5] = bf_hi(w.z); f[6] = bf_lo(w.w); f[7] = bf_hi(w.w);
}
__device__ __forceinline__ u32x4 pack8(const float (&f)[8]) {
    u32x4 w; w.x = cvt_pk_bf16(f[0], f[1]); w.y = cvt_pk_bf16(f[2], f[3]); w.z = cvt_pk_bf16(f[4], f[5]); w.w = cvt_pk_bf16(f[6], f[7]); return w;
}


#define XB_TMO      128
#define XB_XCNT(j)  (256  + 64 * (j))
#define XB_XSUB(j)  (1280 + 64 * (j))
#define XB_XGEN(j)  (2304 + 64 * (j))
#define XB_TOP      3328
#define XB_TOPGEN   3392
#define XCD_BAR_WORDS 3456
#define XB_SPIN_CAP (1u << 22)
__device__ __forceinline__ unsigned xb_ld(unsigned* p)              { return __hip_atomic_load(p, __ATOMIC_RELAXED, __HIP_MEMORY_SCOPE_AGENT); }
__device__ __forceinline__ unsigned xb_add(unsigned* p, unsigned v) { return __hip_atomic_fetch_add(p, v, __ATOMIC_RELAXED, __HIP_MEMORY_SCOPE_AGENT); }
__device__ __forceinline__ unsigned xb_xcc_id() { return (unsigned)__builtin_amdgcn_s_getreg((3 << 11) | 20) & 0xFu; }
#define XB_SPIN(cond, bar) do { unsigned _sp = 0; while (cond) { __builtin_amdgcn_s_sleep(1); \
    if ((++_sp & 255u) == 0u) { if (xb_ld(&(bar)[XB_TMO])) break; if (_sp > XB_SPIN_CAP) { atomicAdd(&(bar)[XB_TMO], 1u); break; } } } } while (0)
struct XcdBarrier { unsigned* bar; unsigned x; volatile LAS unsigned* st; };
__device__ __forceinline__ XcdBarrier xcd_barrier_post(unsigned* bar, volatile LAS unsigned* st, bool t0) {
    XcdBarrier b; b.bar = bar; b.x = xb_xcc_id(); b.st = st;
    if (t0) (void)xb_add(&bar[XB_XCNT(b.x)], 1u);
    return b;
}
__device__ __forceinline__ void xcd_barrier_complete(unsigned* bar, unsigned x, unsigned& nloc, unsigned& nx) {
    const unsigned G = gridDim.x * gridDim.y * gridDim.z;
    unsigned sum, cnt, mine, sp = 0u;
    for (;;) {
        sum = 0u; cnt = 0u; mine = 0u;
#pragma unroll
        for (unsigned j = 0; j < 16; ++j) { const unsigned c = xb_ld(&bar[XB_XCNT(j)]); sum += c; cnt += (c > 0u) ? 1u : 0u; mine = (j == x) ? c : mine; }
        if (sum == G) break;
        __builtin_amdgcn_s_sleep(1);
        if ((++sp & 255u) == 0u) { if (xb_ld(&bar[XB_TMO])) break; if (sp > XB_SPIN_CAP) { atomicAdd(&bar[XB_TMO], 1u); break; } }
    }
    nloc = mine > 0u ? mine : 1u; nx = cnt > 0u ? cnt : 1u;
}
__device__ __forceinline__ void xcd_barrier(const XcdBarrier& b, bool t0) {
    asm volatile("s_waitcnt vmcnt(0)" ::: "memory");
    __syncthreads();
    if (t0) {
        unsigned* bar = b.bar;
        __builtin_amdgcn_s_waitcnt(0);
        unsigned nloc = b.st[0], nx = b.st[1];
        if (nloc == 0u) { xcd_barrier_complete(bar, b.x, nloc, nx); b.st[0] = nloc; b.st[1] = nx; }
        const unsigned old = xb_add(&bar[XB_XSUB(b.x)], 1u);
        const unsigned gen = old / nloc;
        if (old + 1u == (gen + 1u) * nloc) {
            __builtin_amdgcn_fence(__ATOMIC_RELEASE, "agent");
            asm volatile("s_waitcnt vmcnt(0)" ::: "memory");
            const unsigned og = xb_add(&bar[XB_TOP], 1u);
            const unsigned tg = og / nx;
            if (og + 1u == (tg + 1u) * nx) xb_add(&bar[XB_TOPGEN], 1u);
            else XB_SPIN(xb_ld(&bar[XB_TOPGEN]) == tg, bar);
            __builtin_amdgcn_fence(__ATOMIC_ACQUIRE, "agent");
            xb_add(&bar[XB_XGEN(b.x)], 1u);
            asm volatile("s_waitcnt vmcnt(0)" ::: "memory");
        } else {
            XB_SPIN(xb_ld(&bar[XB_XGEN(b.x)]) == gen, bar);
            __builtin_amdgcn_fence(__ATOMIC_ACQUIRE, "agent");
            asm volatile("s_waitcnt vmcnt(0)" ::: "memory");
        }
    }
    __syncthreads();
}

constexpr int BM = 256, BK = 64, HALF = 128, HTB = HALF * BK * 2, NXCD = 8, WGM = 8;
__device__ __forceinline__ int lds_byte(int r, int c) { const int st = (r >> 4) * 2 + (c >> 5), rr = r & 15, cc = c & 31, ob = rr * 64 + cc * 2; return st * 1024 + (ob ^ (((ob >> 9) & 1) << 5)); }
__device__ __forceinline__ void stage_rc(int b, int& R, int& C) { const int st = b / 1024, sb = b % 1024, swz = sb ^ (((sb >> 9) & 1) << 5); R = (st >> 1) * 16 + swz / 64; C = (st & 1) * 32 + (swz % 64) / 2; }
__device__ __forceinline__ int perm32(int rho) { const int n = rho >> 4, i = rho & 15; return 8 * (i >> 2) + 4 * n + (i & 3); }

struct Unit { int pm, pn; };
struct Gemm { const bf16_t* A; const bf16_t* Bt; int lda, ldb, K; size_t a_pm, a_pn, b_pn, b_pb, a_pn2; };
__device__ __forceinline__ Gemm plain_gemm(const bf16_t* A, const bf16_t* Bt, int K) { Gemm g; g.A = A; g.Bt = Bt; g.lda = K; g.ldb = K; g.K = K; g.a_pm = (size_t)BM * K * 2; g.a_pn = 0; g.b_pn = (size_t)BM * K * 2; g.b_pb = 0; g.a_pn2 = 0; return g; }

struct StaticOrder {
    int nM, nN, nwg, G, c;
    __device__ void init(int nM_, int nN_, int G_, int c_) { nM = nM_; nN = nN_; nwg = nM * nN; G = G_; c = c_; }
    __device__ bool next(int i, Unit& u) const {
        const long L = (long)i * G + c; if (L >= nwg) return false;
        int wgid = (int)L; { const int q = nwg / NXCD, r = nwg % NXCD, xcd = wgid % NXCD, off = wgid / NXCD; wgid = (xcd < r ? xcd * (q + 1) : r * (q + 1) + (xcd - r) * q) + off; }
        const int nig = WGM * nN, gid = wgid / nig, fm = gid * WGM, gsz = (nM - fm) < WGM ? (nM - fm) : WGM;
        u.pm = fm + ((wgid % nig) % gsz); u.pn = (wgid % nig) / gsz; return true;
    }
};

typedef f32x4 Acc[2][2][4][2];

template <class Epi>
__device__ __forceinline__ void gemm_phase(LAS unsigned char* lds, const int wid, const Gemm g, const StaticOrder& S, const Epi& E) {
    const int lane = lane_id(), tid = wid * 64 + lane, wr = wid >> 2, wc = wid & 3, fr = lane & 15, fq = lane >> 4;
    const int nt = g.K / BK;
    unsigned voffA[2], voffB[2];
#pragma unroll
    for (int i = 0; i < 2; ++i) { int R, C; stage_rc(tid * 16 + i * 8192, R, C); const int Rb = Epi::PERM ? ((R & ~31) + perm32(R & 31)) : R;
        voffA[i] = (unsigned)(R * g.lda + C) * 2u; voffB[i] = (unsigned)(Rb * g.ldb + C) * 2u; }
    const size_t kstep = (size_t)(BK * 2);
    const size_t hstepA = (size_t)HALF * g.lda * 2, hstepB = (size_t)HALF * g.ldb * 2;
    const unsigned ldsw = (unsigned)wid * 1024u;
    const int aoff = lds_byte(wr * 64 + fr, fq * 8), boff = lds_byte(wc * 32 + fr, fq * 8);
#define PG8_SA(b, h) (((b) * 2 + (h)) * HTB)
#define PG8_SB(b, h) ((4 + (b) * 2 + (h)) * HTB)
#define PG8_STAGE(bufoff, gbase, voff) do { _Pragma("unroll") for (int _i = 0; _i < 2; ++_i) \
        __builtin_amdgcn_global_load_lds((const unsigned*)((const char*)(gbase) + (voff)[_i]), (LAS unsigned*)(lds + (bufoff) + ldsw + _i * 8192), 16, 0, 0); } while (0)
#define PG8_LDA(dst, b, h) do { _Pragma("unroll") for (int m = 0; m < 4; ++m) _Pragma("unroll") for (int k = 0; k < 2; ++k) dst[m][k] = *(const LAS bf16x8*)(lds + PG8_SA(b, h) + aoff + m * 2048 + k * 1024); } while (0)
#define PG8_LDB(dst, b, h) do { _Pragma("unroll") for (int n = 0; n < 2; ++n) _Pragma("unroll") for (int k = 0; k < 2; ++k) dst[n][k] = *(const LAS bf16x8*)(lds + PG8_SB(b, h) + boff + n * 2048 + k * 1024); } while (0)
#define PG8_MMA(ai, bj, At, Bt) do { __builtin_amdgcn_s_setprio(1); _Pragma("unroll") for (int m = 0; m < 4; ++m) _Pragma("unroll") for (int n = 0; n < 2; ++n) _Pragma("unroll") for (int k = 0; k < 2; ++k) \
        acc[ai][bj][m][n] = __builtin_amdgcn_mfma_f32_16x16x32_bf16(Bt[n][k], At[m][k], acc[ai][bj][m][n], 0, 0, 0); __builtin_amdgcn_s_setprio(0); } while (0)
#define PG8_WAIT_V(n) asm volatile("s_waitcnt vmcnt(" #n ")" ::: "memory")
#define PG8_WAIT_L(n) asm volatile("s_waitcnt lgkmcnt(" #n ")" ::: "memory")
#define PG8_BAR __builtin_amdgcn_s_barrier()
#define PG8_SCHED __builtin_amdgcn_sched_barrier(0)
#define PG8_UA(u) ((const char*)g.A + (size_t)(u).pm * g.a_pm + (size_t)(u).pn * g.a_pn + (size_t)((u).pn >> 1) * g.a_pn2)
#define PG8_UB(u) ((const char*)g.Bt + (size_t)(u).pn * g.b_pn + (size_t)((u).pm >> 3) * g.b_pb)
    Unit cur, nxt; int ui = 0;
    if (!S.next(0, cur)) return;
    Acc acc;
#pragma unroll
    for (int a = 0; a < 2; ++a)
#pragma unroll
        for (int b = 0; b < 2; ++b)
#pragma unroll
            for (int m = 0; m < 4; ++m)
#pragma unroll
                for (int n = 0; n < 2; ++n) acc[a][b][m][n] = (f32x4){0.f, 0.f, 0.f, 0.f};
    bf16x8 At[4][2], B0[2][2], B1[2][2];
    const char* cA = PG8_UA(cur); const char* cB = PG8_UB(cur);
    PG8_STAGE(PG8_SB(0, 0), cB, voffB); PG8_STAGE(PG8_SB(0, 1), cB + hstepB, voffB); PG8_STAGE(PG8_SA(0, 0), cA, voffA); PG8_STAGE(PG8_SA(0, 1), cA + hstepA, voffA);
    if (wr == 1) PG8_BAR;
    PG8_WAIT_V(2); PG8_BAR;
    PG8_STAGE(PG8_SB(1, 0), cB + kstep, voffB); PG8_STAGE(PG8_SA(1, 0), cA + kstep, voffA); PG8_STAGE(PG8_SB(1, 1), cB + hstepB + kstep, voffB);
    PG8_WAIT_V(6); PG8_BAR;
    for (;;) {
        const bool has_next = S.next(ui + 1, nxt);
        const char* nA = has_next ? PG8_UA(nxt) : cA; const char* nB = has_next ? PG8_UB(nxt) : cB;
        for (int t = 0; t < nt; t += 2) {
            const bool last = (t == nt - 2);
            const char* a1 = cA + (size_t)(t + 1) * kstep;
            const char* a2 = last ? nA : cA + (size_t)(t + 2) * kstep; const char* b2 = last ? nB : cB + (size_t)(t + 2) * kstep;
            const char* a3 = a2 + kstep; const char* b3 = b2 + kstep;
            PG8_LDB(B0, 0, 0); PG8_LDB(B1, 0, 1); PG8_SCHED; PG8_LDA(At, 0, 0); PG8_STAGE(PG8_SA(1, 1), a1 + hstepA, voffA);
            PG8_WAIT_V(8); PG8_WAIT_L(0); PG8_BAR; PG8_MMA(0, 0, At, B0); PG8_MMA(0, 1, At, B1); PG8_BAR; PG8_SCHED;
            PG8_LDA(At, 0, 1); PG8_STAGE(PG8_SB(0, 0), b2, voffB); PG8_STAGE(PG8_SB(0, 1), b2 + hstepB, voffB); PG8_STAGE(PG8_SA(0, 0), a2, voffA);
            PG8_WAIT_V(8); PG8_WAIT_L(0); PG8_BAR; PG8_MMA(1, 0, At, B0); PG8_MMA(1, 1, At, B1); PG8_BAR; PG8_SCHED;
            PG8_LDB(B0, 1, 0); PG8_LDB(B1, 1, 1); PG8_SCHED; PG8_LDA(At, 1, 0); PG8_STAGE(PG8_SA(0, 1), a2 + hstepA, voffA);
            PG8_WAIT_V(8); PG8_WAIT_L(0); PG8_BAR; PG8_MMA(0, 0, At, B0); PG8_MMA(0, 1, At, B1); PG8_BAR; PG8_SCHED;
            PG8_LDA(At, 1, 1); PG8_STAGE(PG8_SB(1, 0), b3, voffB); PG8_STAGE(PG8_SB(1, 1), b3 + hstepB, voffB); PG8_STAGE(PG8_SA(1, 0), a3, voffA);
            PG8_WAIT_V(8); PG8_WAIT_L(0); PG8_BAR; PG8_MMA(1, 0, At, B0); PG8_MMA(1, 1, At, B1); PG8_BAR; PG8_SCHED;
        }
        if (wr == 0) PG8_BAR;
        E(acc, cur, wr, wc, fr, fq);
        if (!has_next) break;
#pragma unroll
        for (int a = 0; a < 2; ++a)
#pragma unroll
            for (int b = 0; b < 2; ++b)
#pragma unroll
                for (int m = 0; m < 4; ++m)
#pragma unroll
                    for (int n = 0; n < 2; ++n) acc[a][b][m][n] = (f32x4){0.f, 0.f, 0.f, 0.f};
        cur = nxt; cA = nA; cB = nB; ++ui;
        if (wr == 1) PG8_BAR;
    }
    PG8_WAIT_V(0);
    PG8_BAR;
#undef PG8_SA
#undef PG8_SB
#undef PG8_STAGE
#undef PG8_LDA
#undef PG8_LDB
#undef PG8_MMA
#undef PG8_WAIT_V
#undef PG8_WAIT_L
#undef PG8_BAR
#undef PG8_SCHED
#undef PG8_UA
#undef PG8_UB
}

#define EPI_ROWS_BEGIN for (int ai = 0; ai < 2; ++ai) { _Pragma("unroll") for (int m = 0; m < 4; ++m) { const int r = u.pm * BM + ai * HALF + wr * 64 + m * 16 + fr;
#define EPI_ROWS_END } }

__device__ __forceinline__ float rstd_from16(const float* ss, int r) { return rsqrtf(ss[r] * (1.0f / 1024.0f) + NORM_EPS); }

struct EpiProj { static constexpr bool PERM = true;
    const float* rstd; const float* bias; bf16_t* PR; bf16_t* PX; bf16_t* PY;
    __device__ __forceinline__ void operator()(Acc& acc, const Unit& u, int wr, int wc, int fr, int fq) const {
        bf16_t* base; int ld, colt;
        if (u.pn < 7) { base = PR; ld = RW; colt = u.pn * 256; } else if (u.pn < 9) { base = PX; ld = 512; colt = (u.pn - 7) * 256; } else { base = PY; ld = 512; colt = (u.pn - 9) * 256; }
        const int col0 = colt + wc * 32 + 8 * fq, bcol0 = u.pn * 256 + wc * 32 + 8 * fq;
        f32x4 bv[2][2];
#pragma unroll
        for (int bj = 0; bj < 2; ++bj)
#pragma unroll
            for (int n = 0; n < 2; ++n) bv[bj][n] = *(const f32x4*)(bias + bcol0 + bj * HALF + 4 * n);
#pragma unroll
        EPI_ROWS_BEGIN
            const float rs = rstd[r]; bf16_t* rowp = base + (size_t)r * ld + col0;
#pragma unroll
            for (int bj = 0; bj < 2; ++bj) { const f32x4 v0 = acc[ai][bj][m][0] * rs + bv[bj][0], v1 = acc[ai][bj][m][1] * rs + bv[bj][1];
                u32x4 w; w.x = cvt_pk_bf16(v0[0], v0[1]); w.y = cvt_pk_bf16(v0[2], v0[3]); w.z = cvt_pk_bf16(v1[0], v1[1]); w.w = cvt_pk_bf16(v1[2], v1[3]);
                *(u32x4*)(rowp + bj * HALF) = w; }
        EPI_ROWS_END
    }
};
struct EpiGab { static constexpr bool PERM = true;
    const float* rstd; const float* bias; bf16_t* O; int cofs;
    __device__ __forceinline__ void operator()(Acc& acc, const Unit& u, int wr, int wc, int fr, int fq) const {
        const int col0 = cofs + u.pn * 256 + wc * 32 + 8 * fq;
        f32x4 bv[2][2];
#pragma unroll
        for (int bj = 0; bj < 2; ++bj)
#pragma unroll
            for (int n = 0; n < 2; ++n) bv[bj][n] = *(const f32x4*)(bias + col0 + bj * HALF + 4 * n);
#pragma unroll
        EPI_ROWS_BEGIN
            const float rs = rstd[r]; bf16_t* rowp = O + (size_t)r * 2048 + col0;
#pragma unroll
            for (int bj = 0; bj < 2; ++bj) { f32x4 v0 = acc[ai][bj][m][0] * rs + bv[bj][0], v1 = acc[ai][bj][m][1] * rs + bv[bj][1];
#pragma unroll
                for (int j = 0; j < 4; ++j) { v0[j] = sigmoidf_(v0[j]); v1[j] = sigmoidf_(v1[j]); }
                u32x4 w; w.x = cvt_pk_bf16(v0[0], v0[1]); w.y = cvt_pk_bf16(v0[2], v0[3]); w.z = cvt_pk_bf16(v1[0], v1[1]); w.w = cvt_pk_bf16(v1[2], v1[3]);
                *(u32x4*)(rowp + bj * HALF) = w; }
        EPI_ROWS_END
    }
};
struct EpiPlain { static constexpr bool PERM = true;
    bf16_t* O; int ldc;
    __device__ __forceinline__ void operator()(Acc& acc, const Unit& u, int wr, int wc, int fr, int fq) const {
        const int col0 = u.pn * 256 + wc * 32 + 8 * fq;
#pragma unroll
        EPI_ROWS_BEGIN
            bf16_t* rowp = O + (size_t)r * ldc + col0;
#pragma unroll
            for (int bj = 0; bj < 2; ++bj) { const f32x4 v0 = acc[ai][bj][m][0], v1 = acc[ai][bj][m][1];
                u32x4 w; w.x = cvt_pk_bf16(v0[0], v0[1]); w.y = cvt_pk_bf16(v0[2], v0[3]); w.z = cvt_pk_bf16(v1[0], v1[1]); w.w = cvt_pk_bf16(v1[2], v1[3]);
                *(u32x4*)(rowp + bj * HALF) = w; }
        EPI_ROWS_END
    }
};
struct EpiLora { static constexpr bool PERM = true;
    const float* w0; const float* a0; bf16_t* O;
    __device__ __forceinline__ void operator()(Acc& acc, const Unit& u, int wr, int wc, int fr, int fq) const {
        const int kind = u.pn >> 1, ch0 = (u.pn & 1) * 256 + wc * 32 + 8 * fq, col0 = u.pn * 256 + wc * 32 + 8 * fq;
        const float* bsrc = kind == 0 ? w0 : a0;
        f32x4 bv[2][2];
#pragma unroll
        for (int bj = 0; bj < 2; ++bj)
#pragma unroll
            for (int n = 0; n < 2; ++n) bv[bj][n] = kind < 2 ? *(const f32x4*)(bsrc + ch0 + bj * HALF + 4 * n) : (f32x4){0.f, 0.f, 0.f, 0.f};
        const float sc = kind == 0 ? 0.6065306597126334f : 1.0f;
#pragma unroll
        EPI_ROWS_BEGIN
            bf16_t* rowp = O + (size_t)r * 1536 + col0;
#pragma unroll
            for (int bj = 0; bj < 2; ++bj) { f32x4 v0 = acc[ai][bj][m][0] + bv[bj][0], v1 = acc[ai][bj][m][1] + bv[bj][1];
                if (kind < 2) {
#pragma unroll
                    for (int j = 0; j < 4; ++j) { v0[j] = sc * sigmoidf_(v0[j]); v1[j] = sc * sigmoidf_(v1[j]); } }
                u32x4 w; w.x = cvt_pk_bf16(v0[0], v0[1]); w.y = cvt_pk_bf16(v0[2], v0[3]); w.z = cvt_pk_bf16(v1[0], v1[1]); w.w = cvt_pk_bf16(v1[2], v1[3]);
                *(u32x4*)(rowp + bj * HALF) = w; }
        EPI_ROWS_END
    }
};
struct EpiRg { static constexpr bool PERM = true;
    const float* ba; const float* bx; const float* lam; const bf16_t* XBC; bf16_t* LA; bf16_t* U;
    __device__ __forceinline__ void operator()(Acc& acc, const Unit& u, int wr, int wc, int fr, int fq) const {
        const int ch0 = u.pn * 128 + wc * 32 + 8 * fq;
        float vba[8], vbx[8], vls[8];
#pragma unroll
        for (int j = 0; j < 8; ++j) { vba[j] = ba[ch0 + j]; vbx[j] = bx[ch0 + j]; vls[j] = -8.0f * log1pf(__expf(-lam[ch0 + j])); }
#pragma unroll
        EPI_ROWS_BEGIN
            const bool first = (r & (SEQ - 1)) == 0;
            float xb[8]; unpack8(*(const u32x4*)(XBC + (size_t)r * 512 + ch0), xb);
            float la[8], uu[8];
#pragma unroll
            for (int j = 0; j < 8; ++j) { const float ga = sigmoidf_(acc[ai][0][m][j >> 2][j & 3] + vba[j]), gx = sigmoidf_(acc[ai][1][m][j >> 2][j & 3] + vbx[j]);
                la[j] = vls[j] * ga; const float a = __expf(la[j]); const float mult = first ? 1.0f : sqrtf(fmaxf(1.0f - a * a, 0.f)); uu[j] = xb[j] * gx * mult; }
            *(u32x4*)(LA + (size_t)r * 512 + ch0) = pack8(la); *(u32x4*)(U + (size_t)r * 512 + ch0) = pack8(uu);
        EPI_ROWS_END
    }
};
template <bool FIRST> struct EpiBranch { static constexpr bool PERM = true;
    const bf16_t* G; bf16_t* M;
    __device__ __forceinline__ void operator()(Acc& acc, const Unit& u, int wr, int wc, int fr, int fq) const {
        const int col0 = u.pn * 256 + wc * 32 + 8 * fq;
#pragma unroll
        EPI_ROWS_BEGIN
#pragma unroll
            for (int bj = 0; bj < 2; ++bj) { const int c = col0 + bj * HALF;
                float gv[8]; unpack8(*(const u32x4*)(G + (size_t)r * 2048 + (FIRST ? 0 : 1024) + c), gv);
                float o[8];
                if (!FIRST) unpack8(*(const u32x4*)(M + (size_t)r * 1024 + c), o);
#pragma unroll
                for (int j = 0; j < 8; ++j) { const float p = acc[ai][bj][m][j >> 2][j & 3] * gv[j]; o[j] = FIRST ? p : o[j] + p; }
                *(u32x4*)(M + (size_t)r * 1024 + c) = pack8(o); }
        EPI_ROWS_END
    }
};
template <bool BASE_F32> struct EpiRes { static constexpr bool PERM = true;
    const void* base; bf16_t* XB; float* ssp;
    __device__ __forceinline__ void operator()(Acc& acc, const Unit& u, int wr, int wc, int fr, int fq) const {
        const int col0 = u.pn * 256 + wc * 32 + 8 * fq;
#pragma unroll
        EPI_ROWS_BEGIN
            float s = 0.f;
#pragma unroll
            for (int bj = 0; bj < 2; ++bj) { const size_t off = (size_t)r * 1024 + col0 + bj * HALF; float o[8];
                if (BASE_F32) { const f32x4 b0 = *(const f32x4*)((const float*)base + off), b1 = *(const f32x4*)((const float*)base + off + 4);
                    o[0] = b0[0]; o[1] = b0[1]; o[2] = b0[2]; o[3] = b0[3]; o[4] = b1[0]; o[5] = b1[1]; o[6] = b1[2]; o[7] = b1[3]; }
                else unpack8(*(const u32x4*)((const bf16_t*)base + off), o);
#pragma unroll
                for (int j = 0; j < 8; ++j) { o[j] += acc[ai][bj][m][j >> 2][j & 3]; s += o[j] * o[j]; }
                *(u32x4*)(XB + off) = pack8(o); }
            s += __shfl_xor(s, 16); s += __shfl_xor(s, 32);
            if (fq == 0) atomicAdd(ssp + r, s);
        EPI_ROWS_END
    }
};
struct EpiQ { static constexpr bool PERM = true;
    const float* ssp; bf16_t* O;
    __device__ __forceinline__ void operator()(Acc& acc, const Unit& u, int wr, int wc, int fr, int fq) const {
        const int col0 = u.pn * 256 + wc * 32 + 8 * fq;
#pragma unroll
        EPI_ROWS_BEGIN
            const float rs = rstd_from16(ssp, r) * 0.0625f; bf16_t* rowp = O + (size_t)r * 1024 + col0;
#pragma unroll
            for (int bj = 0; bj < 2; ++bj) { const f32x4 v0 = acc[ai][bj][m][0] * rs, v1 = acc[ai][bj][m][1] * rs;
                u32x4 w; w.x = cvt_pk_bf16(v0[0], v0[1]); w.y = cvt_pk_bf16(v0[2], v0[3]); w.z = cvt_pk_bf16(v1[0], v1[1]); w.w = cvt_pk_bf16(v1[2], v1[3]);
                *(u32x4*)(rowp + bj * HALF) = w; }
        EPI_ROWS_END
    }
};
struct EpiSc { static constexpr bool PERM = true;
    bf16_t* O; float* ssp;
    __device__ __forceinline__ void operator()(Acc& acc, const Unit& u, int wr, int wc, int fr, int fq) const {
        const int col0 = u.pn * 256 + wc * 32 + 8 * fq;
#pragma unroll
        EPI_ROWS_BEGIN
            bf16_t* rowp = O + (size_t)r * 1024 + col0; float s = 0.f;
#pragma unroll
            for (int bj = 0; bj < 2; ++bj) { f32x4 v0 = acc[ai][bj][m][0], v1 = acc[ai][bj][m][1];
#pragma unroll
                for (int j = 0; j < 4; ++j) { v0[j] = __expf(v0[j]); v1[j] = __expf(v1[j]); }
                s += ((v0[0] + v0[1]) + (v0[2] + v0[3])) + ((v1[0] + v1[1]) + (v1[2] + v1[3]));
                u32x4 w; w.x = cvt_pk_bf16(v0[0], v0[1]); w.y = cvt_pk_bf16(v0[2], v0[3]); w.z = cvt_pk_bf16(v1[0], v1[1]); w.w = cvt_pk_bf16(v1[2], v1[3]);
                *(u32x4*)(rowp + bj * HALF) = w; }
            s += __shfl_xor(s, 16); s += __shfl_xor(s, 32);
            if (fq == 0) ssp[(size_t)r * 16 + u.pn * 4 + wc] = s;
        EPI_ROWS_END
    }
};
struct EpiPv { static constexpr bool PERM = true;
    const float* ssp; bf16_t* O;
    __device__ __forceinline__ void operator()(Acc& acc, const Unit& u, int wr, int wc, int fr, int fq) const {
        const int col0 = u.pn * 256 + wc * 32 + 8 * fq;
#pragma unroll
        EPI_ROWS_BEGIN
            const f32x4 sp = *(const f32x4*)(ssp + (size_t)r * 16 + u.pn * 4); const float rs = 1.0f / ((sp.x + sp.y) + (sp.z + sp.w));
            bf16_t* rowp = O + (size_t)r * 1024 + col0;
#pragma unroll
            for (int bj = 0; bj < 2; ++bj) { const f32x4 v0 = acc[ai][bj][m][0] * rs, v1 = acc[ai][bj][m][1] * rs;
                u32x4 w; w.x = cvt_pk_bf16(v0[0], v0[1]); w.y = cvt_pk_bf16(v0[2], v0[3]); w.z = cvt_pk_bf16(v1[0], v1[1]); w.w = cvt_pk_bf16(v1[2], v1[3]);
                *(u32x4*)(rowp + bj * HALF) = w; }
        EPI_ROWS_END
    }
};
__device__ __forceinline__ float dpp_ror1(float v) { return __int_as_float(__builtin_amdgcn_update_dpp(0, __float_as_int(v), 0x121, 0xf, 0xf, false)); }
__device__ __forceinline__ float dpp_ror2(float v) { return __int_as_float(__builtin_amdgcn_update_dpp(0, __float_as_int(v), 0x122, 0xf, 0xf, false)); }
struct EpiFfnAct { static constexpr bool PERM = true;
    const float* ssp; const float* cw; const float* cb; bf16_t* ACT; bf16_t* HG;
    __device__ __forceinline__ void operator()(Acc& acc, const Unit& u, int wr, int wc, int fr_, int fq_) const {
        const int l_ = lane_id(), fr = l_ & 15, fq = l_ >> 4;
        const int col0 = u.pn * 128 + wc * 32 + 8 * fq;
#pragma unroll
        for (int ai = 0; ai < 2; ++ai) {
            const int rbase = u.pm * BM + ai * HALF + wr * 64 + fr;
            float rs[4];
#pragma unroll
            for (int m = 0; m < 4; ++m) rs[m] = rstd_from16(ssp, rbase + m * 16);
            const size_t grp = (size_t)(rbase >> 6);
            if (fr < 2) { float t[8];
#pragma unroll
                for (int j = 0; j < 8; ++j) t[j] = acc[ai][0][0][j >> 2][j & 3] * rs[0];
                *(u32x4*)(HG + (grp * 4 + 2 + fr) * DFF + col0) = pack8(t); }
            if (fr >= 14) { float t[8];
#pragma unroll
                for (int j = 0; j < 8; ++j) t[j] = acc[ai][0][3][j >> 2][j & 3] * rs[3];
                *(u32x4*)(HG + (grp * 4 + (fr - 14)) * DFF + col0) = pack8(t); }
#pragma unroll
            for (int j = 0; j < 8; ++j) {
                const float w0 = cw[col0 + j], w1 = cw[DFF + col0 + j], w2 = cw[2 * DFF + col0 + j], b0 = cb[col0 + j];
                float g[4], r1[4], r2[4];
#pragma unroll
                for (int m = 0; m < 4; ++m) { g[m] = acc[ai][0][m][j >> 2][j & 3] * rs[m]; r1[m] = dpp_ror1(g[m]); r2[m] = dpp_ror2(g[m]); }
#pragma unroll
                for (int m = 0; m < 4; ++m) {
                    const float p1 = fr >= 1 ? r1[m] : r1[m > 0 ? m - 1 : 0], p2 = fr >= 2 ? r2[m] : r2[m > 0 ? m - 1 : 0];
                    const float up = acc[ai][1][m][j >> 2][j & 3] * rs[m];
                    const float gate = b0 + w0 * p2 + w1 * p1 + w2 * g[m];
                    acc[ai][1][m][j >> 2][j & 3] = (m == 0 && fr < 2) ? up : gelu_tanh(gate) * up;
                }
            }
#pragma unroll
            for (int m = 0; m < 4; ++m) { const f32x4 v0 = acc[ai][1][m][0], v1 = acc[ai][1][m][1];
                u32x4 w; w.x = cvt_pk_bf16(v0[0], v0[1]); w.y = cvt_pk_bf16(v0[2], v0[3]); w.z = cvt_pk_bf16(v1[0], v1[1]); w.w = cvt_pk_bf16(v1[2], v1[3]);
                *(u32x4*)(ACT + (size_t)(rbase + m * 16) * DFF + col0) = w; }
        }
    }
};

struct Args { const float* in[37]; float* out; unsigned char* ws; int ph_lo, ph_hi; };
enum { I_X = 0, I_MEM, I_NMIXG, I_WIN, I_BIN, I_MU, I_W0, I_WUP, I_A0, I_AUP, I_GUP, I_KK, I_KA, I_RK, I_LNXG, I_LNXB, I_WBA, I_CBW, I_CBB, I_WRGA, I_BRGA, I_WRGX, I_BRGX,
       I_LAM, I_WBB, I_WMIX, I_NXG, I_NMEMG, I_WCQ, I_WCKV, I_WCO, I_NFFNG, I_WFFI, I_FCW, I_FCB, I_WFFO, I_NFING };

__device__ __forceinline__ void transpose_item(const float* W, int ldw, int K, bf16_t* WT, int ldd, const float* gain, int map, int srcofs, LAS float* scr, int item, int lane) {
    const int nkb = K / 64, nb = item / nkb, kb = item % nkb, k0 = 64 * kb, n0 = 32 * nb;
    int ns = n0 + srcofs;
    if (map == 1) { const int tile = n0 >> 8, c = n0 & 255; ns = c < 128 ? tile * 128 + c : DFF + tile * 128 + (c - 128); }
#pragma unroll
    for (int i = 0; i < 32; ++i) { const int kk = 2 * i + (lane >> 5); float v = W[(size_t)(k0 + kk) * ldw + ns + (lane & 31)]; if (gain) v *= gain[k0 + kk]; scr[kk * 33 + (lane & 31)] = v; }
    asm volatile("s_waitcnt lgkmcnt(0)" ::: "memory");
    const int c = lane & 7;
#pragma unroll
    for (int j = 0; j < 4; ++j) { const int n = (lane >> 3) + 8 * j; const LAS float* s = scr + (8 * c) * 33 + n;
        u32x4 o; o.x = cvt_pk_bf16(s[0 * 33], s[1 * 33]); o.y = cvt_pk_bf16(s[2 * 33], s[3 * 33]); o.z = cvt_pk_bf16(s[4 * 33], s[5 * 33]); o.w = cvt_pk_bf16(s[6 * 33], s[7 * 33]);
        *(u32x4*)(WT + (size_t)(n0 + n) * ldd + k0 + 8 * c) = o; }
    asm volatile("s_waitcnt lgkmcnt(0)" ::: "memory");
}

__device__ __forceinline__ void phase_prep(const Args& a, LAS unsigned char* lds, int wave, int G) {
    const int lane = lane_id();
    unsigned char* ws = a.ws;
    LAS float* scr = (LAS float*)(lds + wave * 16384);
    const int gw = blockIdx.x * 8 + wave, NGW = G * 8;
#define TITEMS(K_, Nd_) (((K_) / 64) * ((Nd_) / 32))
#define TJOB(W_, ldw_, K_, Nd_, dst_, gain_, map_, srcofs_) if (r < TITEMS(K_, Nd_)) { transpose_item((W_), (ldw_), (K_), (bf16_t*)(ws + (dst_)), (K_), (gain_), (map_), (srcofs_), scr, r, lane); continue; } r -= TITEMS(K_, Nd_);
    constexpr int NITEMS_ALL = TITEMS(1024, PIN) + 2 * TITEMS(512, 1024) + 5 * TITEMS(1024, 1024) + TITEMS(1024, 2 * DFF) + TITEMS(DFF, 1024);
    for (int it = gw; it < NITEMS_ALL; it += NGW) {
        int r = it;
        TJOB(a.in[I_WFFI], 2 * DFF, 1024, 2 * DFF, WS_WFFI, a.in[I_NFFNG], 1, 0)
        TJOB(a.in[I_WIN], PIN, 1024, PIN, WS_WIN, a.in[I_NMIXG], 0, 0)
        TJOB(a.in[I_WFFO], 1024, DFF, 1024, WS_WFFO, nullptr, 0, 0)
        TJOB(a.in[I_WMIX], 1024, 1024, 1024, WS_WMIX, nullptr, 0, 0)
        TJOB(a.in[I_WCQ], 1024, 1024, 1024, WS_WCQ, a.in[I_NXG], 0, 0)
        TJOB(a.in[I_WCKV], 2048, 1024, 1024, WS_WK, nullptr, 0, 0)
        TJOB(a.in[I_WCKV], 2048, 1024, 1024, WS_WV, nullptr, 0, 1024)
        TJOB(a.in[I_WCO], 1024, 1024, 1024, WS_WCO, nullptr, 0, 0)
        TJOB(a.in[I_WBA], 1024, 512, 1024, WS_WA, nullptr, 0, 0)
        TJOB(a.in[I_WBB], 1024, 512, 1024, WS_WB, nullptr, 0, 0)
    }
#undef TJOB
#undef TITEMS
    { float* z1 = (float*)(ws + WS_SSP1); float* z2 = (float*)(ws + WS_SSP2); float* z3 = (float*)(ws + WS_SSP3);
      for (int i = blockIdx.x * 512 + wave * 64 + lane; i < T; i += G * 512) { z1[i] = 0.f; z2[i] = 0.f; z3[i] = 0.f; } }
    const int gid = blockIdx.x * 512 + wave * 64 + lane, NT = G * 512;
    { bf16_t* WL = (bf16_t*)(ws + WS_WLORA);
      for (int i = gid; i < 1536 * 256; i += NT) { const int n = i >> 8, k = i & 255, kind = n >> 9, c = n & 511; float v = 0.f;
          if (kind == 0 && k < 64) v = a.in[I_WUP][k * 512 + c]; else if (kind == 1 && k >= 64 && k < 128) v = a.in[I_AUP][(k - 64) * 512 + c]; else if (kind == 2 && k >= 128) v = a.in[I_GUP][(k - 128) * 512 + c];
          WL[i] = f2bf(v); } }
    { bf16_t* WR = (bf16_t*)(ws + WS_WRG);
      for (int i = gid; i < 1024 * 256; i += NT) { const int n = i >> 8, kk = i & 255, pn = n >> 8, c = n & 255, ch = pn * 128 + (c & 127), hb = ch >> 6, j = ch & 63, k = 256 * (pn >> 1) + kk; float v = 0.f;
          if ((k >> 6) == hb) v = (c < 128 ? a.in[I_WRGA] : a.in[I_WRGX])[(hb * 64 + (k & 63)) * 64 + j];
          WR[i] = f2bf(v); } }
    { const float* x = a.in[I_X]; bf16_t* XB = (bf16_t*)(ws + WS_XB); float* rstd = (float*)(ws + WS_RSTDX);
      for (int r0 = gw; r0 < T; r0 += 4 * NGW) {
          f32x4 v[4][4]; float s[4];
#pragma unroll
          for (int q = 0; q < 4; ++q) { const int r = r0 + q * NGW; s[q] = 0.f; if (r < T) { const f32x4* xr = (const f32x4*)(x + (size_t)r * D) + lane;
#pragma unroll
              for (int j = 0; j < 4; ++j) v[q][j] = xr[64 * j]; } else {
#pragma unroll
              for (int j = 0; j < 4; ++j) v[q][j] = (f32x4){0.f, 0.f, 0.f, 0.f}; } }
#pragma unroll
          for (int q = 0; q < 4; ++q) {
#pragma unroll
              for (int j = 0; j < 4; ++j) s[q] += (v[q][j].x * v[q][j].x + v[q][j].y * v[q][j].y) + (v[q][j].z * v[q][j].z + v[q][j].w * v[q][j].w);
              s[q] = wave_sum(s[q]); }
#pragma unroll
          for (int q = 0; q < 4; ++q) { const int r = r0 + q * NGW; if (r < T) { if (lane == 0) rstd[r] = rsqrtf(s[q] * (1.0f / D) + NORM_EPS);
              u32x2* o = (u32x2*)(XB + (size_t)r * D) + lane;
#pragma unroll
              for (int j = 0; j < 4; ++j) { u32x2 w; w.x = cvt_pk_bf16(v[q][j].x, v[q][j].y); w.y = cvt_pk_bf16(v[q][j].z, v[q][j].w); o[64 * j] = w; } } } } }
    { const float* x = a.in[I_MEM]; bf16_t* XB = (bf16_t*)(ws + WS_MEMN); const float* g = a.in[I_NMEMG];
      for (int r = gw; r < TM; r += NGW) { const f32x4* xr = (const f32x4*)(x + (size_t)r * D) + lane; f32x4 v[4]; float s = 0.f;
#pragma unroll
          for (int j = 0; j < 4; ++j) { v[j] = xr[64 * j]; s += (v[j].x * v[j].x + v[j].y * v[j].y) + (v[j].z * v[j].z + v[j].w * v[j].w); }
          s = wave_sum(s); const float rs = rsqrtf(s * (1.0f / D) + NORM_EPS);
          u32x2* o = (u32x2*)(XB + (size_t)r * D) + lane;
#pragma unroll
          for (int j = 0; j < 4; ++j) { const f32x4 gg = ((const f32x4*)g)[lane + 64 * j]; u32x2 w; w.x = cvt_pk_bf16(v[j].x * rs * gg.x, v[j].y * rs * gg.y); w.y = cvt_pk_bf16(v[j].z * rs * gg.z, v[j].w * rs * gg.w); o[64 * j] = w; } } }
}

__device__ __forceinline__ float tanh_fast(float v) { return 1.0f - 2.0f * __builtin_amdgcn_rcpf(__expf(2.0f * v) + 1.0f); }
__device__ __forceinline__ void phase_elem2(const Args& a, int wave, int G) {
    unsigned char* ws = a.ws;
    const bf16_t* PR = (const bf16_t*)(ws + WS_PR); const bf16_t* PX = (const bf16_t*)(ws + WS_PX);
    bf16_t* LIN = (bf16_t*)(ws + WS_LIN); bf16_t* XBC = (bf16_t*)(ws + WS_XBC);
    const size_t gid = (size_t)blockIdx.x * 512 + wave * 64 + lane_id(), NT = (size_t)G * 512;
    {
        const int c = (int)(gid & 31) * 8; float mu[8];
#pragma unroll
        for (int j = 0; j < 8; ++j) mu[j] = a.in[I_MU][1536 + c + j];
        const size_t N = (size_t)T * 32;
        for (size_t i0 = gid; i0 < N; i0 += 4 * NT) {
            u32x4 P[4], Q[4]; bool hp[4], ok[4];
#pragma unroll
            for (int u = 0; u < 4; ++u) { const size_t i = i0 + u * NT; ok[u] = i < N; const int t = (int)((ok[u] ? i : i0) >> 5); hp[u] = (t & (SEQ - 1)) != 0;
                P[u] = *(const u32x4*)(PR + (size_t)t * RW + 1536 + c); Q[u] = *(const u32x4*)(PR + (size_t)(hp[u] ? t - 1 : t) * RW + 1536 + c); }
#pragma unroll
            for (int u = 0; u < 4; ++u) { const size_t i = i0 + u * NT; if (!ok[u]) continue; const int t = (int)(i >> 5);
                float p[8], pp[8], o[8]; unpack8(P[u], p); unpack8(Q[u], pp);
#pragma unroll
                for (int j = 0; j < 8; ++j) { const float q = hp[u] ? pp[j] : 0.f; const float v = p[j] + (q - p[j]) * mu[j]; o[j] = c < 64 ? tanh_fast(v) : (c < 128 ? v : sigmoidf_(v)); }
                *(u32x4*)(LIN + (size_t)t * 256 + c) = pack8(o); }
        }
    }
    {
        const int c = (int)(gid & 63) * 8; float w[4][8], b0[8];
#pragma unroll
        for (int j = 0; j < 8; ++j) { b0[j] = a.in[I_CBB][c + j];
#pragma unroll
            for (int k = 0; k < 4; ++k) w[k][j] = a.in[I_CBW][k * 512 + c + j]; }
        const size_t N = (size_t)T * 64;
        for (size_t i0 = gid; i0 < N; i0 += 4 * NT) {
            u32x4 X[4][4]; bool ok[4]; int tl[4];
#pragma unroll
            for (int u = 0; u < 4; ++u) { const size_t i = i0 + u * NT; ok[u] = i < N; const int t = (int)((ok[u] ? i : i0) >> 6); tl[u] = t & (SEQ - 1);
#pragma unroll
                for (int k = 0; k < 4; ++k) { const int dt = 3 - k; X[u][k] = *(const u32x4*)(PX + (size_t)(tl[u] >= dt ? t - dt : t) * 512 + c); } }
#pragma unroll
            for (int u = 0; u < 4; ++u) { const size_t i = i0 + u * NT; if (!ok[u]) continue; const int t = (int)(i >> 6);
                float o[8];
#pragma unroll
                for (int j = 0; j < 8; ++j) o[j] = b0[j];
#pragma unroll
                for (int k = 0; k < 4; ++k) { float p[8]; unpack8(X[u][k], p); const bool in = tl[u] >= 3 - k;
#pragma unroll
                    for (int j = 0; j < 8; ++j) o[j] += in ? p[j] * w[k][j] : 0.f; }
                *(u32x4*)(XBC + (size_t)t * 512 + c) = pack8(o); }
        }
    }
}

#define DPP_BC(JJ) " row_newbcast:" #JJ " row_mask:0xf bank_mask:0xf"
#define RW_SA(JJ)  asm("v_fmac_f32_dpp %0, %1, %2" DPP_BC(JJ) : "+v"(sacc[JJ & 3]) : "v"(va), "v"(S[JJ]));
#define RW_T1(JJ) { asm("v_mul_f32_dpp %0, %1, %2" DPP_BC(JJ) : "=v"(Tn[JJ]) : "v"(vw), "v"(S[JJ])); \
    asm("v_fmac_f32_dpp %0, %1, %2" DPP_BC(JJ) : "+v"(Tn[JJ]) : "v"(vk), "v"(vv)); }
#define RW_T2(JJ) { asm("v_fmac_f32_dpp %0, %1, %2" DPP_BC(JJ) : "+v"(Tn[JJ]) : "v"(vb), "v"(sa)); \
    S[JJ] = Tn[JJ]; \
    asm("v_fmac_f32_dpp %0, %1, %2" DPP_BC(JJ) : "+v"(yacc[JJ & 3]) : "v"(vr), "v"(S[JJ])); }
#define RW_ALL16(M) M(0) M(1) M(2) M(3) M(4) M(5) M(6) M(7) M(8) M(9) M(10) M(11) M(12) M(13) M(14) M(15)

constexpr int RB = 32;
constexpr int PSTEP = 6 * 64;
constexpr int PBUF = RB * PSTEP * 4;

__device__ __forceinline__ float dpp_ror_add(float v, const int ctrl_sel) {
    int t;
    switch (ctrl_sel) {
        case 8: t = __builtin_amdgcn_update_dpp(0, __float_as_int(v), 0x128, 0xf, 0xf, false); break;
        case 4: t = __builtin_amdgcn_update_dpp(0, __float_as_int(v), 0x124, 0xf, 0xf, false); break;
        case 2: t = __builtin_amdgcn_update_dpp(0, __float_as_int(v), 0x122, 0xf, 0xf, false); break;
        default: t = __builtin_amdgcn_update_dpp(0, __float_as_int(v), 0x121, 0xf, 0xf, false); break;
    }
    return v + __int_as_float(t);
}
__device__ __forceinline__ float cross_row_allsum(float v) {
    auto r = __builtin_amdgcn_permlane32_swap(__float_as_uint(v), __float_as_uint(v), false, false);
    v = __uint_as_float(r[0]) + __uint_as_float(r[1]);
    auto r2 = __builtin_amdgcn_permlane16_swap(__float_as_uint(v), __float_as_uint(v), false, false);
    return __uint_as_float(r2[0]) + __uint_as_float(r2[1]);
}
__device__ __forceinline__ float wave_allsum(float v) {
    v = dpp_ror_add(v, 8); v = dpp_ror_add(v, 4); v = dpp_ror_add(v, 2); v = dpp_ror_add(v, 1);
    return cross_row_allsum(v);
}
__device__ __forceinline__ void lds_barrier() { asm volatile("s_waitcnt lgkmcnt(0)" ::: "memory"); __builtin_amdgcn_s_barrier(); asm volatile("" ::: "memory"); }

constexpr int NPS = RB / 4;
__device__ __forceinline__ void prod_load(const Args& a, bf16_t (&raw)[NPS][8], int tok0, int h, int p, int lane) {
    const bf16_t* PR = (const bf16_t*)(a.ws + WS_PR); const bf16_t* LOUT = (const bf16_t*)(a.ws + WS_LOUT);
#pragma unroll
    for (int i = 0; i < NPS; ++i) { const int tok = tok0 + p + 4 * i; const bool has_prev = (tok & (SEQ - 1)) != 0;
        const bf16_t* prow = PR + (size_t)tok * RW + h * 64 + lane; const bf16_t* qrow = has_prev ? prow - RW : prow; const bf16_t* lrow = LOUT + (size_t)tok * 1536 + h * 64 + lane;
        raw[i][0] = prow[0]; raw[i][1] = prow[512]; raw[i][2] = prow[1024]; raw[i][3] = qrow[0]; raw[i][4] = qrow[512]; raw[i][5] = qrow[1024]; raw[i][6] = lrow[0]; raw[i][7] = lrow[512]; }
}
__device__ __forceinline__ void prod_compute(const Args& a, const bf16_t (&raw)[NPS][8], LAS float* pb, int tok0, int h, int p, int lane, float mu_r, float mu_k, float mu_v, float ckk, float cka, float crk) {
    float* BON = (float*)(a.ws + WS_BON);
#pragma unroll
    for (int i = 0; i < NPS; ++i) { const int s = p + 4 * i, tok = tok0 + s; const bool has_prev = (tok & (SEQ - 1)) != 0;
        const float rr = bf1(raw[i][0]), kr = bf1(raw[i][1]), vr_ = bf1(raw[i][2]);
        const float rp = has_prev ? bf1(raw[i][3]) : 0.f, kp = has_prev ? bf1(raw[i][4]) : 0.f, vp = has_prev ? bf1(raw[i][5]) : 0.f;
        const float e = bf1(raw[i][6]), av = bf1(raw[i][7]);
        const float r = rr + (rp - rr) * mu_r, k0 = kr + (kp - kr) * mu_k, v = vr_ + (vp - vr_) * mu_v;
        const float w = __expf(-e);
        const float kk = k0 * ckk; const float n2 = wave_allsum(kk * kk); const float kkn = kk * rsqrtf(fmaxf(n2, 1e-24f));
        const float k2 = k0 * (1.0f + (av - 1.0f) * cka);
        const float bon = wave_allsum(r * k2 * crk);
        LAS float* pp = pb + s * PSTEP;
        pp[lane] = -kkn; pp[64 + lane] = kkn * av; pp[128 + lane] = k2; pp[192 + lane] = w; pp[256 + lane] = r; pp[320 + lane] = v;
        if (lane == 0) BON[(size_t)tok * 8 + h] = bon; }
}

__device__ __forceinline__ void phase_scan(const Args& a, LAS unsigned char* lds, int wave, int G) {
    const int lane = lane_id();
    unsigned char* ws = a.ws;
    constexpr int SB = 16, NBLK = SEQ / RB;
    for (int pair = blockIdx.x; pair < 256; pair += G) {
        const int b = pair >> 3, h = pair & 7, tokb = b * SEQ;
        if (wave < 4) {
            const int il = lane & 15, irow = 16 * wave + il;
            float S[16];
#pragma unroll
            for (int j = 0; j < 16; ++j) S[j] = 0.f;
            bf16_t* YRAW = (bf16_t*)(ws + WS_YRAW);
            lds_barrier();
            for (int blk = 0; blk < NBLK; ++blk) {
                const LAS float* pb = (const LAS float*)(lds + (blk & 1) * PBUF);
#pragma unroll 2
                for (int s = 0; s < RB; ++s) {
                    const LAS float* pp = pb + s * PSTEP;
                    float va = pp[lane], vb = pp[64 + lane], vk = pp[128 + lane], vw = pp[192 + lane], vr = pp[256 + lane]; const float vv = pp[320 + irow];
                    asm volatile("s_nop 1" : "+v"(va), "+v"(vb), "+v"(vk), "+v"(vw), "+v"(vr));
                    float sacc[4] = {0.f, 0.f, 0.f, 0.f}, yacc[4] = {0.f, 0.f, 0.f, 0.f};
                    RW_ALL16(RW_SA)
                    float sa = (sacc[0] + sacc[1]) + (sacc[2] + sacc[3]);
                    float Tn[16];
                    RW_ALL16(RW_T1)
                    sa = cross_row_allsum(sa);
                    RW_ALL16(RW_T2)
                    float y = (yacc[0] + yacc[1]) + (yacc[2] + yacc[3]);
                    y = cross_row_allsum(y);
                    const int tok = tokb + blk * RB + s;
                    if (lane < 16) YRAW[(size_t)tok * 512 + h * 64 + irow] = f2bf(y);
                }
                lds_barrier();
            }
        } else {
            const float mu_r = a.in[I_MU][h * 64 + lane], mu_k = a.in[I_MU][512 + h * 64 + lane], mu_v = a.in[I_MU][1024 + h * 64 + lane];
            const float ckk = a.in[I_KK][h * 64 + lane], cka = a.in[I_KA][h * 64 + lane], crk = a.in[I_RK][h * 64 + lane];
            const size_t base = (size_t)tokb * 512 + h * 64 + lane;
            const bf16_t* LA = (const bf16_t*)(ws + WS_RGLA) + base; const bf16_t* U = (const bf16_t*)(ws + WS_RGU) + base; const bf16_t* PY = (const bf16_t*)(ws + WS_PY) + base;
            bf16_t* YB = (bf16_t*)(ws + WS_YB) + base;
            bf16_t cla[SB], cu[SB], cpy[SB]; float hh = 0.f;
#pragma unroll
            for (int s = 0; s < SB; ++s) { cla[s] = 0; cu[s] = 0; cpy[s] = 0; }
            if (wave == 4) {
#pragma unroll
                for (int s = 0; s < SB; ++s) { cla[s] = LA[(size_t)s * 512]; cu[s] = U[(size_t)s * 512]; cpy[s] = PY[(size_t)s * 512]; }
            }
            bf16_t raw[NPS][8];
            prod_load(a, raw, tokb, h, wave - 4, lane); prod_compute(a, raw, (LAS float*)lds, tokb, h, wave - 4, lane, mu_r, mu_k, mu_v, ckk, cka, crk); prod_load(a, raw, tokb + RB, h, wave - 4, lane);
            lds_barrier();
            for (int blk = 0; blk < NBLK; ++blk) {
                if (blk + 1 < NBLK) { prod_compute(a, raw, (LAS float*)(lds + ((blk + 1) & 1) * PBUF), tokb + (blk + 1) * RB, h, wave - 4, lane, mu_r, mu_k, mu_v, ckk, cka, crk);
                    if (blk + 2 < NBLK) prod_load(a, raw, tokb + (blk + 2) * RB, h, wave - 4, lane); }
                if (wave == 4) {
                    for (int sub = 0; sub < RB / SB; ++sub) {
                        const int t0 = blk * RB + sub * SB, tn = (t0 + SB < SEQ) ? t0 + SB : t0;
                        bf16_t nla[SB], nu[SB], npy[SB];
#pragma unroll
                        for (int s = 0; s < SB; ++s) { nla[s] = LA[(size_t)(tn + s) * 512]; nu[s] = U[(size_t)(tn + s) * 512]; npy[s] = PY[(size_t)(tn + s) * 512]; }
#pragma unroll
                        for (int s = 0; s < SB; ++s) { hh = __expf(bf1(cla[s])) * hh + bf1(cu[s]); YB[(size_t)(t0 + s) * 512] = f2bf(hh * gelu_tanh(bf1(cpy[s]))); }
#pragma unroll
                        for (int s = 0; s < SB; ++s) { cla[s] = nla[s]; cu[s] = nu[s]; cpy[s] = npy[s]; }
                    }
                }
                lds_barrier();
            }
        }
    }
    asm volatile("s_waitcnt vmcnt(0)" ::: "memory");
}

__device__ __forceinline__ void phase_post(const Args& a, int wave, int G) {
    unsigned char* ws = a.ws;
    const bf16_t* PR = (const bf16_t*)(ws + WS_PR); const bf16_t* LOUT = (const bf16_t*)(ws + WS_LOUT); const bf16_t* YRAW = (const bf16_t*)(ws + WS_YRAW);
    const float* BON = (const float*)(ws + WS_BON); bf16_t* YA = (bf16_t*)(ws + WS_YA);
    const size_t gid = (size_t)blockIdx.x * 512 + wave * 64 + lane_id(), NT = (size_t)G * 512;
    const int c = (int)(gid & 63) * 8, h = c >> 6; float mu[8], lg[8], lb[8];
#pragma unroll
    for (int j = 0; j < 8; ++j) { mu[j] = a.in[I_MU][1024 + c + j]; lg[j] = a.in[I_LNXG][c + j]; lb[j] = a.in[I_LNXB][c + j]; }
    const size_t N = (size_t)T * 64;
    for (size_t i0 = gid; i0 < N; i0 += 4 * NT) {
        u32x4 Y[4], V[4], VP[4], GG[4]; float bn[4]; bool ok[4], hp[4];
#pragma unroll
        for (int u = 0; u < 4; ++u) { const size_t i = i0 + u * NT; ok[u] = i < N; const int t = (int)((ok[u] ? i : i0) >> 6); hp[u] = (t & (SEQ - 1)) != 0;
            Y[u] = *(const u32x4*)(YRAW + (size_t)t * 512 + c); V[u] = *(const u32x4*)(PR + (size_t)t * RW + 1024 + c); VP[u] = *(const u32x4*)(PR + (size_t)(hp[u] ? t - 1 : t) * RW + 1024 + c);
            GG[u] = *(const u32x4*)(LOUT + (size_t)t * 1536 + 1024 + c); bn[u] = BON[(size_t)t * 8 + h]; }
#pragma unroll
        for (int u = 0; u < 4; ++u) { const size_t i = i0 + u * NT; const int t = (int)((ok[u] ? i : i0) >> 6);
            float y[8], v[8], vp[8], g[8], o[8]; unpack8(Y[u], y); unpack8(V[u], v); unpack8(VP[u], vp); unpack8(GG[u], g);
            float s = 0.f;
#pragma unroll
            for (int j = 0; j < 8; ++j) s += y[j];
            s += __shfl_xor(s, 1); s += __shfl_xor(s, 2); s += __shfl_xor(s, 4);
            const float mean = s * (1.0f / 64.0f); float q = 0.f;
#pragma unroll
            for (int j = 0; j < 8; ++j) { const float d = y[j] - mean; q += d * d; }
            q += __shfl_xor(q, 1); q += __shfl_xor(q, 2); q += __shfl_xor(q, 4);
            const float rs = rsqrtf(q * (1.0f / 64.0f) + LNX_EPS);
#pragma unroll
            for (int j = 0; j < 8; ++j) { const float pv = hp[u] ? vp[j] : 0.f; const float vv = v[j] + (pv - v[j]) * mu[j];
                o[j] = ((y[j] - mean) * rs * lg[j] + lb[j] + bn[u] * vv) * g[j]; }
            if (ok[u]) *(u32x4*)(YA + (size_t)t * 512 + c) = pack8(o); }
    }
}

__device__ __forceinline__ void phase_ffnfix(const Args& a, int wave, int G) {
    unsigned char* ws = a.ws;
    const bf16_t* HG = (const bf16_t*)(ws + WS_HG); bf16_t* ACT = (bf16_t*)(ws + WS_UU);
    const float* cw = a.in[I_FCW]; const float* cb = a.in[I_FCB];
    const size_t gid = (size_t)blockIdx.x * 512 + wave * 64 + lane_id(), NT = (size_t)G * 512;
    constexpr int CPR = DFF / 8;
    for (size_t i = gid; i < (size_t)(T / 64) * 2 * CPR; i += NT) {
        const int c = (int)(i % CPR) * 8, rho = (int)((i / CPR) & 1), grp = (int)(i / (2 * CPR)); const int t = grp * 64 + rho; const bool first = (grp & 31) == 0;
        float p2[8], p1[8], cur[8], up[8], o[8];
#pragma unroll
        for (int j = 0; j < 8; ++j) { p2[j] = 0.f; p1[j] = 0.f; }
        if (rho == 0) { if (!first) { unpack8(*(const u32x4*)(HG + ((size_t)(grp - 1) * 4 + 0) * DFF + c), p2); unpack8(*(const u32x4*)(HG + ((size_t)(grp - 1) * 4 + 1) * DFF + c), p1); } }
        else { if (!first) unpack8(*(const u32x4*)(HG + ((size_t)(grp - 1) * 4 + 1) * DFF + c), p2); unpack8(*(const u32x4*)(HG + ((size_t)grp * 4 + 2) * DFF + c), p1); }
        unpack8(*(const u32x4*)(HG + ((size_t)grp * 4 + 2 + rho) * DFF + c), cur);
        unpack8(*(const u32x4*)(ACT + (size_t)t * DFF + c), up);
#pragma unroll
        for (int j = 0; j < 8; ++j) o[j] = gelu_tanh(cb[c + j] + cw[c + j] * p2[j] + cw[DFF + c + j] * p1[j] + cw[2 * DFF + c + j] * cur[j]) * up[j];
        *(u32x4*)(ACT + (size_t)t * DFF + c) = pack8(o);
    }
}

__device__ __forceinline__ void phase_final(const Args& a, int wave, int G) {
    const int lane = lane_id();
    const float* ssp = (const float*)(a.ws + WS_SSP3); const float* g = a.in[I_NFING]; const bf16_t* X3 = (const bf16_t*)(a.ws + WS_X3B);
    const int gw = blockIdx.x * 8 + wave, NGW = G * 8;
    for (int r0 = gw; r0 < T; r0 += 4 * NGW) {
        u32x4 v[4][2]; float rs[4];
#pragma unroll
        for (int q = 0; q < 4; ++q) { const int r = r0 + q * NGW; if (r < T) { rs[q] = rstd_from16(ssp, r); const u32x4* xr = (const u32x4*)(X3 + (size_t)r * D) + lane; v[q][0] = xr[0]; v[q][1] = xr[64]; } }
#pragma unroll
        for (int q = 0; q < 4; ++q) { const int r = r0 + q * NGW; if (r < T) {
#pragma unroll
            for (int j = 0; j < 2; ++j) { float x[8]; unpack8(v[q][j], x); const int c = 512 * j + 8 * lane; const f32x4 g0 = *(const f32x4*)(g + c), g1 = *(const f32x4*)(g + c + 4);
                f32x4* o = (f32x4*)(a.out + (size_t)r * D + c);
                o[0] = (f32x4){x[0] * rs[q] * g0[0], x[1] * rs[q] * g0[1], x[2] * rs[q] * g0[2], x[3] * rs[q] * g0[3]};
                o[1] = (f32x4){x[4] * rs[q] * g1[0], x[5] * rs[q] * g1[1], x[6] * rs[q] * g1[2], x[7] * rs[q] * g1[3]}; } } }
    }
}

constexpr int NPHASE = 13;
__global__ void __launch_bounds__(512, 2) mega(Args a) {
    extern __shared__ __attribute__((aligned(16))) unsigned char lds_raw[];
    LAS unsigned char* lds = (LAS unsigned char*)lds_raw;
    cg::grid_group grid = cg::this_grid();
    const int wave = __builtin_amdgcn_readfirstlane((int)threadIdx.x >> 6), G = gridDim.x, bid = blockIdx.x;
    unsigned char* ws = a.ws;
    const int lo = a.ph_lo, hi = a.ph_hi;
    const bool t0 = (wave == 0) && (lane_id() == 0);
    volatile LAS unsigned* misc = (volatile LAS unsigned*)(lds + 131072 + 320);
    if (t0) { misc[0] = 0u; misc[1] = 0u; }
    __syncthreads();
    XcdBarrier xb = xcd_barrier_post((unsigned*)(ws + WS_CTL), misc, t0);
    if (a.ph_hi < 0) grid.sync();
#define IN(k) (lo <= (k) && (k) < hi)
#define SEAM(k) do { if (IN(k) && IN((k) + 1)) xcd_barrier(xb, t0); } while (0)
    bf16_t* const XB = (bf16_t*)(ws + WS_XB);
    const float* rstdx = (const float*)(ws + WS_RSTDX);
    StaticOrder S;

    if (IN(0)) for (int rep_ = 0; rep_ < REPS(0); ++rep_) { phase_prep(a, lds, wave, G); __syncthreads(); } SEAM(0);

    if (IN(1)) for (int rep_ = 0; rep_ < REPS(1); ++rep_) {
        { Gemm g = plain_gemm(XB, (const bf16_t*)(ws + WS_WIN), 1024); S.init(T / BM, 11, G, bid);
          EpiProj E{rstdx, a.in[I_BIN], (bf16_t*)(ws + WS_PR), (bf16_t*)(ws + WS_PX), (bf16_t*)(ws + WS_PY)}; gemm_phase(lds, wave, g, S, E); }
        if ((G & 15) == 0) {
            const int hg = G >> 1, hb_ = (bid >> 4) * 8 + (bid & 7);
            if (((bid >> 3) & 1) == 0) { Gemm g = plain_gemm((const bf16_t*)(ws + WS_MEMN), (const bf16_t*)(ws + WS_WK), 1024); S.init(TM / BM, 4, hg, hb_);
                EpiPlain E{(bf16_t*)(ws + WS_KM), 1024}; gemm_phase(lds, wave, g, S, E); }
            else { Gemm g = plain_gemm((const bf16_t*)(ws + WS_WV), (const bf16_t*)(ws + WS_MEMN), 1024); S.init(4, TM / BM, hg, hb_);
                EpiPlain E{(bf16_t*)(ws + WS_VT), TM}; gemm_phase(lds, wave, g, S, E); }
        } else {
            { Gemm g = plain_gemm((const bf16_t*)(ws + WS_MEMN), (const bf16_t*)(ws + WS_WK), 1024); S.init(TM / BM, 4, G, bid);
              EpiPlain E{(bf16_t*)(ws + WS_KM), 1024}; gemm_phase(lds, wave, g, S, E); }
            { Gemm g = plain_gemm((const bf16_t*)(ws + WS_WV), (const bf16_t*)(ws + WS_MEMN), 1024); S.init(4, TM / BM, G, bid);
              EpiPlain E{(bf16_t*)(ws + WS_VT), TM}; gemm_phase(lds, wave, g, S, E); }
        }
    } SEAM(1);

    if (IN(2)) for (int rep_ = 0; rep_ < REPS(2); ++rep_) phase_elem2(a, wave, G); SEAM(2);
#ifdef PROBE_SYNC
    for (int i_ = 0; i_ < 16; ++i_) grid.sync();
#endif

    if (IN(3)) for (int rep_ = 0; rep_ < REPS(3); ++rep_) {
        { Gemm g = plain_gemm((const bf16_t*)(ws + WS_LIN), (const bf16_t*)(ws + WS_WLORA), 256); S.init(T / BM, 6, G, bid);
          EpiLora E{a.in[I_W0], a.in[I_A0], (bf16_t*)(ws + WS_LOUT)}; gemm_phase(lds, wave, g, S, E); }
        { Gemm g = plain_gemm((const bf16_t*)(ws + WS_XBC), (const bf16_t*)(ws + WS_WRG), 256); g.lda = 512; g.a_pm = (size_t)BM * 512 * 2; g.a_pn2 = 512; S.init(T / BM, 4, G, bid);
          EpiRg E{a.in[I_BRGA], a.in[I_BRGX], a.in[I_LAM], (const bf16_t*)(ws + WS_XBC), (bf16_t*)(ws + WS_RGLA), (bf16_t*)(ws + WS_RGU)}; gemm_phase(lds, wave, g, S, E); }
    } SEAM(3);

    if (IN(4)) for (int rep_ = 0; rep_ < REPS(4); ++rep_) phase_scan(a, lds, wave, G); SEAM(4);
    if (IN(5)) for (int rep_ = 0; rep_ < REPS(5); ++rep_) phase_post(a, wave, G); SEAM(5);

    if (IN(6)) for (int rep_ = 0; rep_ < REPS(6); ++rep_) {
        S.init(T / BM, 4, G, bid);
        { Gemm g = plain_gemm(XB, (const bf16_t*)(ws + WS_WIN) + (size_t)2816 * 1024, 1024); EpiGab E{rstdx, a.in[I_BIN] + 2816, (bf16_t*)(ws + WS_GAB), 0}; gemm_phase(lds, wave, g, S, E); }
        { Gemm g = plain_gemm((const bf16_t*)(ws + WS_YA), (const bf16_t*)(ws + WS_WA), 512); EpiBranch<true> E{(const bf16_t*)(ws + WS_GAB), (bf16_t*)(ws + WS_MERGED)}; gemm_phase(lds, wave, g, S, E); }
        { Gemm g = plain_gemm(XB, (const bf16_t*)(ws + WS_WIN) + (size_t)3840 * 1024, 1024); EpiGab E{rstdx, a.in[I_BIN] + 2816, (bf16_t*)(ws + WS_GAB), 1024}; gemm_phase(lds, wave, g, S, E); }
        { Gemm g = plain_gemm((const bf16_t*)(ws + WS_YB), (const bf16_t*)(ws + WS_WB), 512); EpiBranch<false> E{(const bf16_t*)(ws + WS_GAB), (bf16_t*)(ws + WS_MERGED)}; gemm_phase(lds, wave, g, S, E); }
    } SEAM(6);
    if (IN(7)) for (int rep_ = 0; rep_ < REPS(7); ++rep_) { Gemm g = plain_gemm((const bf16_t*)(ws + WS_MERGED), (const bf16_t*)(ws + WS_WMIX), 1024); S.init(T / BM, 4, G, bid);
        EpiRes<true> E{a.in[I_X], (bf16_t*)(ws + WS_X1B), (float*)(ws + WS_SSP1)}; gemm_phase(lds, wave, g, S, E); } SEAM(7);
    if (IN(8)) for (int rep_ = 0; rep_ < REPS(8); ++rep_) {
        S.init(T / BM, 4, G, bid);
        { Gemm g = plain_gemm((const bf16_t*)(ws + WS_X1B), (const bf16_t*)(ws + WS_WCQ), 1024);
          EpiQ E{(const float*)(ws + WS_SSP1), (bf16_t*)(ws + WS_Q)}; gemm_phase(lds, wave, g, S, E); }
        { Gemm g; g.A = (const bf16_t*)(ws + WS_Q); g.Bt = (const bf16_t*)(ws + WS_KM); g.lda = 1024; g.ldb = 1024; g.K = 256;
          g.a_pm = (size_t)BM * 1024 * 2; g.a_pn = 512; g.b_pn = 512; g.b_pb = (size_t)NMEM * 1024 * 2; g.a_pn2 = 0;
          EpiSc E{(bf16_t*)(ws + WS_PEXP), (float*)(ws + WS_SSPA)}; gemm_phase(lds, wave, g, S, E); }
        { Gemm g; g.A = (const bf16_t*)(ws + WS_PEXP); g.Bt = (const bf16_t*)(ws + WS_VT); g.lda = 1024; g.ldb = TM; g.K = 256;
          g.a_pm = (size_t)BM * 1024 * 2; g.a_pn = 512; g.b_pn = (size_t)256 * TM * 2; g.b_pb = 512; g.a_pn2 = 0;
          EpiPv E{(const float*)(ws + WS_SSPA), (bf16_t*)(ws + WS_O)}; gemm_phase(lds, wave, g, S, E); }
    } SEAM(8);
    if (IN(9)) for (int rep_ = 0; rep_ < REPS(9); ++rep_) { Gemm g = plain_gemm((const bf16_t*)(ws + WS_O), (const bf16_t*)(ws + WS_WCO), 1024); S.init(T / BM, 4, G, bid);
        EpiRes<false> E{(const bf16_t*)(ws + WS_X1B), (bf16_t*)(ws + WS_X2B), (float*)(ws + WS_SSP2)}; gemm_phase(lds, wave, g, S, E); } SEAM(9);
    if (IN(10)) for (int rep_ = 0; rep_ < REPS(10); ++rep_) { Gemm g = plain_gemm((const bf16_t*)(ws + WS_X2B), (const bf16_t*)(ws + WS_WFFI), 1024); S.init(T / BM, 22, G, bid);
        EpiFfnAct E{(const float*)(ws + WS_SSP2), a.in[I_FCW], a.in[I_FCB], (bf16_t*)(ws + WS_UU), (bf16_t*)(ws + WS_HG)}; gemm_phase(lds, wave, g, S, E); } SEAM(10);
    if (IN(11)) for (int rep_ = 0; rep_ < REPS(11); ++rep_) phase_ffnfix(a, wave, G); SEAM(11);
    if (IN(12)) for (int rep_ = 0; rep_ < REPS(12); ++rep_) { Gemm g = plain_gemm((const bf16_t*)(ws + WS_UU), (const bf16_t*)(ws + WS_WFFO), DFF); S.init(T / BM, 4, G, bid);
        EpiRes<false> E{(const bf16_t*)(ws + WS_X2B), (bf16_t*)(ws + WS_X3B), (float*)(ws + WS_SSP3)}; gemm_phase(lds, wave, g, S, E); } SEAM(12);
    if (IN(13)) for (int rep_ = 0; rep_ < REPS(13); ++rep_) phase_final(a, wave, G);
#undef IN
#undef SEAM
}

extern "C" void kernel_launch(void* const* d_in, const int* in_sizes, int n_in, void* d_out, int out_size, void* d_ws, size_t ws_size, hipStream_t stream) {
    static int grid = 0;
    if (grid == 0) {
        if (n_in != 37 || in_sizes[0] != T * D || out_size != T * D || ws_size < WS_END) {
            fprintf(stderr, "kernel_launch: unexpected shapes (n_in %d, in0 %d, out %d, ws %zu < %zu); nothing launched\n", n_in, n_in > 0 ? in_sizes[0] : -1, out_size, ws_size, (size_t)WS_END); grid = -1; return; }
        int dev = 0, cus = 0, per_cu = 0;
        if (hipGetDevice(&dev) != hipSuccess || hipDeviceGetAttribute(&cus, hipDeviceAttributeMultiprocessorCount, dev) != hipSuccess) { grid = -1; return; }
        if (hipFuncSetAttribute((const void*)mega, hipFuncAttributeMaxDynamicSharedMemorySize, LDS_BYTES) != hipSuccess) { fprintf(stderr, "kernel_launch: hipFuncSetAttribute failed\n"); grid = -1; return; }
        if (hipOccupancyMaxActiveBlocksPerMultiprocessor(&per_cu, (const void*)mega, 512, LDS_BYTES) != hipSuccess || per_cu < 1) { fprintf(stderr, "kernel_launch: occupancy query says %d\n", per_cu); per_cu = 1; }
        (void)hipGetLastError();
        grid = cus * 1;
    }
    if (grid < 0) return;
    if (hipMemsetAsync((char*)d_ws + WS_CTL, 0, CTL_BYTES, stream) != hipSuccess) { fprintf(stderr, "kernel_launch: memset failed\n"); return; }
    Args a{};
    for (int i = 0; i < 37; ++i) a.in[i] = (const float*)d_in[i];
    a.out = (float*)d_out; a.ws = (unsigned char*)d_ws;
#if MK_SPLIT
    for (int ph = 0; ph <= NPHASE; ++ph) {
        a.ph_lo = ph; a.ph_hi = ph + 1; void* args[] = {&a};
        hipError_t e = hipLaunchCooperativeKernel((const void*)mega, dim3(grid), dim3(512), args, LDS_BYTES, stream);
        if (e != hipSuccess) { fprintf(stderr, "kernel_launch: launch of phase %d failed: %s\n", ph, hipGetErrorString(e)); break; }
    }
#else
    a.ph_lo = 0; a.ph_hi = NPHASE + 1; void* args[] = {&a};
    hipError_t e = hipLaunchCooperativeKernel((const void*)mega, dim3(grid), dim3(512), args, LDS_BYTES, stream);
    if (e != hipSuccess) fprintf(stderr, "kernel_launch: cooperative launch failed: %s (grid %d)\n", hipGetErrorString(e), grid);
#endif
}
```

```cpp
#include <hip/hip_runtime.h>
#include <hip/hip_cooperative_groups.h>
#include <cstdio>
namespace cg = cooperative_groups;

#ifndef MK_SPLIT
#define MK_SPLIT 0
#endif

#ifndef DUP_PHASE
#define DUP_PHASE -1
#endif
#define REPS(k) ((DUP_PHASE == (k)) ? 2 : 1)
#define LAS __attribute__((address_space(3)))
typedef unsigned short bf16_t;
typedef short bf16x8 __attribute__((ext_vector_type(8)));
typedef float f32x4 __attribute__((ext_vector_type(4)));
typedef float f32x2 __attribute__((ext_vector_type(2)));
typedef unsigned u32x4 __attribute__((ext_vector_type(4)));
typedef unsigned u32x2 __attribute__((ext_vector_type(2)));

constexpr int T = 65536, D = 1024, SEQ = 2048, NB = 32, NMEM = 256, TM = NB * NMEM;
constexpr int AW = 512, RW = 1792, PIN = 4864, DFF = 2816;
constexpr float NORM_EPS = 1e-6f, LNX_EPS = 64e-5f;

constexpr size_t MiB = 1u << 20;
constexpr size_t WS_WIN = 0;
constexpr size_t WS_WFFI = 10 * MiB;
constexpr size_t WS_WFFO = 21 * MiB;
constexpr size_t WS_WMIX = 27 * MiB, WS_WCQ = 29 * MiB, WS_WK = 31 * MiB, WS_WV = 33 * MiB, WS_WCO = 35 * MiB;
constexpr size_t WS_WA = 37 * MiB, WS_WB = 38 * MiB;
constexpr size_t WS_WLORA = 39 * MiB;
constexpr size_t WS_WRG = 40 * MiB;
constexpr size_t WS_CTL = 46 * MiB, CTL_BYTES = 16384;
constexpr size_t WS_RSTDX = 48 * MiB;
constexpr size_t WS_SSP1 = 49 * MiB, WS_SSP2 = 53 * MiB, WS_SSP3 = 57 * MiB, WS_SSPA = 61 * MiB;
constexpr size_t WS_BON = 65 * MiB;
constexpr size_t WS_MEMN = 68 * MiB, WS_KM = 84 * MiB, WS_VT = 100 * MiB;
constexpr size_t WS_XB = 120 * MiB;
constexpr size_t WS_PR = 248 * MiB;
constexpr size_t WS_PX = 472 * MiB, WS_PY = 536 * MiB;
constexpr size_t WS_LIN = 600 * MiB, WS_XBC = 632 * MiB;
constexpr size_t WS_LOUT = 696 * MiB;
constexpr size_t WS_RGLA = 888 * MiB, WS_RGU = 952 * MiB;
constexpr size_t WS_YRAW = WS_PX, WS_YB = WS_LIN, WS_YA = WS_RGLA;
constexpr size_t WS_GAB = 248 * MiB;
constexpr size_t WS_MERGED = 696 * MiB;
constexpr size_t WS_X1B = WS_XB, WS_Q = 248 * MiB, WS_PEXP = 376 * MiB, WS_O = 504 * MiB, WS_X2B = WS_XB;
constexpr size_t WS_X3B = 376 * MiB;
constexpr size_t WS_HG = 248 * MiB, WS_UU = 600 * MiB;
constexpr size_t WS_END = 1016 * MiB;

constexpr int LDS_BYTES = 147456;

__device__ __forceinline__ unsigned cvt_pk_bf16(float lo, float hi) { unsigned r; asm("v_cvt_pk_bf16_f32 %0, %1, %2" : "=v"(r) : "v"(lo), "v"(hi)); return r; }
__device__ __forceinline__ float bf_lo(unsigned w) { return __uint_as_float(w << 16); }
__device__ __forceinline__ float bf_hi(unsigned w) { return __uint_as_float(w & 0xffff0000u); }
__device__ __forceinline__ float bf1(bf16_t b) { return __uint_as_float(((unsigned)b) << 16); }
__device__ __forceinline__ bf16_t f2bf(float f) { return (bf16_t)(cvt_pk_bf16(f, 0.f) & 0xffffu); }
__device__ __forceinline__ float sigmoidf_(float x) { return __builtin_amdgcn_rcpf(1.0f + __expf(-x)); }
__device__ __forceinline__ float gelu_tanh(float x) { const float z = 1.5957691216057308f * (x + 0.044715f * x * x * x); return x * sigmoidf_(z); }
__device__ __forceinline__ int lane_id() { int l; asm volatile("v_mbcnt_lo_u32_b32 %0, -1, 0\n\tv_mbcnt_hi_u32_b32 %0, -1, %0" : "=v"(l)); return l; }
__device__ __forceinline__ float wave_sum(float v) {
#pragma unroll
    for (int o = 1; o < 64; o <<= 1) v += __shfl_xor(v, o);
    return v;
}
__device__ __forceinline__ void unpack8(const u32x4 w, float (&f)[8]) {
    f[0] = bf_lo(w.x); f[1] = bf_hi(w.x); f[2] = bf_lo(w.y); f[3] = bf_hi(w.y); f[4] = bf_lo(w.z); f[5] = bf_hi(w.z); f[6] = bf_lo(w.w); f[7] = bf_hi(w.w);
}
__device__ __forceinline__ u32x4 pack8(const float (&f)[8]) {
    u32x4 w; w.x = cvt_pk_bf16(f[0], f[1]); w.y = cvt_pk_bf16(f[2], f[3]); w.z = cvt_pk_bf16(f[4], f[5]); w.w = cvt_pk_bf16(f[6], f[7]); return w;
}


#define XB_TMO      128
#define XB_XCNT(j)  (256  + 64 * (j))
#define XB_XSUB(j)  (1280 + 64 * (j))
#define XB_XGEN(j)  (2304 + 64 * (j))
#define XB_TOP      3328
#define XB_TOPGEN   3392
#define XCD_BAR_WORDS 3456
#define XB_SPIN_CAP (1u << 22)
__device__ __forceinline__ unsigned xb_ld(unsigned* p)              { return __hip_atomic_load(p, __ATOMIC_RELAXED, __HIP_MEMORY_SCOPE_AGENT); }
__device__ __forceinline__ unsigned xb_add(unsigned* p, unsigned v) { return __hip_atomic_fetch_add(p, v, __ATOMIC_RELAXED, __HIP_MEMORY_SCOPE_AGENT); }
__device__ __forceinline__ unsigned xb_xcc_id() { return (unsigned)__builtin_amdgcn_s_getreg((3 << 11) | 20) & 0xFu; }
#define XB_SPIN(cond, bar) do { unsigned _sp = 0; while (cond) { __builtin_amdgcn_s_sleep(1); \
    if ((++_sp & 255u) == 0u) { if (xb_ld(&(bar)[XB_TMO])) break; if (_sp > XB_SPIN_CAP) { atomicAdd(&(bar)[XB_TMO], 1u); break; } } } } while (0)
struct XcdBarrier { unsigned* bar; unsigned x; volatile LAS unsigned* st; };
__device__ __forceinline__ XcdBarrier xcd_barrier_post(unsigned* bar, volatile LAS unsigned* st, bool t0) {
    XcdBarrier b; b.bar = bar; b.x = xb_xcc_id(); b.st = st;
    if (t0) (void)xb_add(&bar[XB_XCNT(b.x)], 1u);
    return b;
}
__device__ __forceinline__ void xcd_barrier_complete(unsigned* bar, unsigned x, unsigned& nloc, unsigned& nx) {
    const unsigned G = gridDim.x * gridDim.y * gridDim.z;
    unsigned sum, cnt, mine, sp = 0u;
    for (;;) {
        sum = 0u; cnt = 0u; mine = 0u;
#pragma unroll
        for (unsigned j = 0; j < 16; ++j) { const unsigned c = xb_ld(&bar[XB_XCNT(j)]); sum += c; cnt += (c > 0u) ? 1u : 0u; mine = (j == x) ? c : mine; }
        if (sum == G) break;
        __builtin_amdgcn_s_sleep(1);
        if ((++sp & 255u) == 0u) { if (xb_ld(&bar[XB_TMO])) break; if (sp > XB_SPIN_CAP) { atomicAdd(&bar[XB_TMO], 1u); break; } }
    }
    nloc = mine > 0u ? mine : 1u; nx = cnt > 0u ? cnt : 1u;
}
__device__ __forceinline__ void xcd_barrier(const XcdBarrier& b, bool t0) {
    asm volatile("s_waitcnt vmcnt(0)" ::: "memory");
    __syncthreads();
    if (t0) {
        unsigned* bar = b.bar;
        __builtin_amdgcn_s_waitcnt(0);
        unsigned nloc = b.st[0], nx = b.st[1];
        if (nloc == 0u) { xcd_barrier_complete(bar, b.x, nloc, nx); b.st[0] = nloc; b.st[1] = nx; }
        const unsigned old = xb_add(&bar[XB_XSUB(b.x)], 1u);
        const unsigned gen = old / nloc;
        if (old + 1u == (gen + 1u) * nloc) {
            __builtin_amdgcn_fence(__ATOMIC_RELEASE, "agent");
            asm volatile("s_waitcnt vmcnt(0)" ::: "memory");
            const unsigned og = xb_add(&bar[XB_TOP], 1u);
            const unsigned tg = og / nx;
            if (og + 1u == (tg + 1u) * nx) xb_add(&bar[XB_TOPGEN], 1u);
            else XB_SPIN(xb_ld(&bar[XB_TOPGEN]) == tg, bar);
            __builtin_amdgcn_fence(__ATOMIC_ACQUIRE, "agent");
            xb_add(&bar[XB_XGEN(b.x)], 1u);
            asm volatile("s_waitcnt vmcnt(0)" ::: "memory");
        } else {
            XB_SPIN(xb_ld(&bar[XB_XGEN(b.x)]) == gen, bar);
            __builtin_amdgcn_fence(__ATOMIC_ACQUIRE, "agent");
            asm volatile("s_waitcnt vmcnt(0)" ::: "memory");
        }
    }
    __syncthreads();
}

constexpr int BM = 256, BK = 64, HALF = 128, HTB = HALF * BK * 2, NXCD = 8, WGM = 8;
__device__ __forceinline__ int lds_byte(int r, int c) { const int st = (r >> 4) * 2 + (c >> 5), rr = r & 15, cc = c & 31, ob = rr * 64 + cc * 2; return st * 1024 + (ob ^ (((ob >> 9) & 1) << 5)); }
__device__ __forceinline__ void stage_rc(int b, int& R, int& C) { const int st = b / 1024, sb = b % 1024, swz = sb ^ (((sb >> 9) & 1) << 5); R = (st >> 1) * 16 + swz / 64; C = (st & 1) * 32 + (swz % 64) / 2; }
__device__ __forceinline__ int perm32(int rho) { const int n = rho >> 4, i = rho & 15; return 8 * (i >> 2) + 4 * n + (i & 3); }

struct Unit { int pm, pn; };
struct Gemm { const bf16_t* A; const bf16_t* Bt; int lda, ldb, K; size_t a_pm, a_pn, b_pn, b_pb, a_pn2; };
__device__ __forceinline__ Gemm plain_gemm(const bf16_t* A, const bf16_t* Bt, int K) { Gemm g; g.A = A; g.Bt = Bt; g.lda = K; g.ldb = K; g.K = K; g.a_pm = (size_t)BM * K * 2; g.a_pn = 0; g.b_pn = (size_t)BM * K * 2; g.b_pb = 0; g.a_pn2 = 0; return g; }

struct StaticOrder {
    int nM, nN, nwg, G, c;
    __device__ void init(int nM_, int nN_, int G_, int c_) { nM = nM_; nN = nN_; nwg = nM * nN; G = G_; c = c_; }
    __device__ bool next(int i, Unit& u) const {
        const long L = (long)i * G + c; if (L >= nwg) return false;
        int wgid = (int)L; { const int q = nwg / NXCD, r = nwg % NXCD, xcd = wgid % NXCD, off = wgid / NXCD; wgid = (xcd < r ? xcd * (q + 1) : r * (q + 1) + (xcd - r) * q) + off; }
        const int nig = WGM * nN, gid = wgid / nig, fm = gid * WGM, gsz = (nM - fm) < WGM ? (nM - fm) : WGM;
        u.pm = fm + ((wgid % nig) % gsz); u.pn = (wgid % nig) / gsz; return true;
    }
};

typedef f32x4 Acc[2][2][4][2];

template <class Epi>
__device__ __forceinline__ void gemm_phase(LAS unsigned char* lds, const int wid, const Gemm g, const StaticOrder& S, const Epi& E) {
    const int lane = lane_id(), tid = wid * 64 + lane, wr = wid >> 2, wc = wid & 3, fr = lane & 15, fq = lane >> 4;
    const int nt = g.K / BK;
    unsigned voffA[2], voffB[2];
#pragma unroll
    for (int i = 0; i < 2; ++i) { int R, C; stage_rc(tid * 16 + i * 8192, R, C); const int Rb = Epi::PERM ? ((R & ~31) + perm32(R & 31)) : R;
        voffA[i] = (unsigned)(R * g.lda + C) * 2u; voffB[i] = (unsigned)(Rb * g.ldb + C) * 2u; }
    const size_t kstep = (size_t)(BK * 2);
    const size_t hstepA = (size_t)HALF * g.lda * 2, hstepB = (size_t)HALF * g.ldb * 2;
    const unsigned ldsw = (unsigned)wid * 1024u;
    const int aoff = lds_byte(wr * 64 + fr, fq * 8), boff = lds_byte(wc * 32 + fr, fq * 8);
#define PG8_SA(b, h) (((b) * 2 + (h)) * HTB)
#define PG8_SB(b, h) ((4 + (b) * 2 + (h)) * HTB)
#define PG8_STAGE(bufoff, gbase, voff) do { _Pragma("unroll") for (int _i = 0; _i < 2; ++_i) \
        __builtin_amdgcn_global_load_lds((const unsigned*)((const char*)(gbase) + (voff)[_i]), (LAS unsigned*)(lds + (bufoff) + ldsw + _i * 8192), 16, 0, 0); } while (0)
#define PG8_LDA(dst, b, h) do { _Pragma("unroll") for (int m = 0; m < 4; ++m) _Pragma("unroll") for (int k = 0; k < 2; ++k) dst[m][k] = *(const LAS bf16x8*)(lds + PG8_SA(b, h) + aoff + m * 2048 + k * 1024); } while (0)
#define PG8_LDB(dst, b, h) do { _Pragma("unroll") for (int n = 0; n < 2; ++n) _Pragma("unroll") for (int k = 0; k < 2; ++k) dst[n][k] = *(const LAS bf16x8*)(lds + PG8_SB(b, h) + boff + n * 2048 + k * 1024); } while (0)
#define PG8_MMA(ai, bj, At, Bt) do { __builtin_amdgcn_s_setprio(1); _Pragma("unroll") for (int m = 0; m < 4; ++m) _Pragma("unroll") for (int n = 0; n < 2; ++n) _Pragma("unroll") for (int k = 0; k < 2; ++k) \
        acc[ai][bj][m][n] = __builtin_amdgcn_mfma_f32_16x16x32_bf16(Bt[n][k], At[m][k], acc[ai][bj][m][n], 0, 0, 0); __builtin_amdgcn_s_setprio(0); } while (0)
#define PG8_WAIT_V(n) asm volatile("s_waitcnt vmcnt(" #n ")" ::: "memory")
#define PG8_WAIT_L(n) asm volatile("s_waitcnt lgkmcnt(" #n ")" ::: "memory")
#define PG8_BAR __builtin_amdgcn_s_barrier()
#define PG8_SCHED __builtin_amdgcn_sched_barrier(0)
#define PG8_UA(u) ((const char*)g.A + (size_t)(u).pm * g.a_pm + (size_t)(u).pn * g.a_pn + (size_t)((u).pn >> 1) * g.a_pn2)
#define PG8_UB(u) ((const char*)g.Bt + (size_t)(u).pn * g.b_pn + (size_t)((u).pm >> 3) * g.b_pb)
    Unit cur, nxt; int ui = 0;
    if (!S.next(0, cur)) return;
    Acc acc;
#pragma unroll
    for (int a = 0; a < 2; ++a)
#pragma unroll
        for (int b = 0; b < 2; ++b)
#pragma unroll
            for (int m = 0; m < 4; ++m)
#pragma unroll
                for (int n = 0; n < 2; ++n) acc[a][b][m][n] = (f32x4){0.f, 0.f, 0.f, 0.f};
    bf16x8 At[4][2], B0[2][2], B1[2][2];
    const char* cA = PG8_UA(cur); const char* cB = PG8_UB(cur);
    PG8_STAGE(PG8_SB(0, 0), cB, voffB); PG8_STAGE(PG8_SB(0, 1), cB + hstepB, voffB); PG8_STAGE(PG8_SA(0, 0), cA, voffA); PG8_STAGE(PG8_SA(0, 1), cA + hstepA, voffA);
    if (wr == 1) PG8_BAR;
    PG8_WAIT_V(2); PG8_BAR;
    PG8_STAGE(PG8_SB(1, 0), cB + kstep, voffB); PG8_STAGE(PG8_SA(1, 0), cA + kstep, voffA); PG8_STAGE(PG8_SB(1, 1), cB + hstepB + kstep, voffB);
    PG8_WAIT_V(6); PG8_BAR;
    for (;;) {
        const bool has_next = S.next(ui + 1, nxt);
        const char* nA = has_next ? PG8_UA(nxt) : cA; const char* nB = has_next ? PG8_UB(nxt) : cB;
        for (int t = 0; t < nt; t += 2) {
            const bool last = (t == nt - 2);
            const char* a1 = cA + (size_t)(t + 1) * kstep;
            const char* a2 = last ? nA : cA + (size_t)(t + 2) * kstep; const char* b2 = last ? nB : cB + (size_t)(t + 2) * kstep;
            const char* a3 = a2 + kstep; const char* b3 = b2 + kstep;
            PG8_LDB(B0, 0, 0); PG8_LDB(B1, 0, 1); PG8_SCHED; PG8_LDA(At, 0, 0); PG8_STAGE(PG8_SA(1, 1), a1 + hstepA, voffA);
            PG8_WAIT_V(8); PG8_WAIT_L(0); PG8_BAR; PG8_MMA(0, 0, At, B0); PG8_MMA(0, 1, At, B1); PG8_BAR; PG8_SCHED;
            PG8_LDA(At, 0, 1); PG8_STAGE(PG8_SB(0, 0), b2, voffB); PG8_STAGE(PG8_SB(0, 1), b2 + hstepB, voffB); PG8_STAGE(PG8_SA(0, 0), a2, voffA);
            PG8_WAIT_V(8); PG8_WAIT_L(0); PG8_BAR; PG8_MMA(1, 0, At, B0); PG8_MMA(1, 1, At, B1); PG8_BAR; PG8_SCHED;
            PG8_LDB(B0, 1, 0); PG8_LDB(B1, 1, 1); PG8_SCHED; PG8_LDA(At, 1, 0); PG8_STAGE(PG8_SA(0, 1), a2 + hstepA, voffA);
            PG8_WAIT_V(8); PG8_WAIT_L(0); PG8_BAR; PG8_MMA(0, 0, At, B0); PG8_MMA(0, 1, At, B1); PG8_BAR; PG8_SCHED;
            PG8_LDA(At, 1, 1); PG8_STAGE(PG8_SB(1, 0), b3, voffB); PG8_STAGE(PG8_SB(1, 1), b3 + hstepB, voffB); PG8_STAGE(PG8_SA(1, 0), a3, voffA);
            PG8_WAIT_V(8); PG8_WAIT_L(0); PG8_BAR; PG8_MMA(1, 0, At, B0); PG8_MMA(1, 1, At, B1); PG8_BAR; PG8_SCHED;
        }
        if (wr == 0) PG8_BAR;
        E(acc, cur, wr, wc, fr, fq);
        if (!has_next) break;
#pragma unroll
        for (int a = 0; a < 2; ++a)
#pragma unroll
            for (int b = 0; b < 2; ++b)
#pragma unroll
                for (int m = 0; m < 4; ++m)
#pragma unroll
                    for (int n = 0; n < 2; ++n) acc[a][b][m][n] = (f32x4){0.f, 0.f, 0.f, 0.f};
        cur = nxt; cA = nA; cB = nB; ++ui;
        if (wr == 1) PG8_BAR;
    }
    PG8_WAIT_V(0);
    PG8_BAR;
#undef PG8_SA
#undef PG8_SB
#undef PG8_STAGE
#undef PG8_LDA
#undef PG8_LDB
#undef PG8_MMA
#undef PG8_WAIT_V
#undef PG8_WAIT_L
#undef PG8_BAR
#undef PG8_SCHED
#undef PG8_UA
#undef PG8_UB
}

#define EPI_ROWS_BEGIN for (int ai = 0; ai < 2; ++ai) { _Pragma("unroll") for (int m = 0; m < 4; ++m) { const int r = u.pm * BM + ai * HALF + wr * 64 + m * 16 + fr;
#define EPI_ROWS_END } }

__device__ __forceinline__ float rstd_from16(const float* ss, int r) { return rsqrtf(ss[r] * (1.0f / 1024.0f) + NORM_EPS); }

struct EpiProj { static constexpr bool PERM = true;
    const float* rstd; const float* bias; bf16_t* PR; bf16_t* PX; bf16_t* PY;
    __device__ __forceinline__ void operator()(Acc& acc, const Unit& u, int wr, int wc, int fr, int fq) const {
        bf16_t* base; int ld, colt;
        if (u.pn < 7) { base = PR; ld = RW; colt = u.pn * 256; } else if (u.pn < 9) { base = PX; ld = 512; colt = (u.pn - 7) * 256; } else { base = PY; ld = 512; colt = (u.pn - 9) * 256; }
        const int col0 = colt + wc * 32 + 8 * fq, bcol0 = u.pn * 256 + wc * 32 + 8 * fq;
        f32x4 bv[2][2];
#pragma unroll
        for (int bj = 0; bj < 2; ++bj)
#pragma unroll
            for (int n = 0; n < 2; ++n) bv[bj][n] = *(const f32x4*)(bias + bcol0 + bj * HALF + 4 * n);
#pragma unroll
        EPI_ROWS_BEGIN
            const float rs = rstd[r]; bf16_t* rowp = base + (size_t)r * ld + col0;
#pragma unroll
            for (int bj = 0; bj < 2; ++bj) { const f32x4 v0 = acc[ai][bj][m][0] * rs + bv[bj][0], v1 = acc[ai][bj][m][1] * rs + bv[bj][1];
                u32x4 w; w.x = cvt_pk_bf16(v0[0], v0[1]); w.y = cvt_pk_bf16(v0[2], v0[3]); w.z = cvt_pk_bf16(v1[0], v1[1]); w.w = cvt_pk_bf16(v1[2], v1[3]);
                *(u32x4*)(rowp + bj * HALF) = w; }
        EPI_ROWS_END
    }
};
struct EpiGab { static constexpr bool PERM = true;
    const float* rstd; const float* bias; bf16_t* O; int cofs;
    __device__ __forceinline__ void operator()(Acc& acc, const Unit& u, int wr, int wc, int fr, int fq) const {
        const int col0 = cofs + u.pn * 256 + wc * 32 + 8 * fq;
        f32x4 bv[2][2];
#pragma unroll
        for (int bj = 0; bj < 2; ++bj)
#pragma unroll
            for (int n = 0; n < 2; ++n) bv[bj][n] = *(const f32x4*)(bias + col0 + bj * HALF + 4 * n);
#pragma unroll
        EPI_ROWS_BEGIN
            const float rs = rstd[r]; bf16_t* rowp = O + (size_t)r * 2048 + col0;
#pragma unroll
            for (int bj = 0; bj < 2; ++bj) { f32x4 v0 = acc[ai][bj][m][0] * rs + bv[bj][0], v1 = acc[ai][bj][m][1] * rs + bv[bj][1];
#pragma unroll
                for (int j = 0; j < 4; ++j) { v0[j] = sigmoidf_(v0[j]); v1[j] = sigmoidf_(v1[j]); }
                u32x4 w; w.x = cvt_pk_bf16(v0[0], v0[1]); w.y = cvt_pk_bf16(v0[2], v0[3]); w.z = cvt_pk_bf16(v1[0], v1[1]); w.w = cvt_pk_bf16(v1[2], v1[3]);
                *(u32x4*)(rowp + bj * HALF) = w; }
        EPI_ROWS_END
    }
};
struct EpiPlain { static constexpr bool PERM = true;
    bf16_t* O; int ldc;
    __device__ __forceinline__ void operator()(Acc& acc, const Unit& u, int wr, int wc, int fr, int fq) const {
        const int col0 = u.pn * 256 + wc * 32 + 8 * fq;
#pragma unroll
        EPI_ROWS_BEGIN
            bf16_t* rowp = O + (size_t)r * ldc + col0;
#pragma unroll
            for (int bj = 0; bj < 2; ++bj) { const f32x4 v0 = acc[ai][bj][m][0], v1 = acc[ai][bj][m][1];
                u32x4 w; w.x = cvt_pk_bf16(v0[0], v0[1]); w.y = cvt_pk_bf16(v0[2], v0[3]); w.z = cvt_pk_bf16(v1[0], v1[1]); w.w = cvt_pk_bf16(v1[2], v1[3]);
                *(u32x4*)(rowp + bj * HALF) = w; }
        EPI_ROWS_END
    }
};
struct EpiLora { static constexpr bool PERM = true;
    const float* w0; const float* a0; bf16_t* O;
    __device__ __forceinline__ void operator()(Acc& acc, const Unit& u, int wr, int wc, int fr, int fq) const {
        const int kind = u.pn >> 1, ch0 = (u.pn & 1) * 256 + wc * 32 + 8 * fq, col0 = u.pn * 256 + wc * 32 + 8 * fq;
        const float* bsrc = kind == 0 ? w0 : a0;
        f32x4 bv[2][2];
#pragma unroll
        for (int bj = 0; bj < 2; ++bj)
#pragma unroll
            for (int n = 0; n < 2; ++n) bv[bj][n] = kind < 2 ? *(const f32x4*)(bsrc + ch0 + bj * HALF + 4 * n) : (f32x4){0.f, 0.f, 0.f, 0.f};
        const float sc = kind == 0 ? 0.6065306597126334f : 1.0f;
#pragma unroll
        EPI_ROWS_BEGIN
            bf16_t* rowp = O + (size_t)r * 1536 + col0;
#pragma unroll
            for (int bj = 0; bj < 2; ++bj) { f32x4 v0 = acc[ai][bj][m][0] + bv[bj][0], v1 = acc[ai][bj][m][1] + bv[bj][1];
                if (kind < 2) {
#pragma unroll
                    for (int j = 0; j < 4; ++j) { v0[j] = sc * sigmoidf_(v0[j]); v1[j] = sc * sigmoidf_(v1[j]); } }
                u32x4 w; w.x = cvt_pk_bf16(v0[0], v0[1]); w.y = cvt_pk_bf16(v0[2], v0[3]); w.z = cvt_pk_bf16(v1[0], v1[1]); w.w = cvt_pk_bf16(v1[2], v1[3]);
                *(u32x4*)(rowp + bj * HALF) = w; }
        EPI_ROWS_END
    }
};
struct EpiRg { static constexpr bool PERM = true;
    const float* ba; const float* bx; const float* lam; const bf16_t* XBC; bf16_t* LA; bf16_t* U;
    __device__ __forceinline__ void operator()(Acc& acc, const Unit& u, int wr, int wc, int fr, int fq) const {
        const int ch0 = u.pn * 128 + wc * 32 + 8 * fq;
        float vba[8], vbx[8], vls[8];
#pragma unroll
        for (int j = 0; j < 8; ++j) { vba[j] = ba[ch0 + j]; vbx[j] = bx[ch0 + j]; vls[j] = -8.0f * log1pf(__expf(-lam[ch0 + j])); }
#pragma unroll
        EPI_ROWS_BEGIN
            const bool first = (r & (SEQ - 1)) == 0;
            float xb[8]; unpack8(*(const u32x4*)(XBC + (size_t)r * 512 + ch0), xb);
            float la[8], uu[8];
#pragma unroll
            for (int j = 0; j < 8; ++j) { const float ga = sigmoidf_(acc[ai][0][m][j >> 2][j & 3] + vba[j]), gx = sigmoidf_(acc[ai][1][m][j >> 2][j & 3] + vbx[j]);
                la[j] = vls[j] * ga; const float a = __expf(la[j]); const float mult = first ? 1.0f : sqrtf(fmaxf(1.0f - a * a, 0.f)); uu[j] = xb[j] * gx * mult; }
            *(u32x4*)(LA + (size_t)r * 512 + ch0) = pack8(la); *(u32x4*)(U + (size_t)r * 512 + ch0) = pack8(uu);
        EPI_ROWS_END
    }
};
template <bool FIRST> struct EpiBranch { static constexpr bool PERM = true;
    const bf16_t* G; bf16_t* M;
    __device__ __forceinline__ void operator()(Acc& acc, const Unit& u, int wr, int wc, int fr, int fq) const {
        const int col0 = u.pn * 256 + wc * 32 + 8 * fq;
#pragma unroll
        EPI_ROWS_BEGIN
#pragma unroll
            for (int bj = 0; bj < 2; ++bj) { const int c = col0 + bj * HALF;
                float gv[8]; unpack8(*(const u32x4*)(G + (size_t)r * 2048 + (FIRST ? 0 : 1024) + c), gv);
                float o[8];
                if (!FIRST) unpack8(*(const u32x4*)(M + (size_t)r * 1024 + c), o);
#pragma unroll
                for (int j = 0; j < 8; ++j) { const float p = acc[ai][bj][m][j >> 2][j & 3] * gv[j]; o[j] = FIRST ? p : o[j] + p; }
                *(u32x4*)(M + (size_t)r * 1024 + c) = pack8(o); }
        EPI_ROWS_END
    }
};
template <bool BASE_F32> struct EpiRes { static constexpr bool PERM = true;
    const void* base; bf16_t* XB; float* ssp;
    __device__ __forceinline__ void operator()(Acc& acc, const Unit& u, int wr, int wc, int fr, int fq) const {
        const int col0 = u.pn * 256 + wc * 32 + 8 * fq;
#pragma unroll
        EPI_ROWS_BEGIN
            float s = 0.f;
#pragma unroll
            for (int bj = 0; bj < 2; ++bj) { const size_t off = (size_t)r * 1024 + col0 + bj * HALF; float o[8];
                if (BASE_F32) { const f32x4 b0 = *(const f32x4*)((const float*)base + off), b1 = *(const f32x4*)((const float*)base + off + 4);
                    o[0] = b0[0]; o[1] = b0[1]; o[2] = b0[2]; o[3] = b0[3]; o[4] = b1[0]; o[5] = b1[1]; o[6] = b1[2]; o[7] = b1[3]; }
                else unpack8(*(const u32x4*)((const bf16_t*)base + off), o);
#pragma unroll
                for (int j = 0; j < 8; ++j) { o[j] += acc[ai][bj][m][j >> 2][j & 3]; s += o[j] * o[j]; }
                *(u32x4*)(XB + off) = pack8(o); }
            s += __shfl_xor(s, 16); s += __shfl_xor(s, 32);
            if (fq == 0) atomicAdd(ssp + r, s);
        EPI_ROWS_END
    }
};
struct EpiQ { static constexpr bool PERM = true;
    const float* ssp; bf16_t* O;
    __device__ __forceinline__ void operator()(Acc& acc, const Unit& u, int wr, int wc, int fr, int fq) const {
        const int col0 = u.pn * 256 + wc * 32 + 8 * fq;
#pragma unroll
        EPI_ROWS_BEGIN
            const float rs = rstd_from16(ssp, r) * 0.0625f; bf16_t* rowp = O + (size_t)r * 1024 + col0;
#pragma unroll
            for (int bj = 0; bj < 2; ++bj) { const f32x4 v0 = acc[ai][bj][m][0] * rs, v1 = acc[ai][bj][m][1] * rs;
                u32x4 w; w.x = cvt_pk_bf16(v0[0], v0[1]); w.y = cvt_pk_bf16(v0[2], v0[3]); w.z = cvt_pk_bf16(v1[0], v1[1]); w.w = cvt_pk_bf16(v1[2], v1[3]);
                *(u32x4*)(rowp + bj * HALF) = w; }
        EPI_ROWS_END
    }
};
struct EpiSc { static constexpr bool PERM = true;
    bf16_t* O; float* ssp;
    __device__ __forceinline__ void operator()(Acc& acc, const Unit& u, int wr, int wc, int fr, int fq) const {
        const int col0 = u.pn * 256 + wc * 32 + 8 * fq;
#pragma unroll
        EPI_ROWS_BEGIN
            bf16_t* rowp = O + (size_t)r * 1024 + col0; float s = 0.f;
#pragma unroll
            for (int bj = 0; bj < 2; ++bj) { f32x4 v0 = acc[ai][bj][m][0], v1 = acc[ai][bj][m][1];
#pragma unroll
                for (int j = 0; j < 4; ++j) { v0[j] = __expf(v0[j]); v1[j] = __expf(v1[j]); }
                s += ((v0[0] + v0[1]) + (v0[2] + v0[3])) + ((v1[0] + v1[1]) + (v1[2] + v1[3]));
                u32x4 w; w.x = cvt_pk_bf16(v0[0], v0[1]); w.y = cvt_pk_bf16(v0[2], v0[3]); w.z = cvt_pk_bf16(v1[0], v1[1]); w.w = cvt_pk_bf16(v1[2], v1[3]);
                *(u32x4*)(rowp + bj * HALF) = w; }
            s += __shfl_xor(s, 16); s += __shfl_xor(s, 32);
            if (fq == 0) ssp[(size_t)r * 16 + u.pn * 4 + wc] = s;
        EPI_ROWS_END
    }
};
struct EpiPv { static constexpr bool PERM = true;
    const float* ssp; bf16_t* O;
    __device__ __forceinline__ void operator()(Acc& acc, const Unit& u, int wr, int wc, int fr, int fq) const {
        const int col0 = u.pn * 256 + wc * 32 + 8 * fq;
#pragma unroll
        EPI_ROWS_BEGIN
            const f32x4 sp = *(const f32x4*)(ssp + (size_t)r * 16 + u.pn * 4); const float rs = 1.0f / ((sp.x + sp.y) + (sp.z + sp.w));
            bf16_t* rowp = O + (size_t)r * 1024 + col0;
#pragma unroll
            for (int bj = 0; bj < 2; ++bj) { const f32x4 v0 = acc[ai][bj][m][0] * rs, v1 = acc[ai][bj][m][1] * rs;
                u32x4 w; w.x = cvt_pk_bf16(v0[0], v0[1]); w.y = cvt_pk_bf16(v0[2], v0[3]); w.z = cvt_pk_bf16(v1[0], v1[1]); w.w = cvt_pk_bf16(v1[2], v1[3]);
                *(u32x4*)(rowp + bj * HALF) = w; }
        EPI_ROWS_END
    }
};
__device__ __forceinline__ float dpp_ror1(float v) { return __int_as_float(__builtin_amdgcn_update_dpp(0, __float_as_int(v), 0x121, 0xf, 0xf, false)); }
__device__ __forceinline__ float dpp_ror2(float v) { return __int_as_float(__builtin_amdgcn_update_dpp(0, __float_as_int(v), 0x122, 0xf, 0xf, false)); }
struct EpiFfnAct { static constexpr bool PERM = true;
    const float* ssp; const float* cw; const float* cb; bf16_t* ACT; bf16_t* HG;
    __device__ __forceinline__ void operator()(Acc& acc, const Unit& u, int wr, int wc, int fr_, int fq_) const {
        const int l_ = lane_id(), fr = l_ & 15, fq = l_ >> 4;
        const int col0 = u.pn * 128 + wc * 32 + 8 * fq;
#pragma unroll
        for (int ai = 0; ai < 2; ++ai) {
            const int rbase = u.pm * BM + ai * HALF + wr * 64 + fr;
            float rs[4];
#pragma unroll
            for (int m = 0; m < 4; ++m) rs[m] = rstd_from16(ssp, rbase + m * 16);
            const size_t grp = (size_t)(rbase >> 6);
            if (fr < 2) { float t[8];
#pragma unroll
                for (int j = 0; j < 8; ++j) t[j] = acc[ai][0][0][j >> 2][j & 3] * rs[0];
                *(u32x4*)(HG + (grp * 4 + 2 + fr) * DFF + col0) = pack8(t); }
            if (fr >= 14) { float t[8];
#pragma unroll
                for (int j = 0; j < 8; ++j) t[j] = acc[ai][0][3][j >> 2][j & 3] * rs[3];
                *(u32x4*)(HG + (grp * 4 + (fr - 14)) * DFF + col0) = pack8(t); }
#pragma unroll
            for (int j = 0; j < 8; ++j) {
                const float w0 = cw[col0 + j], w1 = cw[DFF + col0 + j], w2 = cw[2 * DFF + col0 + j], b0 = cb[col0 + j];
                float g[4], r1[4], r2[4];
#pragma unroll
                for (int m = 0; m < 4; ++m) { g[m] = acc[ai][0][m][j >> 2][j & 3] * rs[m]; r1[m] = dpp_ror1(g[m]); r2[m] = dpp_ror2(g[m]); }
#pragma unroll
                for (int m = 0; m < 4; ++m) {
                    const float p1 = fr >= 1 ? r1[m] : r1[m > 0 ? m - 1 : 0], p2 = fr >= 2 ? r2[m] : r2[m > 0 ? m - 1 : 0];
                    const float up = acc[ai][1][m][j >> 2][j & 3] * rs[m];
                    const float gate = b0 + w0 * p2 + w1 * p1 + w2 * g[m];
                    acc[ai][1][m][j >> 2][j & 3] = (m == 0 && fr < 2) ? up : gelu_tanh(gate) * up;
                }
            }
#pragma unroll
            for (int m = 0; m < 4; ++m) { const f32x4 v0 = acc[ai][1][m][0], v1 = acc[ai][1][m][1];
                u32x4 w; w.x = cvt_pk_bf16(v0[0], v0[1]); w.y = cvt_pk_bf16(v0[2], v0[3]); w.z = cvt_pk_bf16(v1[0], v1[1]); w.w = cvt_pk_bf16(v1[2], v1[3]);
                *(u32x4*)(ACT + (size_t)(rbase + m * 16) * DFF + col0) = w; }
        }
    }
};

struct Args { const float* in[37]; float* out; unsigned char* ws; int ph_lo, ph_hi; };
enum { I_X = 0, I_MEM, I_NMIXG, I_WIN, I_BIN, I_MU, I_W0, I_WUP, I_A0, I_AUP, I_GUP, I_KK, I_KA, I_RK, I_LNXG, I_LNXB, I_WBA, I_CBW, I_CBB, I_WRGA, I_BRGA, I_WRGX, I_BRGX,
       I_LAM, I_WBB, I_WMIX, I_NXG, I_NMEMG, I_WCQ, I_WCKV, I_WCO, I_NFFNG, I_WFFI, I_FCW, I_FCB, I_WFFO, I_NFING };

__device__ __forceinline__ void transpose_item(const float* W, int ldw, int K, bf16_t* WT, int ldd, const float* gain, int map, int srcofs, LAS float* scr, int item, int lane) {
    const int nkb = K / 64, nb = item / nkb, kb = item % nkb, k0 = 64 * kb, n0 = 32 * nb;
    int ns = n0 + srcofs;
    if (map == 1) { const int tile = n0 >> 8, c = n0 & 255; ns = c < 128 ? tile * 128 + c : DFF + tile * 128 + (c - 128); }
#pragma unroll
    for (int i = 0; i < 32; ++i) { const int kk = 2 * i + (lane >> 5); float v = W[(size_t)(k0 + kk) * ldw + ns + (lane & 31)]; if (gain) v *= gain[k0 + kk]; scr[kk * 33 + (lane & 31)] = v; }
    asm volatile("s_waitcnt lgkmcnt(0)" ::: "memory");
    const int c = lane & 7;
#pragma unroll
    for (int j = 0; j < 4; ++j) { const int n = (lane >> 3) + 8 * j; const LAS float* s = scr + (8 * c) * 33 + n;
        u32x4 o; o.x = cvt_pk_bf16(s[0 * 33], s[1 * 33]); o.y = cvt_pk_bf16(s[2 * 33], s[3 * 33]); o.z = cvt_pk_bf16(s[4 * 33], s[5 * 33]); o.w = cvt_pk_bf16(s[6 * 33], s[7 * 33]);
        *(u32x4*)(WT + (size_t)(n0 + n) * ldd + k0 + 8 * c) = o; }
    asm volatile("s_waitcnt lgkmcnt(0)" ::: "memory");
}

__device__ __forceinline__ void phase_prep(const Args& a, LAS unsigned char* lds, int wave, int G) {
    const int lane = lane_id();
    unsigned char* ws = a.ws;
    LAS float* scr = (LAS float*)(lds + wave * 16384);
    const int gw = blockIdx.x * 8 + wave, NGW = G * 8;
#define TITEMS(K_, Nd_) (((K_) / 64) * ((Nd_) / 32))
#define TJOB(W_, ldw_, K_, Nd_, dst_, gain_, map_, srcofs_) if (r < TITEMS(K_, Nd_)) { transpose_item((W_), (ldw_), (K_), (bf16_t*)(ws + (dst_)), (K_), (gain_), (map_), (srcofs_), scr, r, lane); continue; } r -= TITEMS(K_, Nd_);
    constexpr int NITEMS_ALL = TITEMS(1024, PIN) + 2 * TITEMS(512, 1024) + 5 * TITEMS(1024, 1024) + TITEMS(1024, 2 * DFF) + TITEMS(DFF, 1024);
    for (int it = gw; it < NITEMS_ALL; it += NGW) {
        int r = it;
        TJOB(a.in[I_WFFI], 2 * DFF, 1024, 2 * DFF, WS_WFFI, a.in[I_NFFNG], 1, 0)
        TJOB(a.in[I_WIN], PIN, 1024, PIN, WS_WIN, a.in[I_NMIXG], 0, 0)
        TJOB(a.in[I_WFFO], 1024, DFF, 1024, WS_WFFO, nullptr, 0, 0)
        TJOB(a.in[I_WMIX], 1024, 1024, 1024, WS_WMIX, nullptr, 0, 0)
        TJOB(a.in[I_WCQ], 1024, 1024, 1024, WS_WCQ, a.in[I_NXG], 0, 0)
        TJOB(a.in[I_WCKV], 2048, 1024, 1024, WS_WK, nullptr, 0, 0)
        TJOB(a.in[I_WCKV], 2048, 1024, 1024, WS_WV, nullptr, 0, 1024)
        TJOB(a.in[I_WCO], 1024, 1024, 1024, WS_WCO, nullptr, 0, 0)
        TJOB(a.in[I_WBA], 1024, 512, 1024, WS_WA, nullptr, 0, 0)
        TJOB(a.in[I_WBB], 1024, 512, 1024, WS_WB, nullptr, 0, 0)
    }
#undef TJOB
#undef TITEMS
    { float* z1 = (float*)(ws + WS_SSP1); float* z2 = (float*)(ws + WS_SSP2); float* z3 = (float*)(ws + WS_SSP3);
      for (int i = blockIdx.x * 512 + wave * 64 + lane; i < T; i += G * 512) { z1[i] = 0.f; z2[i] = 0.f; z3[i] = 0.f; } }
    const int gid = blockIdx.x * 512 + wave * 64 + lane, NT = G * 512;
    { bf16_t* WL = (bf16_t*)(ws + WS_WLORA);
      for (int i = gid; i < 1536 * 256; i += NT) { const int n = i >> 8, k = i & 255, kind = n >> 9, c = n & 511; float v = 0.f;
          if (kind == 0 && k < 64) v = a.in[I_WUP][k * 512 + c]; else if (kind == 1 && k >= 64 && k < 128) v = a.in[I_AUP][(k - 64) * 512 + c]; else if (kind == 2 && k >= 128) v = a.in[I_GUP][(k - 128) * 512 + c];
          WL[i] = f2bf(v); } }
    { bf16_t* WR = (bf16_t*)(ws + WS_WRG);
      for (int i = gid; i < 1024 * 256; i += NT) { const int n = i >> 8, kk = i & 255, pn = n >> 8, c = n & 255, ch = pn * 128 + (c & 127), hb = ch >> 6, j = ch & 63, k = 256 * (pn >> 1) + kk; float v = 0.f;
          if ((k >> 6) == hb) v = (c < 128 ? a.in[I_WRGA] : a.in[I_WRGX])[(hb * 64 + (k & 63)) * 64 + j];
          WR[i] = f2bf(v); } }
    { const float* x = a.in[I_X]; bf16_t* XB = (bf16_t*)(ws + WS_XB); float* rstd = (float*)(ws + WS_RSTDX);
      for (int r0 = gw; r0 < T; r0 += 4 * NGW) {
          f32x4 v[4][4]; float s[4];
#pragma unroll
          for (int q = 0; q < 4; ++q) { const int r = r0 + q * NGW; s[q] = 0.f; if (r < T) { const f32x4* xr = (const f32x4*)(x + (size_t)r * D) + lane;
#pragma unroll
              for (int j = 0; j < 4; ++j) v[q][j] = xr[64 * j]; } else {
#pragma unroll
              for (int j = 0; j < 4; ++j) v[q][j] = (f32x4){0.f, 0.f, 0.f, 0.f}; } }
#pragma unroll
          for (int q = 0; q < 4; ++q) {
#pragma unroll
              for (int j = 0; j < 4; ++j) s[q] += (v[q][j].x * v[q][j].x + v[q][j].y * v[q][j].y) + (v[q][j].z * v[q][j].z + v[q][j].w * v[q][j].w);
              s[q] = wave_sum(s[q]); }
#pragma unroll
          for (int q = 0; q < 4; ++q) { const int r = r0 + q * NGW; if (r < T) { if (lane == 0) rstd[r] = rsqrtf(s[q] * (1.0f / D) + NORM_EPS);
              u32x2* o = (u32x2*)(XB + (size_t)r * D) + lane;
#pragma unroll
              for (int j = 0; j < 4; ++j) { u32x2 w; w.x = cvt_pk_bf16(v[q][j].x, v[q][j].y); w.y = cvt_pk_bf16(v[q][j].z, v[q][j].w); o[64 * j] = w; } } } } }
    { const float* x = a.in[I_MEM]; bf16_t* XB = (bf16_t*)(ws + WS_MEMN); const float* g = a.in[I_NMEMG];
      for (int r0 = gw; r0 < TM; r0 += 4 * NGW) {
          f32x4 v[4][4]; float sq[4];
#pragma unroll
          for (int q = 0; q < 4; ++q) { const int r = r0 + q * NGW; const f32x4* xr = (const f32x4*)(x + (size_t)(r < TM ? r : r0) * D) + lane;
#pragma unroll
              for (int j = 0; j < 4; ++j) v[q][j] = xr[64 * j]; }
#pragma unroll
          for (int q = 0; q < 4; ++q) { float t = 0.f;
#pragma unroll
              for (int j = 0; j < 4; ++j) t += (v[q][j].x * v[q][j].x + v[q][j].y * v[q][j].y) + (v[q][j].z * v[q][j].z + v[q][j].w * v[q][j].w);
              sq[q] = wave_sum(t); }
#pragma unroll
          for (int q = 0; q < 4; ++q) { const int r = r0 + q * NGW; if (r < TM) { const float rs = rsqrtf(sq[q] * (1.0f / D) + NORM_EPS); u32x2* o = (u32x2*)(XB + (size_t)r * D) + lane;
#pragma unroll
              for (int j = 0; j < 4; ++j) { const f32x4 gg = ((const f32x4*)g)[lane + 64 * j]; u32x2 w; w.x = cvt_pk_bf16(v[q][j].x * rs * gg.x, v[q][j].y * rs * gg.y); w.y = cvt_pk_bf16(v[q][j].z * rs * gg.z, v[q][j].w * rs * gg.w); o[64 * j] = w; } } } } }
}

__device__ __forceinline__ float tanh_fast(float v) { return 1.0f - 2.0f * __builtin_amdgcn_rcpf(__expf(2.0f * v) + 1.0f); }
__device__ __forceinline__ void phase_elem2(const Args& a, int wave, int G) {
    unsigned char* ws = a.ws;
    const bf16_t* PR = (const bf16_t*)(ws + WS_PR); const bf16_t* PX = (const bf16_t*)(ws + WS_PX);
    bf16_t* LIN = (bf16_t*)(ws + WS_LIN); bf16_t* XBC = (bf16_t*)(ws + WS_XBC);
    const size_t gid = (size_t)blockIdx.x * 512 + wave * 64 + lane_id(), NT = (size_t)G * 512;
    {
        const int c = (int)(gid & 31) * 8; float mu[8];
#pragma unroll
        for (int j = 0; j < 8; ++j) mu[j] = a.in[I_MU][1536 + c + j];
        const size_t N = (size_t)T * 32;
        for (size_t i0 = gid; i0 < N; i0 += 4 * NT) {
            u32x4 P[4], Q[4]; bool hp[4], ok[4];
#pragma unroll
            for (int u = 0; u < 4; ++u) { const size_t i = i0 + u * NT; ok[u] = i < N; const int t = (int)((ok[u] ? i : i0) >> 5); hp[u] = (t & (SEQ - 1)) != 0;
                P[u] = *(const u32x4*)(PR + (size_t)t * RW + 1536 + c); Q[u] = *(const u32x4*)(PR + (size_t)(hp[u] ? t - 1 : t) * RW + 1536 + c); }
#pragma unroll
            for (int u = 0; u < 4; ++u) { const size_t i = i0 + u * NT; if (!ok[u]) continue; const int t = (int)(i >> 5);
                float p[8], pp[8], o[8]; unpack8(P[u], p); unpack8(Q[u], pp);
#pragma unroll
                for (int j = 0; j < 8; ++j) { const float q = hp[u] ? pp[j] : 0.f; const float v = p[j] + (q - p[j]) * mu[j]; o[j] = c < 64 ? tanh_fast(v) : (c < 128 ? v : sigmoidf_(v)); }
                *(u32x4*)(LIN + (size_t)t * 256 + c) = pack8(o); }
        }
    }
    {
        const int c = (int)(gid & 63) * 8; float w[4][8], b0[8];
#pragma unroll
        for (int j = 0; j < 8; ++j) { b0[j] = a.in[I_CBB][c + j];
#pragma unroll
            for (int k = 0; k < 4; ++k) w[k][j] = a.in[I_CBW][k * 512 + c + j]; }
        const size_t N = (size_t)T * 64;
        for (size_t i0 = gid; i0 < N; i0 += 4 * NT) {
            u32x4 X[4][4]; bool ok[4]; int tl[4];
#pragma unroll
            for (int u = 0; u < 4; ++u) { const size_t i = i0 + u * NT; ok[u] = i < N; const int t = (int)((ok[u] ? i : i0) >> 6); tl[u] = t & (SEQ - 1);
#pragma unroll
                for (int k = 0; k < 4; ++k) { const int dt = 3 - k; X[u][k] = *(const u32x4*)(PX + (size_t)(tl[u] >= dt ? t - dt : t) * 512 + c); } }
#pragma unroll
            for (int u = 0; u < 4; ++u) { const size_t i = i0 + u * NT; if (!ok[u]) continue; const int t = (int)(i >> 6);
                float o[8];
#pragma unroll
                for (int j = 0; j < 8; ++j) o[j] = b0[j];
#pragma unroll
                for (int k = 0; k < 4; ++k) { float p[8]; unpack8(X[u][k], p); const bool in = tl[u] >= 3 - k;
#pragma unroll
                    for (int j = 0; j < 8; ++j) o[j] += in ? p[j] * w[k][j] : 0.f; }
                *(u32x4*)(XBC + (size_t)t * 512 + c) = pack8(o); }
        }
    }
}

#define DPP_BC(JJ) " row_newbcast:" #JJ " row_mask:0xf bank_mask:0xf"
#define RW_SA(JJ)  asm("v_fmac_f32_dpp %0, %1, %2" DPP_BC(JJ) : "+v"(sacc[JJ & 3]) : "v"(va), "v"(S[JJ]));
#define RW_T1(JJ) { asm("v_mul_f32_dpp %0, %1, %2" DPP_BC(JJ) : "=v"(Tn[JJ]) : "v"(vw), "v"(S[JJ])); \
    asm("v_fmac_f32_dpp %0, %1, %2" DPP_BC(JJ) : "+v"(Tn[JJ]) : "v"(vk), "v"(vv)); }
#define RW_T2(JJ) { asm("v_fmac_f32_dpp %0, %1, %2" DPP_BC(JJ) : "+v"(Tn[JJ]) : "v"(vb), "v"(sa)); \
    S[JJ] = Tn[JJ]; \
    asm("v_fmac_f32_dpp %0, %1, %2" DPP_BC(JJ) : "+v"(yacc[JJ & 3]) : "v"(vr), "v"(S[JJ])); }
#define RW_ALL16(M) M(0) M(1) M(2) M(3) M(4) M(5) M(6) M(7) M(8) M(9) M(10) M(11) M(12) M(13) M(14) M(15)

constexpr int RB = 32;
constexpr int PSTEP = 6 * 64;
constexpr int PBUF = RB * PSTEP * 4;

__device__ __forceinline__ float dpp_ror_add(float v, const int ctrl_sel) {
    int t;
    switch (ctrl_sel) {
        case 8: t = __builtin_amdgcn_update_dpp(0, __float_as_int(v), 0x128, 0xf, 0xf, false); break;
        case 4: t = __builtin_amdgcn_update_dpp(0, __float_as_int(v), 0x124, 0xf, 0xf, false); break;
        case 2: t = __builtin_amdgcn_update_dpp(0, __float_as_int(v), 0x122, 0xf, 0xf, false); break;
        default: t = __builtin_amdgcn_update_dpp(0, __float_as_int(v), 0x121, 0xf, 0xf, false); break;
    }
    return v + __int_as_float(t);
}
__device__ __forceinline__ float cross_row_allsum(float v) {
    auto r = __builtin_amdgcn_permlane32_swap(__float_as_uint(v), __float_as_uint(v), false, false);
    v = __uint_as_float(r[0]) + __uint_as_float(r[1]);
    auto r2 = __builtin_amdgcn_permlane16_swap(__float_as_uint(v), __float_as_uint(v), false, false);
    return __uint_as_float(r2[0]) + __uint_as_float(r2[1]);
}
__device__ __forceinline__ float wave_allsum(float v) {
    v = dpp_ror_add(v, 8); v = dpp_ror_add(v, 4); v = dpp_ror_add(v, 2); v = dpp_ror_add(v, 1);
    return cross_row_allsum(v);
}
__device__ __forceinline__ void lds_barrier() { asm volatile("s_waitcnt lgkmcnt(0)" ::: "memory"); __builtin_amdgcn_s_barrier(); asm volatile("" ::: "memory"); }

constexpr int NPS = RB / 4;
__device__ __forceinline__ void prod_load(const Args& a, bf16_t (&raw)[NPS][8], int tok0, int h, int p, int lane) {
    const bf16_t* PR = (const bf16_t*)(a.ws + WS_PR); const bf16_t* LOUT = (const bf16_t*)(a.ws + WS_LOUT);
#pragma unroll
    for (int i = 0; i < NPS; ++i) { const int tok = tok0 + p + 4 * i; const bool has_prev = (tok & (SEQ - 1)) != 0;
        const bf16_t* prow = PR + (size_t)tok * RW + h * 64 + lane; const bf16_t* qrow = has_prev ? prow - RW : prow; const bf16_t* lrow = LOUT + (size_t)tok * 1536 + h * 64 + lane;
        raw[i][0] = prow[0]; raw[i][1] = prow[512]; raw[i][2] = prow[1024]; raw[i][3] = qrow[0]; raw[i][4] = qrow[512]; raw[i][5] = qrow[1024]; raw[i][6] = lrow[0]; raw[i][7] = lrow[512]; }
}
__device__ __forceinline__ void prod_compute(const Args& a, const bf16_t (&raw)[NPS][8], LAS float* pb, int tok0, int h, int p, int lane, float mu_r, float mu_k, float mu_v, float ckk, float cka, float crk) {
    float* BON = (float*)(a.ws + WS_BON);
#pragma unroll
    for (int i = 0; i < NPS; ++i) { const int s = p + 4 * i, tok = tok0 + s; const bool has_prev = (tok & (SEQ - 1)) != 0;
        const float rr = bf1(raw[i][0]), kr = bf1(raw[i][1]), vr_ = bf1(raw[i][2]);
        const float rp = has_prev ? bf1(raw[i][3]) : 0.f, kp = has_prev ? bf1(raw[i][4]) : 0.f, vp = has_prev ? bf1(raw[i][5]) : 0.f;
        const float e = bf1(raw[i][6]), av = bf1(raw[i][7]);
        const float r = rr + (rp - rr) * mu_r, k0 = kr + (kp - kr) * mu_k, v = vr_ + (vp - vr_) * mu_v;
        const float w = __expf(-e);
        const float kk = k0 * ckk; const float n2 = wave_allsum(kk * kk); const float kkn = kk * rsqrtf(fmaxf(n2, 1e-24f));
        const float k2 = k0 * (1.0f + (av - 1.0f) * cka);
        const float bon = wave_allsum(r * k2 * crk);
        LAS float* pp = pb + s * PSTEP;
        pp[lane] = -kkn; pp[64 + lane] = kkn * av; pp[128 + lane] = k2; pp[192 + lane] = w; pp[256 + lane] = r; pp[320 + lane] = v;
        if (lane == 0) BON[(size_t)tok * 8 + h] = bon; }
}

__device__ __forceinline__ void phase_scan(const Args& a, LAS unsigned char* lds, int wave, int G) {
    const int lane = lane_id();
    unsigned char* ws = a.ws;
    constexpr int SB = 16, NBLK = SEQ / RB;
    for (int pair = blockIdx.x; pair < 256; pair += G) {
        const int b = pair >> 3, h = pair & 7, tokb = b * SEQ;
        if (wave < 4) {
            const int il = lane & 15, irow = 16 * wave + il;
            float S[16];
#pragma unroll
            for (int j = 0; j < 16; ++j) S[j] = 0.f;
            bf16_t* YRAW = (bf16_t*)(ws + WS_YRAW);
            lds_barrier();
            for (int blk = 0; blk < NBLK; ++blk) {
                const LAS float* pb = (const LAS float*)(lds + (blk & 1) * PBUF);
#pragma unroll 2
                for (int s = 0; s < RB; ++s) {
                    const LAS float* pp = pb + s * PSTEP;
                    float va = pp[lane], vb = pp[64 + lane], vk = pp[128 + lane], vw = pp[192 + lane], vr = pp[256 + lane]; const float vv = pp[320 + irow];
                    asm volatile("s_nop 1" : "+v"(va), "+v"(vb), "+v"(vk), "+v"(vw), "+v"(vr));
                    float sacc[4] = {0.f, 0.f, 0.f, 0.f}, yacc[4] = {0.f, 0.f, 0.f, 0.f};
                    RW_ALL16(RW_SA)
                    float sa = (sacc[0] + sacc[1]) + (sacc[2] + sacc[3]);
                    float Tn[16];
                    RW_ALL16(RW_T1)
                    sa = cross_row_allsum(sa);
                    RW_ALL16(RW_T2)
                    float y = (yacc[0] + yacc[1]) + (yacc[2] + yacc[3]);
                    y = cross_row_allsum(y);
                    const int tok = tokb + blk * RB + s;
                    YRAW[(size_t)tok * 512 + h * 64 + irow] = f2bf(y);
                }
                lds_barrier();
            }
        } else {
            const float mu_r = a.in[I_MU][h * 64 + lane], mu_k = a.in[I_MU][512 + h * 64 + lane], mu_v = a.in[I_MU][1024 + h * 64 + lane];
            const float ckk = a.in[I_KK][h * 64 + lane], cka = a.in[I_KA][h * 64 + lane], crk = a.in[I_RK][h * 64 + lane];
            const size_t base = (size_t)tokb * 512 + h * 64 + lane;
            const bf16_t* LA = (const bf16_t*)(ws + WS_RGLA) + base; const bf16_t* U = (const bf16_t*)(ws + WS_RGU) + base; const bf16_t* PY = (const bf16_t*)(ws + WS_PY) + base;
            bf16_t* YB = (bf16_t*)(ws + WS_YB) + base;
            bf16_t cla[SB], cu[SB], cpy[SB]; float hh = 0.f;
#pragma unroll
            for (int s = 0; s < SB; ++s) { cla[s] = 0; cu[s] = 0; cpy[s] = 0; }
            if (wave == 4) {
#pragma unroll
                for (int s = 0; s < SB; ++s) { cla[s] = LA[(size_t)s * 512]; cu[s] = U[(size_t)s * 512]; cpy[s] = PY[(size_t)s * 512]; }
            }
            bf16_t raw[NPS][8];
            prod_load(a, raw, tokb, h, wave - 4, lane); prod_compute(a, raw, (LAS float*)lds, tokb, h, wave - 4, lane, mu_r, mu_k, mu_v, ckk, cka, crk); prod_load(a, raw, tokb + RB, h, wave - 4, lane);
            lds_barrier();
            for (int blk = 0; blk < NBLK; ++blk) {
                if (blk + 1 < NBLK) { prod_compute(a, raw, (LAS float*)(lds + ((blk + 1) & 1) * PBUF), tokb + (blk + 1) * RB, h, wave - 4, lane, mu_r, mu_k, mu_v, ckk, cka, crk);
                    if (blk + 2 < NBLK) prod_load(a, raw, tokb + (blk + 2) * RB, h, wave - 4, lane); }
                if (wave == 4) {
                    for (int sub = 0; sub < RB / SB; ++sub) {
                        const int t0 = blk * RB + sub * SB, tn = (t0 + SB < SEQ) ? t0 + SB : t0;
                        bf16_t nla[SB], nu[SB], npy[SB];
#pragma unroll
                        for (int s = 0; s < SB; ++s) { nla[s] = LA[(size_t)(tn + s) * 512]; nu[s] = U[(size_t)(tn + s) * 512]; npy[s] = PY[(size_t)(tn + s) * 512]; }
#pragma unroll
                        for (int s = 0; s < SB; ++s) { hh = __expf(bf1(cla[s])) * hh + bf1(cu[s]); YB[(size_t)(t0 + s) * 512] = f2bf(hh * gelu_tanh(bf1(cpy[s]))); }
#pragma unroll
                        for (int s = 0; s < SB; ++s) { cla[s] = nla[s]; cu[s] = nu[s]; cpy[s] = npy[s]; }
                    }
                }
                lds_barrier();
            }
        }
    }
    asm volatile("s_waitcnt vmcnt(0)" ::: "memory");
}

__device__ __forceinline__ void phase_post(const Args& a, int wave, int G) {
    unsigned char* ws = a.ws;
    const bf16_t* PR = (const bf16_t*)(ws + WS_PR); const bf16_t* LOUT = (const bf16_t*)(ws + WS_LOUT); const bf16_t* YRAW = (const bf16_t*)(ws + WS_YRAW);
    const float* BON = (const float*)(ws + WS_BON); bf16_t* YA = (bf16_t*)(ws + WS_YA);
    const size_t gid = (size_t)blockIdx.x * 512 + wave * 64 + lane_id(), NT = (size_t)G * 512;
    const int c = (int)(gid & 63) * 8, h = c >> 6; float mu[8], lg[8], lb[8];
#pragma unroll
    for (int j = 0; j < 8; ++j) { mu[j] = a.in[I_MU][1024 + c + j]; lg[j] = a.in[I_LNXG][c + j]; lb[j] = a.in[I_LNXB][c + j]; }
    const size_t N = (size_t)T * 64;
    for (size_t i0 = gid; i0 < N; i0 += 4 * NT) {
        u32x4 Y[4], V[4], VP[4], GG[4]; float bn[4]; bool ok[4], hp[4];
#pragma unroll
        for (int u = 0; u < 4; ++u) { const size_t i = i0 + u * NT; ok[u] = i < N; const int t = (int)((ok[u] ? i : i0) >> 6); hp[u] = (t & (SEQ - 1)) != 0;
            Y[u] = *(const u32x4*)(YRAW + (size_t)t * 512 + c); V[u] = *(const u32x4*)(PR + (size_t)t * RW + 1024 + c); VP[u] = *(const u32x4*)(PR + (size_t)(hp[u] ? t - 1 : t) * RW + 1024 + c);
            GG[u] = *(const u32x4*)(LOUT + (size_t)t * 1536 + 1024 + c); bn[u] = BON[(size_t)t * 8 + h]; }
#pragma unroll
        for (int u = 0; u < 4; ++u) { const size_t i = i0 + u * NT; const int t = (int)((ok[u] ? i : i0) >> 6);
            float y[8], v[8], vp[8], g[8], o[8]; unpack8(Y[u], y); unpack8(V[u], v); unpack8(VP[u], vp); unpack8(GG[u], g);
            float s = 0.f;
#pragma unroll
            for (int j = 0; j < 8; ++j) s += y[j];
            s += __shfl_xor(s, 1); s += __shfl_xor(s, 2); s += __shfl_xor(s, 4);
            const float mean = s * (1.0f / 64.0f); float q = 0.f;
#pragma unroll
            for (int j = 0; j < 8; ++j) { const float d = y[j] - mean; q += d * d; }
            q += __shfl_xor(q, 1); q += __shfl_xor(q, 2); q += __shfl_xor(q, 4);
            const float rs = rsqrtf(q * (1.0f / 64.0f) + LNX_EPS);
#pragma unroll
            for (int j = 0; j < 8; ++j) { const float pv = hp[u] ? vp[j] : 0.f; const float vv = v[j] + (pv - v[j]) * mu[j];
                o[j] = ((y[j] - mean) * rs * lg[j] + lb[j] + bn[u] * vv) * g[j]; }
            if (ok[u]) *(u32x4*)(YA + (size_t)t * 512 + c) = pack8(o); }
    }
}

__device__ __forceinline__ void phase_ffnfix(const Args& a, int wave, int G) {
    unsigned char* ws = a.ws;
    const bf16_t* HG = (const bf16_t*)(ws + WS_HG); bf16_t* ACT = (bf16_t*)(ws + WS_UU);
    const float* cw = a.in[I_FCW]; const float* cb = a.in[I_FCB];
    const size_t gid = (size_t)blockIdx.x * 512 + wave * 64 + lane_id(), NT = (size_t)G * 512;
    constexpr int CPR = DFF / 8; const size_t N = (size_t)(T / 64) * 2 * CPR;
    for (size_t i0 = gid; i0 < N; i0 += 2 * NT) {
        u32x4 P2[2], P1[2], CU[2], UP[2]; f32x4 W[2][8]; bool ok[2], first[2]; int cc[2], tt[2], rr[2];
#pragma unroll
        for (int u = 0; u < 2; ++u) { const size_t i = i0 + u * NT; ok[u] = i < N; const size_t ii = ok[u] ? i : i0;
            const int c = (int)(ii % CPR) * 8, rho = (int)((ii / CPR) & 1), grp = (int)(ii / (2 * CPR)); first[u] = (grp & 31) == 0; cc[u] = c; rr[u] = rho; tt[u] = grp * 64 + rho;
            const int gp = first[u] ? grp : grp - 1;
            P2[u] = *(const u32x4*)(HG + ((size_t)gp * 4 + rho) * DFF + c);
            P1[u] = *(const u32x4*)(HG + (rho == 0 ? ((size_t)gp * 4 + 1) : ((size_t)grp * 4 + 2)) * DFF + c);
            CU[u] = *(const u32x4*)(HG + ((size_t)grp * 4 + 2 + rho) * DFF + c);
            UP[u] = *(const u32x4*)(ACT + (size_t)tt[u] * DFF + c);
#pragma unroll
            for (int k = 0; k < 3; ++k) { W[u][2 * k] = *(const f32x4*)(cw + k * DFF + c); W[u][2 * k + 1] = *(const f32x4*)(cw + k * DFF + c + 4); }
            W[u][6] = *(const f32x4*)(cb + c); W[u][7] = *(const f32x4*)(cb + c + 4); }
#pragma unroll
        for (int u = 0; u < 2; ++u) { if (!ok[u]) continue;
            float p2[8], p1[8], cur[8], up[8], o[8]; unpack8(P2[u], p2); unpack8(P1[u], p1); unpack8(CU[u], cur); unpack8(UP[u], up);
            const bool z2 = first[u], z1 = first[u] && rr[u] == 0;
#pragma unroll
            for (int j = 0; j < 8; ++j) { const float a2 = z2 ? 0.f : p2[j], a1 = z1 ? 0.f : p1[j];
                o[j] = gelu_tanh(W[u][6 + (j >> 2)][j & 3] + W[u][0 + (j >> 2)][j & 3] * a2 + W[u][2 + (j >> 2)][j & 3] * a1 + W[u][4 + (j >> 2)][j & 3] * cur[j]) * up[j]; }
            *(u32x4*)(ACT + (size_t)tt[u] * DFF + cc[u]) = pack8(o); }
    }
}

__device__ __forceinline__ void phase_final(const Args& a, int wave, int G) {
    const int lane = lane_id();
    const float* ssp = (const float*)(a.ws + WS_SSP3); const float* g = a.in[I_NFING]; const bf16_t* X3 = (const bf16_t*)(a.ws + WS_X3B);
    const int gw = blockIdx.x * 8 + wave, NGW = G * 8;
    for (int r0 = gw; r0 < T; r0 += 4 * NGW) {
        u32x4 v[4][2]; float rs[4];
#pragma unroll
        for (int q = 0; q < 4; ++q) { const int r = r0 + q * NGW; if (r < T) { rs[q] = rstd_from16(ssp, r); const u32x4* xr = (const u32x4*)(X3 + (size_t)r * D) + lane; v[q][0] = xr[0]; v[q][1] = xr[64]; } }
#pragma unroll
        for (int q = 0; q < 4; ++q) { const int r = r0 + q * NGW; if (r < T) {
#pragma unroll
            for (int j = 0; j < 2; ++j) { float x[8]; unpack8(v[q][j], x); const int c = 512 * j + 8 * lane; const f32x4 g0 = *(const f32x4*)(g + c), g1 = *(const f32x4*)(g + c + 4);
                f32x4* o = (f32x4*)(a.out + (size_t)r * D + c);
                o[0] = (f32x4){x[0] * rs[q] * g0[0], x[1] * rs[q] * g0[1], x[2] * rs[q] * g0[2], x[3] * rs[q] * g0[3]};
                o[1] = (f32x4){x[4] * rs[q] * g1[0], x[5] * rs[q] * g1[1], x[6] * rs[q] * g1[2], x[7] * rs[q] * g1[3]}; } } }
    }
}

constexpr int NPHASE = 13;
__global__ void __launch_bounds__(512, 2) mega(Args a) {
    extern __shared__ __attribute__((aligned(16))) unsigned char lds_raw[];
    LAS unsigned char* lds = (LAS unsigned char*)lds_raw;
    cg::grid_group grid = cg::this_grid();
    const int wave = __builtin_amdgcn_readfirstlane((int)threadIdx.x >> 6), G = gridDim.x, bid = blockIdx.x;
    unsigned char* ws = a.ws;
    const int lo = a.ph_lo, hi = a.ph_hi;
    const bool t0 = (wave == 0) && (lane_id() == 0);
    volatile LAS unsigned* misc = (volatile LAS unsigned*)(lds + 131072 + 320);
    if (t0) { misc[0] = 0u; misc[1] = 0u; }
    __syncthreads();
    XcdBarrier xb = xcd_barrier_post((unsigned*)(ws + WS_CTL), misc, t0);
    if (a.ph_hi < 0) grid.sync();
#define IN(k) (lo <= (k) && (k) < hi)
#define SEAM(k) do { if (IN(k) && IN((k) + 1)) xcd_barrier(xb, t0); } while (0)
    bf16_t* const XB = (bf16_t*)(ws + WS_XB);
    const float* rstdx = (const float*)(ws + WS_RSTDX);
    StaticOrder S;

    if (IN(0)) for (int rep_ = 0; rep_ < REPS(0); ++rep_) { phase_prep(a, lds, wave, G); __syncthreads(); } SEAM(0);

    if (IN(1)) for (int rep_ = 0; rep_ < REPS(1); ++rep_) {
        { Gemm g = plain_gemm(XB, (const bf16_t*)(ws + WS_WIN), 1024); S.init(T / BM, 11, G, bid);
          EpiProj E{rstdx, a.in[I_BIN], (bf16_t*)(ws + WS_PR), (bf16_t*)(ws + WS_PX), (bf16_t*)(ws + WS_PY)}; gemm_phase(lds, wave, g, S, E); }
        if ((G & 15) == 0) {
            const int hg = G >> 1, hb_ = (bid >> 4) * 8 + (bid & 7);
            if (((bid >> 3) & 1) == 0) { Gemm g = plain_gemm((const bf16_t*)(ws + WS_MEMN), (const bf16_t*)(ws + WS_WK), 1024); S.init(TM / BM, 4, hg, hb_);
                EpiPlain E{(bf16_t*)(ws + WS_KM), 1024}; gemm_phase(lds, wave, g, S, E); }
            else { Gemm g = plain_gemm((const bf16_t*)(ws + WS_WV), (const bf16_t*)(ws + WS_MEMN), 1024); S.init(4, TM / BM, hg, hb_);
                EpiPlain E{(bf16_t*)(ws + WS_VT), TM}; gemm_phase(lds, wave, g, S, E); }
        } else {
            { Gemm g = plain_gemm((const bf16_t*)(ws + WS_MEMN), (const bf16_t*)(ws + WS_WK), 1024); S.init(TM / BM, 4, G, bid);
              EpiPlain E{(bf16_t*)(ws + WS_KM), 1024}; gemm_phase(lds, wave, g, S, E); }
            { Gemm g = plain_gemm((const bf16_t*)(ws + WS_WV), (const bf16_t*)(ws + WS_MEMN), 1024); S.init(4, TM / BM, G, bid);
              EpiPlain E{(bf16_t*)(ws + WS_VT), TM}; gemm_phase(lds, wave, g, S, E); }
        }
    } SEAM(1);

    if (IN(2)) for (int rep_ = 0; rep_ < REPS(2); ++rep_) phase_elem2(a, wave, G); SEAM(2);
#ifdef PROBE_SYNC
    for (int i_ = 0; i_ < 16; ++i_) grid.sync();
#endif

    if (IN(3)) for (int rep_ = 0; rep_ < REPS(3); ++rep_) {
        { Gemm g = plain_gemm((const bf16_t*)(ws + WS_LIN), (const bf16_t*)(ws + WS_WLORA), 256); S.init(T / BM, 6, G, bid);
          EpiLora E{a.in[I_W0], a.in[I_A0], (bf16_t*)(ws + WS_LOUT)}; gemm_phase(lds, wave, g, S, E); }
        { Gemm g = plain_gemm((const bf16_t*)(ws + WS_XBC), (const bf16_t*)(ws + WS_WRG), 256); g.lda = 512; g.a_pm = (size_t)BM * 512 * 2; g.a_pn2 = 512; S.init(T / BM, 4, G, bid);
          EpiRg E{a.in[I_BRGA], a.in[I_BRGX], a.in[I_LAM], (const bf16_t*)(ws + WS_XBC), (bf16_t*)(ws + WS_RGLA), (bf16_t*)(ws + WS_RGU)}; gemm_phase(lds, wave, g, S, E); }
    } SEAM(3);

    if (IN(4)) for (int rep_ = 0; rep_ < REPS(4); ++rep_) phase_scan(a, lds, wave, G); SEAM(4);
    if (IN(5)) for (int rep_ = 0; rep_ < REPS(5); ++rep_) phase_post(a, wave, G); SEAM(5);

    if (IN(6)) for (int rep_ = 0; rep_ < REPS(6); ++rep_) {
        S.init(T / BM, 4, G, bid);
        { Gemm g = plain_gemm(XB, (const bf16_t*)(ws + WS_WIN) + (size_t)2816 * 1024, 1024); EpiGab E{rstdx, a.in[I_BIN] + 2816, (bf16_t*)(ws + WS_GAB), 0}; gemm_phase(lds, wave, g, S, E); }
        { Gemm g = plain_gemm((const bf16_t*)(ws + WS_YA), (const bf16_t*)(ws + WS_WA), 512); EpiBranch<true> E{(const bf16_t*)(ws + WS_GAB), (bf16_t*)(ws + WS_MERGED)}; gemm_phase(lds, wave, g, S, E); }
        { Gemm g = plain_gemm(XB, (const bf16_t*)(ws + WS_WIN) + (size_t)3840 * 1024, 1024); EpiGab E{rstdx, a.in[I_BIN] + 2816, (bf16_t*)(ws + WS_GAB), 1024}; gemm_phase(lds, wave, g, S, E); }
        { Gemm g = plain_gemm((const bf16_t*)(ws + WS_YB), (const bf16_t*)(ws + WS_WB), 512); EpiBranch<false> E{(const bf16_t*)(ws + WS_GAB), (bf16_t*)(ws + WS_MERGED)}; gemm_phase(lds, wave, g, S, E); }
    } SEAM(6);
    if (IN(7)) for (int rep_ = 0; rep_ < REPS(7); ++rep_) { Gemm g = plain_gemm((const bf16_t*)(ws + WS_MERGED), (const bf16_t*)(ws + WS_WMIX), 1024); S.init(T / BM, 4, G, bid);
        EpiRes<true> E{a.in[I_X], (bf16_t*)(ws + WS_X1B), (float*)(ws + WS_SSP1)}; gemm_phase(lds, wave, g, S, E); } SEAM(7);
    if (IN(8)) for (int rep_ = 0; rep_ < REPS(8); ++rep_) {
        S.init(T / BM, 4, G, bid);
        { Gemm g = plain_gemm((const bf16_t*)(ws + WS_X1B), (const bf16_t*)(ws + WS_WCQ), 1024);
          EpiQ E{(const float*)(ws + WS_SSP1), (bf16_t*)(ws + WS_Q)}; gemm_phase(lds, wave, g, S, E); }
        { Gemm g; g.A = (const bf16_t*)(ws + WS_Q); g.Bt = (const bf16_t*)(ws + WS_KM); g.lda = 1024; g.ldb = 1024; g.K = 256;
          g.a_pm = (size_t)BM * 1024 * 2; g.a_pn = 512; g.b_pn = 512; g.b_pb = (size_t)NMEM * 1024 * 2; g.a_pn2 = 0;
          EpiSc E{(bf16_t*)(ws + WS_PEXP), (float*)(ws + WS_SSPA)}; gemm_phase(lds, wave, g, S, E); }
        { Gemm g; g.A = (const bf16_t*)(ws + WS_PEXP); g.Bt = (const bf16_t*)(ws + WS_VT); g.lda = 1024; g.ldb = TM; g.K = 256;
          g.a_pm = (size_t)BM * 1024 * 2; g.a_pn = 512; g.b_pn = (size_t)256 * TM * 2; g.b_pb = 512; g.a_pn2 = 0;
          EpiPv E{(const float*)(ws + WS_SSPA), (bf16_t*)(ws + WS_O)}; gemm_phase(lds, wave, g, S, E); }
    } SEAM(8);
    if (IN(9)) for (int rep_ = 0; rep_ < REPS(9); ++rep_) { Gemm g = plain_gemm((const bf16_t*)(ws + WS_O), (const bf16_t*)(ws + WS_WCO), 1024); S.init(T / BM, 4, G, bid);
        EpiRes<false> E{(const bf16_t*)(ws + WS_X1B), (bf16_t*)(ws + WS_X2B), (float*)(ws + WS_SSP2)}; gemm_phase(lds, wave, g, S, E); } SEAM(9);
    if (IN(10)) for (int rep_ = 0; rep_ < REPS(10); ++rep_) { Gemm g = plain_gemm((const bf16_t*)(ws + WS_X2B), (const bf16_t*)(ws + WS_WFFI), 1024); S.init(T / BM, 22, G, bid);
        EpiFfnAct E{(const float*)(ws + WS_SSP2), a.in[I_FCW], a.in[I_FCB], (bf16_t*)(ws + WS_UU), (bf16_t*)(ws + WS_HG)}; gemm_phase(lds, wave, g, S, E); } SEAM(10);
    if (IN(11)) for (int rep_ = 0; rep_ < REPS(11); ++rep_) phase_ffnfix(a, wave, G); SEAM(11);
    if (IN(12)) for (int rep_ = 0; rep_ < REPS(12); ++rep_) { Gemm g = plain_gemm((const bf16_t*)(ws + WS_UU), (const bf16_t*)(ws + WS_WFFO), DFF); S.init(T / BM, 4, G, bid);
        EpiRes<false> E{(const bf16_t*)(ws + WS_X2B), (bf16_t*)(ws + WS_X3B), (float*)(ws + WS_SSP3)}; gemm_phase(lds, wave, g, S, E); } SEAM(12);
    if (IN(13)) for (int rep_ = 0; rep_ < REPS(13); ++rep_) phase_final(a, wave, G);
#undef IN
#undef SEAM
}

extern "C" void kernel_launch(void* const* d_in, const int* in_sizes, int n_in, void* d_out, int out_size, void* d_ws, size_t ws_size, hipStream_t stream) {
    static int grid = 0;
    if (grid == 0) {
        if (n_in != 37 || in_sizes[0] != T * D || out_size != T * D || ws_size < WS_END) {
            fprintf(stderr, "kernel_launch: unexpected shapes (n_in %d, in0 %d, out %d, ws %zu < %zu); nothing launched\n", n_in, n_in > 0 ? in_sizes[0] : -1, out_size, ws_size, (size_t)WS_END); grid = -1; return; }
        int dev = 0, cus = 0, per_cu = 0;
        if (hipGetDevice(&dev) != hipSuccess || hipDeviceGetAttribute(&cus, hipDeviceAttributeMultiprocessorCount, dev) != hipSuccess) { grid = -1; return; }
        if (hipFuncSetAttribute((const void*)mega, hipFuncAttributeMaxDynamicSharedMemorySize, LDS_BYTES) != hipSuccess) { fprintf(stderr, "kernel_launch: hipFuncSetAttribute failed\n"); grid = -1; return; }
        if (hipOccupancyMaxActiveBlocksPerMultiprocessor(&per_cu, (const void*)mega, 512, LDS_BYTES) != hipSuccess || per_cu < 1) { fprintf(stderr, "kernel_launch: occupancy query says %d\n", per_cu); per_cu = 1; }
        (void)hipGetLastError();
        grid = cus * 1;
    }
    if (grid < 0) return;
    if (hipMemsetAsync((char*)d_ws + WS_CTL, 0, CTL_BYTES, stream) != hipSuccess) { fprintf(stderr, "kernel_launch: memset failed\n"); return; }
    Args a{};
    for (int i = 0; i < 37; ++i) a.in[i] = (const float*)d_in[i];
    a.out = (float*)d_out; a.ws = (unsigned char*)d_ws;
#if MK_SPLIT
    for (int ph = 0; ph <= NPHASE; ++ph) {
        a.ph_lo = ph; a.ph_hi = ph + 1; void* args[] = {&a};
        hipError_t e = hipLaunchCooperativeKernel((const void*)mega, dim3(grid), dim3(512), args, LDS_BYTES, stream);
        if (e != hipSuccess) { fprintf(stderr, "kernel_launch: launch of phase %d failed: %s\n", ph, hipGetErrorString(e)); break; }
    }
#else
    a.ph_lo = 0; a.ph_hi = NPHASE + 1; void* args[] = {&a};
    hipError_t e = hipLaunchCooperativeKernel((const void*)mega, dim3(grid), dim3(512), args, LDS_BYTES, stream);
    if (e != hipSuccess) fprintf(stderr, "kernel_launch: cooperative launch failed: %s (grid %d)\n", hipGetErrorString(e), grid);
#endif
}
```

```cpp
#include <hip/hip_runtime.h>
#include <hip/hip_cooperative_groups.h>
#include <cstdio>
namespace cg = cooperative_groups;

#ifndef MK_SPLIT
#define MK_SPLIT 0
#endif

#ifndef DUP_PHASE
#define DUP_PHASE -1
#endif
#define REPS(k) ((DUP_PHASE == (k)) ? 2 : 1)
#define LAS __attribute__((address_space(3)))
typedef unsigned short bf16_t;
typedef short bf16x8 __attribute__((ext_vector_type(8)));
typedef float f32x4 __attribute__((ext_vector_type(4)));
typedef float f32x2 __attribute__((ext_vector_type(2)));
typedef unsigned u32x4 __attribute__((ext_vector_type(4)));
typedef unsigned u32x2 __attribute__((ext_vector_type(2)));

constexpr int T = 65536, D = 1024, SEQ = 2048, NB = 32, NMEM = 256, TM = NB * NMEM;
constexpr int AW = 512, RW = 1792, PIN = 4864, DFF = 2816;
constexpr float NORM_EPS = 1e-6f, LNX_EPS = 64e-5f;

constexpr size_t MiB = 1u << 20;
constexpr size_t WS_WIN = 0;
constexpr size_t WS_WFFI = 10 * MiB;
constexpr size_t WS_WFFO = 21 * MiB;
constexpr size_t WS_WMIX = 27 * MiB, WS_WCQ = 29 * MiB, WS_WK = 31 * MiB, WS_WV = 33 * MiB, WS_WCO = 35 * MiB;
constexpr size_t WS_WA = 37 * MiB, WS_WB = 38 * MiB;
constexpr size_t WS_WLORA = 39 * MiB;
constexpr size_t WS_WRG = 40 * MiB;
constexpr size_t WS_CTL = 46 * MiB, CTL_BYTES = 16384;
constexpr size_t WS_RSTDX = 48 * MiB;
constexpr size_t WS_SSP1 = 49 * MiB, WS_SSP2 = 53 * MiB, WS_SSP3 = 57 * MiB, WS_SSPA = 61 * MiB;
constexpr size_t WS_BON = 65 * MiB;
constexpr size_t WS_MEMN = 68 * MiB, WS_KM = 84 * MiB, WS_VT = 100 * MiB;
constexpr size_t WS_XB = 120 * MiB;
constexpr size_t WS_PR = 248 * MiB;
constexpr size_t WS_PX = 472 * MiB, WS_PY = 536 * MiB;
constexpr size_t WS_LIN = 600 * MiB, WS_XBC = 632 * MiB;
constexpr size_t WS_LOUT = 696 * MiB;
constexpr size_t WS_RGLA = 888 * MiB, WS_RGU = 952 * MiB;
constexpr size_t WS_YRAW = WS_PX, WS_YB = WS_LIN, WS_YA = WS_RGLA;
constexpr size_t WS_GAB = 248 * MiB;
constexpr size_t WS_MERGED = 696 * MiB;
constexpr size_t WS_X1B = WS_XB, WS_Q = 248 * MiB, WS_PEXP = 376 * MiB, WS_O = 504 * MiB, WS_X2B = WS_XB;
constexpr size_t WS_X3B = 376 * MiB;
constexpr size_t WS_HG = 248 * MiB, WS_UU = 600 * MiB;
constexpr size_t WS_END = 1016 * MiB;

constexpr int LDS_BYTES = 147456;

__device__ __forceinline__ unsigned cvt_pk_bf16(float lo, float hi) { unsigned r; asm("v_cvt_pk_bf16_f32 %0, %1, %2" : "=v"(r) : "v"(lo), "v"(hi)); return r; }
__device__ __forceinline__ float bf_lo(unsigned w) { return __uint_as_float(w << 16); }
__device__ __forceinline__ float bf_hi(unsigned w) { return __uint_as_float(w & 0xffff0000u); }
__device__ __forceinline__ float bf1(bf16_t b) { return __uint_as_float(((unsigned)b) << 16); }
__device__ __forceinline__ bf16_t f2bf(float f) { return (bf16_t)(cvt_pk_bf16(f, 0.f) & 0xffffu); }
__device__ __forceinline__ float sigmoidf_(float x) { return __builtin_amdgcn_rcpf(1.0f + __expf(-x)); }
__device__ __forceinline__ float gelu_tanh(float x) { const float z = 1.5957691216057308f * (x + 0.044715f * x * x * x); return x * sigmoidf_(z); }
__device__ __forceinline__ int lane_id() { int l; asm volatile("v_mbcnt_lo_u32_b32 %0, -1, 0\n\tv_mbcnt_hi_u32_b32 %0, -1, %0" : "=v"(l)); return l; }
__device__ __forceinline__ float wave_sum(float v) {
#pragma unroll
    for (int o = 1; o < 64; o <<= 1) v += __shfl_xor(v, o);
    return v;
}
__device__ __forceinline__ void unpack8(const u32x4 w, float (&f)[8]) {
    f[0] = bf_lo(w.x); f[1] = bf_hi(w.x); f[2] = bf_lo(w.y); f[3] = bf_hi(w.y); f[4] = bf_lo(w.z); f[5] = bf_hi(w.z); f[6] = bf_lo(w.w); f[7] = bf_hi(w.w);
}
__device__ __forceinline__ u32x4 pack8(const float (&f)[8]) {
    u32x4 w; w.x = cvt_pk_bf16(f[0], f[1]); w.y = cvt_pk_bf16(f[2], f[3]); w.z = cvt_pk_bf16(f[4], f[5]); w.w = cvt_pk_bf16(f[6], f[7]); return w;
}


#define XB_TMO      128
#define XB_XCNT(j)  (256  + 64 * (j))
#define XB_XSUB(j)  (1280 + 64 * (j))
#define XB_XGEN(j)  (2304 + 64 * (j))
#define XB_TOP      3328
#define XB_TOPGEN   3392
#define XCD_BAR_WORDS 3456
#define XB_SPIN_CAP (1u << 22)
__device__ __forceinline__ unsigned xb_ld(unsigned* p)              { return __hip_atomic_load(p, __ATOMIC_RELAXED, __HIP_MEMORY_SCOPE_AGENT); }
__device__ __forceinline__ unsigned xb_add(unsigned* p, unsigned v) { return __hip_atomic_fetch_add(p, v, __ATOMIC_RELAXED, __HIP_MEMORY_SCOPE_AGENT); }
__device__ __forceinline__ unsigned xb_xcc_id() { return (unsigned)__builtin_amdgcn_s_getreg((3 << 11) | 20) & 0xFu; }
#define XB_SPIN(cond, bar) do { unsigned _sp = 0; while (cond) { __builtin_amdgcn_s_sleep(1); \
    if ((++_sp & 255u) == 0u) { if (xb_ld(&(bar)[XB_TMO])) break; if (_sp > XB_SPIN_CAP) { atomicAdd(&(bar)[XB_TMO], 1u); break; } } } } while (0)
struct XcdBarrier { unsigned* bar; unsigned x; volatile LAS unsigned* st; };
__device__ __forceinline__ XcdBarrier xcd_barrier_post(unsigned* bar, volatile LAS unsigned* st, bool t0) {
    XcdBarrier b; b.bar = bar; b.x = xb_xcc_id(); b.st = st;
    if (t0) (void)xb_add(&bar[XB_XCNT(b.x)], 1u);
    return b;
}
__device__ __forceinline__ void xcd_barrier_complete(unsigned* bar, unsigned x, unsigned& nloc, unsigned& nx) {
    const unsigned G = gridDim.x * gridDim.y * gridDim.z;
    unsigned sum, cnt, mine, sp = 0u;
    for (;;) {
        sum = 0u; cnt = 0u; mine = 0u;
#pragma unroll
        for (unsigned j = 0; j < 16; ++j) { const unsigned c = xb_ld(&bar[XB_XCNT(j)]); sum += c; cnt += (c > 0u) ? 1u : 0u; mine = (j == x) ? c : mine; }
        if (sum == G) break;
        __builtin_amdgcn_s_sleep(1);
        if ((++sp & 255u) == 0u) { if (xb_ld(&bar[XB_TMO])) break; if (sp > XB_SPIN_CAP) { atomicAdd(&bar[XB_TMO], 1u); break; } }
    }
    nloc = mine > 0u ? mine : 1u; nx = cnt > 0u ? cnt : 1u;
}
__device__ __forceinline__ void xcd_barrier(const XcdBarrier& b, bool t0) {
    asm volatile("s_waitcnt vmcnt(0)" ::: "memory");
    __syncthreads();
    if (t0) {
        unsigned* bar = b.bar;
        __builtin_amdgcn_s_waitcnt(0);
        unsigned nloc = b.st[0], nx = b.st[1];
        if (nloc == 0u) { xcd_barrier_complete(bar, b.x, nloc, nx); b.st[0] = nloc; b.st[1] = nx; }
        const unsigned old = xb_add(&bar[XB_XSUB(b.x)], 1u);
        const unsigned gen = old / nloc;
        if (old + 1u == (gen + 1u) * nloc) {
            __builtin_amdgcn_fence(__ATOMIC_RELEASE, "agent");
            asm volatile("s_waitcnt vmcnt(0)" ::: "memory");
            const unsigned og = xb_add(&bar[XB_TOP], 1u);
            const unsigned tg = og / nx;
            if (og + 1u == (tg + 1u) * nx) xb_add(&bar[XB_TOPGEN], 1u);
            else XB_SPIN(xb_ld(&bar[XB_TOPGEN]) == tg, bar);
            __builtin_amdgcn_fence(__ATOMIC_ACQUIRE, "agent");
            xb_add(&bar[XB_XGEN(b.x)], 1u);
            asm volatile("s_waitcnt vmcnt(0)" ::: "memory");
        } else {
            XB_SPIN(xb_ld(&bar[XB_XGEN(b.x)]) == gen, bar);
            __builtin_amdgcn_fence(__ATOMIC_ACQUIRE, "agent");
            asm volatile("s_waitcnt vmcnt(0)" ::: "memory");
        }
    }
    __syncthreads();
}

constexpr int BM = 256, BK = 64, HALF = 128, HTB = HALF * BK * 2, NXCD = 8, WGM = 8;
__device__ __forceinline__ int lds_byte(int r, int c) { const int st = (r >> 4) * 2 + (c >> 5), rr = r & 15, cc = c & 31, ob = rr * 64 + cc * 2; return st * 1024 + (ob ^ (((ob >> 9) & 1) << 5)); }
__device__ __forceinline__ void stage_rc(int b, int& R, int& C) { const int st = b / 1024, sb = b % 1024, swz = sb ^ (((sb >> 9) & 1) << 5); R = (st >> 1) * 16 + swz / 64; C = (st & 1) * 32 + (swz % 64) / 2; }
__device__ __forceinline__ int perm32(int rho) { const int n = rho >> 4, i = rho & 15; return 8 * (i >> 2) + 4 * n + (i & 3); }

struct Unit { int pm, pn; };
struct Gemm { const bf16_t* A; const bf16_t* Bt; int lda, ldb, K; size_t a_pm, a_pn, b_pn, b_pb, a_pn2; };
__device__ __forceinline__ Gemm plain_gemm(const bf16_t* A, const bf16_t* Bt, int K) { Gemm g; g.A = A; g.Bt = Bt; g.lda = K; g.ldb = K; g.K = K; g.a_pm = (size_t)BM * K * 2; g.a_pn = 0; g.b_pn = (size_t)BM * K * 2; g.b_pb = 0; g.a_pn2 = 0; return g; }

struct StaticOrder {
    int nM, nN, nwg, G, c;
    __device__ void init(int nM_, int nN_, int G_, int c_) { nM = nM_; nN = nN_; nwg = nM * nN; G = G_; c = c_; }
    __device__ bool next(int i, Unit& u) const {
        const long L = (long)i * G + c; if (L >= nwg) return false;
        int wgid = (int)L; { const int q = nwg / NXCD, r = nwg % NXCD, xcd = wgid % NXCD, off = wgid / NXCD; wgid = (xcd < r ? xcd * (q + 1) : r * (q + 1) + (xcd - r) * q) + off; }
        const int nig = WGM * nN, gid = wgid / nig, fm = gid * WGM, gsz = (nM - fm) < WGM ? (nM - fm) : WGM;
        u.pm = fm + ((wgid % nig) % gsz); u.pn = (wgid % nig) / gsz; return true;
    }
};

typedef f32x4 Acc[2][2][4][2];

template <class Epi>
__device__ __forceinline__ void gemm_phase(LAS unsigned char* lds, const int wid, const Gemm g, const StaticOrder& S, const Epi& E) {
    const int lane = lane_id(), tid = wid * 64 + lane, wr = wid >> 2, wc = wid & 3, fr = lane & 15, fq = lane >> 4;
    const int nt = g.K / BK;
    unsigned voffA[2], voffB[2];
#pragma unroll
    for (int i = 0; i < 2; ++i) { int R, C; stage_rc(tid * 16 + i * 8192, R, C); const int Rb = Epi::PERM ? ((R & ~31) + perm32(R & 31)) : R;
        voffA[i] = (unsigned)(R * g.lda + C) * 2u; voffB[i] = (unsigned)(Rb * g.ldb + C) * 2u; }
    const size_t kstep = (size_t)(BK * 2);
    const size_t hstepA = (size_t)HALF * g.lda * 2, hstepB = (size_t)HALF * g.ldb * 2;
    const unsigned ldsw = (unsigned)wid * 1024u;
    const int aoff = lds_byte(wr * 64 + fr, fq * 8), boff = lds_byte(wc * 32 + fr, fq * 8);
#define PG8_SA(b, h) (((b) * 2 + (h)) * HTB)
#define PG8_SB(b, h) ((4 + (b) * 2 + (h)) * HTB)
#define PG8_STAGE(bufoff, gbase, voff) do { _Pragma("unroll") for (int _i = 0; _i < 2; ++_i) \
        __builtin_amdgcn_global_load_lds((const unsigned*)((const char*)(gbase) + (voff)[_i]), (LAS unsigned*)(lds + (bufoff) + ldsw + _i * 8192), 16, 0, 0); } while (0)
#define PG8_LDA(dst, b, h) do { _Pragma("unroll") for (int m = 0; m < 4; ++m) _Pragma("unroll") for (int k = 0; k < 2; ++k) dst[m][k] = *(const LAS bf16x8*)(lds + PG8_SA(b, h) + aoff + m * 2048 + k * 1024); } while (0)
#define PG8_LDB(dst, b, h) do { _Pragma("unroll") for (int n = 0; n < 2; ++n) _Pragma("unroll") for (int k = 0; k < 2; ++k) dst[n][k] = *(const LAS bf16x8*)(lds + PG8_SB(b, h) + boff + n * 2048 + k * 1024); } while (0)
#define PG8_MMA(ai, bj, At, Bt) do { __builtin_amdgcn_s_setprio(1); _Pragma("unroll") for (int m = 0; m < 4; ++m) _Pragma("unroll") for (int n = 0; n < 2; ++n) _Pragma("unroll") for (int k = 0; k < 2; ++k) \
        acc[ai][bj][m][n] = __builtin_amdgcn_mfma_f32_16x16x32_bf16(Bt[n][k], At[m][k], acc[ai][bj][m][n], 0, 0, 0); __builtin_amdgcn_s_setprio(0); } while (0)
#define PG8_WAIT_V(n) asm volatile("s_waitcnt vmcnt(" #n ")" ::: "memory")
#define PG8_WAIT_L(n) asm volatile("s_waitcnt lgkmcnt(" #n ")" ::: "memory")
#define PG8_BAR __builtin_amdgcn_s_barrier()
#define PG8_SCHED __builtin_amdgcn_sched_barrier(0)
#define PG8_UA(u) ((const char*)g.A + (size_t)(u).pm * g.a_pm + (size_t)(u).pn * g.a_pn + (size_t)((u).pn >> 1) * g.a_pn2)
#define PG8_UB(u) ((const char*)g.Bt + (size_t)(u).pn * g.b_pn + (size_t)((u).pm >> 3) * g.b_pb)
    Unit cur, nxt; int ui = 0;
    if (!S.next(0, cur)) return;
    Acc acc;
#pragma unroll
    for (int a = 0; a < 2; ++a)
#pragma unroll
        for (int b = 0; b < 2; ++b)
#pragma unroll
            for (int m = 0; m < 4; ++m)
#pragma unroll
                for (int n = 0; n < 2; ++n) acc[a][b][m][n] = (f32x4){0.f, 0.f, 0.f, 0.f};
    bf16x8 At[4][2], B0[2][2], B1[2][2];
    const char* cA = PG8_UA(cur); const char* cB = PG8_UB(cur);
    PG8_STAGE(PG8_SB(0, 0), cB, voffB); PG8_STAGE(PG8_SB(0, 1), cB + hstepB, voffB); PG8_STAGE(PG8_SA(0, 0), cA, voffA); PG8_STAGE(PG8_SA(0, 1), cA + hstepA, voffA);
    if (wr == 1) PG8_BAR;
    PG8_WAIT_V(2); PG8_BAR;
    PG8_STAGE(PG8_SB(1, 0), cB + kstep, voffB); PG8_STAGE(PG8_SA(1, 0), cA + kstep, voffA); PG8_STAGE(PG8_SB(1, 1), cB + hstepB + kstep, voffB);
    PG8_WAIT_V(6); PG8_BAR;
    for (;;) {
        const bool has_next = S.next(ui + 1, nxt);
        const char* nA = has_next ? PG8_UA(nxt) : cA; const char* nB = has_next ? PG8_UB(nxt) : cB;
        for (int t = 0; t < nt; t += 2) {
            const bool last = (t == nt - 2);
            const char* a1 = cA + (size_t)(t + 1) * kstep;
            const char* a2 = last ? nA : cA + (size_t)(t + 2) * kstep; const char* b2 = last ? nB : cB + (size_t)(t + 2) * kstep;
            const char* a3 = a2 + kstep; const char* b3 = b2 + kstep;
            PG8_LDB(B0, 0, 0); PG8_LDB(B1, 0, 1); PG8_SCHED; PG8_LDA(At, 0, 0); PG8_STAGE(PG8_SA(1, 1), a1 + hstepA, voffA);
            PG8_WAIT_V(8); PG8_WAIT_L(0); PG8_BAR; PG8_MMA(0, 0, At, B0); PG8_MMA(0, 1, At, B1); PG8_BAR; PG8_SCHED;
            PG8_LDA(At, 0, 1); PG8_STAGE(PG8_SB(0, 0), b2, voffB); PG8_STAGE(PG8_SB(0, 1), b2 + hstepB, voffB); PG8_STAGE(PG8_SA(0, 0), a2, voffA);
            PG8_WAIT_V(8); PG8_WAIT_L(0); PG8_BAR; PG8_MMA(1, 0, At, B0); PG8_MMA(1, 1, At, B1); PG8_BAR; PG8_SCHED;
            PG8_LDB(B0, 1, 0); PG8_LDB(B1, 1, 1); PG8_SCHED; PG8_LDA(At, 1, 0); PG8_STAGE(PG8_SA(0, 1), a2 + hstepA, voffA);
            PG8_WAIT_V(8); PG8_WAIT_L(0); PG8_BAR; PG8_MMA(0, 0, At, B0); PG8_MMA(0, 1, At, B1); PG8_BAR; PG8_SCHED;
            PG8_LDA(At, 1, 1); PG8_STAGE(PG8_SB(1, 0), b3, voffB); PG8_STAGE(PG8_SB(1, 1), b3 + hstepB, voffB); PG8_STAGE(PG8_SA(1, 0), a3, voffA);
            PG8_WAIT_V(8); PG8_WAIT_L(0); PG8_BAR; PG8_MMA(1, 0, At, B0); PG8_MMA(1, 1, At, B1); PG8_BAR; PG8_SCHED;
        }
        if (wr == 0) PG8_BAR;
        E(acc, cur, wr, wc, fr, fq);
        if (!has_next) break;
#pragma unroll
        for (int a = 0; a < 2; ++a)
#pragma unroll
            for (int b = 0; b < 2; ++b)
#pragma unroll
                for (int m = 0; m < 4; ++m)
#pragma unroll
                    for (int n = 0; n < 2; ++n) acc[a][b][m][n] = (f32x4){0.f, 0.f, 0.f, 0.f};
        cur = nxt; cA = nA; cB = nB; ++ui;
        if (wr == 1) PG8_BAR;
    }
    PG8_WAIT_V(0);
    PG8_BAR;
#undef PG8_SA
#undef PG8_SB
#undef PG8_STAGE
#undef PG8_LDA
#undef PG8_LDB
#undef PG8_MMA
#undef PG8_WAIT_V
#undef PG8_WAIT_L
#undef PG8_BAR
#undef PG8_SCHED
#undef PG8_UA
#undef PG8_UB
}

#define EPI_ROWS_BEGIN for (int ai = 0; ai < 2; ++ai) { _Pragma("unroll") for (int m = 0; m < 4; ++m) { const int r = u.pm * BM + ai * HALF + wr * 64 + m * 16 + fr;
#define EPI_ROWS_END } }

__device__ __forceinline__ float rstd_from16(const float* ss, int r) { return rsqrtf(ss[r] * (1.0f / 1024.0f) + NORM_EPS); }

struct EpiProj { static constexpr bool PERM = true;
    const float* rstd; const float* bias; bf16_t* PR; bf16_t* PX; bf16_t* PY;
    __device__ __forceinline__ void operator()(Acc& acc, const Unit& u, int wr, int wc, int fr, int fq) const {
        bf16_t* base; int ld, colt;
        if (u.pn < 7) { base = PR; ld = RW; colt = u.pn * 256; } else if (u.pn < 9) { base = PX; ld = 512; colt = (u.pn - 7) * 256; } else { base = PY; ld = 512; colt = (u.pn - 9) * 256; }
        const int col0 = colt + wc * 32 + 8 * fq, bcol0 = u.pn * 256 + wc * 32 + 8 * fq;
        f32x4 bv[2][2];
#pragma unroll
        for (int bj = 0; bj < 2; ++bj)
#pragma unroll
            for (int n = 0; n < 2; ++n) bv[bj][n] = *(const f32x4*)(bias + bcol0 + bj * HALF + 4 * n);
#pragma unroll
        EPI_ROWS_BEGIN
            const float rs = rstd[r]; bf16_t* rowp = base + (size_t)r * ld + col0;
#pragma unroll
            for (int bj = 0; bj < 2; ++bj) { const f32x4 v0 = acc[ai][bj][m][0] * rs + bv[bj][0], v1 = acc[ai][bj][m][1] * rs + bv[bj][1];
                u32x4 w; w.x = cvt_pk_bf16(v0[0], v0[1]); w.y = cvt_pk_bf16(v0[2], v0[3]); w.z = cvt_pk_bf16(v1[0], v1[1]); w.w = cvt_pk_bf16(v1[2], v1[3]);
                *(u32x4*)(rowp + bj * HALF) = w; }
        EPI_ROWS_END
    }
};
struct EpiGab { static constexpr bool PERM = true;
    const float* rstd; const float* bias; bf16_t* O; int cofs;
    __device__ __forceinline__ void operator()(Acc& acc, const Unit& u, int wr, int wc, int fr, int fq) const {
        const int col0 = cofs + u.pn * 256 + wc * 32 + 8 * fq;
        f32x4 bv[2][2];
#pragma unroll
        for (int bj = 0; bj < 2; ++bj)
#pragma unroll
            for (int n = 0; n < 2; ++n) bv[bj][n] = *(const f32x4*)(bias + col0 + bj * HALF + 4 * n);
#pragma unroll
        EPI_ROWS_BEGIN
            const float rs = rstd[r]; bf16_t* rowp = O + (size_t)r * 2048 + col0;
#pragma unroll
            for (int bj = 0; bj < 2; ++bj) { f32x4 v0 = acc[ai][bj][m][0] * rs + bv[bj][0], v1 = acc[ai][bj][m][1] * rs + bv[bj][1];
#pragma unroll
                for (int j = 0; j < 4; ++j) { v0[j] = sigmoidf_(v0[j]); v1[j] = sigmoidf_(v1[j]); }
                u32x4 w; w.x = cvt_pk_bf16(v0[0], v0[1]); w.y = cvt_pk_bf16(v0[2], v0[3]); w.z = cvt_pk_bf16(v1[0], v1[1]); w.w = cvt_pk_bf16(v1[2], v1[3]);
                *(u32x4*)(rowp + bj * HALF) = w; }
        EPI_ROWS_END
    }
};
struct EpiPlain { static constexpr bool PERM = true;
    bf16_t* O; int ldc;
    __device__ __forceinline__ void operator()(Acc& acc, const Unit& u, int wr, int wc, int fr, int fq) const {
        const int col0 = u.pn * 256 + wc * 32 + 8 * fq;
#pragma unroll
        EPI_ROWS_BEGIN
            bf16_t* rowp = O + (size_t)r * ldc + col0;
#pragma unroll
            for (int bj = 0; bj < 2; ++bj) { const f32x4 v0 = acc[ai][bj][m][0], v1 = acc[ai][bj][m][1];
                u32x4 w; w.x = cvt_pk_bf16(v0[0], v0[1]); w.y = cvt_pk_bf16(v0[2], v0[3]); w.z = cvt_pk_bf16(v1[0], v1[1]); w.w = cvt_pk_bf16(v1[2], v1[3]);
                *(u32x4*)(rowp + bj * HALF) = w; }
        EPI_ROWS_END
    }
};
struct EpiLora { static constexpr bool PERM = true;
    const float* w0; const float* a0; bf16_t* O;
    __device__ __forceinline__ void operator()(Acc& acc, const Unit& u, int wr, int wc, int fr, int fq) const {
        const int kind = u.pn >> 1, ch0 = (u.pn & 1) * 256 + wc * 32 + 8 * fq, col0 = u.pn * 256 + wc * 32 + 8 * fq;
        const float* bsrc = kind == 0 ? w0 : a0;
        f32x4 bv[2][2];
#pragma unroll
        for (int bj = 0; bj < 2; ++bj)
#pragma unroll
            for (int n = 0; n < 2; ++n) bv[bj][n] = kind < 2 ? *(const f32x4*)(bsrc + ch0 + bj * HALF + 4 * n) : (f32x4){0.f, 0.f, 0.f, 0.f};
        const float sc = kind == 0 ? 0.6065306597126334f : 1.0f;
#pragma unroll
        EPI_ROWS_BEGIN
            bf16_t* rowp = O + (size_t)r * 1536 + col0;
#pragma unroll
            for (int bj = 0; bj < 2; ++bj) { f32x4 v0 = acc[ai][bj][m][0] + bv[bj][0], v1 = acc[ai][bj][m][1] + bv[bj][1];
                if (kind < 2) {
#pragma unroll
                    for (int j = 0; j < 4; ++j) { v0[j] = sc * sigmoidf_(v0[j]); v1[j] = sc * sigmoidf_(v1[j]); } }
                u32x4 w; w.x = cvt_pk_bf16(v0[0], v0[1]); w.y = cvt_pk_bf16(v0[2], v0[3]); w.z = cvt_pk_bf16(v1[0], v1[1]); w.w = cvt_pk_bf16(v1[2], v1[3]);
                *(u32x4*)(rowp + bj * HALF) = w; }
        EPI_ROWS_END
    }
};
struct EpiRg { static constexpr bool PERM = true;
    const float* ba; const float* bx; const float* lam; const bf16_t* XBC; bf16_t* LA; bf16_t* U;
    __device__ __forceinline__ void operator()(Acc& acc, const Unit& u, int wr, int wc, int fr, int fq) const {
        const int ch0 = u.pn * 128 + wc * 32 + 8 * fq;
        float vba[8], vbx[8], vls[8];
#pragma unroll
        for (int j = 0; j < 8; ++j) { vba[j] = ba[ch0 + j]; vbx[j] = bx[ch0 + j]; vls[j] = -8.0f * log1pf(__expf(-lam[ch0 + j])); }
#pragma unroll
        EPI_ROWS_BEGIN
            const bool first = (r & (SEQ - 1)) == 0;
            float xb[8]; unpack8(*(const u32x4*)(XBC + (size_t)r * 512 + ch0), xb);
            float la[8], uu[8];
#pragma unroll
            for (int j = 0; j < 8; ++j) { const float ga = sigmoidf_(acc[ai][0][m][j >> 2][j & 3] + vba[j]), gx = sigmoidf_(acc[ai][1][m][j >> 2][j & 3] + vbx[j]);
                la[j] = vls[j] * ga; const float a = __expf(la[j]); const float mult = first ? 1.0f : sqrtf(fmaxf(1.0f - a * a, 0.f)); uu[j] = xb[j] * gx * mult; }
            *(u32x4*)(LA + (size_t)r * 512 + ch0) = pack8(la); *(u32x4*)(U + (size_t)r * 512 + ch0) = pack8(uu);
        EPI_ROWS_END
    }
};
template <bool FIRST> struct EpiBranch { static constexpr bool PERM = true;
    const bf16_t* G; bf16_t* M;
    __device__ __forceinline__ void operator()(Acc& acc, const Unit& u, int wr, int wc, int fr, int fq) const {
        const int col0 = u.pn * 256 + wc * 32 + 8 * fq;
#pragma unroll
        EPI_ROWS_BEGIN
#pragma unroll
            for (int bj = 0; bj < 2; ++bj) { const int c = col0 + bj * HALF;
                float gv[8]; unpack8(*(const u32x4*)(G + (size_t)r * 2048 + (FIRST ? 0 : 1024) + c), gv);
                float o[8];
                if (!FIRST) unpack8(*(const u32x4*)(M + (size_t)r * 1024 + c), o);
#pragma unroll
                for (int j = 0; j < 8; ++j) { const float p = acc[ai][bj][m][j >> 2][j & 3] * gv[j]; o[j] = FIRST ? p : o[j] + p; }
                *(u32x4*)(M + (size_t)r * 1024 + c) = pack8(o); }
        EPI_ROWS_END
    }
};
template <bool BASE_F32> struct EpiRes { static constexpr bool PERM = true;
    const void* base; bf16_t* XB; float* ssp;
    __device__ __forceinline__ void operator()(Acc& acc, const Unit& u, int wr, int wc, int fr, int fq) const {
        const int col0 = u.pn * 256 + wc * 32 + 8 * fq;
#pragma unroll
        EPI_ROWS_BEGIN
            float s = 0.f;
#pragma unroll
            for (int bj = 0; bj < 2; ++bj) { const size_t off = (size_t)r * 1024 + col0 + bj * HALF; float o[8];
                if (BASE_F32) { const f32x4 b0 = *(const f32x4*)((const float*)base + off), b1 = *(const f32x4*)((const float*)base + off + 4);
                    o[0] = b0[0]; o[1] = b0[1]; o[2] = b0[2]; o[3] = b0[3]; o[4] = b1[0]; o[5] = b1[1]; o[6] = b1[2]; o[7] = b1[3]; }
                else unpack8(*(const u32x4*)((const bf16_t*)base + off), o);
#pragma unroll
                for (int j = 0; j < 8; ++j) { o[j] += acc[ai][bj][m][j >> 2][j & 3]; s += o[j] * o[j]; }
                *(u32x4*)(XB + off) = pack8(o); }
            s += __shfl_xor(s, 16); s += __shfl_xor(s, 32);
            if (fq == 0) atomicAdd(ssp + r, s);
        EPI_ROWS_END
    }
};
struct EpiQ { static constexpr bool PERM = true;
    const float* ssp; bf16_t* O;
    __device__ __forceinline__ void operator()(Acc& acc, const Unit& u, int wr, int wc, int fr, int fq) const {
        const int col0 = u.pn * 256 + wc * 32 + 8 * fq;
#pragma unroll
        EPI_ROWS_BEGIN
            const float rs = rstd_from16(ssp, r) * 0.0625f; bf16_t* rowp = O + (size_t)r * 1024 + col0;
#pragma unroll
            for (int bj = 0; bj < 2; ++bj) { const f32x4 v0 = acc[ai][bj][m][0] * rs, v1 = acc[ai][bj][m][1] * rs;
                u32x4 w; w.x = cvt_pk_bf16(v0[0], v0[1]); w.y = cvt_pk_bf16(v0[2], v0[3]); w.z = cvt_pk_bf16(v1[0], v1[1]); w.w = cvt_pk_bf16(v1[2], v1[3]);
                *(u32x4*)(rowp + bj * HALF) = w; }
        EPI_ROWS_END
    }
};
struct EpiSc { static constexpr bool PERM = true;
    bf16_t* O; float* ssp;
    __device__ __forceinline__ void operator()(Acc& acc, const Unit& u, int wr, int wc, int fr, int fq) const {
        const int col0 = u.pn * 256 + wc * 32 + 8 * fq;
#pragma unroll
        EPI_ROWS_BEGIN
            bf16_t* rowp = O + (size_t)r * 1024 + col0; float s = 0.f;
#pragma unroll
            for (int bj = 0; bj < 2; ++bj) { f32x4 v0 = acc[ai][bj][m][0], v1 = acc[ai][bj][m][1];
#pragma unroll
                for (int j = 0; j < 4; ++j) { v0[j] = __expf(v0[j]); v1[j] = __expf(v1[j]); }
                s += ((v0[0] + v0[1]) + (v0[2] + v0[3])) + ((v1[0] + v1[1]) + (v1[2] + v1[3]));
                u32x4 w; w.x = cvt_pk_bf16(v0[0], v0[1]); w.y = cvt_pk_bf16(v0[2], v0[3]); w.z = cvt_pk_bf16(v1[0], v1[1]); w.w = cvt_pk_bf16(v1[2], v1[3]);
                *(u32x4*)(rowp + bj * HALF) = w; }
            s += __shfl_xor(s, 16); s += __shfl_xor(s, 32);
            if (fq == 0) ssp[(size_t)r * 16 + u.pn * 4 + wc] = s;
        EPI_ROWS_END
    }
};
struct EpiPv { static constexpr bool PERM = true;
    const float* ssp; bf16_t* O;
    __device__ __forceinline__ void operator()(Acc& acc, const Unit& u, int wr, int wc, int fr, int fq) const {
        const int col0 = u.pn * 256 + wc * 32 + 8 * fq;
#pragma unroll
        EPI_ROWS_BEGIN
            const f32x4 sp = *(const f32x4*)(ssp + (size_t)r * 16 + u.pn * 4); const float rs = 1.0f / ((sp.x + sp.y) + (sp.z + sp.w));
            bf16_t* rowp = O + (size_t)r * 1024 + col0;
#pragma unroll
            for (int bj = 0; bj < 2; ++bj) { const f32x4 v0 = acc[ai][bj][m][0] * rs, v1 = acc[ai][bj][m][1] * rs;
                u32x4 w; w.x = cvt_pk_bf16(v0[0], v0[1]); w.y = cvt_pk_bf16(v0[2], v0[3]); w.z = cvt_pk_bf16(v1[0], v1[1]); w.w = cvt_pk_bf16(v1[2], v1[3]);
                *(u32x4*)(rowp + bj * HALF) = w; }
        EPI_ROWS_END
    }
};
__device__ __forceinline__ float dpp_ror1(float v) { return __int_as_float(__builtin_amdgcn_update_dpp(0, __float_as_int(v), 0x121, 0xf, 0xf, false)); }
__device__ __forceinline__ float dpp_ror2(float v) { return __int_as_float(__builtin_amdgcn_update_dpp(0, __float_as_int(v), 0x122, 0xf, 0xf, false)); }
struct EpiFfnAct { static constexpr bool PERM = true;
    const float* ssp; const float* cw; const float* cb; bf16_t* ACT; bf16_t* HG;
    __device__ __forceinline__ void operator()(Acc& acc, const Unit& u, int wr, int wc, int fr_, int fq_) const {
        const int l_ = lane_id(), fr = l_ & 15, fq = l_ >> 4;
        const int col0 = u.pn * 128 + wc * 32 + 8 * fq;
#pragma unroll
        for (int ai = 0; ai < 2; ++ai) {
            const int rbase = u.pm * BM + ai * HALF + wr * 64 + fr;
            float rs[4];
#pragma unroll
            for (int m = 0; m < 4; ++m) rs[m] = rstd_from16(ssp, rbase + m * 16);
            const size_t grp = (size_t)(rbase >> 6);
            if (fr < 2) { float t[8];
#pragma unroll
                for (int j = 0; j < 8; ++j) t[j] = acc[ai][0][0][j >> 2][j & 3] * rs[0];
                *(u32x4*)(HG + (grp * 4 + 2 + fr) * DFF + col0) = pack8(t); }
            if (fr >= 14) { float t[8];
#pragma unroll
                for (int j = 0; j < 8; ++j) t[j] = acc[ai][0][3][j >> 2][j & 3] * rs[3];
                *(u32x4*)(HG + (grp * 4 + (fr - 14)) * DFF + col0) = pack8(t); }
#pragma unroll
            for (int j = 0; j < 8; ++j) {
                const float w0 = cw[col0 + j], w1 = cw[DFF + col0 + j], w2 = cw[2 * DFF + col0 + j], b0 = cb[col0 + j];
                float g[4], r1[4], r2[4];
#pragma unroll
                for (int m = 0; m < 4; ++m) { g[m] = acc[ai][0][m][j >> 2][j & 3] * rs[m]; r1[m] = dpp_ror1(g[m]); r2[m] = dpp_ror2(g[m]); }
#pragma unroll
                for (int m = 0; m < 4; ++m) {
                    const float p1 = fr >= 1 ? r1[m] : r1[m > 0 ? m - 1 : 0], p2 = fr >= 2 ? r2[m] : r2[m > 0 ? m - 1 : 0];
                    const float up = acc[ai][1][m][j >> 2][j & 3] * rs[m];
                    const float gate = b0 + w0 * p2 + w1 * p1 + w2 * g[m];
                    acc[ai][1][m][j >> 2][j & 3] = (m == 0 && fr < 2) ? up : gelu_tanh(gate) * up;
                }
            }
#pragma unroll
            for (int m = 0; m < 4; ++m) { const f32x4 v0 = acc[ai][1][m][0], v1 = acc[ai][1][m][1];
                u32x4 w; w.x = cvt_pk_bf16(v0[0], v0[1]); w.y = cvt_pk_bf16(v0[2], v0[3]); w.z = cvt_pk_bf16(v1[0], v1[1]); w.w = cvt_pk_bf16(v1[2], v1[3]);
                *(u32x4*)(ACT + (size_t)(rbase + m * 16) * DFF + col0) = w; }
        }
    }
};

struct Args { const float* in[37]; float* out; unsigned char* ws; int ph_lo, ph_hi; };
enum { I_X = 0, I_MEM, I_NMIXG, I_WIN, I_BIN, I_MU, I_W0, I_WUP, I_A0, I_AUP, I_GUP, I_KK, I_KA, I_RK, I_LNXG, I_LNXB, I_WBA, I_CBW, I_CBB, I_WRGA, I_BRGA, I_WRGX, I_BRGX,
       I_LAM, I_WBB, I_WMIX, I_NXG, I_NMEMG, I_WCQ, I_WCKV, I_WCO, I_NFFNG, I_WFFI, I_FCW, I_FCB, I_WFFO, I_NFING };

__device__ __forceinline__ void transpose_item(const float* W, int ldw, int K, bf16_t* WT, int ldd, const float* gain, int map, int srcofs, LAS float* scr, int item, int lane) {
    const int nkb = K / 64, nb = item / nkb, kb = item % nkb, k0 = 64 * kb, n0 = 32 * nb;
    int ns = n0 + srcofs;
    if (map == 1) { const int tile = n0 >> 8, c = n0 & 255; ns = c < 128 ? tile * 128 + c : DFF + tile * 128 + (c - 128); }
#pragma unroll
    for (int i = 0; i < 32; ++i) { const int kk = 2 * i + (lane >> 5); float v = W[(size_t)(k0 + kk) * ldw + ns + (lane & 31)]; if (gain) v *= gain[k0 + kk]; scr[kk * 33 + (lane & 31)] = v; }
    asm volatile("s_waitcnt lgkmcnt(0)" ::: "memory");
    const int c = lane & 7;
#pragma unroll
    for (int j = 0; j < 4; ++j) { const int n = (lane >> 3) + 8 * j; const LAS float* s = scr + (8 * c) * 33 + n;
        u32x4 o; o.x = cvt_pk_bf16(s[0 * 33], s[1 * 33]); o.y = cvt_pk_bf16(s[2 * 33], s[3 * 33]); o.z = cvt_pk_bf16(s[4 * 33], s[5 * 33]); o.w = cvt_pk_bf16(s[6 * 33], s[7 * 33]);
        *(u32x4*)(WT + (size_t)(n0 + n) * ldd + k0 + 8 * c) = o; }
    asm volatile("s_waitcnt lgkmcnt(0)" ::: "memory");
}

__device__ __forceinline__ void phase_prep(const Args& a, LAS unsigned char* lds, int wave, int G) {
    const int lane = lane_id();
    unsigned char* ws = a.ws;
    LAS float* scr = (LAS float*)(lds + wave * 16384);
    const int gw = blockIdx.x * 8 + wave, NGW = G * 8;
#define TITEMS(K_, Nd_) (((K_) / 64) * ((Nd_) / 32))
#define TJOB(W_, ldw_, K_, Nd_, dst_, gain_, map_, srcofs_) if (r < TITEMS(K_, Nd_)) { transpose_item((W_), (ldw_), (K_), (bf16_t*)(ws + (dst_)), (K_), (gain_), (map_), (srcofs_), scr, r, lane); continue; } r -= TITEMS(K_, Nd_);
    constexpr int NITEMS_ALL = TITEMS(1024, PIN) + 2 * TITEMS(512, 1024) + 5 * TITEMS(1024, 1024) + TITEMS(1024, 2 * DFF) + TITEMS(DFF, 1024);
    for (int it = gw; it < NITEMS_ALL; it += NGW) {
        int r = it;
        TJOB(a.in[I_WFFI], 2 * DFF, 1024, 2 * DFF, WS_WFFI, a.in[I_NFFNG], 1, 0)
        TJOB(a.in[I_WIN], PIN, 1024, PIN, WS_WIN, a.in[I_NMIXG], 0, 0)
        TJOB(a.in[I_WFFO], 1024, DFF, 1024, WS_WFFO, nullptr, 0, 0)
        TJOB(a.in[I_WMIX], 1024, 1024, 1024, WS_WMIX, nullptr, 0, 0)
        TJOB(a.in[I_WCQ], 1024, 1024, 1024, WS_WCQ, a.in[I_NXG], 0, 0)
        TJOB(a.in[I_WCKV], 2048, 1024, 1024, WS_WK, nullptr, 0, 0)
        TJOB(a.in[I_WCKV], 2048, 1024, 1024, WS_WV, nullptr, 0, 1024)
        TJOB(a.in[I_WCO], 1024, 1024, 1024, WS_WCO, nullptr, 0, 0)
        TJOB(a.in[I_WBA], 1024, 512, 1024, WS_WA, nullptr, 0, 0)
        TJOB(a.in[I_WBB], 1024, 512, 1024, WS_WB, nullptr, 0, 0)
    }
#undef TJOB
#undef TITEMS
    { float* z1 = (float*)(ws + WS_SSP1); float* z2 = (float*)(ws + WS_SSP2); float* z3 = (float*)(ws + WS_SSP3);
      for (int i = blockIdx.x * 512 + wave * 64 + lane; i < T; i += G * 512) { z1[i] = 0.f; z2[i] = 0.f; z3[i] = 0.f; } }
    const int gid = blockIdx.x * 512 + wave * 64 + lane, NT = G * 512;
    { bf16_t* WL = (bf16_t*)(ws + WS_WLORA);
      for (int i = gid; i < 1536 * 256; i += NT) { const int n = i >> 8, k = i & 255, kind = n >> 9, c = n & 511; float v = 0.f;
          if (kind == 0 && k < 64) v = a.in[I_WUP][k * 512 + c]; else if (kind == 1 && k >= 64 && k < 128) v = a.in[I_AUP][(k - 64) * 512 + c]; else if (kind == 2 && k >= 128) v = a.in[I_GUP][(k - 128) * 512 + c];
          WL[i] = f2bf(v); } }
    { bf16_t* WR = (bf16_t*)(ws + WS_WRG);
      for (int i = gid; i < 1024 * 256; i += NT) { const int n = i >> 8, kk = i & 255, pn = n >> 8, c = n & 255, ch = pn * 128 + (c & 127), hb = ch >> 6, j = ch & 63, k = 256 * (pn >> 1) + kk; float v = 0.f;
          if ((k >> 6) == hb) v = (c < 128 ? a.in[I_WRGA] : a.in[I_WRGX])[(hb * 64 + (k & 63)) * 64 + j];
          WR[i] = f2bf(v); } }
    { const float* x = a.in[I_X]; bf16_t* XB = (bf16_t*)(ws + WS_XB); float* rstd = (float*)(ws + WS_RSTDX);
      for (int r0 = gw; r0 < T; r0 += 4 * NGW) {
          f32x4 v[4][4]; float s[4];
#pragma unroll
          for (int q = 0; q < 4; ++q) { const int r = r0 + q * NGW; s[q] = 0.f; if (r < T) { const f32x4* xr = (const f32x4*)(x + (size_t)r * D) + lane;
#pragma unroll
              for (int j = 0; j < 4; ++j) v[q][j] = xr[64 * j]; } else {
#pragma unroll
              for (int j = 0; j < 4; ++j) v[q][j] = (f32x4){0.f, 0.f, 0.f, 0.f}; } }
#pragma unroll
          for (int q = 0; q < 4; ++q) {
#pragma unroll
              for (int j = 0; j < 4; ++j) s[q] += (v[q][j].x * v[q][j].x + v[q][j].y * v[q][j].y) + (v[q][j].z * v[q][j].z + v[q][j].w * v[q][j].w);
              s[q] = wave_sum(s[q]); }
#pragma unroll
          for (int q = 0; q < 4; ++q) { const int r = r0 + q * NGW; if (r < T) { if (lane == 0) rstd[r] = rsqrtf(s[q] * (1.0f / D) + NORM_EPS);
              u32x2* o = (u32x2*)(XB + (size_t)r * D) + lane;
#pragma unroll
              for (int j = 0; j < 4; ++j) { u32x2 w; w.x = cvt_pk_bf16(v[q][j].x, v[q][j].y); w.y = cvt_pk_bf16(v[q][j].z, v[q][j].w); o[64 * j] = w; } } } } }
    { const float* x = a.in[I_MEM]; bf16_t* XB = (bf16_t*)(ws + WS_MEMN); const float* g = a.in[I_NMEMG];
      for (int r0 = gw; r0 < TM; r0 += 4 * NGW) {
          f32x4 v[4][4]; float sq[4];
#pragma unroll
          for (int q = 0; q < 4; ++q) { const int r = r0 + q * NGW; const f32x4* xr = (const f32x4*)(x + (size_t)(r < TM ? r : r0) * D) + lane;
#pragma unroll
              for (int j = 0; j < 4; ++j) v[q][j] = xr[64 * j]; }
#pragma unroll
          for (int q = 0; q < 4; ++q) { float t = 0.f;
#pragma unroll
              for (int j = 0; j < 4; ++j) t += (v[q][j].x * v[q][j].x + v[q][j].y * v[q][j].y) + (v[q][j].z * v[q][j].z + v[q][j].w * v[q][j].w);
              sq[q] = wave_sum(t); }
#pragma unroll
          for (int q = 0; q < 4; ++q) { const int r = r0 + q * NGW; if (r < TM) { const float rs = rsqrtf(sq[q] * (1.0f / D) + NORM_EPS); u32x2* o = (u32x2*)(XB + (size_t)r * D) + lane;
#pragma unroll
              for (int j = 0; j < 4; ++j) { const f32x4 gg = ((const f32x4*)g)[lane + 64 * j]; u32x2 w; w.x = cvt_pk_bf16(v[q][j].x * rs * gg.x, v[q][j].y * rs * gg.y); w.y = cvt_pk_bf16(v[q][j].z * rs * gg.z, v[q][j].w * rs * gg.w); o[64 * j] = w; } } } } }
}

__device__ __forceinline__ float tanh_fast(float v) { return 1.0f - 2.0f * __builtin_amdgcn_rcpf(__expf(2.0f * v) + 1.0f); }
__device__ __forceinline__ void phase_elem2(const Args& a, int wave, int G) {
    unsigned char* ws = a.ws;
    const bf16_t* PR = (const bf16_t*)(ws + WS_PR); const bf16_t* PX = (const bf16_t*)(ws + WS_PX);
    bf16_t* LIN = (bf16_t*)(ws + WS_LIN); bf16_t* XBC = (bf16_t*)(ws + WS_XBC);
    const size_t gid = (size_t)blockIdx.x * 512 + wave * 64 + lane_id(), NT = (size_t)G * 512;
    {
        const int c = (int)(gid & 31) * 8; float mu[8];
#pragma unroll
        for (int j = 0; j < 8; ++j) mu[j] = a.in[I_MU][1536 + c + j];
        const size_t N = (size_t)T * 32;
        for (size_t i0 = gid; i0 < N; i0 += 4 * NT) {
            u32x4 P[4], Q[4]; bool hp[4], ok[4];
#pragma unroll
            for (int u = 0; u < 4; ++u) { const size_t i = i0 + u * NT; ok[u] = i < N; const int t = (int)((ok[u] ? i : i0) >> 5); hp[u] = (t & (SEQ - 1)) != 0;
                P[u] = *(const u32x4*)(PR + (size_t)t * RW + 1536 + c); Q[u] = *(const u32x4*)(PR + (size_t)(hp[u] ? t - 1 : t) * RW + 1536 + c); }
#pragma unroll
            for (int u = 0; u < 4; ++u) { const size_t i = i0 + u * NT; if (!ok[u]) continue; const int t = (int)(i >> 5);
                float p[8], pp[8], o[8]; unpack8(P[u], p); unpack8(Q[u], pp);
#pragma unroll
                for (int j = 0; j < 8; ++j) { const float q = hp[u] ? pp[j] : 0.f; const float v = p[j] + (q - p[j]) * mu[j]; o[j] = c < 64 ? tanh_fast(v) : (c < 128 ? v : sigmoidf_(v)); }
                *(u32x4*)(LIN + (size_t)t * 256 + c) = pack8(o); }
        }
    }
    {
        const int c = (int)(gid & 63) * 8; float w[4][8], b0[8];
#pragma unroll
        for (int j = 0; j < 8; ++j) { b0[j] = a.in[I_CBB][c + j];
#pragma unroll
            for (int k = 0; k < 4; ++k) w[k][j] = a.in[I_CBW][k * 512 + c + j]; }
        const size_t N = (size_t)T * 64;
        for (size_t i0 = gid; i0 < N; i0 += 4 * NT) {
            u32x4 X[4][4]; bool ok[4]; int tl[4];
#pragma unroll
            for (int u = 0; u < 4; ++u) { const size_t i = i0 + u * NT; ok[u] = i < N; const int t = (int)((ok[u] ? i : i0) >> 6); tl[u] = t & (SEQ - 1);
#pragma unroll
                for (int k = 0; k < 4; ++k) { const int dt = 3 - k; X[u][k] = *(const u32x4*)(PX + (size_t)(tl[u] >= dt ? t - dt : t) * 512 + c); } }
#pragma unroll
            for (int u = 0; u < 4; ++u) { const size_t i = i0 + u * NT; if (!ok[u]) continue; const int t = (int)(i >> 6);
                float o[8];
#pragma unroll
                for (int j = 0; j < 8; ++j) o[j] = b0[j];
#pragma unroll
                for (int k = 0; k < 4; ++k) { float p[8]; unpack8(X[u][k], p); const bool in = tl[u] >= 3 - k;
#pragma unroll
                    for (int j = 0; j < 8; ++j) o[j] += in ? p[j] * w[k][j] : 0.f; }
                *(u32x4*)(XBC + (size_t)t * 512 + c) = pack8(o); }
        }
    }
}

#define DPP_BC(JJ) " row_newbcast:" #JJ " row_mask:0xf bank_mask:0xf"
#define RW_SA(JJ)  asm("v_fmac_f32_dpp %0, %1, %2" DPP_BC(JJ) : "+v"(sacc[JJ & 3]) : "v"(va), "v"(S[JJ]));
#define RW_SA0(JJ) asm("v_mul_f32_dpp %0, %1, %2" DPP_BC(JJ) : "=v"(sacc[JJ & 3]) : "v"(va), "v"(S[JJ]));
#define RW_T1(JJ) { asm("v_mul_f32_dpp %0, %1, %2" DPP_BC(JJ) : "=v"(Tn[JJ]) : "v"(vw), "v"(S[JJ])); \
    asm("v_fmac_f32_dpp %0, %1, %2" DPP_BC(JJ) : "+v"(Tn[JJ]) : "v"(vk), "v"(vv)); }
#define RW_T2(JJ) { asm("v_fmac_f32_dpp %0, %1, %2" DPP_BC(JJ) : "+v"(Tn[JJ]) : "v"(vb), "v"(sa)); \
    S[JJ] = Tn[JJ]; \
    asm("v_fmac_f32_dpp %0, %1, %2" DPP_BC(JJ) : "+v"(yacc[JJ & 3]) : "v"(vr), "v"(S[JJ])); }
#define RW_T2a(JJ) { asm("v_fmac_f32_dpp %0, %1, %2" DPP_BC(JJ) : "+v"(Tn[JJ]) : "v"(vb), "v"(sa)); \
    S[JJ] = Tn[JJ]; \
    asm("v_mul_f32_dpp %0, %1, %2" DPP_BC(JJ) : "=v"(yacc[JJ & 3]) : "v"(vr), "v"(S[JJ])); }
#define RW_ALL16(M) M(0) M(1) M(2) M(3) M(4) M(5) M(6) M(7) M(8) M(9) M(10) M(11) M(12) M(13) M(14) M(15)

constexpr int RB = 32;
constexpr int PSTEP = 6 * 64;
constexpr int PBUF = RB * PSTEP * 4;

__device__ __forceinline__ float dpp_ror_add(float v, const int ctrl_sel) {
    int t;
    switch (ctrl_sel) {
        case 8: t = __builtin_amdgcn_update_dpp(0, __float_as_int(v), 0x128, 0xf, 0xf, false); break;
        case 4: t = __builtin_amdgcn_update_dpp(0, __float_as_int(v), 0x124, 0xf, 0xf, false); break;
        case 2: t = __builtin_amdgcn_update_dpp(0, __float_as_int(v), 0x122, 0xf, 0xf, false); break;
        default: t = __builtin_amdgcn_update_dpp(0, __float_as_int(v), 0x121, 0xf, 0xf, false); break;
    }
    return v + __int_as_float(t);
}
__device__ __forceinline__ float cross_row_allsum(float v) {
    auto r = __builtin_amdgcn_permlane32_swap(__float_as_uint(v), __float_as_uint(v), false, false);
    v = __uint_as_float(r[0]) + __uint_as_float(r[1]);
    auto r2 = __builtin_amdgcn_permlane16_swap(__float_as_uint(v), __float_as_uint(v), false, false);
    return __uint_as_float(r2[0]) + __uint_as_float(r2[1]);
}
__device__ __forceinline__ float wave_allsum(float v) {
    v = dpp_ror_add(v, 8); v = dpp_ror_add(v, 4); v = dpp_ror_add(v, 2); v = dpp_ror_add(v, 1);
    return cross_row_allsum(v);
}
__device__ __forceinline__ void lds_barrier() { asm volatile("s_waitcnt lgkmcnt(0)" ::: "memory"); __builtin_amdgcn_s_barrier(); asm volatile("" ::: "memory"); }

constexpr int NPS = RB / 4;
__device__ __forceinline__ void prod_load(const Args& a, bf16_t (&raw)[NPS][8], int tok0, int h, int p, int lane) {
    const bf16_t* PR = (const bf16_t*)(a.ws + WS_PR); const bf16_t* LOUT = (const bf16_t*)(a.ws + WS_LOUT);
#pragma unroll
    for (int i = 0; i < NPS; ++i) { const int tok = tok0 + p + 4 * i; const bool has_prev = (tok & (SEQ - 1)) != 0;
        const bf16_t* prow = PR + (size_t)tok * RW + h * 64 + lane; const bf16_t* qrow = has_prev ? prow - RW : prow; const bf16_t* lrow = LOUT + (size_t)tok * 1536 + h * 64 + lane;
        raw[i][0] = prow[0]; raw[i][1] = prow[512]; raw[i][2] = prow[1024]; raw[i][3] = qrow[0]; raw[i][4] = qrow[512]; raw[i][5] = qrow[1024]; raw[i][6] = lrow[0]; raw[i][7] = lrow[512]; }
}
__device__ __forceinline__ void prod_compute(const Args& a, const bf16_t (&raw)[NPS][8], LAS float* pb, int tok0, int h, int p, int lane, float mu_r, float mu_k, float mu_v, float ckk, float cka, float crk) {
    float* BON = (float*)(a.ws + WS_BON);
#pragma unroll
    for (int i = 0; i < NPS; ++i) { const int s = p + 4 * i, tok = tok0 + s; const bool has_prev = (tok & (SEQ - 1)) != 0;
        const float rr = bf1(raw[i][0]), kr = bf1(raw[i][1]), vr_ = bf1(raw[i][2]);
        const float rp = has_prev ? bf1(raw[i][3]) : 0.f, kp = has_prev ? bf1(raw[i][4]) : 0.f, vp = has_prev ? bf1(raw[i][5]) : 0.f;
        const float e = bf1(raw[i][6]), av = bf1(raw[i][7]);
        const float r = rr + (rp - rr) * mu_r, k0 = kr + (kp - kr) * mu_k, v = vr_ + (vp - vr_) * mu_v;
        const float w = __expf(-e);
        const float kk = k0 * ckk; const float n2 = wave_allsum(kk * kk); const float kkn = kk * rsqrtf(fmaxf(n2, 1e-24f));
        const float k2 = k0 * (1.0f + (av - 1.0f) * cka);
        const float bon = wave_allsum(r * k2 * crk);
        LAS float* pp = pb + s * PSTEP;
        pp[lane] = -kkn; pp[64 + lane] = kkn * av; pp[128 + lane] = k2; pp[192 + lane] = w; pp[256 + lane] = r; pp[320 + lane] = v;
        if (lane == 0) BON[(size_t)tok * 8 + h] = bon; }
}

__device__ __forceinline__ void phase_scan(const Args& a, LAS unsigned char* lds, int wave, int G) {
    const int lane = lane_id();
    unsigned char* ws = a.ws;
    constexpr int SB = 16, NBLK = SEQ / RB;
    for (int pair = blockIdx.x; pair < 256; pair += G) {
        const int b = pair >> 3, h = pair & 7, tokb = b * SEQ;
        if (wave < 4) {
            const int il = lane & 15, irow = 16 * wave + il;
            float S[16];
#pragma unroll
            for (int j = 0; j < 16; ++j) S[j] = 0.f;
            bf16_t* YRAW = (bf16_t*)(ws + WS_YRAW);
            lds_barrier();
            for (int blk = 0; blk < NBLK; ++blk) {
                const LAS float* pb = (const LAS float*)(lds + (blk & 1) * PBUF);
#pragma unroll 2
                for (int s = 0; s < RB; ++s) {
                    const LAS float* pp = pb + s * PSTEP;
                    float va = pp[lane], vb = pp[64 + lane], vk = pp[128 + lane], vw = pp[192 + lane], vr = pp[256 + lane]; const float vv = pp[320 + irow];
                    asm volatile("s_nop 1" : "+v"(va), "+v"(vb), "+v"(vk), "+v"(vw), "+v"(vr));
                    float sacc[4], yacc[4];
                    RW_SA0(0) RW_SA0(1) RW_SA0(2) RW_SA0(3) RW_SA(4) RW_SA(5) RW_SA(6) RW_SA(7) RW_SA(8) RW_SA(9) RW_SA(10) RW_SA(11) RW_SA(12) RW_SA(13) RW_SA(14) RW_SA(15)
                    float sa = (sacc[0] + sacc[1]) + (sacc[2] + sacc[3]);
                    float Tn[16];
                    RW_ALL16(RW_T1)
                    sa = cross_row_allsum(sa);
                    RW_T2a(0) RW_T2a(1) RW_T2a(2) RW_T2a(3) RW_T2(4) RW_T2(5) RW_T2(6) RW_T2(7) RW_T2(8) RW_T2(9) RW_T2(10) RW_T2(11) RW_T2(12) RW_T2(13) RW_T2(14) RW_T2(15)
                    float y = (yacc[0] + yacc[1]) + (yacc[2] + yacc[3]);
                    y = cross_row_allsum(y);
                    const int tok = tokb + blk * RB + s;
                    YRAW[(size_t)tok * 512 + h * 64 + irow] = f2bf(y);
                }
                lds_barrier();
            }
        } else {
            const float mu_r = a.in[I_MU][h * 64 + lane], mu_k = a.in[I_MU][512 + h * 64 + lane], mu_v = a.in[I_MU][1024 + h * 64 + lane];
            const float ckk = a.in[I_KK][h * 64 + lane], cka = a.in[I_KA][h * 64 + lane], crk = a.in[I_RK][h * 64 + lane];
            const size_t base = (size_t)tokb * 512 + h * 64 + lane;
            const bf16_t* LA = (const bf16_t*)(ws + WS_RGLA) + base; const bf16_t* U = (const bf16_t*)(ws + WS_RGU) + base; const bf16_t* PY = (const bf16_t*)(ws + WS_PY) + base;
            bf16_t* YB = (bf16_t*)(ws + WS_YB) + base;
            bf16_t cla[SB], cu[SB], cpy[SB]; float hh = 0.f;
#pragma unroll
            for (int s = 0; s < SB; ++s) { cla[s] = 0; cu[s] = 0; cpy[s] = 0; }
            if (wave == 4) {
#pragma unroll
                for (int s = 0; s < SB; ++s) { cla[s] = LA[(size_t)s * 512]; cu[s] = U[(size_t)s * 512]; cpy[s] = PY[(size_t)s * 512]; }
            }
            bf16_t raw[NPS][8];
            prod_load(a, raw, tokb, h, wave - 4, lane); prod_compute(a, raw, (LAS float*)lds, tokb, h, wave - 4, lane, mu_r, mu_k, mu_v, ckk, cka, crk); prod_load(a, raw, tokb + RB, h, wave - 4, lane);
            lds_barrier();
            for (int blk = 0; blk < NBLK; ++blk) {
                if (blk + 1 < NBLK) { prod_compute(a, raw, (LAS float*)(lds + ((blk + 1) & 1) * PBUF), tokb + (blk + 1) * RB, h, wave - 4, lane, mu_r, mu_k, mu_v, ckk, cka, crk);
                    if (blk + 2 < NBLK) prod_load(a, raw, tokb + (blk + 2) * RB, h, wave - 4, lane); }
                if (wave == 4) {
                    for (int sub = 0; sub < RB / SB; ++sub) {
                        const int t0 = blk * RB + sub * SB, tn = (t0 + SB < SEQ) ? t0 + SB : t0;
                        bf16_t nla[SB], nu[SB], npy[SB];
#pragma unroll
                        for (int s = 0; s < SB; ++s) { nla[s] = LA[(size_t)(tn + s) * 512]; nu[s] = U[(size_t)(tn + s) * 512]; npy[s] = PY[(size_t)(tn + s) * 512]; }
#pragma unroll
                        for (int s = 0; s < SB; ++s) { hh = __expf(bf1(cla[s])) * hh + bf1(cu[s]); YB[(size_t)(t0 + s) * 512] = f2bf(hh * gelu_tanh(bf1(cpy[s]))); }
#pragma unroll
                        for (int s = 0; s < SB; ++s) { cla[s] = nla[s]; cu[s] = nu[s]; cpy[s] = npy[s]; }
                    }
                }
                lds_barrier();
            }
        }
    }
    asm volatile("s_waitcnt vmcnt(0)" ::: "memory");
}

__device__ __forceinline__ void phase_post(const Args& a, int wave, int G) {
    unsigned char* ws = a.ws;
    const bf16_t* PR = (const bf16_t*)(ws + WS_PR); const bf16_t* LOUT = (const bf16_t*)(ws + WS_LOUT); const bf16_t* YRAW = (const bf16_t*)(ws + WS_YRAW);
    const float* BON = (const float*)(ws + WS_BON); bf16_t* YA = (bf16_t*)(ws + WS_YA);
    const size_t gid = (size_t)blockIdx.x * 512 + wave * 64 + lane_id(), NT = (size_t)G * 512;
    const int c = (int)(gid & 63) * 8, h = c >> 6; float mu[8], lg[8], lb[8];
#pragma unroll
    for (int j = 0; j < 8; ++j) { mu[j] = a.in[I_MU][1024 + c + j]; lg[j] = a.in[I_LNXG][c + j]; lb[j] = a.in[I_LNXB][c + j]; }
    const size_t N = (size_t)T * 64;
    for (size_t i0 = gid; i0 < N; i0 += 4 * NT) {
        u32x4 Y[4], V[4], VP[4], GG[4]; float bn[4]; bool ok[4], hp[4];
#pragma unroll
        for (int u = 0; u < 4; ++u) { const size_t i = i0 + u * NT; ok[u] = i < N; const int t = (int)((ok[u] ? i : i0) >> 6); hp[u] = (t & (SEQ - 1)) != 0;
            Y[u] = *(const u32x4*)(YRAW + (size_t)t * 512 + c); V[u] = *(const u32x4*)(PR + (size_t)t * RW + 1024 + c); VP[u] = *(const u32x4*)(PR + (size_t)(hp[u] ? t - 1 : t) * RW + 1024 + c);
            GG[u] = *(const u32x4*)(LOUT + (size_t)t * 1536 + 1024 + c); bn[u] = BON[(size_t)t * 8 + h]; }
#pragma unroll
        for (int u = 0; u < 4; ++u) { const size_t i = i0 + u * NT; const int t = (int)((ok[u] ? i : i0) >> 6);
            float y[8], v[8], vp[8], g[8], o[8]; unpack8(Y[u], y); unpack8(V[u], v); unpack8(VP[u], vp); unpack8(GG[u], g);
            float s = 0.f;
#pragma unroll
            for (int j = 0; j < 8; ++j) s += y[j];
            s += __shfl_xor(s, 1); s += __shfl_xor(s, 2); s += __shfl_xor(s, 4);
            const float mean = s * (1.0f / 64.0f); float q = 0.f;
#pragma unroll
            for (int j = 0; j < 8; ++j) { const float d = y[j] - mean; q += d * d; }
            q += __shfl_xor(q, 1); q += __shfl_xor(q, 2); q += __shfl_xor(q, 4);
            const float rs = rsqrtf(q * (1.0f / 64.0f) + LNX_EPS);
#pragma unroll
            for (int j = 0; j < 8; ++j) { const float pv = hp[u] ? vp[j] : 0.f; const float vv = v[j] + (pv - v[j]) * mu[j];
                o[j] = ((y[j] - mean) * rs * lg[j] + lb[j] + bn[u] * vv) * g[j]; }
            if (ok[u]) *(u32x4*)(YA + (size_t)t * 512 + c) = pack8(o); }
    }
}

__device__ __forceinline__ void phase_ffnfix(const Args& a, int wave, int G) {
    unsigned char* ws = a.ws;
    const bf16_t* HG = (const bf16_t*)(ws + WS_HG); bf16_t* ACT = (bf16_t*)(ws + WS_UU);
    const float* cw = a.in[I_FCW]; const float* cb = a.in[I_FCB];
    const size_t gid = (size_t)blockIdx.x * 512 + wave * 64 + lane_id(), NT = (size_t)G * 512;
    constexpr int CPR = DFF / 8; const size_t N = (size_t)(T / 64) * 2 * CPR;
    for (size_t i0 = gid; i0 < N; i0 += 2 * NT) {
        u32x4 P2[2], P1[2], CU[2], UP[2]; f32x4 W[2][8]; bool ok[2], first[2]; int cc[2], tt[2], rr[2];
#pragma unroll
        for (int u = 0; u < 2; ++u) { const size_t i = i0 + u * NT; ok[u] = i < N; const size_t ii = ok[u] ? i : i0;
            const int c = (int)(ii % CPR) * 8, rho = (int)((ii / CPR) & 1), grp = (int)(ii / (2 * CPR)); first[u] = (grp & 31) == 0; cc[u] = c; rr[u] = rho; tt[u] = grp * 64 + rho;
            const int gp = first[u] ? grp : grp - 1;
            P2[u] = *(const u32x4*)(HG + ((size_t)gp * 4 + rho) * DFF + c);
            P1[u] = *(const u32x4*)(HG + (rho == 0 ? ((size_t)gp * 4 + 1) : ((size_t)grp * 4 + 2)) * DFF + c);
            CU[u] = *(const u32x4*)(HG + ((size_t)grp * 4 + 2 + rho) * DFF + c);
            UP[u] = *(const u32x4*)(ACT + (size_t)tt[u] * DFF + c);
#pragma unroll
            for (int k = 0; k < 3; ++k) { W[u][2 * k] = *(const f32x4*)(cw + k * DFF + c); W[u][2 * k + 1] = *(const f32x4*)(cw + k * DFF + c + 4); }
            W[u][6] = *(const f32x4*)(cb + c); W[u][7] = *(const f32x4*)(cb + c + 4); }
#pragma unroll
        for (int u = 0; u < 2; ++u) { if (!ok[u]) continue;
            float p2[8], p1[8], cur[8], up[8], o[8]; unpack8(P2[u], p2); unpack8(P1[u], p1); unpack8(CU[u], cur); unpack8(UP[u], up);
            const bool z2 = first[u], z1 = first[u] && rr[u] == 0;
#pragma unroll
            for (int j = 0; j < 8; ++j) { const float a2 = z2 ? 0.f : p2[j], a1 = z1 ? 0.f : p1[j];
                o[j] = gelu_tanh(W[u][6 + (j >> 2)][j & 3] + W[u][0 + (j >> 2)][j & 3] * a2 + W[u][2 + (j >> 2)][j & 3] * a1 + W[u][4 + (j >> 2)][j & 3] * cur[j]) * up[j]; }
            *(u32x4*)(ACT + (size_t)tt[u] * DFF + cc[u]) = pack8(o); }
    }
}

__device__ __forceinline__ void phase_final(const Args& a, int wave, int G) {
    const int lane = lane_id();
    const float* ssp = (const float*)(a.ws + WS_SSP3); const float* g = a.in[I_NFING]; const bf16_t* X3 = (const bf16_t*)(a.ws + WS_X3B);
    const int gw = blockIdx.x * 8 + wave, NGW = G * 8;
    for (int r0 = gw; r0 < T; r0 += 4 * NGW) {
        u32x4 v[4][2]; float rs[4];
#pragma unroll
        for (int q = 0; q < 4; ++q) { const int r = r0 + q * NGW; if (r < T) { rs[q] = rstd_from16(ssp, r); const u32x4* xr = (const u32x4*)(X3 + (size_t)r * D) + lane; v[q][0] = xr[0]; v[q][1] = xr[64]; } }
#pragma unroll
        for (int q = 0; q < 4; ++q) { const int r = r0 + q * NGW; if (r < T) {
#pragma unroll
            for (int j = 0; j < 2; ++j) { float x[8]; unpack8(v[q][j], x); const int c = 512 * j + 8 * lane; const f32x4 g0 = *(const f32x4*)(g + c), g1 = *(const f32x4*)(g + c + 4);
                f32x4* o = (f32x4*)(a.out + (size_t)r * D + c);
                o[0] = (f32x4){x[0] * rs[q] * g0[0], x[1] * rs[q] * g0[1], x[2] * rs[q] * g0[2], x[3] * rs[q] * g0[3]};
                o[1] = (f32x4){x[4] * rs[q] * g1[0], x[5] * rs[q] * g1[1], x[6] * rs[q] * g1[2], x[7] * rs[q] * g1[3]}; } } }
    }
}

constexpr int NPHASE = 13;
__global__ void __launch_bounds__(512, 2) mega(Args a) {
    extern __shared__ __attribute__((aligned(16))) unsigned char lds_raw[];
    LAS unsigned char* lds = (LAS unsigned char*)lds_raw;
    cg::grid_group grid = cg::this_grid();
    const int wave = __builtin_amdgcn_readfirstlane((int)threadIdx.x >> 6), G = gridDim.x, bid = blockIdx.x;
    unsigned char* ws = a.ws;
    const int lo = a.ph_lo, hi = a.ph_hi;
    const bool t0 = (wave == 0) && (lane_id() == 0);
    volatile LAS unsigned* misc = (volatile LAS unsigned*)(lds + 131072 + 320);
    if (t0) { misc[0] = 0u; misc[1] = 0u; }
    __syncthreads();
    XcdBarrier xb = xcd_barrier_post((unsigned*)(ws + WS_CTL), misc, t0);
    if (a.ph_hi < 0) grid.sync();
#define IN(k) (lo <= (k) && (k) < hi)
#define SEAM(k) do { if (IN(k) && IN((k) + 1)) xcd_barrier(xb, t0); } while (0)
    bf16_t* const XB = (bf16_t*)(ws + WS_XB);
    const float* rstdx = (const float*)(ws + WS_RSTDX);
    StaticOrder S;

    if (IN(0)) for (int rep_ = 0; rep_ < REPS(0); ++rep_) { phase_prep(a, lds, wave, G); __syncthreads(); } SEAM(0);

    if (IN(1)) for (int rep_ = 0; rep_ < REPS(1); ++rep_) {
        { Gemm g = plain_gemm(XB, (const bf16_t*)(ws + WS_WIN), 1024); S.init(T / BM, 11, G, bid);
          EpiProj E{rstdx, a.in[I_BIN], (bf16_t*)(ws + WS_PR), (bf16_t*)(ws + WS_PX), (bf16_t*)(ws + WS_PY)}; gemm_phase(lds, wave, g, S, E); }
        if ((G & 15) == 0) {
            const int hg = G >> 1, hb_ = (bid >> 4) * 8 + (bid & 7);
            if (((bid >> 3) & 1) == 0) { Gemm g = plain_gemm((const bf16_t*)(ws + WS_MEMN), (const bf16_t*)(ws + WS_WK), 1024); S.init(TM / BM, 4, hg, hb_);
                EpiPlain E{(bf16_t*)(ws + WS_KM), 1024}; gemm_phase(lds, wave, g, S, E); }
            else { Gemm g = plain_gemm((const bf16_t*)(ws + WS_WV), (const bf16_t*)(ws + WS_MEMN), 1024); S.init(4, TM / BM, hg, hb_);
                EpiPlain E{(bf16_t*)(ws + WS_VT), TM}; gemm_phase(lds, wave, g, S, E); }
        } else {
            { Gemm g = plain_gemm((const bf16_t*)(ws + WS_MEMN), (const bf16_t*)(ws + WS_WK), 1024); S.init(TM / BM, 4, G, bid);
              EpiPlain E{(bf16_t*)(ws + WS_KM), 1024}; gemm_phase(lds, wave, g, S, E); }
            { Gemm g = plain_gemm((const bf16_t*)(ws + WS_WV), (const bf16_t*)(ws + WS_MEMN), 1024); S.init(4, TM / BM, G, bid);
              EpiPlain E{(bf16_t*)(ws + WS_VT), TM}; gemm_phase(lds, wave, g, S, E); }
        }
    } SEAM(1);

    if (IN(2)) for (int rep_ = 0; rep_ < REPS(2); ++rep_) phase_elem2(a, wave, G); SEAM(2);
#ifdef PROBE_SYNC
    for (int i_ = 0; i_ < 16; ++i_) grid.sync();
#endif

    if (IN(3)) for (int rep_ = 0; rep_ < REPS(3); ++rep_) {
        { Gemm g = plain_gemm((const bf16_t*)(ws + WS_LIN), (const bf16_t*)(ws + WS_WLORA), 256); S.init(T / BM, 6, G, bid);
          EpiLora E{a.in[I_W0], a.in[I_A0], (bf16_t*)(ws + WS_LOUT)}; gemm_phase(lds, wave, g, S, E); }
        { Gemm g = plain_gemm((const bf16_t*)(ws + WS_XBC), (const bf16_t*)(ws + WS_WRG), 256); g.lda = 512; g.a_pm = (size_t)BM * 512 * 2; g.a_pn2 = 512; S.init(T / BM, 4, G, bid);
          EpiRg E{a.in[I_BRGA], a.in[I_BRGX], a.in[I_LAM], (const bf16_t*)(ws + WS_XBC), (bf16_t*)(ws + WS_RGLA), (bf16_t*)(ws + WS_RGU)}; gemm_phase(lds, wave, g, S, E); }
    } SEAM(3);

    if (IN(4)) for (int rep_ = 0; rep_ < REPS(4); ++rep_) phase_scan(a, lds, wave, G); SEAM(4);
    if (IN(5)) for (int rep_ = 0; rep_ < REPS(5); ++rep_) phase_post(a, wave, G); SEAM(5);

    if (IN(6)) for (int rep_ = 0; rep_ < REPS(6); ++rep_) {
        S.init(T / BM, 4, G, bid);
        { Gemm g = plain_gemm(XB, (const bf16_t*)(ws + WS_WIN) + (size_t)2816 * 1024, 1024); EpiGab E{rstdx, a.in[I_BIN] + 2816, (bf16_t*)(ws + WS_GAB), 0}; gemm_phase(lds, wave, g, S, E); }
        { Gemm g = plain_gemm((const bf16_t*)(ws + WS_YA), (const bf16_t*)(ws + WS_WA), 512); EpiBranch<true> E{(const bf16_t*)(ws + WS_GAB), (bf16_t*)(ws + WS_MERGED)}; gemm_phase(lds, wave, g, S, E); }
        { Gemm g = plain_gemm(XB, (const bf16_t*)(ws + WS_WIN) + (size_t)3840 * 1024, 1024); EpiGab E{rstdx, a.in[I_BIN] + 2816, (bf16_t*)(ws + WS_GAB), 1024}; gemm_phase(lds, wave, g, S, E); }
        { Gemm g = plain_gemm((const bf16_t*)(ws + WS_YB), (const bf16_t*)(ws + WS_WB), 512); EpiBranch<false> E{(const bf16_t*)(ws + WS_GAB), (bf16_t*)(ws + WS_MERGED)}; gemm_phase(lds, wave, g, S, E); }
    } SEAM(6);
    if (IN(7)) for (int rep_ = 0; rep_ < REPS(7); ++rep_) { Gemm g = plain_gemm((const bf16_t*)(ws + WS_MERGED), (const bf16_t*)(ws + WS_WMIX), 1024); S.init(T / BM, 4, G, bid);
        EpiRes<true> E{a.in[I_X], (bf16_t*)(ws + WS_X1B), (float*)(ws + WS_SSP1)}; gemm_phase(lds, wave, g, S, E); } SEAM(7);
    if (IN(8)) for (int rep_ = 0; rep_ < REPS(8); ++rep_) {
        S.init(T / BM, 4, G, bid);
        { Gemm g = plain_gemm((const bf16_t*)(ws + WS_X1B), (const bf16_t*)(ws + WS_WCQ), 1024);
          EpiQ E{(const float*)(ws + WS_SSP1), (bf16_t*)(ws + WS_Q)}; gemm_phase(lds, wave, g, S, E); }
        { Gemm g; g.A = (const bf16_t*)(ws + WS_Q); g.Bt = (const bf16_t*)(ws + WS_KM); g.lda = 1024; g.ldb = 1024; g.K = 256;
          g.a_pm = (size_t)BM * 1024 * 2; g.a_pn = 512; g.b_pn = 512; g.b_pb = (size_t)NMEM * 1024 * 2; g.a_pn2 = 0;
          EpiSc E{(bf16_t*)(ws + WS_PEXP), (float*)(ws + WS_SSPA)}; gemm_phase(lds, wave, g, S, E); }
        { Gemm g; g.A = (const bf16_t*)(ws + WS_PEXP); g.Bt = (const bf16_t*)(ws + WS_VT); g.lda = 1024; g.ldb = TM; g.K = 256;
          g.a_pm = (size_t)BM * 1024 * 2; g.a_pn = 512; g.b_pn = (size_t)256 * TM * 2; g.b_pb = 512; g.a_pn2 = 0;
          EpiPv E{(const float*)(ws + WS_SSPA), (bf16_t*)(ws + WS_O)}; gemm_phase(lds, wave, g, S, E); }
    } SEAM(8);
    if (IN(9)) for (int rep_ = 0; rep_ < REPS(9); ++rep_) { Gemm g = plain_gemm((const bf16_t*)(ws + WS_O), (const bf16_t*)(ws + WS_WCO), 1024); S.init(T / BM, 4, G, bid);
        EpiRes<false> E{(const bf16_t*)(ws + WS_X1B), (bf16_t*)(ws + WS_X2B), (float*)(ws + WS_SSP2)}; gemm_phase(lds, wave, g, S, E); } SEAM(9);
    if (IN(10)) for (int rep_ = 0; rep_ < REPS(10); ++rep_) { Gemm g = plain_gemm((const bf16_t*)(ws + WS_X2B), (const bf16_t*)(ws + WS_WFFI), 1024); S.init(T / BM, 22, G, bid);
        EpiFfnAct E{(const float*)(ws + WS_SSP2), a.in[I_FCW], a.in[I_FCB], (bf16_t*)(ws + WS_UU), (bf16_t*)(ws + WS_HG)}; gemm_phase(lds, wave, g, S, E); } SEAM(10);
    if (IN(11)) for (int rep_ = 0; rep_ < REPS(11); ++rep_) phase_ffnfix(a, wave, G); SEAM(11);
    if (IN(12)) for (int rep_ = 0; rep_ < REPS(12); ++rep_) { Gemm g = plain_gemm((const bf16_t*)(ws + WS_UU), (const bf16_t*)(ws + WS_WFFO), DFF); S.init(T / BM, 4, G, bid);
        EpiRes<false> E{(const bf16_t*)(ws + WS_X2B), (bf16_t*)(ws + WS_X3B), (float*)(ws + WS_SSP3)}; gemm_phase(lds, wave, g, S, E); } SEAM(12);
    if (IN(13)) for (int rep_ = 0; rep_ < REPS(13); ++rep_) phase_final(a, wave, G);
#undef IN
#undef SEAM
}

extern "C" void kernel_launch(void* const* d_in, const int* in_sizes, int n_in, void* d_out, int out_size, void* d_ws, size_t ws_size, hipStream_t stream) {
    static int grid = 0;
    if (grid == 0) {
        if (n_in != 37 || in_sizes[0] != T * D || out_size != T * D || ws_size < WS_END) {
            fprintf(stderr, "kernel_launch: unexpected shapes (n_in %d, in0 %d, out %d, ws %zu < %zu); nothing launched\n", n_in, n_in > 0 ? in_sizes[0] : -1, out_size, ws_size, (size_t)WS_END); grid = -1; return; }
        int dev = 0, cus = 0, per_cu = 0;
        if (hipGetDevice(&dev) != hipSuccess || hipDeviceGetAttribute(&cus, hipDeviceAttributeMultiprocessorCount, dev) != hipSuccess) { grid = -1; return; }
        if (hipFuncSetAttribute((const void*)mega, hipFuncAttributeMaxDynamicSharedMemorySize, LDS_BYTES) != hipSuccess) { fprintf(stderr, "kernel_launch: hipFuncSetAttribute failed\n"); grid = -1; return; }
        if (hipOccupancyMaxActiveBlocksPerMultiprocessor(&per_cu, (const void*)mega, 512, LDS_BYTES) != hipSuccess || per_cu < 1) { fprintf(stderr, "kernel_launch: occupancy query says %d\n", per_cu); per_cu = 1; }
        (void)hipGetLastError();
        grid = cus * 1;
    }
    if (grid < 0) return;
    if (hipMemsetAsync((char*)d_ws + WS_CTL, 0, CTL_BYTES, stream) != hipSuccess) { fprintf(stderr, "kernel_launch: memset failed\n"); return; }
    Args a{};
    for (int i = 0; i < 37; ++i) a.in[i] = (const float*)d_in[i];
    a.out = (float*)d_out; a.ws = (unsigned char*)d_ws;
#if MK_SPLIT
    for (int ph = 0; ph <= NPHASE; ++ph) {
        a.ph_lo = ph; a.ph_hi = ph + 1; void* args[] = {&a};
        hipError_t e = hipLaunchCooperativeKernel((const void*)mega, dim3(grid), dim3(512), args, LDS_BYTES, stream);
        if (e != hipSuccess) { fprintf(stderr, "kernel_launch: launch of phase %d failed: %s\n", ph, hipGetErrorString(e)); break; }
    }
#else
    a.ph_lo = 0; a.ph_hi = NPHASE + 1; void* args[] = {&a};
    hipError_t e = hipLaunchCooperativeKernel((const void*)mega, dim3(grid), dim3(512), args, LDS_BYTES, stream);
    if (e != hipSuccess) fprintf(stderr, "kernel_launch: cooperative launch failed: %s (grid %d)\n", hipGetErrorString(e), grid);
#endif
}
```
